# Optimizing an MI355X kernel written in HIP

```python
import math
import jax, jax.numpy as jnp
from jax import lax
import numpy as np

D_MODEL = 1024
BATCH = 4
SEQ = 8192
DEPTH = 2

GRID_W = 64
CTX_LEN = 256
HEAD_DIM = 64
N_GROUPS = 4
GROUP_HEADS = D_MODEL // HEAD_DIM // N_GROUPS
GROUP_W = GROUP_HEADS * HEAD_DIM
N_KV = 2
KV_W = N_KV * HEAD_DIM
WINDOW = 128
BLOCK = 128
RET_CHUNK = 128
D_FF = ((8 * D_MODEL // 3 + 255) // 256) * 256
W_RANK = 64
A_RANK = 64
G_RANK = 128
ROPE_BASE = 10000.0
RMS_EPS = 1e-6
GN_EPS = 64e-5
DECAY_SCALE = 0.6065306597126334
N_MOD = 9
PROJ_SIZES = (GROUP_W, KV_W, KV_W,
              GROUP_W, KV_W, KV_W,
              GROUP_W, GROUP_W, GROUP_W, GROUP_W, GROUP_W,
              3 * GROUP_W, G_RANK, W_RANK, W_RANK, A_RANK, A_RANK)
PROJ_COLS = sum(PROJ_SIZES)
RWKV_MIX = 3 * GROUP_W + W_RANK + A_RANK

kernel_name = 'hybrid_parallel_group_flow_block'


def rms_norm(x, g):
    xf = x.astype(jnp.float32)
    y = xf * lax.rsqrt(jnp.mean(xf * xf, -1, keepdims=True) + RMS_EPS)
    return (y * g.astype(jnp.float32)).astype(x.dtype)


def head_norm(y, g, b=None):
    yf = y.astype(jnp.float32)
    mu = jnp.mean(yf, -1, keepdims=True)
    yn = (yf - mu) * lax.rsqrt(jnp.mean(jnp.square(yf - mu), -1, keepdims=True) + GN_EPS)
    yn = yn.reshape(y.shape[:-2] + (y.shape[-2] * y.shape[-1],)) * g
    return yn if b is None else yn + b


def modulate(h, shift, scale):
    return h * (1.0 + scale) + shift


def swiglu(h, w_in, w_out):
    u = h @ w_in
    return (jax.nn.silu(u[..., :D_FF]) * u[..., D_FF:]) @ w_out


def heads(t):
    return t.reshape(t.shape[:-1] + (t.shape[-1] // HEAD_DIM, HEAD_DIM))


def flip(t):
    return jnp.flip(t, axis=1)


def split_cols(p):
    out, o = [], 0
    for s in PROJ_SIZES:
        out.append(p[..., o:o + s])
        o += s
    return out


def rope_cos_sin(pos, dim):
    inv = 1.0 / (ROPE_BASE ** (jnp.arange(0, dim, 2, dtype=jnp.float32) / dim))
    ang = pos.astype(jnp.float32)[:, None] * inv[None, :]
    return jnp.cos(ang), jnp.sin(ang)


def apply_rope(x, cos, sin):
    half = x.shape[-1] // 2
    xf = x.astype(jnp.float32)
    x1, x2 = xf[..., :half], xf[..., half:]
    c, s = cos[None, :, None, :], sin[None, :, None, :]
    return jnp.concatenate([x1 * c - x2 * s, x2 * c + x1 * s], -1).astype(x.dtype)


def apply_axial_rope(x, rope_row, rope_col):
    half = x.shape[-1] // 2
    return jnp.concatenate([apply_rope(x[..., :half], *rope_row), apply_rope(x[..., half:], *rope_col)], -1)


def dense_attn(q, k, v, sink=None):
    b_, tq, h, hd = q.shape
    g = h // N_KV
    qg = q.reshape(b_, tq, N_KV, g, hd)
    s = jnp.einsum('bqkgd,bskd->bkgqs', qg, k).astype(jnp.float32) * hd ** -0.5
    if sink is not None:
        sk = jnp.broadcast_to(sink.reshape(N_KV, g)[None, :, :, None, None].astype(jnp.float32), s.shape[:-1] + (1,))
        s = jnp.concatenate([s, sk], -1)
    p = jax.nn.softmax(s, axis=-1)[..., :k.shape[1]]
    o = jnp.einsum('bkgqs,bskd->bqkgd', p.astype(v.dtype), v)
    return o.reshape(b_, tq, h * hd)


def window_attn_latent(q, k, v, kc, vc, sink):
    b_, n, h, hd = q.shape
    nb = n // BLOCK
    g = h // N_KV
    qb = q.reshape(b_, nb, BLOCK, N_KV, g, hd)

    def band(t):
        tp = jnp.pad(t, ((0, 0), (BLOCK, BLOCK), (0, 0), (0, 0))).reshape(b_, nb + 2, BLOCK, N_KV, hd)
        return jnp.concatenate([tp[:, :-2], tp[:, 1:-1], tp[:, 2:]], axis=2)

    kw, vw = band(k), band(v)
    scale = hd ** -0.5
    s_win = jnp.einsum('bnqkgd,bnskd->bnkgqs', qb, kw).astype(jnp.float32) * scale
    s_ctx = jnp.einsum('bnqkgd,bskd->bnkgqs', qb, kc).astype(jnp.float32) * scale
    qpos = jnp.arange(nb)[:, None, None] * BLOCK + jnp.arange(BLOCK)[None, :, None]
    kpos = jnp.arange(nb)[:, None, None] * BLOCK - BLOCK + jnp.arange(3 * BLOCK)[None, None, :]
    valid = (jnp.abs(kpos - qpos) <= WINDOW) & (kpos >= 0) & (kpos < n)
    s_win = jnp.where(valid[None, :, None, None], s_win, -jnp.inf)
    sk = jnp.broadcast_to(sink.reshape(N_KV, g)[None, None, :, :, None, None].astype(jnp.float32), s_ctx.shape[:-1] + (1,))
    p = jax.nn.softmax(jnp.concatenate([s_win, s_ctx, sk], -1), axis=-1)
    w3 = 3 * BLOCK
    o = (jnp.einsum('bnkgqs,bnskd->bnqkgd', p[..., :w3].astype(v.dtype), vw)
         + jnp.einsum('bnkgqs,bskd->bnqkgd', p[..., w3:w3 + kc.shape[1]].astype(vc.dtype), vc))
    return o.reshape(b_, n, h * hd)


def global_attn_latent(q, k_all, v_all):
    b_, n, h, hd = q.shape
    nb = n // BLOCK
    qb = jnp.moveaxis(q.reshape(b_, nb, BLOCK, h, hd), 1, 0)
    ob = lax.map(lambda qi: dense_attn(qi, k_all, v_all), qb)
    return jnp.moveaxis(ob, 0, 1).reshape(b_, n, h * hd)


def retention_chunked(q, k, v, log_gamma, s0):
    b_, t, h, dk = q.shape
    c = RET_CHUNK
    nc = t // c
    qc = q.astype(jnp.float32).reshape(b_, nc, c, h, dk)
    kc = k.astype(jnp.float32).reshape(b_, nc, c, h, dk)
    vc = v.astype(jnp.float32).reshape(b_, nc, c, h, -1)
    idx = jnp.arange(c, dtype=jnp.float32)
    rel = idx[:, None] - idx[None, :]
    d_intra = jnp.where(rel[None] >= 0, jnp.exp(jnp.maximum(rel, 0.0)[None] * log_gamma[:, None, None]), 0.0)
    att = jnp.einsum('bnihd,bnjhd->bnhij', qc, kc) * d_intra[None, None]
    o_intra = jnp.einsum('bnhij,bnjhe->bnihe', att, vc)
    k_w = jnp.exp((c - 1 - idx)[None, :] * log_gamma[:, None])
    u = jnp.einsum('bnjhd,hj,bnjhe->nbhde', kc, k_w, vc)
    chunk_decay = jnp.exp(c * log_gamma)[None, :, None, None]

    def step(s, u_n):
        return chunk_decay * s + u_n, s

    s_final, s_prev = lax.scan(step, s0, u)
    q_w = jnp.exp((idx + 1)[None, :] * log_gamma[:, None])
    o_cross = jnp.einsum('bnihd,hi,nbhde->bnihe', qc, q_w, s_prev)
    return (o_intra + o_cross).reshape(b_, t, h, -1), s_final


def token_shift(z, reverse):
    if reverse:
        return jnp.pad(z[:, 1:], ((0, 0), (0, 1), (0, 0)))
    return jnp.pad(z[:, :-1], ((0, 0), (1, 0), (0, 0)))


def rwkv7_scan(r, w, k, v, a, b, s0, reverse):
    def step(s, inp):
        r_t, w_t, k_t, v_t, a_t, b_t = inp
        sa = jnp.einsum('bhij,bhj->bhi', s, a_t)
        s = s * w_t[:, :, None, :] + sa[..., None] * b_t[:, :, None, :] + v_t[..., None] * k_t[:, :, None, :]
        return s, jnp.einsum('bhij,bhj->bhi', s, r_t)

    xs = tuple(jnp.moveaxis(t, 1, 0) for t in (r, w, k, v, a, b))
    s_final, y = lax.scan(step, s0, xs, reverse=reverse)
    return jnp.moveaxis(y, 0, 1), s_final


def rwkv7_direction(rkv, w_low, a_low, s0, reverse, mu, w0, w2, a0, a2, rho, k_k, k_a, ln_g, ln_b):
    z = jnp.concatenate([rkv, w_low, a_low], -1).astype(jnp.float32)
    z = z + mu * (token_shift(z, reverse) - z)
    r, k, v = z[..., :GROUP_W], z[..., GROUP_W:2 * GROUP_W], z[..., 2 * GROUP_W:3 * GROUP_W]
    w_in_ = z[..., 3 * GROUP_W:3 * GROUP_W + W_RANK]
    a_in = z[..., 3 * GROUP_W + W_RANK:]
    decay = jnp.exp(-DECAY_SCALE * jax.nn.sigmoid(w0 + jnp.tanh(w_in_) @ w2))
    a = jax.nn.sigmoid(a0 + a_in @ a2)
    kk = heads(k * k_k)
    kk = kk / jnp.maximum(jnp.sqrt(jnp.sum(kk * kk, -1, keepdims=True)), 1e-12)
    k_t = k * (1.0 + (a - 1.0) * k_a)
    r_h, k_h, v_h = heads(r), heads(k_t), heads(v)
    y, s_final = rwkv7_scan(r_h, heads(decay), k_h, v_h, -kk, kk * heads(a), s0, reverse)
    bonus = jnp.sum(r_h * k_h * rho, -1, keepdims=True) * v_h
    y = head_norm(y, ln_g, ln_b) + bonus.reshape(bonus.shape[:2] + (GROUP_W,))
    return y, s_final


def mixer(h, hc, w_in_l, w_out_l, sink, qk_g, ret_g, mu, w0, w2, a0, a2, rho, k_k, k_a, g2, ln_g, ln_b,
          rope_row, rope_col, rope_seq, log_gamma, need_ctx_out):
    (qa, ka, va, qb, kb, vb, qr, kr, vr, grf, grb, rkv, gd, wdf, wdb, adf, adb) = split_cols(h @ w_in_l)
    (cqa, cka, cva, cqb, ckb, cvb, cqr, ckr, cvr, cgrf, cgrb, crkv, cgd, cwdf, cwdb, cadf, cadb) = split_cols(hc @ w_in_l)
    b_ = h.shape[0]
    cka_h, cva_h = heads(cka), heads(cva)
    out_a = window_attn_latent(apply_axial_rope(heads(qa), rope_row, rope_col),
                               apply_axial_rope(heads(ka), rope_row, rope_col), heads(va), cka_h, cva_h, sink)
    ckb_h, cvb_h = rms_norm(heads(ckb), qk_g[1]), heads(cvb)
    qb_h = apply_axial_rope(rms_norm(heads(qb), qk_g[0]), rope_row, rope_col)
    kb_h = apply_axial_rope(rms_norm(heads(kb), qk_g[1]), rope_row, rope_col)
    out_b = global_attn_latent(qb_h, jnp.concatenate([kb_h, ckb_h], 1), jnp.concatenate([heads(vb), cvb_h], 1))
    zeros = jnp.zeros((b_, GROUP_HEADS, HEAD_DIM, HEAD_DIM), jnp.float32)
    k_scale = HEAD_DIM ** -0.5
    cq_r, ck_r, cv_r = heads(cqr), heads(ckr) * k_scale, heads(cvr)
    oc_f, sc_f = retention_chunked(cq_r, ck_r, cv_r, log_gamma, zeros)
    oc_b, sc_b = retention_chunked(flip(cq_r), flip(ck_r), flip(cv_r), log_gamma, zeros)
    q_r = apply_rope(heads(qr), *rope_seq)
    k_r = apply_rope(heads(kr), *rope_seq) * k_scale
    v_r = heads(vr)
    o_f, _ = retention_chunked(q_r, k_r, v_r, log_gamma, sc_f)
    o_b, _ = retention_chunked(flip(q_r), flip(k_r), flip(v_r), log_gamma, sc_b)
    out_c = head_norm(o_f, ret_g) * jax.nn.silu(grf) + head_norm(flip(o_b), ret_g) * jax.nn.silu(grb)
    yc_f, sdc_f = rwkv7_direction(crkv, cwdf, cadf, zeros, False, mu[0], w0[0], w2[0], a0[0], a2[0], rho[0], k_k, k_a, ln_g, ln_b)
    yc_b, sdc_b = rwkv7_direction(crkv, cwdb, cadb, zeros, True, mu[1], w0[1], w2[1], a0[1], a2[1], rho[1], k_k, k_a, ln_g, ln_b)
    y_f, _ = rwkv7_direction(rkv, wdf, adf, sdc_f, False, mu[0], w0[0], w2[0], a0[0], a2[0], rho[0], k_k, k_a, ln_g, ln_b)
    y_b, _ = rwkv7_direction(rkv, wdb, adb, sdc_b, True, mu[1], w0[1], w2[1], a0[1], a2[1], rho[1], k_k, k_a, ln_g, ln_b)
    out_d = (y_f + y_b) * (jax.nn.sigmoid(gd) @ g2)
    dt = h.dtype
    out = jnp.concatenate([out_a, out_b, out_c.astype(dt), out_d.astype(dt)], -1) @ w_out_l
    if not need_ctx_out:
        return out, None
    oac = dense_attn(heads(cqa), cka_h, cva_h, sink)
    obc = dense_attn(rms_norm(heads(cqb), qk_g[0]), ckb_h, cvb_h)
    occ = head_norm(oc_f, ret_g) * jax.nn.silu(cgrf) + head_norm(flip(oc_b), ret_g) * jax.nn.silu(cgrb)
    odc = (yc_f + yc_b) * (jax.nn.sigmoid(cgd) @ g2)
    out_ctx = jnp.concatenate([oac, obc, occ.astype(dt), odc.astype(dt)], -1) @ w_out_l
    return out, out_ctx


def setup_inputs(seed: int = 0) -> dict:
    key = jax.random.key(seed)
    ks = jax.random.split(key, 26)
    D = D_MODEL
    L = DEPTH

    def nrm(k, shape, s):
        return jax.random.normal(k, shape, jnp.float32) * s

    return {
        'x': nrm(ks[0], (BATCH, SEQ, D), 1.0),
        'c': nrm(ks[1], (BATCH, D), 1.0),
        'ctx': nrm(ks[2], (BATCH, CTX_LEN, D), 1.0),
        'c_ctx': nrm(ks[3], (D,), 1.0),
        'w_mod': nrm(ks[4], (L, D, N_MOD * D), 0.5 * D ** -0.5),
        'b_mod': nrm(ks[5], (L, N_MOD * D), 0.01),
        'norm_g': 1.0 + nrm(ks[6], (L, 3, D), 0.02),
        'ffn_w_in': nrm(ks[7], (L, 2, D, 2 * D_FF), D ** -0.5),
        'ffn_w_out': nrm(ks[8], (L, 2, D_FF, D), D_FF ** -0.5),
        'w_in': nrm(ks[9], (L, D, PROJ_COLS), D ** -0.5),
        'w_out': nrm(ks[10], (L, N_GROUPS * GROUP_W, D), (N_GROUPS * GROUP_W) ** -0.5),
        'attn_sink': nrm(ks[11], (L, GROUP_HEADS), 1.0),
        'qk_norm_g': 1.0 + nrm(ks[12], (L, 2, HEAD_DIM), 0.02),
        'ret_norm_g': 1.0 + nrm(ks[13], (L, GROUP_W), 0.02),
        'rwkv_mu': jax.random.uniform(ks[14], (L, 2, RWKV_MIX), jnp.float32),
        'rwkv_w0': jax.random.uniform(ks[15], (L, 2, GROUP_W), jnp.float32, -4.0, 2.0),
        'rwkv_w2': nrm(ks[16], (L, 2, W_RANK, GROUP_W), 0.1 * W_RANK ** -0.5),
        'rwkv_a0': nrm(ks[17], (L, 2, GROUP_W), 0.5),
        'rwkv_a2': nrm(ks[18], (L, 2, A_RANK, GROUP_W), 0.1 * A_RANK ** -0.5),
        'rwkv_rho': nrm(ks[19], (L, 2, GROUP_HEADS, HEAD_DIM), 0.1),
        'rwkv_k_k': 1.0 + nrm(ks[20], (L, GROUP_W), 0.1),
        'rwkv_k_a': 1.0 + nrm(ks[21], (L, GROUP_W), 0.1),
        'rwkv_g2': nrm(ks[22], (L, G_RANK, GROUP_W), G_RANK ** -0.5),
        'rwkv_ln_g': 1.0 + nrm(ks[23], (L, GROUP_W), 0.02),
        'rwkv_ln_b': nrm(ks[24], (L, GROUP_W), 0.01),
        'final_norm_g': 1.0 + nrm(ks[25], (D,), 0.02),
    }


def reference(x, c, ctx, c_ctx, w_mod, b_mod, norm_g, ffn_w_in, ffn_w_out, w_in, w_out, attn_sink, qk_norm_g,
              ret_norm_g, rwkv_mu, rwkv_w0, rwkv_w2, rwkv_a0, rwkv_a2, rwkv_rho, rwkv_k_k, rwkv_k_a, rwkv_g2,
              rwkv_ln_g, rwkv_ln_b, final_norm_g):
    n_tok = x.shape[1]
    rows = n_tok // GRID_W
    row = jnp.repeat(jnp.arange(rows), GRID_W)
    col = jnp.arange(rows * GRID_W) % GRID_W
    rope_row = rope_cos_sin(row, HEAD_DIM // 2)
    rope_col = rope_cos_sin(col, HEAD_DIM // 2)
    rope_seq = rope_cos_sin(jnp.arange(n_tok), HEAD_DIM)
    log_gamma = jnp.log1p(-jnp.exp2(-5.0 - jnp.arange(GROUP_HEADS, dtype=jnp.float32)))
    xc = ctx
    for l in range(DEPTH):
        need_ctx_out = l < DEPTH - 1
        mod = (jax.nn.silu(c) @ w_mod[l] + b_mod[l]).reshape(c.shape[0], N_MOD, 1, D_MODEL)
        mod_c = (jax.nn.silu(c_ctx) @ w_mod[l] + b_mod[l]).reshape(N_MOD, 1, D_MODEL)
        x = x + 0.5 * mod[:, 2] * swiglu(modulate(rms_norm(x, norm_g[l, 0]), mod[:, 0], mod[:, 1]), ffn_w_in[l, 0], ffn_w_out[l, 0])
        xc = xc + 0.5 * mod_c[2] * swiglu(modulate(rms_norm(xc, norm_g[l, 0]), mod_c[0], mod_c[1]), ffn_w_in[l, 0], ffn_w_out[l, 0])
        h = modulate(rms_norm(x, norm_g[l, 1]), mod[:, 3], mod[:, 4])
        hc = modulate(rms_norm(xc, norm_g[l, 1]), mod_c[3], mod_c[4])
        y, yc = mixer(h, hc, w_in[l], w_out[l], attn_sink[l], qk_norm_g[l], ret_norm_g[l], rwkv_mu[l], rwkv_w0[l],
                      rwkv_w2[l], rwkv_a0[l], rwkv_a2[l], rwkv_rho[l], rwkv_k_k[l], rwkv_k_a[l], rwkv_g2[l],
                      rwkv_ln_g[l], rwkv_ln_b[l], rope_row, rope_col, rope_seq, log_gamma, need_ctx_out)
        x = x + mod[:, 5] * y
        x = x + 0.5 * mod[:, 8] * swiglu(modulate(rms_norm(x, norm_g[l, 2]), mod[:, 6], mod[:, 7]), ffn_w_in[l, 1], ffn_w_out[l, 1])
        if need_ctx_out:
            xc = xc + mod_c[5] * yc
            xc = xc + 0.5 * mod_c[8] * swiglu(modulate(rms_norm(xc, norm_g[l, 2]), mod_c[6], mod_c[7]), ffn_w_in[l, 1], ffn_w_out[l, 1])
    return rms_norm(x, final_norm_g)
```

```cpp
#include <hip/hip_runtime.h>
#include <hip/hip_bf16.h>
#include <hip/hip_cooperative_groups.h>
#include <cstdio>
namespace cg = cooperative_groups;

#ifndef MULTI_LAUNCH
#define MULTI_LAUNCH 0
#endif

typedef unsigned short u16;
using bf16x8 = __attribute__((ext_vector_type(8))) short;
using bf16x4 = __attribute__((ext_vector_type(4))) short;
using f32x4 = __attribute__((ext_vector_type(4))) float;

constexpr int D = 1024;
constexpr int TLAT = 32768;
constexpr int TCTX = 1024;
constexpr int TALL = TLAT + TCTX;
constexpr int SEQ = 8192;
constexpr int CTXL = 256;
constexpr int STOT = SEQ + CTXL;
constexpr int DFF = 2816;
constexpr int PC = 3456;
constexpr int P2C = 1664;
constexpr int NMOD = 9 * D;
constexpr float LOG2E = 1.4426950408889634f;
constexpr float RMS_EPS = 1e-6f;
constexpr float GN_EPS = 64e-5f;

constexpr size_t MiB = 1ull << 20;
constexpr size_t OFF_WFFI = 0;
constexpr size_t OFF_WFFO = 44 * MiB;
constexpr size_t OFF_WIN = 66 * MiB;
constexpr size_t OFF_WOUT = OFF_WIN + 27 * MiB / 2;
constexpr size_t OFF_MOD = OFF_WOUT + 4 * MiB;
constexpr size_t OFF_ROPE = OFF_MOD + MiB / 2;
constexpr size_t OFF_XC = OFF_ROPE + 5 * MiB / 2;
constexpr size_t OFF_H = OFF_XC + 4 * MiB;
constexpr size_t OFF_P2 = OFF_H + 66 * MiB;
constexpr size_t OFF_BIG = OFF_P2 + 429 * MiB / 4;
constexpr size_t SZ_Q = (size_t)TALL * 256 * 2;
constexpr size_t SZ_KV2 = (size_t)4 * 2 * STOT * 64 * 2;
constexpr size_t SZ_KV4 = (size_t)4 * 4 * STOT * 64 * 2;
constexpr size_t OFF_QA = OFF_BIG;
constexpr size_t OFF_QB = OFF_QA + SZ_Q;
constexpr size_t OFF_QR = OFF_QB + SZ_Q;
constexpr size_t OFF_KA = OFF_QR + SZ_Q;
constexpr size_t OFF_VA = OFF_KA + SZ_KV2;
constexpr size_t OFF_KB = OFF_VA + SZ_KV2;
constexpr size_t OFF_VB = OFF_KB + SZ_KV2;
constexpr size_t OFF_KR = OFF_VB + SZ_KV2;
constexpr size_t OFF_VR = OFF_KR + SZ_KV4;
constexpr size_t OFF_U = OFF_VR + SZ_KV4;
constexpr size_t OFF_SP = OFF_U + (size_t)16 * 66 * 2 * 4096 * 4;
constexpr size_t OFF_PREP = OFF_BIG;
constexpr size_t OFF_YRAW = OFF_PREP + (size_t)32 * STOT * 384 * 2;
constexpr size_t WS_END = OFF_YRAW + (size_t)2 * TALL * 256 * 2;
static_assert(WS_END <= 512 * MiB, "workspace overflow");
static_assert(OFF_SP + (size_t)16 * 66 * 2 * 4096 * 2 <= 512 * MiB, "workspace overflow");
static_assert(OFF_P2 + (size_t)TALL * DFF * 2 <= 512 * MiB, "act overflow");

struct Params {
  const float *x, *c, *ctx, *c_ctx, *w_mod, *b_mod, *norm_g, *ffn_w_in, *ffn_w_out, *w_in, *w_out, *attn_sink, *qk_g,
      *ret_g, *mu, *w0, *w2, *a0, *a2, *rho, *k_k, *k_a, *g2, *ln_g, *ln_b, *final_g;
  float* out;
  unsigned char* ws;
};

__device__ __forceinline__ int TIDX() { int t = threadIdx.x; asm volatile("" : "+v"(t)); return t & 255; }
__device__ __forceinline__ int BIDX() { int t = blockIdx.x; asm volatile("" : "+s"(t)); return t; }
__device__ __forceinline__ u16 f2bf(float f) {
  unsigned u = __float_as_uint(f);
  u += 0x7fffu + ((u >> 16) & 1u);
  return (u16)(u >> 16);
}
__device__ __forceinline__ float bf2f(u16 h) { return __uint_as_float(((unsigned)h) << 16); }
__device__ __forceinline__ float sigmoidf_(float x) { return 1.f / (1.f + __expf(-x)); }
__device__ __forceinline__ float siluf_(float x) { return x / (1.f + __expf(-x)); }
__device__ __forceinline__ float wave_sum(float v) {
#pragma unroll
  for (int o = 32; o >= 1; o >>= 1) v += __shfl_xor(v, o);
  return v;
}
template <int CTRL>
__device__ __forceinline__ float dpp_f(float x) {
  return __builtin_bit_cast(float, __builtin_amdgcn_update_dpp(0, __builtin_bit_cast(int, x), CTRL, 0xf, 0xf, true));
}
__device__ __forceinline__ float row16_sum(float x) {
  x += dpp_f<0xB1>(x);
  x += dpp_f<0x4E>(x);
  x += dpp_f<0x141>(x);
  x += dpp_f<0x140>(x);
  return x;
}
__device__ __forceinline__ bf16x4 pack4(float a, float b, float c, float d) {
  bf16x4 r;
  r[0] = (short)f2bf(a); r[1] = (short)f2bf(b); r[2] = (short)f2bf(c); r[3] = (short)f2bf(d);
  return r;
}
__device__ __forceinline__ bf16x8 cat8(bf16x4 a, bf16x4 b) {
  bf16x8 r;
  r[0] = a[0]; r[1] = a[1]; r[2] = a[2]; r[3] = a[3]; r[4] = b[0]; r[5] = b[1]; r[6] = b[2]; r[7] = b[3];
  return r;
}
__device__ __forceinline__ const float* rrow(const float* lat, const float* cx, int r) {
  return r < TLAT ? lat + (size_t)r * D : cx + (size_t)(r - TLAT) * D;
}
__device__ __forceinline__ float* wrow(float* lat, float* cx, int r) {
  return r < TLAT ? lat + (size_t)r * D : cx + (size_t)(r - TLAT) * D;
}
__device__ __forceinline__ int mod_index(int r) { return r < TLAT ? (r >> 13) : 4; }
__device__ __forceinline__ void row_bpos(int r, int& b, int& pos) {
  if (r < TLAT) { b = r >> 13; pos = r & 8191; }
  else { int rc = r - TLAT; b = rc >> 8; pos = SEQ + (rc & 255); }
}
__device__ __forceinline__ int bpos_row(int b, int pos) {
  return pos < SEQ ? b * SEQ + pos : TLAT + b * CTXL + (pos - SEQ);
}

__device__ __forceinline__ void phase_init(const Params& p, unsigned char* smem) {
  const int tid = TIDX();
  const int nb = gridDim.x, bid = BIDX();
  {
    float2* seq = (float2*)(p.ws + OFF_ROPE);
    float2* rowt = seq + 8192 * 32;
    float2* colt = rowt + 128 * 16;
    for (int i = bid * 256 + tid; i < 8192 * 32 + 128 * 16 + 64 * 16; i += nb * 256) {
      float ang;
      float2* dst;
      if (i < 8192 * 32) {
        int t = i >> 5, k = i & 31;
        float inv = 1.0f / powf(10000.0f, (float)(2 * k) / 64.0f);
        ang = (float)t * inv;
        dst = seq + i;
      } else {
        int j = i - 8192 * 32;
        int pidx = (j < 128 * 16) ? (j >> 4) : ((j - 128 * 16) >> 4);
        int k = j & 15;
        float inv = 1.0f / powf(10000.0f, (float)(2 * k) / 32.0f);
        ang = (float)pidx * inv;
        dst = rowt + j;
      }
      *dst = make_float2(cosf(ang), sinf(ang));
    }
    (void)colt;
  }
  {
    float* sc = (float*)smem;
    float* red = sc + 5 * 1024;
    for (int item = bid; item < 288; item += nb) {
      const int l = item / 144, cb = item % 144;
      __syncthreads();
      for (int i = tid; i < 5 * 1024; i += 256) {
        int m = i >> 10, k = i & 1023;
        float v = (m < 4) ? p.c[m * 1024 + k] : p.c_ctx[k];
        sc[i] = siluf_(v);
      }
      __syncthreads();
      const int cq = tid & 15, kg = tid >> 4;
      float acc[5][4];
#pragma unroll
      for (int m = 0; m < 5; ++m)
#pragma unroll
        for (int q = 0; q < 4; ++q) acc[m][q] = 0.f;
      const float* wbase = p.w_mod + (size_t)l * 1024 * NMOD + cb * 64 + cq * 4;
      for (int kk = 0; kk < 64; ++kk) {
        int k = kg * 64 + kk;
        float4 w4 = *(const float4*)(wbase + (size_t)k * NMOD);
#pragma unroll
        for (int m = 0; m < 5; ++m) {
          float s = sc[m * 1024 + k];
          acc[m][0] += s * w4.x; acc[m][1] += s * w4.y; acc[m][2] += s * w4.z; acc[m][3] += s * w4.w;
        }
      }
#pragma unroll
      for (int m = 0; m < 5; ++m)
#pragma unroll
        for (int q = 0; q < 4; ++q) red[(kg * 5 + m) * 64 + cq * 4 + q] = acc[m][q];
      __syncthreads();
      float* modp = (float*)(p.ws + OFF_MOD);
      for (int o = tid; o < 320; o += 256) {
        int m = o >> 6, cc = o & 63;
        float s = 0.f;
        for (int g = 0; g < 16; ++g) s += red[(g * 5 + m) * 64 + cc];
        int col = cb * 64 + cc;
        modp[((size_t)l * 5 + m) * NMOD + col] = s + p.b_mod[(size_t)l * NMOD + col];
      }
    }
    __syncthreads();
  }
  {
    float* tile = (float*)smem;
    constexpr int N_FFI = 4 * 16 * 88, N_FFO = 4 * 44 * 16, N_WIN = 2 * 16 * 54, N_WOUT = 2 * 16 * 16;
    for (int item = bid; item < N_FFI + N_FFO + N_WIN + N_WOUT; item += nb) {
      const float* src; u16* dst; int K, N, kt, nt; bool perm = false;
      int it = item;
      if (it < N_FFI) {
        int mtx = it / (16 * 88); it %= (16 * 88);
        K = 1024; N = 5632; kt = it / 88; nt = it % 88; perm = true;
        src = p.ffn_w_in + (size_t)mtx * 1024 * 5632;
        dst = (u16*)(p.ws + OFF_WFFI) + (size_t)mtx * 5632 * 1024;
      } else if (it < N_FFI + N_FFO) {
        it -= N_FFI;
        int mtx = it / (44 * 16); it %= (44 * 16);
        K = 2816; N = 1024; kt = it / 16; nt = it % 16;
        src = p.ffn_w_out + (size_t)mtx * 2816 * 1024;
        dst = (u16*)(p.ws + OFF_WFFO) + (size_t)mtx * 1024 * 2816;
      } else if (it < N_FFI + N_FFO + N_WIN) {
        it -= N_FFI + N_FFO;
        int mtx = it / (16 * 54); it %= (16 * 54);
        K = 1024; N = 3456; kt = it / 54; nt = it % 54;
        src = p.w_in + (size_t)mtx * 1024 * 3456;
        dst = (u16*)(p.ws + OFF_WIN) + (size_t)mtx * 3456 * 1024;
      } else {
        it -= N_FFI + N_FFO + N_WIN;
        int mtx = it / 256; it %= 256;
        K = 1024; N = 1024; kt = it / 16; nt = it % 16;
        src = p.w_out + (size_t)mtx * 1024 * 1024;
        dst = (u16*)(p.ws + OFF_WOUT) + (size_t)mtx * 1024 * 1024;
      }
      __syncthreads();
      {
        const int r = tid >> 4, c4 = tid & 15;
        int np = nt * 64 + c4 * 4;
        int scol = np;
        if (perm) {
          int blk = np >> 7, sub = (np & 127) >> 4, i = np & 15;
          scol = ((sub & 1) ? DFF : 0) + blk * 64 + (sub >> 1) * 16 + i;
        }
#pragma unroll
        for (int ps = 0; ps < 4; ++ps) {
          int k = kt * 64 + ps * 16 + r;
          float4 v = *(const float4*)(src + (size_t)k * N + scol);
          float* tp = tile + (ps * 16 + r) * 65 + c4 * 4;
          tp[0] = v.x; tp[1] = v.y; tp[2] = v.z; tp[3] = v.w;
        }
      }
      __syncthreads();
      {
        const int n = tid >> 2, kq = tid & 3;
        bf16x8 o0, o1;
#pragma unroll
        for (int i = 0; i < 8; ++i) {
          o0[i] = (short)f2bf(tile[(kq * 16 + i) * 65 + n]);
          o1[i] = (short)f2bf(tile[(kq * 16 + 8 + i) * 65 + n]);
        }
        u16* dp = dst + (size_t)(nt * 64 + n) * K + kt * 64 + kq * 16;
        *(bf16x8*)dp = o0;
        *(bf16x8*)(dp + 8) = o1;
      }
    }
    __syncthreads();
  }
}

__device__ __forceinline__ void phase_norm(const Params& p, int l, int which, const float* lat, const float* cx) {
  const int lane = TIDX() & 63, wid = TIDX() >> 6;
  u16* h = (u16*)(p.ws + OFF_H);
  const float* g = p.norm_g + ((size_t)l * 3 + which) * D;
  const float* modp = (const float*)(p.ws + OFF_MOD) + (size_t)l * 5 * NMOD;
  for (int r = BIDX() * 4 + wid; r < TALL; r += gridDim.x * 4) {
    const float* xr = rrow(lat, cx, r);
    const float* mp = modp + (size_t)mod_index(r) * NMOD + which * 3 * D;
    float4 v[4];
    float ss = 0.f;
#pragma unroll
    for (int i = 0; i < 4; ++i) {
      v[i] = *(const float4*)(xr + i * 256 + lane * 4);
      ss += v[i].x * v[i].x + v[i].y * v[i].y + v[i].z * v[i].z + v[i].w * v[i].w;
    }
    ss = wave_sum(ss);
    float rstd = rsqrtf(ss * (1.f / 1024.f) + RMS_EPS);
#pragma unroll
    for (int i = 0; i < 4; ++i) {
      int col = i * 256 + lane * 4;
      float4 gg = *(const float4*)(g + col);
      float4 sh = *(const float4*)(mp + col);
      float4 scl = *(const float4*)(mp + D + col);
      bf16x4 o = pack4(v[i].x * rstd * gg.x * (1.f + scl.x) + sh.x, v[i].y * rstd * gg.y * (1.f + scl.y) + sh.y,
                       v[i].z * rstd * gg.z * (1.f + scl.z) + sh.z, v[i].w * rstd * gg.w * (1.f + scl.w) + sh.w);
      *(bf16x4*)(h + (size_t)r * D + col) = o;
    }
  }
}

__device__ __forceinline__ void phase_final_norm(const Params& p) {
  const int lane = TIDX() & 63, wid = TIDX() >> 6;
  for (int r = BIDX() * 4 + wid; r < TLAT; r += gridDim.x * 4) {
    float* xr = p.out + (size_t)r * D;
    float4 v[4];
    float ss = 0.f;
#pragma unroll
    for (int i = 0; i < 4; ++i) {
      v[i] = *(const float4*)(xr + i * 256 + lane * 4);
      ss += v[i].x * v[i].x + v[i].y * v[i].y + v[i].z * v[i].z + v[i].w * v[i].w;
    }
    ss = wave_sum(ss);
    float rstd = rsqrtf(ss * (1.f / 1024.f) + RMS_EPS);
#pragma unroll
    for (int i = 0; i < 4; ++i) {
      int col = i * 256 + lane * 4;
      float4 gg = *(const float4*)(p.final_g + col);
      float4 o = make_float4(v[i].x * rstd * gg.x, v[i].y * rstd * gg.y, v[i].z * rstd * gg.z, v[i].w * rstd * gg.w);
      *(float4*)(xr + col) = o;
    }
  }
}

__device__ __forceinline__ void gemm_mainloop(const u16* __restrict__ A, const u16* __restrict__ Bt, int K, int brow,
                                              int bcol, f32x4 (&acc)[4][4], unsigned char* smem) {
  const int tid = TIDX(), wid = tid >> 6, lane = tid & 63, wr = wid >> 1, wc = wid & 1, fr = lane & 15, fq = lane >> 4;
  unsigned char* SA = smem;
  unsigned char* SB = smem + 8192;
#pragma unroll
  for (int m = 0; m < 4; ++m)
#pragma unroll
    for (int n = 0; n < 4; ++n) acc[m][n] = f32x4{0.f, 0.f, 0.f, 0.f};
  const int nk = K / 32;
  for (int t = 0; t < nk; ++t) {
#pragma unroll
    for (int i = 0; i < 2; ++i) {
      int b = tid * 16 + i * 4096, r = b >> 6, c = (b & 63) >> 1;
      *(bf16x8*)(SA + b) = *(const bf16x8*)(A + (size_t)(brow + r) * K + t * 32 + c);
      *(bf16x8*)(SB + b) = *(const bf16x8*)(Bt + (size_t)(bcol + r) * K + t * 32 + c);
    }
    __syncthreads();
    bf16x8 af[4], bfr[4];
#pragma unroll
    for (int m = 0; m < 4; ++m) af[m] = *(const bf16x8*)(SA + (wr * 64 + m * 16 + fr) * 64 + fq * 16);
#pragma unroll
    for (int n = 0; n < 4; ++n) bfr[n] = *(const bf16x8*)(SB + (wc * 64 + n * 16 + fr) * 64 + fq * 16);
#pragma unroll
    for (int m = 0; m < 4; ++m)
#pragma unroll
      for (int n = 0; n < 4; ++n) acc[m][n] = __builtin_amdgcn_mfma_f32_16x16x32_bf16(af[m], bfr[n], acc[m][n], 0, 0, 0);
    __syncthreads();
  }
}

__device__ __forceinline__ void phase_ffn_in(const Params& p, int l, int f, unsigned char* smem) {
  const u16* A = (const u16*)(p.ws + OFF_H);
  const u16* Bt = (const u16*)(p.ws + OFF_WFFI) + (size_t)(l * 2 + f) * 5632 * 1024;
  u16* act = (u16*)(p.ws + OFF_P2);
  const int tid = TIDX(), wid = tid >> 6, lane = tid & 63, wr = wid >> 1, wc = wid & 1, fr = lane & 15, fq = lane >> 4;
  constexpr int NT = 44, MT = TALL / 128;
  for (int tile = BIDX(); tile < MT * NT; tile += gridDim.x) {
    const int tm = tile / NT, tn = tile % NT;
    f32x4 acc[4][4];
    gemm_mainloop(A, Bt, 1024, tm * 128, tn * 128, acc, smem);
#pragma unroll
    for (int m = 0; m < 4; ++m)
#pragma unroll
      for (int q = 0; q < 2; ++q)
#pragma unroll
        for (int j = 0; j < 4; ++j) {
          int row = tm * 128 + wr * 64 + m * 16 + fq * 4 + j;
          int col = tn * 64 + wc * 32 + q * 16 + fr;
          float u1 = acc[m][2 * q][j], u2 = acc[m][2 * q + 1][j];
          act[(size_t)row * DFF + col] = f2bf(siluf_(u1) * u2);
        }
  }
}

__device__ __forceinline__ void phase_resid_gemm(const Params& p, int l, const u16* A, const u16* Bt, int K, int gate, float gscale,
                                 const float* lat_in, const float* cx_in, float* lat_out, float* cx_out,
                                 unsigned char* smem) {
  const int tid = TIDX(), wid = tid >> 6, lane = tid & 63, wr = wid >> 1, wc = wid & 1, fr = lane & 15, fq = lane >> 4;
  constexpr int NT = 8, MT = TALL / 128;
  const float* modp = (const float*)(p.ws + OFF_MOD) + (size_t)l * 5 * NMOD;
  for (int tile = BIDX(); tile < MT * NT; tile += gridDim.x) {
    const int tm = tile / NT, tn = tile % NT;
    f32x4 acc[4][4];
    gemm_mainloop(A, Bt, K, tm * 128, tn * 128, acc, smem);
    const float* mp = modp + (size_t)mod_index(tm * 128) * NMOD + gate * D;
#pragma unroll
    for (int n = 0; n < 4; ++n) {
      int col = tn * 128 + wc * 64 + n * 16 + fr;
      float gv = gscale * mp[col];
#pragma unroll
      for (int m = 0; m < 4; ++m)
#pragma unroll
        for (int j = 0; j < 4; ++j) {
          int row = tm * 128 + wr * 64 + m * 16 + fq * 4 + j;
          float xi = rrow(lat_in, cx_in, row)[col];
          wrow(lat_out, cx_out, row)[col] = xi + gv * acc[m][n][j];
        }
    }
  }
}

__device__ __forceinline__ void phase_inproj(const Params& p, int l, unsigned char* smem) {
  const u16* A = (const u16*)(p.ws + OFF_H);
  const u16* Bt = (const u16*)(p.ws + OFF_WIN) + (size_t)l * PC * 1024;
  const int tid = TIDX(), wid = tid >> 6, lane = tid & 63, wr = wid >> 1, wc = wid & 1, fr = lane & 15, fq = lane >> 4;
  constexpr int NT = 27, MT = TALL / 128;
  const float2* ropeseq = (const float2*)(p.ws + OFF_ROPE);
  const float2* roperow = ropeseq + 8192 * 32;
  const float2* ropecol = roperow + 128 * 16;
  u16* QA = (u16*)(p.ws + OFF_QA); u16* QB = (u16*)(p.ws + OFF_QB); u16* QR = (u16*)(p.ws + OFF_QR);
  u16* KA = (u16*)(p.ws + OFF_KA); u16* VA = (u16*)(p.ws + OFF_VA);
  u16* KB = (u16*)(p.ws + OFF_KB); u16* VB = (u16*)(p.ws + OFF_VB);
  u16* KR = (u16*)(p.ws + OFF_KR); u16* VR = (u16*)(p.ws + OFF_VR);
  u16* P2 = (u16*)(p.ws + OFF_P2);
  for (int tile = BIDX(); tile < MT * NT; tile += gridDim.x) {
    const int tm = tile / NT, tn = tile % NT;
    f32x4 acc[4][4];
    gemm_mainloop(A, Bt, 1024, tm * 128, tn * 128, acc, smem);
    const int r0 = tm * 128 + wr * 64;
    const int c0 = tn * 128 + wc * 64;
    const bool latent = r0 < TLAT;
    if (c0 >= 1792) {
#pragma unroll
      for (int m = 0; m < 4; ++m)
#pragma unroll
        for (int n = 0; n < 4; ++n)
#pragma unroll
          for (int j = 0; j < 4; ++j) {
            int row = r0 + m * 16 + fq * 4 + j;
            P2[(size_t)row * P2C + (c0 - 1792) + n * 16 + fr] = f2bf(acc[m][n][j]);
          }
      continue;
    }
    int kind;
    int ropek;
    int normk;
    float scale = 1.f;
    u16* dst; int hh, nh;
    if (c0 < 256) { kind = 0; ropek = 1; normk = -1; scale = 0.125f; dst = QA; hh = c0 >> 6; nh = 4; }
    else if (c0 < 384) { kind = 1; ropek = 1; normk = -1; dst = KA; hh = (c0 - 256) >> 6; nh = 2; }
    else if (c0 < 512) { kind = 2; ropek = 0; normk = -1; dst = VA; hh = (c0 - 384) >> 6; nh = 2; }
    else if (c0 < 768) { kind = 0; ropek = 1; normk = 0; scale = 0.125f; dst = QB; hh = (c0 - 512) >> 6; nh = 4; }
    else if (c0 < 896) { kind = 1; ropek = 1; normk = 1; dst = KB; hh = (c0 - 768) >> 6; nh = 2; }
    else if (c0 < 1024) { kind = 2; ropek = 0; normk = -1; dst = VB; hh = (c0 - 896) >> 6; nh = 2; }
    else if (c0 < 1280) { kind = 0; ropek = 2; normk = -1; dst = QR; hh = (c0 - 1024) >> 6; nh = 4; }
    else if (c0 < 1536) { kind = 1; ropek = 2; normk = -1; scale = 0.125f; dst = KR; hh = (c0 - 1280) >> 6; nh = 4; }
    else { kind = 2; ropek = 0; normk = -1; dst = VR; hh = (c0 - 1536) >> 6; nh = 4; }
    if (!latent) ropek = 0;
    if (kind == 2) {
#pragma unroll
      for (int m = 0; m < 4; ++m) {
        int b, pos;
        row_bpos(r0 + m * 16 + fq * 4, b, pos);
#pragma unroll
        for (int n = 0; n < 4; ++n) {
          int d = n * 16 + fr;
          bf16x4 o = pack4(acc[m][n][0], acc[m][n][1], acc[m][n][2], acc[m][n][3]);
          *(bf16x4*)(dst + ((size_t)(b * nh + hh) * 64 + d) * STOT + pos) = o;
        }
      }
      continue;
    }
    float gq[4] = {1.f, 1.f, 1.f, 1.f};
    if (normk >= 0) {
#pragma unroll
      for (int n = 0; n < 4; ++n) gq[n] = p.qk_g[((size_t)l * 2 + normk) * 64 + n * 16 + fr];
    }
#pragma unroll
    for (int m = 0; m < 4; ++m)
#pragma unroll
      for (int j = 0; j < 4; ++j) {
        int row = r0 + m * 16 + fq * 4 + j;
        float v0 = acc[m][0][j], v1 = acc[m][1][j], v2 = acc[m][2][j], v3 = acc[m][3][j];
        if (normk >= 0) {
          float ss = v0 * v0 + v1 * v1 + v2 * v2 + v3 * v3;
          ss += __shfl_xor(ss, 1); ss += __shfl_xor(ss, 2); ss += __shfl_xor(ss, 4); ss += __shfl_xor(ss, 8);
          float rstd = rsqrtf(ss * (1.f / 64.f) + RMS_EPS);
          v0 *= rstd * gq[0]; v1 *= rstd * gq[1]; v2 *= rstd * gq[2]; v3 *= rstd * gq[3];
        }
        int b, pos;
        row_bpos(row, b, pos);
        if (ropek == 1) {
          float2 cr = roperow[(pos >> 6) * 16 + fr];
          float2 cc = ropecol[(pos & 63) * 16 + fr];
          float o0 = v0 * cr.x - v1 * cr.y, o1 = v1 * cr.x + v0 * cr.y;
          float o2 = v2 * cc.x - v3 * cc.y, o3 = v3 * cc.x + v2 * cc.y;
          v0 = o0; v1 = o1; v2 = o2; v3 = o3;
        } else if (ropek == 2) {
          float2 ca = ropeseq[pos * 32 + fr];
          float2 cb = ropeseq[pos * 32 + 16 + fr];
          float o0 = v0 * ca.x - v2 * ca.y, o2 = v2 * ca.x + v0 * ca.y;
          float o1 = v1 * cb.x - v3 * cb.y, o3 = v3 * cb.x + v1 * cb.y;
          v0 = o0; v1 = o1; v2 = o2; v3 = o3;
        }
        v0 *= scale; v1 *= scale; v2 *= scale; v3 *= scale;
        u16* dp;
        if (kind == 0) dp = dst + (size_t)row * 256 + hh * 64 + fr;
        else dp = dst + ((size_t)(b * nh + hh) * STOT + pos) * 64 + fr;
        dp[0] = f2bf(v0); dp[16] = f2bf(v1); dp[32] = f2bf(v2); dp[48] = f2bf(v3);
      }
  }
}

__device__ __forceinline__ void attn_item(const u16* __restrict__ Q, const u16* __restrict__ Kb, const u16* __restrict__ Vt,
                          u16* __restrict__ concat, int ccol0, int b, int kvh, int qrow0, int qpos0, int t0, int t1,
                          int c0, int c1, bool masked, const float* sink, unsigned char* smem) {
  const int tid = TIDX(), w = tid >> 6, lane = tid & 63, fr = lane & 15, fq = lane >> 4;
  const int head = kvh * 2 + (w & 1);
  const int qoff = (w >> 1) * 32;
  bf16x8 qf[2][2];
#pragma unroll
  for (int qg = 0; qg < 2; ++qg)
#pragma unroll
    for (int ks = 0; ks < 2; ++ks)
      qf[qg][ks] = *(const bf16x8*)(Q + (size_t)(qrow0 + qoff + qg * 16 + fr) * 256 + head * 64 + ks * 32 + fq * 8);
  f32x4 O[2][4];
  float mrow[2], lrow[2];
#pragma unroll
  for (int qg = 0; qg < 2; ++qg) {
    mrow[qg] = -1e30f; lrow[qg] = 0.f;
#pragma unroll
    for (int dt = 0; dt < 4; ++dt) O[qg][dt] = f32x4{0.f, 0.f, 0.f, 0.f};
  }
  const u16* Kbase = Kb + (size_t)(b * 2 + kvh) * STOT * 64;
  const u16* Vbase = Vt + (size_t)(b * 2 + kvh) * 64 * STOT;
  const int n1 = t1 - t0, total = n1 + (c1 - c0);
  bf16x8 kreg[2], vreg[2];
  auto gload = [&](int i) {
    int tile = i < n1 ? t0 + i : c0 + (i - n1);
#pragma unroll
    for (int ps = 0; ps < 2; ++ps) {
      int idx = tid + ps * 256;
      kreg[ps] = *(const bf16x8*)(Kbase + (size_t)tile * 4096 + idx * 8);
      int d = idx >> 3, ch = idx & 7;
      vreg[ps] = *(const bf16x8*)(Vbase + (size_t)d * STOT + tile * 64 + ch * 8);
    }
  };
  auto lstore = [&](int buf) {
    u16* Ks = (u16*)(smem + buf * 18432);
    u16* Vs = Ks + 64 * 72;
#pragma unroll
    for (int ps = 0; ps < 2; ++ps) {
      int idx = tid + ps * 256;
      int r = idx >> 3, ch = idx & 7;
      *(bf16x8*)(Ks + r * 72 + ch * 8) = kreg[ps];
      *(bf16x8*)(Vs + r * 72 + ch * 8) = vreg[ps];
    }
  };
  __syncthreads();
  gload(0);
  lstore(0);
  __syncthreads();
#pragma unroll 1
  for (int i = 0; i < total; ++i) {
    const int tile = i < n1 ? t0 + i : c0 + (i - n1);
    if (i + 1 < total) gload(i + 1);
    const u16* Ks = (const u16*)(smem + (i & 1) * 18432);
    const u16* Vs = Ks + 64 * 72;
    f32x4 s[2][4];
#pragma unroll
    for (int qg = 0; qg < 2; ++qg)
#pragma unroll
      for (int sub = 0; sub < 4; ++sub) s[qg][sub] = f32x4{0.f, 0.f, 0.f, 0.f};
#pragma unroll
    for (int sub = 0; sub < 4; ++sub)
#pragma unroll
      for (int ks = 0; ks < 2; ++ks) {
        bf16x8 a = *(const bf16x8*)(Ks + (sub * 16 + fr) * 72 + ks * 32 + fq * 8);
#pragma unroll
        for (int qg = 0; qg < 2; ++qg) s[qg][sub] = __builtin_amdgcn_mfma_f32_16x16x32_bf16(a, qf[qg][ks], s[qg][sub], 0, 0, 0);
      }
    __builtin_amdgcn_sched_barrier(0);
    const bool domask = masked && (tile < 128);
    bf16x8 pb[2][2];
#pragma unroll
    for (int qg = 0; qg < 2; ++qg) {
      if (domask) {
        int qpos = qpos0 + qoff + qg * 16 + fr;
#pragma unroll
        for (int sub = 0; sub < 4; ++sub)
#pragma unroll
          for (int j = 0; j < 4; ++j) {
            int kpos = tile * 64 + sub * 16 + fq * 4 + j;
            int dd = kpos - qpos;
            if (dd > 128 || dd < -128) s[qg][sub][j] = -INFINITY;
          }
      }
      float mx = -INFINITY;
#pragma unroll
      for (int sub = 0; sub < 4; ++sub)
#pragma unroll
        for (int j = 0; j < 4; ++j) mx = fmaxf(mx, s[qg][sub][j]);
      mx = fmaxf(mx, __shfl_xor(mx, 16));
      mx = fmaxf(mx, __shfl_xor(mx, 32));
      float mnew = fmaxf(mrow[qg], mx);
      float alpha = exp2f((mrow[qg] - mnew) * LOG2E);
      mrow[qg] = mnew;
      float ml = mnew * LOG2E;
      float ps = 0.f;
#pragma unroll
      for (int sub = 0; sub < 4; ++sub)
#pragma unroll
        for (int j = 0; j < 4; ++j) {
          float pv = exp2f(s[qg][sub][j] * LOG2E - ml);
          s[qg][sub][j] = pv;
          ps += pv;
        }
      lrow[qg] = lrow[qg] * alpha + ps;
#pragma unroll
      for (int dt = 0; dt < 4; ++dt) O[qg][dt] *= alpha;
#pragma unroll
      for (int ks = 0; ks < 2; ++ks)
        pb[qg][ks] = cat8(pack4(s[qg][2 * ks][0], s[qg][2 * ks][1], s[qg][2 * ks][2], s[qg][2 * ks][3]),
                          pack4(s[qg][2 * ks + 1][0], s[qg][2 * ks + 1][1], s[qg][2 * ks + 1][2], s[qg][2 * ks + 1][3]));
      __builtin_amdgcn_sched_barrier(0);
    }
#pragma unroll
    for (int dt = 0; dt < 4; ++dt)
#pragma unroll
      for (int ks = 0; ks < 2; ++ks) {
        const u16* vp = Vs + (dt * 16 + fr) * 72 + ks * 32 + fq * 4;
        bf16x8 va = cat8(*(const bf16x4*)vp, *(const bf16x4*)(vp + 16));
#pragma unroll
        for (int qg = 0; qg < 2; ++qg) O[qg][dt] = __builtin_amdgcn_mfma_f32_16x16x32_bf16(va, pb[qg][ks], O[qg][dt], 0, 0, 0);
      }
    __builtin_amdgcn_sched_barrier(0);
    if (i + 1 < total) lstore((i + 1) & 1);
    __syncthreads();
  }
#pragma unroll
  for (int qg = 0; qg < 2; ++qg) {
    float lt = lrow[qg];
    lt += __shfl_xor(lt, 16);
    lt += __shfl_xor(lt, 32);
    if (sink) lt += exp2f((sink[head] - mrow[qg]) * LOG2E);
    float inv = 1.f / lt;
    int row = qrow0 + qoff + qg * 16 + fr;
#pragma unroll
    for (int dt = 0; dt < 4; ++dt) {
      bf16x4 o = pack4(O[qg][dt][0] * inv, O[qg][dt][1] * inv, O[qg][dt][2] * inv, O[qg][dt][3] * inv);
      *(bf16x4*)(concat + (size_t)row * D + ccol0 + head * 64 + dt * 16 + fq * 4) = o;
    }
  }
}

__device__ __forceinline__ float ret_lg(int h) {
  return log2f(1.0f - exp2f(-5.0f - (float)h));
}

__device__ __forceinline__ void retU_item(const Params& p, int bh, int c, unsigned char* smem) {
  const int tid = TIDX();
  const int b = bh >> 2, h = bh & 3;
  const u16* KR = (const u16*)(p.ws + OFF_KR) + (size_t)bh * STOT * 64;
  const u16* VR = (const u16*)(p.ws + OFF_VR) + (size_t)bh * 64 * STOT;
  (void)b;
  const int pos0 = c < 64 ? c * 128 : SEQ + (c - 64) * 128;
  u16* Kc = (u16*)smem;
  u16* Vj = Kc + 128 * 64;
  __syncthreads();
#pragma unroll
  for (int ps = 0; ps < 4; ++ps) {
    int idx = tid + ps * 256;
    *(bf16x8*)(Kc + idx * 8) = *(const bf16x8*)(KR + (size_t)pos0 * 64 + idx * 8);
    int d = idx >> 4, ch = idx & 15;
    bf16x8 v = *(const bf16x8*)(VR + (size_t)d * STOT + pos0 + ch * 8);
#pragma unroll
    for (int e = 0; e < 8; ++e) Vj[(ch * 8 + e) * 72 + d] = (u16)v[e];
  }
  __syncthreads();
  const int dk = tid >> 2, dv0 = (tid & 3) * 16;
  const float lg = ret_lg(h);
  float af[16], ab[16];
#pragma unroll
  for (int q = 0; q < 16; ++q) { af[q] = 0.f; ab[q] = 0.f; }
  for (int j = 0; j < 128; ++j) {
    float kf = bf2f(Kc[j * 64 + dk]);
    float kfw = kf * exp2f(lg * (float)(127 - j));
    float kbw = kf * exp2f(lg * (float)j);
    bf16x8 v0 = *(const bf16x8*)(Vj + j * 72 + dv0);
    bf16x8 v1 = *(const bf16x8*)(Vj + j * 72 + dv0 + 8);
#pragma unroll
    for (int q = 0; q < 8; ++q) {
      float a = bf2f((u16)v0[q]), bb = bf2f((u16)v1[q]);
      af[q] += kfw * a; ab[q] += kbw * a;
      af[8 + q] += kfw * bb; ab[8 + q] += kbw * bb;
    }
  }
  float* U = (float*)(p.ws + OFF_U) + ((size_t)bh * 66 + c) * 2 * 4096;
#pragma unroll
  for (int q = 0; q < 16; ++q) {
    U[(dv0 + q) * 64 + dk] = af[q];
    U[4096 + (dv0 + q) * 64 + dk] = ab[q];
  }
}

__device__ __forceinline__ void phase_attn(const Params& p, int l, unsigned char* smem) {
  const u16* QA = (const u16*)(p.ws + OFF_QA); const u16* QB = (const u16*)(p.ws + OFF_QB);
  const u16* KA = (const u16*)(p.ws + OFF_KA); const u16* VA = (const u16*)(p.ws + OFF_VA);
  const u16* KB = (const u16*)(p.ws + OFF_KB); const u16* VB = (const u16*)(p.ws + OFF_VB);
  u16* concat = (u16*)(p.ws + OFF_H);
  const float* sink = p.attn_sink + l * 4;
  for (int item = BIDX(); item < 2112 + 1056; item += gridDim.x) {
    if (item >= 2112) {
      int it = item - 2112;
      retU_item(p, it / 66, it % 66, smem);
      continue;
    }
    const bool isB = item < 1024 || (item >= 2048 && item < 2080);
    const bool isctx = item >= 2048;
    int it = item < 1024 ? item : item < 2048 ? item - 1024 : item < 2080 ? item - 2048 : item - 2080;
    int qt, kvh, b, qrow0, qpos0, t0, t1;
    if (!isctx) {
      qt = it & 127; kvh = (it >> 7) & 1; b = it >> 8;
      qrow0 = b * SEQ + qt * 64; qpos0 = qt * 64;
      if (isB) { t0 = 0; t1 = 128; }
      else { t0 = qt - 2 < 0 ? 0 : qt - 2; t1 = qt + 3 > 128 ? 128 : qt + 3; }
    } else {
      qt = it & 3; kvh = (it >> 2) & 1; b = it >> 3;
      qrow0 = TLAT + b * CTXL + qt * 64; qpos0 = 0; t0 = 0; t1 = 0;
    }
    attn_item(isB ? QB : QA, isB ? KB : KA, isB ? VB : VA, concat, isB ? 256 : 0, b, kvh, qrow0, qpos0, t0, t1, 128, 132,
              (!isB) && (!isctx), isB ? nullptr : sink, smem);
  }
}

__device__ __forceinline__ void phase_retscan(const Params& p) {
  const float* U = (const float*)(p.ws + OFF_U);
  u16* SP = (u16*)(p.ws + OFF_SP);
  for (int gid = BIDX() * 256 + TIDX(); gid < 16 * 2 * 4096; gid += gridDim.x * 256) {
    int e = gid & 4095, dir = (gid >> 12) & 1, bh = gid >> 13;
    float g128 = exp2f(128.f * ret_lg(bh & 3));
    float S = 0.f;
    for (int n = 0; n < 66; ++n) {
      int c;
      if (dir == 0) c = n < 2 ? 64 + n : n - 2;
      else c = n < 2 ? 65 - n : 65 - n;
      size_t off = (((size_t)bh * 66 + c) * 2 + dir) * 4096 + e;
      SP[off] = f2bf(S);
      S = g128 * S + U[off];
    }
  }
}

__device__ __forceinline__ void retout_item(const Params& p, int l, int bh, int c, unsigned char* smem) {
  const int tid = TIDX(), w = tid >> 6, lane = tid & 63, fr = lane & 15, fq = lane >> 4;
  const int b = bh >> 2, h = bh & 3;
  const u16* QR = (const u16*)(p.ws + OFF_QR);
  const u16* KR = (const u16*)(p.ws + OFF_KR) + (size_t)bh * STOT * 64;
  const u16* VR = (const u16*)(p.ws + OFF_VR) + (size_t)bh * 64 * STOT;
  const u16* SP = (const u16*)(p.ws + OFF_SP) + ((size_t)bh * 66 + c) * 2 * 4096;
  const u16* P2 = (const u16*)(p.ws + OFF_P2);
  u16* concat = (u16*)(p.ws + OFF_H);
  const int pos0 = c < 64 ? c * 128 : SEQ + (c - 64) * 128;
  const int row0 = bpos_row(b, pos0);
  u16* Kc = (u16*)smem;
  u16* Vs = Kc + 128 * 72;
  __syncthreads();
#pragma unroll
  for (int ps = 0; ps < 4; ++ps) {
    int idx = tid + ps * 256;
    int r = idx >> 3, ch = idx & 7;
    *(bf16x8*)(Kc + r * 72 + ch * 8) = *(const bf16x8*)(KR + (size_t)(pos0 + r) * 64 + ch * 8);
    int d = idx >> 4, c16 = idx & 15;
    *(bf16x8*)(Vs + d * 136 + c16 * 8) = *(const bf16x8*)(VR + (size_t)d * STOT + pos0 + c16 * 8);
  }
  __syncthreads();
  const float lg = ret_lg(h);
#pragma unroll 1
  for (int qg = 0; qg < 2; ++qg) {
    const int i = w * 32 + qg * 16 + fr;
    const int row = row0 + i;
    bf16x8 qf[2];
#pragma unroll
    for (int ks = 0; ks < 2; ++ks) qf[ks] = *(const bf16x8*)(QR + (size_t)row * 256 + h * 64 + ks * 32 + fq * 8);
    f32x4 s[8];
#pragma unroll
    for (int sub = 0; sub < 8; ++sub) {
      s[sub] = f32x4{0.f, 0.f, 0.f, 0.f};
#pragma unroll
      for (int ks = 0; ks < 2; ++ks) {
        bf16x8 a = *(const bf16x8*)(Kc + (sub * 16 + fr) * 72 + ks * 32 + fq * 8);
        s[sub] = __builtin_amdgcn_mfma_f32_16x16x32_bf16(a, qf[ks], s[sub], 0, 0, 0);
      }
    }
    float res[4][4];
#pragma unroll
    for (int dt = 0; dt < 4; ++dt)
#pragma unroll
      for (int j = 0; j < 4; ++j) res[dt][j] = 0.f;
#pragma unroll 1
    for (int dir = 0; dir < 2; ++dir) {
      f32x4 O[4];
      const float qw = dir == 0 ? exp2f(lg * (float)(i + 1)) : exp2f(lg * (float)(128 - i));
#pragma unroll
      for (int dt = 0; dt < 4; ++dt) {
        O[dt] = f32x4{0.f, 0.f, 0.f, 0.f};
#pragma unroll
        for (int ks = 0; ks < 2; ++ks) {
          bf16x8 a = *(const bf16x8*)(SP + dir * 4096 + (dt * 16 + fr) * 64 + ks * 32 + fq * 8);
          O[dt] = __builtin_amdgcn_mfma_f32_16x16x32_bf16(a, qf[ks], O[dt], 0, 0, 0);
        }
        O[dt] *= qw;
      }
      int fqo = fq;
      asm volatile("" : "+v"(fqo));
#pragma unroll
      for (int ks = 0; ks < 4; ++ks) {
        float pv[8];
#pragma unroll
        for (int e = 0; e < 8; ++e) {
          const int sub = 2 * ks + (e >> 2), j = e & 3;
          const int jk = sub * 16 + fqo * 4 + j;
          const int dd = dir == 0 ? i - jk : jk - i;
          pv[e] = dd >= 0 ? s[sub][j] * exp2f(lg * (float)dd) : 0.f;
        }
        bf16x8 pb = cat8(pack4(pv[0], pv[1], pv[2], pv[3]), pack4(pv[4], pv[5], pv[6], pv[7]));
#pragma unroll
        for (int dt = 0; dt < 4; ++dt) {
          const u16* vp = Vs + (dt * 16 + fr) * 136 + ks * 32 + fq * 4;
          bf16x8 va = cat8(*(const bf16x4*)vp, *(const bf16x4*)(vp + 16));
          O[dt] = __builtin_amdgcn_mfma_f32_16x16x32_bf16(va, pb, O[dt], 0, 0, 0);
        }
      }
      float sm = 0.f;
#pragma unroll
      for (int dt = 0; dt < 4; ++dt)
#pragma unroll
        for (int j = 0; j < 4; ++j) sm += O[dt][j];
      sm += __shfl_xor(sm, 16); sm += __shfl_xor(sm, 32);
      const float mu = sm * (1.f / 64.f);
      float vs = 0.f;
#pragma unroll
      for (int dt = 0; dt < 4; ++dt)
#pragma unroll
        for (int j = 0; j < 4; ++j) { float dlt = O[dt][j] - mu; vs += dlt * dlt; }
      vs += __shfl_xor(vs, 16); vs += __shfl_xor(vs, 32);
      const float rstd = rsqrtf(vs * (1.f / 64.f) + GN_EPS);
#pragma unroll
      for (int dt = 0; dt < 4; ++dt) {
        const int d = dt * 16 + fq * 4;
        bf16x4 gt = *(const bf16x4*)(P2 + (size_t)row * P2C + dir * 256 + h * 64 + d);
        float4 rg = *(const float4*)(p.ret_g + (size_t)l * 256 + h * 64 + d);
        res[dt][0] += (O[dt][0] - mu) * rstd * rg.x * siluf_(bf2f((u16)gt[0]));
        res[dt][1] += (O[dt][1] - mu) * rstd * rg.y * siluf_(bf2f((u16)gt[1]));
        res[dt][2] += (O[dt][2] - mu) * rstd * rg.z * siluf_(bf2f((u16)gt[2]));
        res[dt][3] += (O[dt][3] - mu) * rstd * rg.w * siluf_(bf2f((u16)gt[3]));
      }
    }
#pragma unroll
    for (int dt = 0; dt < 4; ++dt)
      *(bf16x4*)(concat + (size_t)row * D + 512 + h * 64 + dt * 16 + fq * 4) = pack4(res[dt][0], res[dt][1], res[dt][2], res[dt][3]);
  }
}

__device__ __forceinline__ void phase_retout(const Params& p, int l, unsigned char* smem) {
  for (int item = BIDX(); item < 16 * 66; item += gridDim.x) retout_item(p, l, item / 66, item % 66, smem);
}

__device__ __forceinline__ void phase_wprep(const Params& p, int l, unsigned char* smem) {
  const int tid = TIDX(), lane = tid & 63, h = tid >> 6;
  const u16* P2 = (const u16*)(p.ws + OFF_P2);
  u16* prep = (u16*)(p.ws + OFF_PREP);
  float* twT = (float*)smem;
  float* amT = twT + 64 * 32;
  for (int item = BIDX(); item < (TALL / 32) * 2; item += gridDim.x) {
    const int dir = item & 1, row0 = (item >> 1) * 32;
    const float* mu = p.mu + ((size_t)l * 2 + dir) * 896;
    __syncthreads();
    {
      const int tok = tid >> 3, e0 = (tid & 7) * 8;
      const int row = row0 + tok;
      int b, pos;
      row_bpos(row, b, pos);
      bool has;
      int nrow;
      if (dir == 0) { has = (pos != 0) && (pos != SEQ); nrow = row - 1; }
      else { has = (pos != SEQ - 1) && (pos != STOT - 1); nrow = row + 1; }
      const u16* cw = P2 + (size_t)row * P2C + 1408 + dir * 64 + e0;
      const u16* ca = P2 + (size_t)row * P2C + 1536 + dir * 64 + e0;
      bf16x8 zw = *(const bf16x8*)cw, za = *(const bf16x8*)ca;
      bf16x8 sw = zw, sa = za;
      if (has) {
        sw = *(const bf16x8*)(P2 + (size_t)nrow * P2C + 1408 + dir * 64 + e0);
        sa = *(const bf16x8*)(P2 + (size_t)nrow * P2C + 1536 + dir * 64 + e0);
      }
#pragma unroll
      for (int e = 0; e < 8; ++e) {
        float z = bf2f((u16)zw[e]), zs = has ? bf2f((u16)sw[e]) : 0.f;
        float m = mu[768 + e0 + e];
        twT[(e0 + e) * 32 + tok] = tanhf(z + m * (zs - z));
        float z2 = bf2f((u16)za[e]), zs2 = has ? bf2f((u16)sa[e]) : 0.f;
        float m2 = mu[832 + e0 + e];
        amT[(e0 + e) * 32 + tok] = z2 + m2 * (zs2 - z2);
      }
    }
    __syncthreads();
    const int col = tid;
    float accw[32], acca[32];
#pragma unroll
    for (int t = 0; t < 32; ++t) { accw[t] = 0.f; acca[t] = 0.f; }
    const float* w2 = p.w2 + ((size_t)l * 2 + dir) * 64 * 256 + col;
    const float* a2 = p.a2 + ((size_t)l * 2 + dir) * 64 * 256 + col;
    for (int kq = 0; kq < 64; ++kq) {
      float wv = w2[kq * 256], av = a2[kq * 256];
#pragma unroll
      for (int t4 = 0; t4 < 8; ++t4) {
        float4 a = *(const float4*)(twT + kq * 32 + t4 * 4);
        float4 bq = *(const float4*)(amT + kq * 32 + t4 * 4);
        accw[t4 * 4 + 0] += a.x * wv; accw[t4 * 4 + 1] += a.y * wv; accw[t4 * 4 + 2] += a.z * wv; accw[t4 * 4 + 3] += a.w * wv;
        acca[t4 * 4 + 0] += bq.x * av; acca[t4 * 4 + 1] += bq.y * av; acca[t4 * 4 + 2] += bq.z * av; acca[t4 * 4 + 3] += bq.w * av;
      }
    }
    const float w0v = p.w0[((size_t)l * 2 + dir) * 256 + col], a0v = p.a0[((size_t)l * 2 + dir) * 256 + col];
    const float kkv = p.k_k[(size_t)l * 256 + col], kav = p.k_a[(size_t)l * 256 + col];
    const float mur = mu[col], muk = mu[256 + col], muv = mu[512 + col];
#pragma unroll
    for (int t = 0; t < 32; ++t) {
      const int row = row0 + t;
      int b, pos;
      row_bpos(row, b, pos);
      bool has;
      int nrow;
      if (dir == 0) { has = (pos != 0) && (pos != SEQ); nrow = row - 1; }
      else { has = (pos != SEQ - 1) && (pos != STOT - 1); nrow = row + 1; }
      const u16* cp = P2 + (size_t)row * P2C + 512 + col;
      const u16* np = P2 + (size_t)(has ? nrow : row) * P2C + 512 + col;
      float zr = bf2f(cp[0]), zk = bf2f(cp[256]), zv = bf2f(cp[512]);
      float sr = has ? bf2f(np[0]) : 0.f, sk = has ? bf2f(np[256]) : 0.f, sv = has ? bf2f(np[512]) : 0.f;
      float r = zr + mur * (sr - zr), k = zk + muk * (sk - zk), v = zv + muv * (sv - zv);
      float lw2 = -0.6065306597126334f * sigmoidf_(w0v + accw[t]) * LOG2E;
      float av = sigmoidf_(a0v + acca[t]);
      float kkr = k * kkv;
      float ss = wave_sum(kkr * kkr);
      float kk = kkr / fmaxf(sqrtf(ss), 1e-12f);
      float kt = k * (1.f + (av - 1.f) * kav);
      u16* dp = prep + (((size_t)(b * 4 + h) * 2 + dir) * STOT + pos) * 384 + lane;
      dp[0] = f2bf(lw2); dp[64] = f2bf(kt); dp[128] = f2bf(kk); dp[192] = f2bf(kk * av); dp[256] = f2bf(r); dp[320] = f2bf(v);
    }
  }
}

__device__ __forceinline__ void phase_wscan(const Params& p, unsigned char* smem) {
  const int tid = TIDX(), w = tid >> 6, lane = tid & 63;
  const int jl4 = (lane & 15) * 4, rsub = lane >> 4;
  const u16* prep = (const u16*)(p.ws + OFF_PREP);
  u16* yraw = (u16*)(p.ws + OFF_YRAW);
  float* bufs = (float*)smem;
  for (int item = BIDX(); item < 128; item += gridDim.x) {
    const int rq = item & 3, seq = item >> 2;
    const int dir = seq & 1, h = (seq >> 1) & 3, b = seq >> 3;
    const int irow = rq * 16 + w * 4 + rsub;
    const u16* base = prep + (size_t)seq * STOT * 384;
    uint4 lreg[3];
    auto gload = [&](int ch) {
#pragma unroll
      for (int ps = 0; ps < 3; ++ps) {
        int q = tid + ps * 256;
        int sidx = q / 48, within = q % 48;
        int n = ch * 16 + sidx;
        int pos = dir == 0 ? (n < CTXL ? SEQ + n : n - CTXL) : (STOT - 1 - n);
        lreg[ps] = *(const uint4*)(base + (size_t)pos * 384 + within * 8);
      }
    };
    auto lstore = [&](int buf) {
#pragma unroll
      for (int ps = 0; ps < 3; ++ps) {
        int q = tid + ps * 256;
        int sidx = q / 48, within = q % 48;
        float* dp = bufs + buf * 6144 + sidx * 384 + within * 8;
        uint4 u = lreg[ps];
        float4 lo = make_float4(__uint_as_float(u.x << 16), __uint_as_float(u.x & 0xffff0000u), __uint_as_float(u.y << 16), __uint_as_float(u.y & 0xffff0000u));
        float4 hi = make_float4(__uint_as_float(u.z << 16), __uint_as_float(u.z & 0xffff0000u), __uint_as_float(u.w << 16), __uint_as_float(u.w & 0xffff0000u));
        *(float4*)dp = lo;
        *(float4*)(dp + 4) = hi;
      }
    };
    float S0 = 0.f, S1 = 0.f, S2 = 0.f, S3 = 0.f;
    __syncthreads();
    gload(0);
    lstore(0);
    __syncthreads();
    constexpr int NCH = STOT / 16;
    for (int ch = 0; ch < NCH; ++ch) {
      if (ch + 1 < NCH) gload(ch + 1);
      const float* bp = bufs + (ch & 1) * 6144;
#pragma unroll 4
      for (int s = 0; s < 16; ++s) {
        const float* sp = bp + s * 384;
        float4 lw = *(const float4*)(sp + jl4);
        float4 kt = *(const float4*)(sp + 64 + jl4);
        float4 kk = *(const float4*)(sp + 128 + jl4);
        float4 bb = *(const float4*)(sp + 192 + jl4);
        float4 rr = *(const float4*)(sp + 256 + jl4);
        float v = sp[320 + irow];
        float sa = (S0 * kk.x + S1 * kk.y) + (S2 * kk.z + S3 * kk.w);
        sa = row16_sum(sa);
        float vk0 = v * kt.x, vk1 = v * kt.y, vk2 = v * kt.z, vk3 = v * kt.w;
        S0 = S0 * exp2f(lw.x) + (vk0 - sa * bb.x);
        S1 = S1 * exp2f(lw.y) + (vk1 - sa * bb.y);
        S2 = S2 * exp2f(lw.z) + (vk2 - sa * bb.z);
        S3 = S3 * exp2f(lw.w) + (vk3 - sa * bb.w);
        float y = (S0 * rr.x + S1 * rr.y) + (S2 * rr.z + S3 * rr.w);
        y = row16_sum(y);
        if ((lane & 15) == 0) {
          int n = ch * 16 + s;
          int pos = dir == 0 ? (n < CTXL ? SEQ + n : n - CTXL) : (STOT - 1 - n);
          yraw[((size_t)dir * TALL + bpos_row(b, pos)) * 256 + h * 64 + irow] = f2bf(y);
        }
      }
      if (ch + 1 < NCH) lstore((ch + 1) & 1);
      __syncthreads();
    }
  }
}

__device__ __forceinline__ void phase_wfin(const Params& p, int l, unsigned char* smem) {
  const int tid = TIDX(), lane = tid & 63, h = tid >> 6, col = tid;
  const u16* P2 = (const u16*)(p.ws + OFF_P2);
  const u16* prep = (const u16*)(p.ws + OFF_PREP);
  const u16* yraw = (const u16*)(p.ws + OFF_YRAW);
  u16* concat = (u16*)(p.ws + OFF_H);
  float* sgT = (float*)smem;
  const float lng = p.ln_g[(size_t)l * 256 + col], lnb = p.ln_b[(size_t)l * 256 + col];
  const float rho0 = p.rho[((size_t)l * 2 + 0) * 256 + col], rho1 = p.rho[((size_t)l * 2 + 1) * 256 + col];
  const float* g2 = p.g2 + (size_t)l * 128 * 256 + col;
  for (int item = BIDX(); item < TALL / 16; item += gridDim.x) {
    const int row0 = item * 16;
    __syncthreads();
    {
      const int tok = tid >> 4, k0 = (tid & 15) * 8;
      bf16x8 g = *(const bf16x8*)(P2 + (size_t)(row0 + tok) * P2C + 1280 + k0);
#pragma unroll
      for (int e = 0; e < 8; ++e) sgT[(k0 + e) * 16 + tok] = sigmoidf_(bf2f((u16)g[e]));
    }
    __syncthreads();
    float acc[16];
#pragma unroll
    for (int t = 0; t < 16; ++t) acc[t] = 0.f;
    for (int k = 0; k < 128; ++k) {
      float gv = g2[k * 256];
#pragma unroll
      for (int t4 = 0; t4 < 4; ++t4) {
        float4 a = *(const float4*)(sgT + k * 16 + t4 * 4);
        acc[t4 * 4 + 0] += a.x * gv; acc[t4 * 4 + 1] += a.y * gv; acc[t4 * 4 + 2] += a.z * gv; acc[t4 * 4 + 3] += a.w * gv;
      }
    }
#pragma unroll
    for (int t = 0; t < 16; ++t) {
      const int row = row0 + t;
      int b, pos;
      row_bpos(row, b, pos);
      float tot = 0.f;
#pragma unroll
      for (int dir = 0; dir < 2; ++dir) {
        float y = bf2f(yraw[((size_t)dir * TALL + row) * 256 + col]);
        float mu = wave_sum(y) * (1.f / 64.f);
        float dl = y - mu;
        float var = wave_sum(dl * dl) * (1.f / 64.f);
        float yn = dl * rsqrtf(var + GN_EPS) * lng + lnb;
        const u16* pp = prep + (((size_t)(b * 4 + h) * 2 + dir) * STOT + pos) * 384 + lane;
        float kt = bf2f(pp[64]), r = bf2f(pp[256]), v = bf2f(pp[320]);
        float bs = wave_sum(r * kt * (dir == 0 ? rho0 : rho1));
        tot += yn + bs * v;
      }
      concat[(size_t)row * D + 768 + col] = f2bf(tot * acc[t]);
    }
  }
}

constexpr int N_PHASES = 1 + 2 * 16 + 1;
__device__ __forceinline__ void run_phase(const Params& p, int ph, unsigned char* smem) {
  if (ph == 0) { phase_init(p, smem); return; }
  if (ph == N_PHASES - 1) { phase_final_norm(p); return; }
  const int l = (ph - 1) / 16, s = (ph - 1) % 16;
  float* xc = (float*)(p.ws + OFF_XC);
  const float* lat_in = (l == 0 && s < 3) ? p.x : p.out;
  const float* cx_in = (l == 0 && s < 3) ? p.ctx : xc;
  const u16* H = (const u16*)(p.ws + OFF_H);
  const u16* ACT = (const u16*)(p.ws + OFF_P2);
  switch (s) {
    case 0: phase_norm(p, l, 0, lat_in, cx_in); break;
    case 1: phase_ffn_in(p, l, 0, smem); break;
    case 2: phase_resid_gemm(p, l, ACT, (const u16*)(p.ws + OFF_WFFO) + (size_t)(l * 2 + 0) * 1024 * DFF, DFF, 2, 0.5f, lat_in, cx_in, p.out, xc, smem); break;
    case 3: phase_norm(p, l, 1, p.out, xc); break;
    case 4: phase_inproj(p, l, smem); break;
    case 5: phase_attn(p, l, smem); break;
    case 6: phase_retscan(p); break;
    case 7: phase_retout(p, l, smem); break;
    case 8: phase_wprep(p, l, smem); break;
    case 9: phase_wscan(p, smem); break;
    case 10: phase_wfin(p, l, smem); break;
    case 11: phase_resid_gemm(p, l, H, (const u16*)(p.ws + OFF_WOUT) + (size_t)l * 1024 * 1024, 1024, 5, 1.0f, p.out, xc, p.out, xc, smem); break;
    case 12: phase_norm(p, l, 2, p.out, xc); break;
    case 13: phase_ffn_in(p, l, 1, smem); break;
    case 14: phase_resid_gemm(p, l, ACT, (const u16*)(p.ws + OFF_WFFO) + (size_t)(l * 2 + 1) * 1024 * DFF, DFF, 8, 0.5f, p.out, xc, p.out, xc, smem); break;
    default: break;
  }
}

#if MULTI_LAUNCH
__global__ void __launch_bounds__(256, 2) k_phase(Params p, int ph) {
  __shared__ __attribute__((aligned(16))) unsigned char smem[49152];
  run_phase(p, ph, smem);
}
#else
__global__ void __launch_bounds__(256, 2) k_mega(Params p) {
  __shared__ __attribute__((aligned(16))) unsigned char smem[49152];
  cg::grid_group grid = cg::this_grid();
  run_phase(p, 0, smem);
  grid.sync();
#pragma unroll 1
  for (int l = 0; l < 2; ++l) {
#pragma unroll 1
    for (int s = 0; s < 15; ++s) {
      run_phase(p, 1 + l * 16 + s, smem);
      grid.sync();
    }
  }
  run_phase(p, N_PHASES - 1, smem);
}
#endif

extern "C" void kernel_launch(void* const* d_in, const int* in_sizes, int n_in, void* d_out, int out_size, void* d_ws,
                              size_t ws_size, hipStream_t stream) {
  Params p{};
  const float** pp = (const float**)&p;
  for (int i = 0; i < 26; ++i) pp[i] = (const float*)d_in[i];
  p.out = (float*)d_out;
  p.ws = (unsigned char*)d_ws;
#if MULTI_LAUNCH
  for (int ph = 0; ph < N_PHASES; ++ph) {
    if (ph > 0 && ((ph - 1) % 16) == 15 && ph != N_PHASES - 1) continue;
    k_phase<<<dim3(512), dim3(256), 0, stream>>>(p, ph);
  }
#else
  static int grid_blocks = 0;
  if (!grid_blocks) {
    int dev = 0, cus = 0, per_cu = 0;
    hipGetDevice(&dev);
    hipDeviceGetAttribute(&cus, hipDeviceAttributeMultiprocessorCount, dev);
    hipOccupancyMaxActiveBlocksPerMultiprocessor(&per_cu, k_mega, 256, 0);
    if (per_cu > 2) per_cu = 2;
    grid_blocks = cus * per_cu;
  }
  void* args[] = {&p};
  hipError_t e = hipLaunchCooperativeKernel((void*)k_mega, dim3(grid_blocks), dim3(256), args, 0, stream);
  if (e != hipSuccess) fprintf(stderr, "cooperative launch failed: %s (grid %d)\n", hipGetErrorString(e), grid_blocks);
#endif
}
```

```cpp
#include <hip/hip_runtime.h>
#include <hip/hip_bf16.h>
#include <hip/hip_cooperative_groups.h>
#include <cstdio>
namespace cg = cooperative_groups;

#ifndef MULTI_LAUNCH
#define MULTI_LAUNCH 0
#endif

typedef unsigned short u16;
using bf16x8 = __attribute__((ext_vector_type(8))) short;
using bf16x4 = __attribute__((ext_vector_type(4))) short;
using f32x4 = __attribute__((ext_vector_type(4))) float;

constexpr int D = 1024;
constexpr int TLAT = 32768;
constexpr int TCTX = 1024;
constexpr int TALL = TLAT + TCTX;
constexpr int SEQ = 8192;
constexpr int CTXL = 256;
constexpr int STOT = SEQ + CTXL;
constexpr int DFF = 2816;
constexpr int PC = 3456;
constexpr int P2C = 1664;
constexpr int NMOD = 9 * D;
constexpr float LOG2E = 1.4426950408889634f;
constexpr float RMS_EPS = 1e-6f;
constexpr float GN_EPS = 64e-5f;

constexpr size_t MiB = 1ull << 20;
constexpr size_t OFF_WFFI = 0;
constexpr size_t OFF_WFFO = 44 * MiB;
constexpr size_t OFF_WIN = 66 * MiB;
constexpr size_t OFF_WOUT = OFF_WIN + 27 * MiB / 2;
constexpr size_t OFF_MOD = OFF_WOUT + 4 * MiB;
constexpr size_t OFF_BAR = OFF_MOD + 384 * 1024;
constexpr size_t OFF_ROPE = OFF_MOD + MiB / 2;
constexpr size_t OFF_XC = OFF_ROPE + 5 * MiB / 2;
constexpr size_t OFF_H = OFF_XC + 4 * MiB;
constexpr size_t OFF_P2 = OFF_H + 66 * MiB;
constexpr size_t OFF_BIG = OFF_P2 + 429 * MiB / 4;
constexpr size_t SZ_Q = (size_t)TALL * 256 * 2;
constexpr size_t SZ_KV2 = (size_t)4 * 2 * STOT * 64 * 2;
constexpr size_t SZ_KV4 = (size_t)4 * 4 * STOT * 64 * 2;
constexpr size_t OFF_QA = OFF_BIG;
constexpr size_t OFF_QB = OFF_QA + SZ_Q;
constexpr size_t OFF_QR = OFF_QB + SZ_Q;
constexpr size_t OFF_KA = OFF_QR + SZ_Q;
constexpr size_t OFF_VA = OFF_KA + SZ_KV2;
constexpr size_t OFF_KB = OFF_VA + SZ_KV2;
constexpr size_t OFF_VB = OFF_KB + SZ_KV2;
constexpr size_t OFF_KR = OFF_VB + SZ_KV2;
constexpr size_t OFF_VR = OFF_KR + SZ_KV4;
constexpr size_t OFF_U = OFF_VR + SZ_KV4;
constexpr size_t OFF_SP = OFF_U + (size_t)16 * 66 * 2 * 4096 * 4;
constexpr size_t OFF_PREP = OFF_BIG;
constexpr size_t OFF_YRAW = OFF_PREP + (size_t)32 * STOT * 384 * 2;
constexpr size_t WS_END = OFF_YRAW + (size_t)2 * TALL * 256 * 2;
static_assert(WS_END <= 512 * MiB, "workspace overflow");
static_assert(OFF_SP + (size_t)16 * 66 * 2 * 4096 * 2 <= 512 * MiB, "workspace overflow");
static_assert(OFF_P2 + (size_t)TALL * DFF * 2 <= 512 * MiB, "act overflow");

struct Params {
  const float *x, *c, *ctx, *c_ctx, *w_mod, *b_mod, *norm_g, *ffn_w_in, *ffn_w_out, *w_in, *w_out, *attn_sink, *qk_g,
      *ret_g, *mu, *w0, *w2, *a0, *a2, *rho, *k_k, *k_a, *g2, *ln_g, *ln_b, *final_g;
  float* out;
  unsigned char* ws;
};

__device__ __forceinline__ int TIDX() { int t = threadIdx.x; asm volatile("" : "+v"(t)); return t & 255; }
__device__ __forceinline__ int BIDX() { int t = blockIdx.x; asm volatile("" : "+s"(t)); return t; }
typedef float f32x2_t __attribute__((ext_vector_type(2)));
typedef __bf16 bf16x2_t __attribute__((ext_vector_type(2)));
__device__ __forceinline__ unsigned pk2bf(float a, float b) {
  f32x2_t v = {a, b};
  return __builtin_bit_cast(unsigned, __builtin_convertvector(v, bf16x2_t));
}
__device__ __forceinline__ u16 f2bf(float f) { return (u16)(pk2bf(f, 0.f) & 0xffffu); }
__device__ __forceinline__ float bf2f(u16 h) { return __uint_as_float(((unsigned)h) << 16); }
__device__ __forceinline__ float sigmoidf_(float x) { return 1.f / (1.f + __expf(-x)); }
__device__ __forceinline__ float siluf_(float x) { return x / (1.f + __expf(-x)); }
__device__ __forceinline__ float wave_sum(float v) {
#pragma unroll
  for (int o = 32; o >= 1; o >>= 1) v += __shfl_xor(v, o);
  return v;
}
template <int CTRL>
__device__ __forceinline__ float dpp_f(float x) {
  return __builtin_bit_cast(float, __builtin_amdgcn_update_dpp(0, __builtin_bit_cast(int, x), CTRL, 0xf, 0xf, true));
}
__device__ __forceinline__ float row16_sum(float x) {
  x += dpp_f<0xB1>(x);
  x += dpp_f<0x4E>(x);
  x += dpp_f<0x141>(x);
  x += dpp_f<0x140>(x);
  return x;
}
__device__ __forceinline__ bf16x4 pack4(float a, float b, float c, float d) {
  uint2 u = make_uint2(pk2bf(a, b), pk2bf(c, d));
  return __builtin_bit_cast(bf16x4, u);
}
__device__ __forceinline__ bf16x8 cat8(bf16x4 a, bf16x4 b) {
  bf16x8 r;
  r[0] = a[0]; r[1] = a[1]; r[2] = a[2]; r[3] = a[3]; r[4] = b[0]; r[5] = b[1]; r[6] = b[2]; r[7] = b[3];
  return r;
}
__device__ __forceinline__ const float* rrow(const float* lat, const float* cx, int r) {
  return r < TLAT ? lat + (size_t)r * D : cx + (size_t)(r - TLAT) * D;
}
__device__ __forceinline__ float* wrow(float* lat, float* cx, int r) {
  return r < TLAT ? lat + (size_t)r * D : cx + (size_t)(r - TLAT) * D;
}
__device__ __forceinline__ int mod_index(int r) { return r < TLAT ? (r >> 13) : 4; }
__device__ __forceinline__ void row_bpos(int r, int& b, int& pos) {
  if (r < TLAT) { b = r >> 13; pos = r & 8191; }
  else { int rc = r - TLAT; b = rc >> 8; pos = SEQ + (rc & 255); }
}
__device__ __forceinline__ int bpos_row(int b, int pos) {
  return pos < SEQ ? b * SEQ + pos : TLAT + b * CTXL + (pos - SEQ);
}


#define XB_TMO      128
#define XB_XCNT(j)  (256  + 64 * (j))
#define XB_XSUB(j)  (1280 + 64 * (j))
#define XB_XGEN(j)  (2304 + 64 * (j))
#define XB_TOP      3328
#define XB_TOPGEN   3392
#define XCD_BAR_WORDS 3456
#define XB_SPIN_CAP (1u << 18)
#define LAS __attribute__((address_space(3)))
__device__ __forceinline__ unsigned xb_ld(unsigned* p) { return __hip_atomic_load(p, __ATOMIC_RELAXED, __HIP_MEMORY_SCOPE_AGENT); }
__device__ __forceinline__ unsigned xb_add(unsigned* p, unsigned v) { return __hip_atomic_fetch_add(p, v, __ATOMIC_RELAXED, __HIP_MEMORY_SCOPE_AGENT); }
__device__ __forceinline__ unsigned xb_xcc_id() { return (unsigned)__builtin_amdgcn_s_getreg((3 << 11) | 20) & 0xFu; }
#define XB_SPIN(cond, bar) do { unsigned _sp = 0; while (cond) { __builtin_amdgcn_s_sleep(1); \
    if ((++_sp & 255u) == 0u) { if (xb_ld(&(bar)[XB_TMO])) break; if (_sp > XB_SPIN_CAP) { atomicAdd(&(bar)[XB_TMO], 1u); break; } } } } while (0)
struct XcdBarrier { unsigned* bar; unsigned x; volatile LAS unsigned* st; };
__device__ __forceinline__ XcdBarrier xcd_barrier_post(unsigned* bar, volatile LAS unsigned* st) {
  XcdBarrier b; b.bar = bar; b.x = xb_xcc_id(); b.st = st;
  if (threadIdx.x == 0) (void)xb_add(&bar[XB_XCNT(b.x)], 1u);
  return b;
}
__device__ __forceinline__ void xcd_barrier_complete(unsigned* bar, unsigned x, unsigned& nloc, unsigned& nx) {
  const unsigned G = gridDim.x * gridDim.y * gridDim.z;
  unsigned sum, cnt, mine, sp = 0u;
  for (;;) {
    sum = 0u; cnt = 0u; mine = 0u;
#pragma unroll
    for (unsigned j = 0; j < 16; ++j) { const unsigned c = xb_ld(&bar[XB_XCNT(j)]); sum += c; cnt += (c > 0u) ? 1u : 0u; mine = (j == x) ? c : mine; }
    if (sum == G) break;
    __builtin_amdgcn_s_sleep(1);
    if ((++sp & 255u) == 0u) { if (xb_ld(&bar[XB_TMO])) break; if (sp > XB_SPIN_CAP) { atomicAdd(&bar[XB_TMO], 1u); break; } }
  }
  nloc = mine > 0u ? mine : 1u; nx = cnt > 0u ? cnt : 1u;
}
__device__ __forceinline__ void xcd_barrier(const XcdBarrier& b) {
  asm volatile("s_waitcnt vmcnt(0)" ::: "memory");
  __syncthreads();
  if (threadIdx.x == 0) {
    unsigned* bar = b.bar;
    __builtin_amdgcn_s_waitcnt(0);
    unsigned nloc = b.st[0], nx = b.st[1];
    if (nloc == 0u) { xcd_barrier_complete(bar, b.x, nloc, nx); b.st[0] = nloc; b.st[1] = nx; }
    const unsigned old = xb_add(&bar[XB_XSUB(b.x)], 1u);
    const unsigned gen = old / nloc;
    if (old + 1u == (gen + 1u) * nloc) {
      __builtin_amdgcn_fence(__ATOMIC_RELEASE, "agent");
      asm volatile("s_waitcnt vmcnt(0)" ::: "memory");
      const unsigned og = xb_add(&bar[XB_TOP], 1u);
      const unsigned tg = og / nx;
      if (og + 1u == (tg + 1u) * nx) xb_add(&bar[XB_TOPGEN], 1u);
      else XB_SPIN(xb_ld(&bar[XB_TOPGEN]) == tg, bar);
      __builtin_amdgcn_fence(__ATOMIC_ACQUIRE, "agent");
      xb_add(&bar[XB_XGEN(b.x)], 1u);
      asm volatile("s_waitcnt vmcnt(0)" ::: "memory");
    } else {
      XB_SPIN(xb_ld(&bar[XB_XGEN(b.x)]) == gen, bar);
      __builtin_amdgcn_fence(__ATOMIC_ACQUIRE, "agent");
      asm volatile("s_waitcnt vmcnt(0)" ::: "memory");
    }
  }
  __syncthreads();
}

__device__ __forceinline__ void phase_init(const Params& p, unsigned char* smem) {
  const int tid = TIDX();
  const int nb = gridDim.x, bid = BIDX();
  {
    float2* seq = (float2*)(p.ws + OFF_ROPE);
    float2* rowt = seq + 8192 * 32;
    float2* colt = rowt + 128 * 16;
    for (int i = bid * 256 + tid; i < 8192 * 32 + 128 * 16 + 64 * 16; i += nb * 256) {
      float ang;
      float2* dst;
      if (i < 8192 * 32) {
        int t = i >> 5, k = i & 31;
        float inv = 1.0f / powf(10000.0f, (float)(2 * k) / 64.0f);
        ang = (float)t * inv;
        dst = seq + i;
      } else {
        int j = i - 8192 * 32;
        int pidx = (j < 128 * 16) ? (j >> 4) : ((j - 128 * 16) >> 4);
        int k = j & 15;
        float inv = 1.0f / powf(10000.0f, (float)(2 * k) / 32.0f);
        ang = (float)pidx * inv;
        dst = rowt + j;
      }
      *dst = make_float2(cosf(ang), sinf(ang));
    }
    (void)colt;
  }
  {
    float* sc = (float*)smem;
    float* red = sc + 5 * 1024;
    for (int item = bid; item < 288; item += nb) {
      const int l = item / 144, cb = item % 144;
      __syncthreads();
      for (int i = tid; i < 5 * 1024; i += 256) {
        int m = i >> 10, k = i & 1023;
        float v = (m < 4) ? p.c[m * 1024 + k] : p.c_ctx[k];
        sc[i] = siluf_(v);
      }
      __syncthreads();
      const int cq = tid & 15, kg = tid >> 4;
      float acc[5][4];
#pragma unroll
      for (int m = 0; m < 5; ++m)
#pragma unroll
        for (int q = 0; q < 4; ++q) acc[m][q] = 0.f;
      const float* wbase = p.w_mod + (size_t)l * 1024 * NMOD + cb * 64 + cq * 4;
      for (int kk = 0; kk < 64; ++kk) {
        int k = kg * 64 + kk;
        float4 w4 = *(const float4*)(wbase + (size_t)k * NMOD);
#pragma unroll
        for (int m = 0; m < 5; ++m) {
          float s = sc[m * 1024 + k];
          acc[m][0] += s * w4.x; acc[m][1] += s * w4.y; acc[m][2] += s * w4.z; acc[m][3] += s * w4.w;
        }
      }
#pragma unroll
      for (int m = 0; m < 5; ++m)
#pragma unroll
        for (int q = 0; q < 4; ++q) red[(kg * 5 + m) * 64 + cq * 4 + q] = acc[m][q];
      __syncthreads();
      float* modp = (float*)(p.ws + OFF_MOD);
      for (int o = tid; o < 320; o += 256) {
        int m = o >> 6, cc = o & 63;
        float s = 0.f;
        for (int g = 0; g < 16; ++g) s += red[(g * 5 + m) * 64 + cc];
        int col = cb * 64 + cc;
        modp[((size_t)l * 5 + m) * NMOD + col] = s + p.b_mod[(size_t)l * NMOD + col];
      }
    }
    __syncthreads();
  }
  {
    float* tile = (float*)smem;
    constexpr int N_FFI = 4 * 16 * 88, N_FFO = 4 * 44 * 16, N_WIN = 2 * 16 * 54, N_WOUT = 2 * 16 * 16;
    for (int item = bid; item < N_FFI + N_FFO + N_WIN + N_WOUT; item += nb) {
      const float* src; u16* dst; int K, N, kt, nt; bool perm = false;
      int it = item;
      if (it < N_FFI) {
        int mtx = it / (16 * 88); it %= (16 * 88);
        K = 1024; N = 5632; kt = it / 88; nt = it % 88; perm = true;
        src = p.ffn_w_in + (size_t)mtx * 1024 * 5632;
        dst = (u16*)(p.ws + OFF_WFFI) + (size_t)mtx * 5632 * 1024;
      } else if (it < N_FFI + N_FFO) {
        it -= N_FFI;
        int mtx = it / (44 * 16); it %= (44 * 16);
        K = 2816; N = 1024; kt = it / 16; nt = it % 16;
        src = p.ffn_w_out + (size_t)mtx * 2816 * 1024;
        dst = (u16*)(p.ws + OFF_WFFO) + (size_t)mtx * 1024 * 2816;
      } else if (it < N_FFI + N_FFO + N_WIN) {
        it -= N_FFI + N_FFO;
        int mtx = it / (16 * 54); it %= (16 * 54);
        K = 1024; N = 3456; kt = it / 54; nt = it % 54;
        src = p.w_in + (size_t)mtx * 1024 * 3456;
        dst = (u16*)(p.ws + OFF_WIN) + (size_t)mtx * 3456 * 1024;
      } else {
        it -= N_FFI + N_FFO + N_WIN;
        int mtx = it / 256; it %= 256;
        K = 1024; N = 1024; kt = it / 16; nt = it % 16;
        src = p.w_out + (size_t)mtx * 1024 * 1024;
        dst = (u16*)(p.ws + OFF_WOUT) + (size_t)mtx * 1024 * 1024;
      }
      __syncthreads();
      {
        const int r = tid >> 4, c4 = tid & 15;
        int np = nt * 64 + c4 * 4;
        int scol = np;
        if (perm) {
          int blk = np >> 7, sub = (np & 127) >> 4, i = np & 15;
          scol = ((sub & 1) ? DFF : 0) + blk * 64 + (sub >> 1) * 16 + i;
        }
#pragma unroll
        for (int ps = 0; ps < 4; ++ps) {
          int k = kt * 64 + ps * 16 + r;
          float4 v = *(const float4*)(src + (size_t)k * N + scol);
          float* tp = tile + (ps * 16 + r) * 65 + c4 * 4;
          tp[0] = v.x; tp[1] = v.y; tp[2] = v.z; tp[3] = v.w;
        }
      }
      __syncthreads();
      {
        const int n = tid >> 2, kq = tid & 3;
        bf16x8 o0, o1;
#pragma unroll
        for (int i = 0; i < 8; ++i) {
          o0[i] = (short)f2bf(tile[(kq * 16 + i) * 65 + n]);
          o1[i] = (short)f2bf(tile[(kq * 16 + 8 + i) * 65 + n]);
        }
        u16* dp = dst + (size_t)(nt * 64 + n) * K + kt * 64 + kq * 16;
        *(bf16x8*)dp = o0;
        *(bf16x8*)(dp + 8) = o1;
      }
    }
    __syncthreads();
  }
}

__device__ __forceinline__ void phase_norm(const Params& p, int l, int which, const float* lat, const float* cx) {
  const int lane = TIDX() & 63, wid = TIDX() >> 6;
  u16* h = (u16*)(p.ws + OFF_H);
  const float* g = p.norm_g + ((size_t)l * 3 + which) * D;
  const float* modp = (const float*)(p.ws + OFF_MOD) + (size_t)l * 5 * NMOD;
  for (int r = BIDX() * 4 + wid; r < TALL; r += gridDim.x * 4) {
    const float* xr = rrow(lat, cx, r);
    const float* mp = modp + (size_t)mod_index(r) * NMOD + which * 3 * D;
    float4 v[4];
    float ss = 0.f;
#pragma unroll
    for (int i = 0; i < 4; ++i) {
      v[i] = *(const float4*)(xr + i * 256 + lane * 4);
      ss += v[i].x * v[i].x + v[i].y * v[i].y + v[i].z * v[i].z + v[i].w * v[i].w;
    }
    ss = wave_sum(ss);
    float rstd = rsqrtf(ss * (1.f / 1024.f) + RMS_EPS);
#pragma unroll
    for (int i = 0; i < 4; ++i) {
      int col = i * 256 + lane * 4;
      float4 gg = *(const float4*)(g + col);
      float4 sh = *(const float4*)(mp + col);
      float4 scl = *(const float4*)(mp + D + col);
      bf16x4 o = pack4(v[i].x * rstd * gg.x * (1.f + scl.x) + sh.x, v[i].y * rstd * gg.y * (1.f + scl.y) + sh.y,
                       v[i].z * rstd * gg.z * (1.f + scl.z) + sh.z, v[i].w * rstd * gg.w * (1.f + scl.w) + sh.w);
      *(bf16x4*)(h + (size_t)r * D + col) = o;
    }
  }
}

__device__ __forceinline__ void phase_final_norm(const Params& p) {
  const int lane = TIDX() & 63, wid = TIDX() >> 6;
  for (int r = BIDX() * 4 + wid; r < TLAT; r += gridDim.x * 4) {
    float* xr = p.out + (size_t)r * D;
    float4 v[4];
    float ss = 0.f;
#pragma unroll
    for (int i = 0; i < 4; ++i) {
      v[i] = *(const float4*)(xr + i * 256 + lane * 4);
      ss += v[i].x * v[i].x + v[i].y * v[i].y + v[i].z * v[i].z + v[i].w * v[i].w;
    }
    ss = wave_sum(ss);
    float rstd = rsqrtf(ss * (1.f / 1024.f) + RMS_EPS);
#pragma unroll
    for (int i = 0; i < 4; ++i) {
      int col = i * 256 + lane * 4;
      float4 gg = *(const float4*)(p.final_g + col);
      float4 o = make_float4(v[i].x * rstd * gg.x, v[i].y * rstd * gg.y, v[i].z * rstd * gg.z, v[i].w * rstd * gg.w);
      *(float4*)(xr + col) = o;
    }
  }
}

template <int MI>
__device__ __forceinline__ void gemm_mainloop(const u16* __restrict__ A, const u16* __restrict__ Bt, int K, int brow,
                                              int bcol, f32x4 (&acc)[MI][4], unsigned char* smem) {
  const int tid = TIDX(), wid = tid >> 6, lane = tid & 63, wr = wid >> 1, wc = wid & 1, fr = lane & 15, fq = lane >> 4;
  constexpr int BM = MI * 32;
  constexpr int ACH = BM * 4 / 256;
  constexpr int STAGE = BM * 64 + 8192;
#pragma unroll
  for (int m = 0; m < MI; ++m)
#pragma unroll
    for (int n = 0; n < 4; ++n) acc[m][n] = f32x4{0.f, 0.f, 0.f, 0.f};
  const int nk = K / 32;
  const int prow = tid >> 2, pq = ((tid & 3) ^ ((tid >> 4) & 3)) * 8;
  const u16* ga = A + (size_t)(brow + prow) * K + pq;
  const u16* gb = Bt + (size_t)(bcol + prow) * K + pq;
  auto stage = [&](int t, int buf) {
    unsigned char* base = smem + buf * STAGE;
#pragma unroll
    for (int i = 0; i < ACH; ++i)
      __builtin_amdgcn_global_load_lds((const unsigned*)(ga + (size_t)i * 64 * K + t * 32),
                                       (__attribute__((address_space(3))) unsigned*)(base + (tid + i * 256) * 16), 16, 0, 0);
#pragma unroll
    for (int i = 0; i < 2; ++i)
      __builtin_amdgcn_global_load_lds((const unsigned*)(gb + (size_t)i * 64 * K + t * 32),
                                       (__attribute__((address_space(3))) unsigned*)(base + BM * 64 + (tid + i * 256) * 16), 16, 0, 0);
  };
  const int swz = (fq ^ ((fr >> 2) & 3)) * 16;
  __syncthreads();
  stage(0, 0);
  for (int t = 0; t < nk; ++t) {
    __syncthreads();
    if (t + 1 < nk) stage(t + 1, (t + 1) & 1);
    const unsigned char* base = smem + (t & 1) * STAGE;
    bf16x8 af[MI], bfr[4];
#pragma unroll
    for (int m = 0; m < MI; ++m) af[m] = *(const bf16x8*)(base + (wr * MI * 16 + m * 16 + fr) * 64 + swz);
#pragma unroll
    for (int n = 0; n < 4; ++n) bfr[n] = *(const bf16x8*)(base + BM * 64 + (wc * 64 + n * 16 + fr) * 64 + swz);
#pragma unroll
    for (int m = 0; m < MI; ++m)
#pragma unroll
      for (int n = 0; n < 4; ++n) acc[m][n] = __builtin_amdgcn_mfma_f32_16x16x32_bf16(af[m], bfr[n], acc[m][n], 0, 0, 0);
  }
}

__device__ __forceinline__ void phase_ffn_in(const Params& p, int l, int f, unsigned char* smem) {
  const u16* A = (const u16*)(p.ws + OFF_H);
  const u16* Bt = (const u16*)(p.ws + OFF_WFFI) + (size_t)(l * 2 + f) * 5632 * 1024;
  u16* act = (u16*)(p.ws + OFF_P2);
  const int tid = TIDX(), wid = tid >> 6, lane = tid & 63, wr = wid >> 1, wc = wid & 1, fr = lane & 15, fq = lane >> 4;
  constexpr int MI = 8, NT = 44, MT = TALL / (MI * 32);
  for (int tile = BIDX(); tile < MT * NT; tile += gridDim.x) {
    const int tm = tile / NT, tn = tile % NT;
    f32x4 acc[MI][4];
    gemm_mainloop<MI>(A, Bt, 1024, tm * MI * 32, tn * 128, acc, smem);
#pragma unroll
    for (int m = 0; m < MI; ++m)
#pragma unroll
      for (int q = 0; q < 2; ++q)
#pragma unroll
        for (int j = 0; j < 4; ++j) {
          int row = tm * MI * 32 + wr * MI * 16 + m * 16 + fq * 4 + j;
          int col = tn * 64 + wc * 32 + q * 16 + fr;
          float u1 = acc[m][2 * q][j], u2 = acc[m][2 * q + 1][j];
          act[(size_t)row * DFF + col] = f2bf(siluf_(u1) * u2);
        }
  }
}

__device__ __forceinline__ void phase_resid_gemm(const Params& p, int l, const u16* A, const u16* Bt, int K, int gate, float gscale,
                                 const float* lat_in, const float* cx_in, float* lat_out, float* cx_out,
                                 unsigned char* smem) {
  const int tid = TIDX(), wid = tid >> 6, lane = tid & 63, wr = wid >> 1, wc = wid & 1, fr = lane & 15, fq = lane >> 4;
  constexpr int MI = 6, NT = 8, MT = TALL / (MI * 32);
  const float* modp = (const float*)(p.ws + OFF_MOD) + (size_t)l * 5 * NMOD + gate * D;
  for (int tile = BIDX(); tile < MT * NT; tile += gridDim.x) {
    const int tm = tile / NT, tn = tile % NT;
    f32x4 acc[MI][4];
    gemm_mainloop<MI>(A, Bt, K, tm * MI * 32, tn * 128, acc, smem);
#pragma unroll
    for (int m = 0; m < MI; ++m)
#pragma unroll
      for (int j = 0; j < 4; ++j) {
        int row = tm * MI * 32 + wr * MI * 16 + m * 16 + fq * 4 + j;
        const float* mp = modp + (size_t)mod_index(row) * NMOD;
        const float* xi = rrow(lat_in, cx_in, row);
        float* xo = wrow(lat_out, cx_out, row);
#pragma unroll
        for (int n = 0; n < 4; ++n) {
          int col = tn * 128 + wc * 64 + n * 16 + fr;
          xo[col] = xi[col] + gscale * mp[col] * acc[m][n][j];
        }
      }
  }
}

__device__ __forceinline__ void phase_inproj(const Params& p, int l, unsigned char* smem) {
  const u16* A = (const u16*)(p.ws + OFF_H);
  const u16* Bt = (const u16*)(p.ws + OFF_WIN) + (size_t)l * PC * 1024;
  const int tid = TIDX(), wid = tid >> 6, lane = tid & 63, wr = wid >> 1, wc = wid & 1, fr = lane & 15, fq = lane >> 4;
  constexpr int MI = 8, NT = 27, MT = TALL / (MI * 32);
  const float2* ropeseq = (const float2*)(p.ws + OFF_ROPE);
  const float2* roperow = ropeseq + 8192 * 32;
  const float2* ropecol = roperow + 128 * 16;
  u16* QA = (u16*)(p.ws + OFF_QA); u16* QB = (u16*)(p.ws + OFF_QB); u16* QR = (u16*)(p.ws + OFF_QR);
  u16* KA = (u16*)(p.ws + OFF_KA); u16* VA = (u16*)(p.ws + OFF_VA);
  u16* KB = (u16*)(p.ws + OFF_KB); u16* VB = (u16*)(p.ws + OFF_VB);
  u16* KR = (u16*)(p.ws + OFF_KR); u16* VR = (u16*)(p.ws + OFF_VR);
  u16* P2 = (u16*)(p.ws + OFF_P2);
  for (int tile = BIDX(); tile < MT * NT; tile += gridDim.x) {
    const int tm = tile / NT, tn = tile % NT;
    f32x4 acc[MI][4];
    gemm_mainloop<MI>(A, Bt, 1024, tm * MI * 32, tn * 128, acc, smem);
    const int r0 = tm * MI * 32 + wr * MI * 16;
    const int c0 = tn * 128 + wc * 64;
    const bool latent = r0 < TLAT;
    if (c0 >= 1792) {
#pragma unroll
      for (int m = 0; m < MI; ++m)
#pragma unroll
        for (int n = 0; n < 4; ++n)
#pragma unroll
          for (int j = 0; j < 4; ++j) {
            int row = r0 + m * 16 + fq * 4 + j;
            P2[(size_t)row * P2C + (c0 - 1792) + n * 16 + fr] = f2bf(acc[m][n][j]);
          }
      continue;
    }
    int kind;
    int ropek;
    int normk;
    float scale = 1.f;
    u16* dst; int hh, nh;
    if (c0 < 256) { kind = 0; ropek = 1; normk = -1; scale = 0.125f * LOG2E; dst = QA; hh = c0 >> 6; nh = 4; }
    else if (c0 < 384) { kind = 1; ropek = 1; normk = -1; dst = KA; hh = (c0 - 256) >> 6; nh = 2; }
    else if (c0 < 512) { kind = 2; ropek = 0; normk = -1; dst = VA; hh = (c0 - 384) >> 6; nh = 2; }
    else if (c0 < 768) { kind = 0; ropek = 1; normk = 0; scale = 0.125f * LOG2E; dst = QB; hh = (c0 - 512) >> 6; nh = 4; }
    else if (c0 < 896) { kind = 1; ropek = 1; normk = 1; dst = KB; hh = (c0 - 768) >> 6; nh = 2; }
    else if (c0 < 1024) { kind = 2; ropek = 0; normk = -1; dst = VB; hh = (c0 - 896) >> 6; nh = 2; }
    else if (c0 < 1280) { kind = 0; ropek = 2; normk = -1; dst = QR; hh = (c0 - 1024) >> 6; nh = 4; }
    else if (c0 < 1536) { kind = 1; ropek = 2; normk = -1; scale = 0.125f; dst = KR; hh = (c0 - 1280) >> 6; nh = 4; }
    else { kind = 2; ropek = 0; normk = -1; dst = VR; hh = (c0 - 1536) >> 6; nh = 4; }
    if (!latent) ropek = 0;
    if (kind == 2) {
#pragma unroll
      for (int m = 0; m < MI; ++m) {
        int b, pos;
        row_bpos(r0 + m * 16 + fq * 4, b, pos);
#pragma unroll
        for (int n = 0; n < 4; ++n) {
          int d = n * 16 + fr;
          bf16x4 o = pack4(acc[m][n][0], acc[m][n][1], acc[m][n][2], acc[m][n][3]);
          *(bf16x4*)(dst + ((size_t)(b * nh + hh) * 64 + d) * STOT + pos) = o;
        }
      }
      continue;
    }
    float gq[4] = {1.f, 1.f, 1.f, 1.f};
    if (normk >= 0) {
#pragma unroll
      for (int n = 0; n < 4; ++n) gq[n] = p.qk_g[((size_t)l * 2 + normk) * 64 + n * 16 + fr];
    }
#pragma unroll
    for (int m = 0; m < MI; ++m)
#pragma unroll
      for (int j = 0; j < 4; ++j) {
        int row = r0 + m * 16 + fq * 4 + j;
        float v0 = acc[m][0][j], v1 = acc[m][1][j], v2 = acc[m][2][j], v3 = acc[m][3][j];
        if (normk >= 0) {
          float ss = v0 * v0 + v1 * v1 + v2 * v2 + v3 * v3;
          ss += __shfl_xor(ss, 1); ss += __shfl_xor(ss, 2); ss += __shfl_xor(ss, 4); ss += __shfl_xor(ss, 8);
          float rstd = rsqrtf(ss * (1.f / 64.f) + RMS_EPS);
          v0 *= rstd * gq[0]; v1 *= rstd * gq[1]; v2 *= rstd * gq[2]; v3 *= rstd * gq[3];
        }
        int b, pos;
        row_bpos(row, b, pos);
        if (ropek == 1) {
          float2 cr = roperow[(pos >> 6) * 16 + fr];
          float2 cc = ropecol[(pos & 63) * 16 + fr];
          float o0 = v0 * cr.x - v1 * cr.y, o1 = v1 * cr.x + v0 * cr.y;
          float o2 = v2 * cc.x - v3 * cc.y, o3 = v3 * cc.x + v2 * cc.y;
          v0 = o0; v1 = o1; v2 = o2; v3 = o3;
        } else if (ropek == 2) {
          float2 ca = ropeseq[pos * 32 + fr];
          float2 cb = ropeseq[pos * 32 + 16 + fr];
          float o0 = v0 * ca.x - v2 * ca.y, o2 = v2 * ca.x + v0 * ca.y;
          float o1 = v1 * cb.x - v3 * cb.y, o3 = v3 * cb.x + v1 * cb.y;
          v0 = o0; v1 = o1; v2 = o2; v3 = o3;
        }
        v0 *= scale; v1 *= scale; v2 *= scale; v3 *= scale;
        u16* dp;
        if (kind == 0) dp = dst + (size_t)row * 256 + hh * 64 + fr;
        else dp = dst + ((size_t)(b * nh + hh) * STOT + pos) * 64 + fr;
        dp[0] = f2bf(v0); dp[16] = f2bf(v1); dp[32] = f2bf(v2); dp[48] = f2bf(v3);
      }
  }
}

__device__ __forceinline__ void attn_item(const u16* __restrict__ Q, const u16* __restrict__ Kb, const u16* __restrict__ Vt,
                          u16* __restrict__ concat, int ccol0, int b, int kvh, int qrow0, int qpos0, int t0, int t1,
                          int c0, int c1, bool masked, const float* sink, unsigned char* smem) {
  const int tid = TIDX(), w = tid >> 6, lane = tid & 63, fr = lane & 15, fq = lane >> 4;
  const int head = kvh * 2 + (w & 1);
  const int qoff = (w >> 1) * 32;
  bf16x8 qf[2][2];
#pragma unroll
  for (int qg = 0; qg < 2; ++qg)
#pragma unroll
    for (int ks = 0; ks < 2; ++ks)
      qf[qg][ks] = *(const bf16x8*)(Q + (size_t)(qrow0 + qoff + qg * 16 + fr) * 256 + head * 64 + ks * 32 + fq * 8);
  f32x4 O[2][4];
  float mrow[2], lrow[2];
#pragma unroll
  for (int qg = 0; qg < 2; ++qg) {
    mrow[qg] = -1e30f; lrow[qg] = 0.f;
#pragma unroll
    for (int dt = 0; dt < 4; ++dt) O[qg][dt] = f32x4{0.f, 0.f, 0.f, 0.f};
  }
  const u16* Kbase = Kb + (size_t)(b * 2 + kvh) * STOT * 64;
  const u16* Vbase = Vt + (size_t)(b * 2 + kvh) * 64 * STOT;
  const int n1 = t1 - t0, total = n1 + (c1 - c0);
  bf16x8 kreg[2], vreg[2];
  auto gload = [&](int i) {
    int tile = i < n1 ? t0 + i : c0 + (i - n1);
#pragma unroll
    for (int ps = 0; ps < 2; ++ps) {
      int idx = tid + ps * 256;
      kreg[ps] = *(const bf16x8*)(Kbase + (size_t)tile * 4096 + idx * 8);
      int d = idx >> 3, ch = idx & 7;
      vreg[ps] = *(const bf16x8*)(Vbase + (size_t)d * STOT + tile * 64 + ch * 8);
    }
  };
  auto lstore = [&](int buf) {
    u16* Ks = (u16*)(smem + buf * 18432);
    u16* Vs = Ks + 64 * 72;
#pragma unroll
    for (int ps = 0; ps < 2; ++ps) {
      int idx = tid + ps * 256;
      int r = idx >> 3, ch = idx & 7;
      *(bf16x8*)(Ks + r * 72 + ch * 8) = kreg[ps];
      *(bf16x8*)(Vs + r * 72 + ch * 8) = vreg[ps];
    }
  };
  __syncthreads();
  gload(0);
  lstore(0);
  __syncthreads();
#pragma unroll 1
  for (int i = 0; i < total; ++i) {
    const int tile = i < n1 ? t0 + i : c0 + (i - n1);
    if (i + 1 < total) gload(i + 1);
    const u16* Ks = (const u16*)(smem + (i & 1) * 18432);
    const u16* Vs = Ks + 64 * 72;
    f32x4 s[2][4];
#pragma unroll
    for (int qg = 0; qg < 2; ++qg)
#pragma unroll
      for (int sub = 0; sub < 4; ++sub) s[qg][sub] = f32x4{0.f, 0.f, 0.f, 0.f};
#pragma unroll
    for (int sub = 0; sub < 4; ++sub)
#pragma unroll
      for (int ks = 0; ks < 2; ++ks) {
        bf16x8 a = *(const bf16x8*)(Ks + (sub * 16 + fr) * 72 + ks * 32 + fq * 8);
#pragma unroll
        for (int qg = 0; qg < 2; ++qg) s[qg][sub] = __builtin_amdgcn_mfma_f32_16x16x32_bf16(a, qf[qg][ks], s[qg][sub], 0, 0, 0);
      }
    __builtin_amdgcn_sched_barrier(0);
    const bool domask = masked && (tile < 128);
    bf16x8 pb[2][2];
#pragma unroll
    for (int qg = 0; qg < 2; ++qg) {
      if (domask) {
        int qpos = qpos0 + qoff + qg * 16 + fr;
#pragma unroll
        for (int sub = 0; sub < 4; ++sub)
#pragma unroll
          for (int j = 0; j < 4; ++j) {
            int kpos = tile * 64 + sub * 16 + fq * 4 + j;
            int dd = kpos - qpos;
            if (dd > 128 || dd < -128) s[qg][sub][j] = -INFINITY;
          }
      }
      float mx = -INFINITY;
#pragma unroll
      for (int sub = 0; sub < 4; ++sub)
#pragma unroll
        for (int j = 0; j < 4; ++j) mx = fmaxf(mx, s[qg][sub][j]);
      mx = fmaxf(mx, __shfl_xor(mx, 16));
      mx = fmaxf(mx, __shfl_xor(mx, 32));
      float mnew = fmaxf(mrow[qg], mx);
      const bool changed = mnew > mrow[qg];
      float alpha = __builtin_amdgcn_exp2f(mrow[qg] - mnew);
      mrow[qg] = mnew;
      float ps = 0.f;
#pragma unroll
      for (int sub = 0; sub < 4; ++sub)
#pragma unroll
        for (int j = 0; j < 4; ++j) {
          float pv = __builtin_amdgcn_exp2f(s[qg][sub][j] - mnew);
          s[qg][sub][j] = pv;
          ps += pv;
        }
      lrow[qg] = lrow[qg] * alpha + ps;
      if (__builtin_amdgcn_ballot_w64(changed) != 0ull) {
#pragma unroll
        for (int dt = 0; dt < 4; ++dt) O[qg][dt] *= alpha;
      }
#pragma unroll
      for (int ks = 0; ks < 2; ++ks)
        pb[qg][ks] = cat8(pack4(s[qg][2 * ks][0], s[qg][2 * ks][1], s[qg][2 * ks][2], s[qg][2 * ks][3]),
                          pack4(s[qg][2 * ks + 1][0], s[qg][2 * ks + 1][1], s[qg][2 * ks + 1][2], s[qg][2 * ks + 1][3]));
      __builtin_amdgcn_sched_barrier(0);
    }
#pragma unroll
    for (int dt = 0; dt < 4; ++dt)
#pragma unroll
      for (int ks = 0; ks < 2; ++ks) {
        const u16* vp = Vs + (dt * 16 + fr) * 72 + ks * 32 + fq * 4;
        bf16x8 va = cat8(*(const bf16x4*)vp, *(const bf16x4*)(vp + 16));
#pragma unroll
        for (int qg = 0; qg < 2; ++qg) O[qg][dt] = __builtin_amdgcn_mfma_f32_16x16x32_bf16(va, pb[qg][ks], O[qg][dt], 0, 0, 0);
      }
    __builtin_amdgcn_sched_barrier(0);
    if (i + 1 < total) lstore((i + 1) & 1);
    __syncthreads();
  }
#pragma unroll
  for (int qg = 0; qg < 2; ++qg) {
    float lt = lrow[qg];
    lt += __shfl_xor(lt, 16);
    lt += __shfl_xor(lt, 32);
    if (sink) lt += __builtin_amdgcn_exp2f(sink[head] * LOG2E - mrow[qg]);
    float inv = 1.f / lt;
    int row = qrow0 + qoff + qg * 16 + fr;
#pragma unroll
    for (int dt = 0; dt < 4; ++dt) {
      bf16x4 o = pack4(O[qg][dt][0] * inv, O[qg][dt][1] * inv, O[qg][dt][2] * inv, O[qg][dt][3] * inv);
      *(bf16x4*)(concat + (size_t)row * D + ccol0 + head * 64 + dt * 16 + fq * 4) = o;
    }
  }
}

__device__ __forceinline__ float ret_lg(int h) {
  return log2f(1.0f - exp2f(-5.0f - (float)h));
}

__device__ __forceinline__ void retU_item(const Params& p, int bh, int c, unsigned char* smem) {
  const int tid = TIDX();
  const int b = bh >> 2, h = bh & 3;
  const u16* KR = (const u16*)(p.ws + OFF_KR) + (size_t)bh * STOT * 64;
  const u16* VR = (const u16*)(p.ws + OFF_VR) + (size_t)bh * 64 * STOT;
  (void)b;
  const int pos0 = c < 64 ? c * 128 : SEQ + (c - 64) * 128;
  u16* Kc = (u16*)smem;
  u16* Vj = Kc + 128 * 64;
  __syncthreads();
#pragma unroll
  for (int ps = 0; ps < 4; ++ps) {
    int idx = tid + ps * 256;
    *(bf16x8*)(Kc + idx * 8) = *(const bf16x8*)(KR + (size_t)pos0 * 64 + idx * 8);
    int d = idx >> 4, ch = idx & 15;
    bf16x8 v = *(const bf16x8*)(VR + (size_t)d * STOT + pos0 + ch * 8);
#pragma unroll
    for (int e = 0; e < 8; ++e) Vj[(ch * 8 + e) * 72 + d] = (u16)v[e];
  }
  __syncthreads();
  const int dk = tid >> 2, dv0 = (tid & 3) * 16;
  const float lg = ret_lg(h);
  float af[16], ab[16];
#pragma unroll
  for (int q = 0; q < 16; ++q) { af[q] = 0.f; ab[q] = 0.f; }
  for (int j = 0; j < 128; ++j) {
    float kf = bf2f(Kc[j * 64 + dk]);
    float kfw = kf * exp2f(lg * (float)(127 - j));
    float kbw = kf * exp2f(lg * (float)j);
    bf16x8 v0 = *(const bf16x8*)(Vj + j * 72 + dv0);
    bf16x8 v1 = *(const bf16x8*)(Vj + j * 72 + dv0 + 8);
#pragma unroll
    for (int q = 0; q < 8; ++q) {
      float a = bf2f((u16)v0[q]), bb = bf2f((u16)v1[q]);
      af[q] += kfw * a; ab[q] += kbw * a;
      af[8 + q] += kfw * bb; ab[8 + q] += kbw * bb;
    }
  }
  float* U = (float*)(p.ws + OFF_U) + ((size_t)bh * 66 + c) * 2 * 4096;
#pragma unroll
  for (int q = 0; q < 16; ++q) {
    U[(dv0 + q) * 64 + dk] = af[q];
    U[4096 + (dv0 + q) * 64 + dk] = ab[q];
  }
}

__device__ __forceinline__ void phase_attn(const Params& p, int l, unsigned char* smem) {
  const u16* QA = (const u16*)(p.ws + OFF_QA); const u16* QB = (const u16*)(p.ws + OFF_QB);
  const u16* KA = (const u16*)(p.ws + OFF_KA); const u16* VA = (const u16*)(p.ws + OFF_VA);
  const u16* KB = (const u16*)(p.ws + OFF_KB); const u16* VB = (const u16*)(p.ws + OFF_VB);
  u16* concat = (u16*)(p.ws + OFF_H);
  const float* sink = p.attn_sink + l * 4;
  for (int item = BIDX(); item < 2112 + 1056; item += gridDim.x) {
    if (item >= 2112) {
      int it = item - 2112;
      retU_item(p, it / 66, it % 66, smem);
      continue;
    }
    const bool isB = item < 1024 || (item >= 2048 && item < 2080);
    const bool isctx = item >= 2048;
    int it = item < 1024 ? item : item < 2048 ? item - 1024 : item < 2080 ? item - 2048 : item - 2080;
    int qt, kvh, b, qrow0, qpos0, t0, t1;
    if (!isctx) {
      qt = it & 127; kvh = (it >> 7) & 1; b = it >> 8;
      qrow0 = b * SEQ + qt * 64; qpos0 = qt * 64;
      if (isB) { t0 = 0; t1 = 128; }
      else { t0 = qt - 2 < 0 ? 0 : qt - 2; t1 = qt + 3 > 128 ? 128 : qt + 3; }
    } else {
      qt = it & 3; kvh = (it >> 2) & 1; b = it >> 3;
      qrow0 = TLAT + b * CTXL + qt * 64; qpos0 = 0; t0 = 0; t1 = 0;
    }
    attn_item(isB ? QB : QA, isB ? KB : KA, isB ? VB : VA, concat, isB ? 256 : 0, b, kvh, qrow0, qpos0, t0, t1, 128, 132,
              (!isB) && (!isctx), isB ? nullptr : sink, smem);
  }
}

__device__ __forceinline__ void phase_retscan(const Params& p) {
  const float* U = (const float*)(p.ws + OFF_U);
  u16* SP = (u16*)(p.ws + OFF_SP);
  for (int gid = BIDX() * 256 + TIDX(); gid < 16 * 2 * 4096; gid += gridDim.x * 256) {
    int e = gid & 4095, dir = (gid >> 12) & 1, bh = gid >> 13;
    float g128 = exp2f(128.f * ret_lg(bh & 3));
    float S = 0.f;
#pragma unroll 1
    for (int n0 = 0; n0 < 66; n0 += 11) {
      float u[11];
      size_t offs[11];
#pragma unroll
      for (int k = 0; k < 11; ++k) {
        int n = n0 + k;
        int c = dir == 0 ? (n < 2 ? 64 + n : n - 2) : 65 - n;
        offs[k] = (((size_t)bh * 66 + c) * 2 + dir) * 4096 + e;
        u[k] = U[offs[k]];
      }
#pragma unroll
      for (int k = 0; k < 11; ++k) {
        SP[offs[k]] = f2bf(S);
        S = g128 * S + u[k];
      }
    }
  }
}

__device__ __forceinline__ void retout_item(const Params& p, int l, int bh, int c, unsigned char* smem) {
  const int tid = TIDX(), w = tid >> 6, lane = tid & 63, fr = lane & 15, fq = lane >> 4;
  const int b = bh >> 2, h = bh & 3;
  const u16* QR = (const u16*)(p.ws + OFF_QR);
  const u16* KR = (const u16*)(p.ws + OFF_KR) + (size_t)bh * STOT * 64;
  const u16* VR = (const u16*)(p.ws + OFF_VR) + (size_t)bh * 64 * STOT;
  const u16* SP = (const u16*)(p.ws + OFF_SP) + ((size_t)bh * 66 + c) * 2 * 4096;
  const u16* P2 = (const u16*)(p.ws + OFF_P2);
  u16* concat = (u16*)(p.ws + OFF_H);
  const int pos0 = c < 64 ? c * 128 : SEQ + (c - 64) * 128;
  const int row0 = bpos_row(b, pos0);
  u16* Kc = (u16*)smem;
  u16* Vs = Kc + 128 * 72;
  __syncthreads();
#pragma unroll
  for (int ps = 0; ps < 4; ++ps) {
    int idx = tid + ps * 256;
    int r = idx >> 3, ch = idx & 7;
    *(bf16x8*)(Kc + r * 72 + ch * 8) = *(const bf16x8*)(KR + (size_t)(pos0 + r) * 64 + ch * 8);
    int d = idx >> 4, c16 = idx & 15;
    *(bf16x8*)(Vs + d * 136 + c16 * 8) = *(const bf16x8*)(VR + (size_t)d * STOT + pos0 + c16 * 8);
  }
  __syncthreads();
  const float lg = ret_lg(h);
#pragma unroll 1
  for (int qg = 0; qg < 2; ++qg) {
    const int i = w * 32 + qg * 16 + fr;
    const int row = row0 + i;
    bf16x8 qf[2];
#pragma unroll
    for (int ks = 0; ks < 2; ++ks) qf[ks] = *(const bf16x8*)(QR + (size_t)row * 256 + h * 64 + ks * 32 + fq * 8);
    f32x4 s[8];
#pragma unroll
    for (int sub = 0; sub < 8; ++sub) {
      s[sub] = f32x4{0.f, 0.f, 0.f, 0.f};
#pragma unroll
      for (int ks = 0; ks < 2; ++ks) {
        bf16x8 a = *(const bf16x8*)(Kc + (sub * 16 + fr) * 72 + ks * 32 + fq * 8);
        s[sub] = __builtin_amdgcn_mfma_f32_16x16x32_bf16(a, qf[ks], s[sub], 0, 0, 0);
      }
    }
    float res[4][4];
#pragma unroll
    for (int dt = 0; dt < 4; ++dt)
#pragma unroll
      for (int j = 0; j < 4; ++j) res[dt][j] = 0.f;
#pragma unroll 1
    for (int dir = 0; dir < 2; ++dir) {
      f32x4 O[4];
      const float qw = dir == 0 ? __builtin_amdgcn_exp2f(lg * (float)(i + 1)) : __builtin_amdgcn_exp2f(lg * (float)(128 - i));
#pragma unroll
      for (int dt = 0; dt < 4; ++dt) {
        O[dt] = f32x4{0.f, 0.f, 0.f, 0.f};
#pragma unroll
        for (int ks = 0; ks < 2; ++ks) {
          bf16x8 a = *(const bf16x8*)(SP + dir * 4096 + (dt * 16 + fr) * 64 + ks * 32 + fq * 8);
          O[dt] = __builtin_amdgcn_mfma_f32_16x16x32_bf16(a, qf[ks], O[dt], 0, 0, 0);
        }
        O[dt] *= qw;
      }
      int fqo = fq;
      asm volatile("" : "+v"(fqo));
#pragma unroll
      for (int ks = 0; ks < 4; ++ks) {
        float pv[8];
#pragma unroll
        for (int e = 0; e < 8; ++e) {
          const int sub = 2 * ks + (e >> 2), j = e & 3;
          const int jk = sub * 16 + fqo * 4 + j;
          const int dd = dir == 0 ? i - jk : jk - i;
          pv[e] = dd >= 0 ? s[sub][j] * __builtin_amdgcn_exp2f(lg * (float)dd) : 0.f;
        }
        bf16x8 pb = cat8(pack4(pv[0], pv[1], pv[2], pv[3]), pack4(pv[4], pv[5], pv[6], pv[7]));
#pragma unroll
        for (int dt = 0; dt < 4; ++dt) {
          const u16* vp = Vs + (dt * 16 + fr) * 136 + ks * 32 + fq * 4;
          bf16x8 va = cat8(*(const bf16x4*)vp, *(const bf16x4*)(vp + 16));
          O[dt] = __builtin_amdgcn_mfma_f32_16x16x32_bf16(va, pb, O[dt], 0, 0, 0);
        }
      }
      float sm = 0.f;
#pragma unroll
      for (int dt = 0; dt < 4; ++dt)
#pragma unroll
        for (int j = 0; j < 4; ++j) sm += O[dt][j];
      sm += __shfl_xor(sm, 16); sm += __shfl_xor(sm, 32);
      const float mu = sm * (1.f / 64.f);
      float vs = 0.f;
#pragma unroll
      for (int dt = 0; dt < 4; ++dt)
#pragma unroll
        for (int j = 0; j < 4; ++j) { float dlt = O[dt][j] - mu; vs += dlt * dlt; }
      vs += __shfl_xor(vs, 16); vs += __shfl_xor(vs, 32);
      const float rstd = rsqrtf(vs * (1.f / 64.f) + GN_EPS);
#pragma unroll
      for (int dt = 0; dt < 4; ++dt) {
        const int d = dt * 16 + fq * 4;
        bf16x4 gt = *(const bf16x4*)(P2 + (size_t)row * P2C + dir * 256 + h * 64 + d);
        float4 rg = *(const float4*)(p.ret_g + (size_t)l * 256 + h * 64 + d);
        res[dt][0] += (O[dt][0] - mu) * rstd * rg.x * siluf_(bf2f((u16)gt[0]));
        res[dt][1] += (O[dt][1] - mu) * rstd * rg.y * siluf_(bf2f((u16)gt[1]));
        res[dt][2] += (O[dt][2] - mu) * rstd * rg.z * siluf_(bf2f((u16)gt[2]));
        res[dt][3] += (O[dt][3] - mu) * rstd * rg.w * siluf_(bf2f((u16)gt[3]));
      }
    }
#pragma unroll
    for (int dt = 0; dt < 4; ++dt)
      *(bf16x4*)(concat + (size_t)row * D + 512 + h * 64 + dt * 16 + fq * 4) = pack4(res[dt][0], res[dt][1], res[dt][2], res[dt][3]);
  }
}

__device__ __forceinline__ void phase_retout(const Params& p, int l, unsigned char* smem) {
  for (int item = BIDX(); item < 16 * 66; item += gridDim.x) retout_item(p, l, item / 66, item % 66, smem);
}

__device__ __forceinline__ void phase_wprep(const Params& p, int l, unsigned char* smem) {
  const int tid = TIDX(), lane = tid & 63, h = tid >> 6;
  const u16* P2 = (const u16*)(p.ws + OFF_P2);
  u16* prep = (u16*)(p.ws + OFF_PREP);
  float* twT = (float*)smem;
  float* amT = twT + 64 * 32;
  for (int item = BIDX(); item < (TALL / 32) * 2; item += gridDim.x) {
    const int dir = item & 1, row0 = (item >> 1) * 32;
    const float* mu = p.mu + ((size_t)l * 2 + dir) * 896;
    __syncthreads();
    {
      const int tok = tid >> 3, e0 = (tid & 7) * 8;
      const int row = row0 + tok;
      int b, pos;
      row_bpos(row, b, pos);
      bool has;
      int nrow;
      if (dir == 0) { has = (pos != 0) && (pos != SEQ); nrow = row - 1; }
      else { has = (pos != SEQ - 1) && (pos != STOT - 1); nrow = row + 1; }
      const u16* cw = P2 + (size_t)row * P2C + 1408 + dir * 64 + e0;
      const u16* ca = P2 + (size_t)row * P2C + 1536 + dir * 64 + e0;
      bf16x8 zw = *(const bf16x8*)cw, za = *(const bf16x8*)ca;
      bf16x8 sw = zw, sa = za;
      if (has) {
        sw = *(const bf16x8*)(P2 + (size_t)nrow * P2C + 1408 + dir * 64 + e0);
        sa = *(const bf16x8*)(P2 + (size_t)nrow * P2C + 1536 + dir * 64 + e0);
      }
#pragma unroll
      for (int e = 0; e < 8; ++e) {
        float z = bf2f((u16)zw[e]), zs = has ? bf2f((u16)sw[e]) : 0.f;
        float m = mu[768 + e0 + e];
        twT[(e0 + e) * 32 + tok] = tanhf(z + m * (zs - z));
        float z2 = bf2f((u16)za[e]), zs2 = has ? bf2f((u16)sa[e]) : 0.f;
        float m2 = mu[832 + e0 + e];
        amT[(e0 + e) * 32 + tok] = z2 + m2 * (zs2 - z2);
      }
    }
    __syncthreads();
    const int col = tid;
    float accw[32], acca[32];
#pragma unroll
    for (int t = 0; t < 32; ++t) { accw[t] = 0.f; acca[t] = 0.f; }
    const float* w2 = p.w2 + ((size_t)l * 2 + dir) * 64 * 256 + col;
    const float* a2 = p.a2 + ((size_t)l * 2 + dir) * 64 * 256 + col;
    for (int kq = 0; kq < 64; ++kq) {
      float wv = w2[kq * 256], av = a2[kq * 256];
#pragma unroll
      for (int t4 = 0; t4 < 8; ++t4) {
        float4 a = *(const float4*)(twT + kq * 32 + t4 * 4);
        float4 bq = *(const float4*)(amT + kq * 32 + t4 * 4);
        accw[t4 * 4 + 0] += a.x * wv; accw[t4 * 4 + 1] += a.y * wv; accw[t4 * 4 + 2] += a.z * wv; accw[t4 * 4 + 3] += a.w * wv;
        acca[t4 * 4 + 0] += bq.x * av; acca[t4 * 4 + 1] += bq.y * av; acca[t4 * 4 + 2] += bq.z * av; acca[t4 * 4 + 3] += bq.w * av;
      }
    }
    const float w0v = p.w0[((size_t)l * 2 + dir) * 256 + col], a0v = p.a0[((size_t)l * 2 + dir) * 256 + col];
    const float kkv = p.k_k[(size_t)l * 256 + col], kav = p.k_a[(size_t)l * 256 + col];
    const float mur = mu[col], muk = mu[256 + col], muv = mu[512 + col];
#pragma unroll
    for (int t = 0; t < 32; ++t) {
      const int row = row0 + t;
      int b, pos;
      row_bpos(row, b, pos);
      bool has;
      int nrow;
      if (dir == 0) { has = (pos != 0) && (pos != SEQ); nrow = row - 1; }
      else { has = (pos != SEQ - 1) && (pos != STOT - 1); nrow = row + 1; }
      const u16* cp = P2 + (size_t)row * P2C + 512 + col;
      const u16* np = P2 + (size_t)(has ? nrow : row) * P2C + 512 + col;
      float zr = bf2f(cp[0]), zk = bf2f(cp[256]), zv = bf2f(cp[512]);
      float sr = has ? bf2f(np[0]) : 0.f, sk = has ? bf2f(np[256]) : 0.f, sv = has ? bf2f(np[512]) : 0.f;
      float r = zr + mur * (sr - zr), k = zk + muk * (sk - zk), v = zv + muv * (sv - zv);
      float lw2 = -0.6065306597126334f * sigmoidf_(w0v + accw[t]) * LOG2E;
      float av = sigmoidf_(a0v + acca[t]);
      float kkr = k * kkv;
      float ss = wave_sum(kkr * kkr);
      float kk = kkr / fmaxf(sqrtf(ss), 1e-12f);
      float kt = k * (1.f + (av - 1.f) * kav);
      u16* dp = prep + (((size_t)(b * 4 + h) * 2 + dir) * STOT + pos) * 384 + lane;
      dp[0] = f2bf(lw2); dp[64] = f2bf(kt); dp[128] = f2bf(kk); dp[192] = f2bf(kk * av); dp[256] = f2bf(r); dp[320] = f2bf(v);
    }
  }
}

typedef float f32x2 __attribute__((ext_vector_type(2)));
__device__ __forceinline__ void phase_wscan(const Params& p, unsigned char* smem) {
  const int tid = TIDX(), w = tid >> 6, lane = tid & 63;
  const int jl4 = (lane & 15) * 4, rsub = lane >> 4;
  const u16* prep = (const u16*)(p.ws + OFF_PREP);
  u16* yraw = (u16*)(p.ws + OFF_YRAW);
  float* bufs = (float*)smem;
  for (int item = BIDX(); item < 128; item += gridDim.x) {
    const int rq = item & 3, seq = item >> 2;
    const int dir = seq & 1, h = (seq >> 1) & 3, b = seq >> 3;
    const int irow = rq * 16 + w * 4 + rsub;
    const u16* base = prep + (size_t)seq * STOT * 384;
    uint4 lreg[3];
    auto gload = [&](int ch) {
#pragma unroll
      for (int ps = 0; ps < 3; ++ps) {
        int q = tid + ps * 256;
        int sidx = q / 48, within = q % 48;
        int n = ch * 16 + sidx;
        int pos = dir == 0 ? (n < CTXL ? SEQ + n : n - CTXL) : (STOT - 1 - n);
        lreg[ps] = *(const uint4*)(base + (size_t)pos * 384 + within * 8);
      }
    };
    auto lstore = [&](int buf) {
#pragma unroll
      for (int ps = 0; ps < 3; ++ps) {
        int q = tid + ps * 256;
        int sidx = q / 48, within = q % 48;
        float* dp = bufs + buf * 6144 + sidx * 384 + within * 8;
        uint4 u = lreg[ps];
        float4 lo = make_float4(__uint_as_float(u.x << 16), __uint_as_float(u.x & 0xffff0000u), __uint_as_float(u.y << 16), __uint_as_float(u.y & 0xffff0000u));
        float4 hi = make_float4(__uint_as_float(u.z << 16), __uint_as_float(u.z & 0xffff0000u), __uint_as_float(u.w << 16), __uint_as_float(u.w & 0xffff0000u));
        if (within < 8) {
          lo.x = __builtin_amdgcn_exp2f(lo.x); lo.y = __builtin_amdgcn_exp2f(lo.y); lo.z = __builtin_amdgcn_exp2f(lo.z); lo.w = __builtin_amdgcn_exp2f(lo.w);
          hi.x = __builtin_amdgcn_exp2f(hi.x); hi.y = __builtin_amdgcn_exp2f(hi.y); hi.z = __builtin_amdgcn_exp2f(hi.z); hi.w = __builtin_amdgcn_exp2f(hi.w);
        }
        *(float4*)dp = lo;
        *(float4*)(dp + 4) = hi;
      }
    };
    f32x2 S01 = {0.f, 0.f}, S23 = {0.f, 0.f};
    __syncthreads();
    gload(0);
    lstore(0);
    __syncthreads();
    constexpr int NCH = STOT / 16;
    for (int ch = 0; ch < NCH; ++ch) {
      if (ch + 1 < NCH) gload(ch + 1);
      const float* bp = bufs + (ch & 1) * 6144;
      const int n0 = ch * 16;
      const int pos0 = dir == 0 ? (n0 < CTXL ? SEQ + n0 : n0 - CTXL) : (STOT - 1 - n0);
      u16* yp = yraw + ((size_t)dir * TALL + bpos_row(b, pos0)) * 256 + h * 64 + irow;
      const int ystride = dir == 0 ? 256 : -256;
      float4 Wq[3], Kq[3], Nq[3], Bq[3], Rq[3];
      float Vq[3];
#define SCAN_LD(slot, st)                                        \
      do {                                                         \
        const float* sp_ = bp + (st) * 384;                        \
        Wq[slot] = *(const float4*)(sp_ + jl4);                    \
        Kq[slot] = *(const float4*)(sp_ + 64 + jl4);               \
        Nq[slot] = *(const float4*)(sp_ + 128 + jl4);              \
        Bq[slot] = *(const float4*)(sp_ + 192 + jl4);              \
        Rq[slot] = *(const float4*)(sp_ + 256 + jl4);              \
        Vq[slot] = sp_[320 + irow];                                \
      } while (0)
      SCAN_LD(0, 0);
      SCAN_LD(1, 1);
      SCAN_LD(2, 2);
#pragma unroll
      for (int s = 0; s < 16; ++s) {
        const int sl = s % 3;
        const float4 wv = Wq[sl], kt = Kq[sl], kk = Nq[sl], bb = Bq[sl], rr = Rq[sl];
        const float v = Vq[sl];
        if (s + 3 < 16) SCAN_LD(sl, s + 3);
        const f32x2 vv = {v, v};
        f32x2 A01 = S01 * f32x2{wv.x, wv.y} + vv * f32x2{kt.x, kt.y};
        f32x2 A23 = S23 * f32x2{wv.z, wv.w} + vv * f32x2{kt.z, kt.w};
        f32x2 pp = S01 * f32x2{kk.x, kk.y} + S23 * f32x2{kk.z, kk.w};
        float sa = row16_sum(pp.x + pp.y);
        const f32x2 nsa = {-sa, -sa};
        S01 = nsa * f32x2{bb.x, bb.y} + A01;
        S23 = nsa * f32x2{bb.z, bb.w} + A23;
        f32x2 yy = S01 * f32x2{rr.x, rr.y} + S23 * f32x2{rr.z, rr.w};
        float y = row16_sum(yy.x + yy.y);
        if ((lane & 15) == 0) yp[s * ystride] = f2bf(y);
      }
#undef SCAN_LD
      if (ch + 1 < NCH) lstore((ch + 1) & 1);
      __syncthreads();
    }
  }
}

__device__ __forceinline__ void phase_wfin(const Params& p, int l, unsigned char* smem) {
  const int tid = TIDX(), lane = tid & 63, h = tid >> 6, col = tid;
  const u16* P2 = (const u16*)(p.ws + OFF_P2);
  const u16* prep = (const u16*)(p.ws + OFF_PREP);
  const u16* yraw = (const u16*)(p.ws + OFF_YRAW);
  u16* concat = (u16*)(p.ws + OFF_H);
  float* sgT = (float*)smem;
  const float lng = p.ln_g[(size_t)l * 256 + col], lnb = p.ln_b[(size_t)l * 256 + col];
  const float rho0 = p.rho[((size_t)l * 2 + 0) * 256 + col], rho1 = p.rho[((size_t)l * 2 + 1) * 256 + col];
  const float* g2 = p.g2 + (size_t)l * 128 * 256 + col;
  for (int item = BIDX(); item < TALL / 16; item += gridDim.x) {
    const int row0 = item * 16;
    __syncthreads();
    {
      const int tok = tid >> 4, k0 = (tid & 15) * 8;
      bf16x8 g = *(const bf16x8*)(P2 + (size_t)(row0 + tok) * P2C + 1280 + k0);
#pragma unroll
      for (int e = 0; e < 8; ++e) sgT[(k0 + e) * 16 + tok] = sigmoidf_(bf2f((u16)g[e]));
    }
    __syncthreads();
    float acc[16];
#pragma unroll
    for (int t = 0; t < 16; ++t) acc[t] = 0.f;
    for (int k = 0; k < 128; ++k) {
      float gv = g2[k * 256];
#pragma unroll
      for (int t4 = 0; t4 < 4; ++t4) {
        float4 a = *(const float4*)(sgT + k * 16 + t4 * 4);
        acc[t4 * 4 + 0] += a.x * gv; acc[t4 * 4 + 1] += a.y * gv; acc[t4 * 4 + 2] += a.z * gv; acc[t4 * 4 + 3] += a.w * gv;
      }
    }
#pragma unroll
    for (int t = 0; t < 16; ++t) {
      const int row = row0 + t;
      int b, pos;
      row_bpos(row, b, pos);
      float tot = 0.f;
#pragma unroll
      for (int dir = 0; dir < 2; ++dir) {
        float y = bf2f(yraw[((size_t)dir * TALL + row) * 256 + col]);
        float mu = wave_sum(y) * (1.f / 64.f);
        float dl = y - mu;
        float var = wave_sum(dl * dl) * (1.f / 64.f);
        float yn = dl * rsqrtf(var + GN_EPS) * lng + lnb;
        const u16* pp = prep + (((size_t)(b * 4 + h) * 2 + dir) * STOT + pos) * 384 + lane;
        float kt = bf2f(pp[64]), r = bf2f(pp[256]), v = bf2f(pp[320]);
        float bs = wave_sum(r * kt * (dir == 0 ? rho0 : rho1));
        tot += yn + bs * v;
      }
      concat[(size_t)row * D + 768 + col] = f2bf(tot * acc[t]);
    }
  }
}

constexpr int N_PHASES = 1 + 2 * 16 + 1;
__device__ __forceinline__ void run_phase(const Params& p, int ph, unsigned char* smem) {
  if (ph == 0) { phase_init(p, smem); return; }
  if (ph == N_PHASES - 1) { phase_final_norm(p); return; }
  const int l = (ph - 1) / 16, s = (ph - 1) % 16;
  float* xc = (float*)(p.ws + OFF_XC);
  const float* lat_in = (l == 0 && s < 3) ? p.x : p.out;
  const float* cx_in = (l == 0 && s < 3) ? p.ctx : xc;
  const u16* H = (const u16*)(p.ws + OFF_H);
  const u16* ACT = (const u16*)(p.ws + OFF_P2);
  switch (s) {
    case 0: phase_norm(p, l, 0, lat_in, cx_in); break;
    case 1: phase_ffn_in(p, l, 0, smem); break;
    case 2: phase_resid_gemm(p, l, ACT, (const u16*)(p.ws + OFF_WFFO) + (size_t)(l * 2 + 0) * 1024 * DFF, DFF, 2, 0.5f, lat_in, cx_in, p.out, xc, smem); break;
    case 3: phase_norm(p, l, 1, p.out, xc); break;
    case 4: phase_inproj(p, l, smem); break;
    case 5: phase_attn(p, l, smem); break;
    case 6: phase_retscan(p); break;
    case 7: phase_retout(p, l, smem); break;
    case 8: phase_wprep(p, l, smem); break;
    case 9: phase_wscan(p, smem); break;
    case 10: phase_wfin(p, l, smem); break;
    case 11: phase_resid_gemm(p, l, H, (const u16*)(p.ws + OFF_WOUT) + (size_t)l * 1024 * 1024, 1024, 5, 1.0f, p.out, xc, p.out, xc, smem); break;
    case 12: phase_norm(p, l, 2, p.out, xc); break;
    case 13: phase_ffn_in(p, l, 1, smem); break;
    case 14: phase_resid_gemm(p, l, ACT, (const u16*)(p.ws + OFF_WFFO) + (size_t)(l * 2 + 1) * 1024 * DFF, DFF, 8, 0.5f, p.out, xc, p.out, xc, smem); break;
    default: break;
  }
}

#if MULTI_LAUNCH
__global__ void __launch_bounds__(256, 2) k_phase(Params p, int ph) {
  __shared__ __attribute__((aligned(16))) unsigned char smem[49152];
  run_phase(p, ph, smem);
}
#else
constexpr int SMEM_BYTES = 65536;
__global__ void __launch_bounds__(256, 2) k_mega(Params p) {
  __shared__ __attribute__((aligned(16))) unsigned char smem[SMEM_BYTES];
  cg::grid_group grid = cg::this_grid();
  volatile LAS unsigned* st = (volatile LAS unsigned*)(smem + SMEM_BYTES - 16);
  if (threadIdx.x == 0) { st[0] = 0u; st[1] = 0u; }
  __syncthreads();
  {
    unsigned* bw = (unsigned*)(p.ws + OFF_BAR);
    for (int i = blockIdx.x * 256 + threadIdx.x; i < XCD_BAR_WORDS; i += gridDim.x * 256) bw[i] = 0u;
  }
  grid.sync();
  XcdBarrier xb = xcd_barrier_post((unsigned*)(p.ws + OFF_BAR), st);
  run_phase(p, 0, smem);
  xcd_barrier(xb);
#pragma unroll 1
  for (int l = 0; l < 2; ++l) {
#pragma unroll 1
    for (int s = 0; s < 15; ++s) {
      run_phase(p, 1 + l * 16 + s, smem);
      xcd_barrier(xb);
#ifdef PROBE_REPEAT
      if ((PROBE_REPEAT >> s) & 1) {
        run_phase(p, 1 + l * 16 + s, smem);
        xcd_barrier(xb);
      }
#endif
    }
  }
  run_phase(p, N_PHASES - 1, smem);
}
#endif

extern "C" void kernel_launch(void* const* d_in, const int* in_sizes, int n_in, void* d_out, int out_size, void* d_ws,
                              size_t ws_size, hipStream_t stream) {
  Params p{};
  const float** pp = (const float**)&p;
  for (int i = 0; i < 26; ++i) pp[i] = (const float*)d_in[i];
  p.out = (float*)d_out;
  p.ws = (unsigned char*)d_ws;
#if MULTI_LAUNCH
  for (int ph = 0; ph < N_PHASES; ++ph) {
    if (ph > 0 && ((ph - 1) % 16) == 15 && ph != N_PHASES - 1) continue;
    k_phase<<<dim3(512), dim3(256), 0, stream>>>(p, ph);
  }
#else
  static int grid_blocks = 0;
  if (!grid_blocks) {
    int dev = 0, cus = 0, per_cu = 0;
    hipGetDevice(&dev);
    hipDeviceGetAttribute(&cus, hipDeviceAttributeMultiprocessorCount, dev);
    hipOccupancyMaxActiveBlocksPerMultiprocessor(&per_cu, k_mega, 256, 0);
    if (per_cu > 2) per_cu = 2;
    grid_blocks = cus * per_cu;
  }
  void* args[] = {&p};
  hipError_t e = hipLaunchCooperativeKernel((void*)k_mega, dim3(grid_blocks), dim3(256), args, 0, stream);
  if (e != hipSuccess) fprintf(stderr, "cooperative launch failed: %s (grid %d)\n", hipGetErrorString(e), grid_blocks);
#endif
}
```

```cpp
#include <hip/hip_runtime.h>
#include <hip/hip_bf16.h>
#include <hip/hip_cooperative_groups.h>
#include <cstdio>
namespace cg = cooperative_groups;

#ifndef MULTI_LAUNCH
#define MULTI_LAUNCH 0
#endif

typedef unsigned short u16;
using bf16x8 = __attribute__((ext_vector_type(8))) short;
using bf16x4 = __attribute__((ext_vector_type(4))) short;
using f32x4 = __attribute__((ext_vector_type(4))) float;

constexpr int D = 1024;
constexpr int TLAT = 32768;
constexpr int TCTX = 1024;
constexpr int TALL = TLAT + TCTX;
constexpr int SEQ = 8192;
constexpr int CTXL = 256;
constexpr int STOT = SEQ + CTXL;
constexpr int DFF = 2816;
constexpr int PC = 3456;
constexpr int P2C = 1664;
constexpr int NMOD = 9 * D;
constexpr float LOG2E = 1.4426950408889634f;
constexpr float RMS_EPS = 1e-6f;
constexpr float GN_EPS = 64e-5f;

constexpr size_t MiB = 1ull << 20;
constexpr size_t OFF_WFFI = 0;
constexpr size_t OFF_WFFO = 44 * MiB;
constexpr size_t OFF_WIN = 66 * MiB;
constexpr size_t OFF_WOUT = OFF_WIN + 27 * MiB / 2;
constexpr size_t OFF_MOD = OFF_WOUT + 4 * MiB;
constexpr size_t OFF_BAR = OFF_MOD + 384 * 1024;
constexpr size_t OFF_ROPE = OFF_MOD + MiB / 2;
constexpr size_t OFF_XC = OFF_ROPE + 5 * MiB / 2;
constexpr size_t OFF_H = OFF_XC + 4 * MiB;
constexpr size_t OFF_P2 = OFF_H + 66 * MiB;
constexpr size_t OFF_BIG = OFF_P2 + 429 * MiB / 4;
constexpr size_t SZ_Q = (size_t)TALL * 256 * 2;
constexpr size_t SZ_KV2 = (size_t)4 * 2 * STOT * 64 * 2;
constexpr size_t SZ_KV4 = (size_t)4 * 4 * STOT * 64 * 2;
constexpr size_t OFF_QA = OFF_BIG;
constexpr size_t OFF_QB = OFF_QA + SZ_Q;
constexpr size_t OFF_QR = OFF_QB + SZ_Q;
constexpr size_t OFF_KA = OFF_QR + SZ_Q;
constexpr size_t OFF_VA = OFF_KA + SZ_KV2;
constexpr size_t OFF_KB = OFF_VA + SZ_KV2;
constexpr size_t OFF_VB = OFF_KB + SZ_KV2;
constexpr size_t OFF_KR = OFF_VB + SZ_KV2;
constexpr size_t OFF_VR = OFF_KR + SZ_KV4;
constexpr size_t OFF_U = OFF_VR + SZ_KV4;
constexpr size_t OFF_SP = OFF_U + (size_t)16 * 66 * 2 * 4096 * 4;
constexpr size_t OFF_PREP = OFF_BIG;
constexpr size_t OFF_YRAW = OFF_PREP + (size_t)32 * STOT * 384 * 2;
constexpr size_t WS_END = OFF_YRAW + (size_t)2 * TALL * 256 * 2;
static_assert(WS_END <= 512 * MiB, "workspace overflow");
static_assert(OFF_SP + (size_t)16 * 66 * 2 * 4096 * 2 <= 512 * MiB, "workspace overflow");
static_assert(OFF_P2 + (size_t)TALL * DFF * 2 <= 512 * MiB, "act overflow");

struct Params {
  const float *x, *c, *ctx, *c_ctx, *w_mod, *b_mod, *norm_g, *ffn_w_in, *ffn_w_out, *w_in, *w_out, *attn_sink, *qk_g,
      *ret_g, *mu, *w0, *w2, *a0, *a2, *rho, *k_k, *k_a, *g2, *ln_g, *ln_b, *final_g;
  float* out;
  unsigned char* ws;
};

__device__ __forceinline__ int TIDX() { int t = threadIdx.x; asm volatile("" : "+v"(t)); return t & 255; }
__device__ __forceinline__ int BIDX() { int t = blockIdx.x; asm volatile("" : "+s"(t)); return t; }
typedef float f32x2_t __attribute__((ext_vector_type(2)));
typedef __bf16 bf16x2_t __attribute__((ext_vector_type(2)));
__device__ __forceinline__ unsigned pk2bf(float a, float b) {
  f32x2_t v = {a, b};
  return __builtin_bit_cast(unsigned, __builtin_convertvector(v, bf16x2_t));
}
__device__ __forceinline__ u16 f2bf(float f) { return (u16)(pk2bf(f, 0.f) & 0xffffu); }
__device__ __forceinline__ float bf2f(u16 h) { return __uint_as_float(((unsigned)h) << 16); }
__device__ __forceinline__ float sigmoidf_(float x) { return 1.f / (1.f + __expf(-x)); }
__device__ __forceinline__ float siluf_(float x) { return x / (1.f + __expf(-x)); }
__device__ __forceinline__ float wave_sum(float v) {
#pragma unroll
  for (int o = 32; o >= 1; o >>= 1) v += __shfl_xor(v, o);
  return v;
}
template <int CTRL>
__device__ __forceinline__ float dpp_f(float x) {
  return __builtin_bit_cast(float, __builtin_amdgcn_update_dpp(0, __builtin_bit_cast(int, x), CTRL, 0xf, 0xf, true));
}
__device__ __forceinline__ float row16_sum(float x) {
  x += dpp_f<0xB1>(x);
  x += dpp_f<0x4E>(x);
  x += dpp_f<0x141>(x);
  x += dpp_f<0x140>(x);
  return x;
}
__device__ __forceinline__ void row16_sum2(float& a, float& b) {
  a += dpp_f<0xB1>(a);  b += dpp_f<0xB1>(b);
  a += dpp_f<0x4E>(a);  b += dpp_f<0x4E>(b);
  a += dpp_f<0x141>(a); b += dpp_f<0x141>(b);
  a += dpp_f<0x140>(a); b += dpp_f<0x140>(b);
}
__device__ __forceinline__ bf16x4 pack4(float a, float b, float c, float d) {
  uint2 u = make_uint2(pk2bf(a, b), pk2bf(c, d));
  return __builtin_bit_cast(bf16x4, u);
}
__device__ __forceinline__ bf16x8 cat8(bf16x4 a, bf16x4 b) {
  bf16x8 r;
  r[0] = a[0]; r[1] = a[1]; r[2] = a[2]; r[3] = a[3]; r[4] = b[0]; r[5] = b[1]; r[6] = b[2]; r[7] = b[3];
  return r;
}
__device__ __forceinline__ const float* rrow(const float* lat, const float* cx, int r) {
  return r < TLAT ? lat + (size_t)r * D : cx + (size_t)(r - TLAT) * D;
}
__device__ __forceinline__ float* wrow(float* lat, float* cx, int r) {
  return r < TLAT ? lat + (size_t)r * D : cx + (size_t)(r - TLAT) * D;
}
__device__ __forceinline__ int mod_index(int r) { return r < TLAT ? (r >> 13) : 4; }
__device__ __forceinline__ void row_bpos(int r, int& b, int& pos) {
  if (r < TLAT) { b = r >> 13; pos = r & 8191; }
  else { int rc = r - TLAT; b = rc >> 8; pos = SEQ + (rc & 255); }
}
__device__ __forceinline__ int bpos_row(int b, int pos) {
  return pos < SEQ ? b * SEQ + pos : TLAT + b * CTXL + (pos - SEQ);
}


#define XB_TMO      128
#define XB_XCNT(j)  (256  + 64 * (j))
#define XB_XSUB(j)  (1280 + 64 * (j))
#define XB_XGEN(j)  (2304 + 64 * (j))
#define XB_TOP      3328
#define XB_TOPGEN   3392
#define XCD_BAR_WORDS 3456
#define XB_SPIN_CAP (1u << 18)
#define LAS __attribute__((address_space(3)))
__device__ __forceinline__ unsigned xb_ld(unsigned* p) { return __hip_atomic_load(p, __ATOMIC_RELAXED, __HIP_MEMORY_SCOPE_AGENT); }
__device__ __forceinline__ unsigned xb_add(unsigned* p, unsigned v) { return __hip_atomic_fetch_add(p, v, __ATOMIC_RELAXED, __HIP_MEMORY_SCOPE_AGENT); }
__device__ __forceinline__ unsigned xb_xcc_id() { return (unsigned)__builtin_amdgcn_s_getreg((3 << 11) | 20) & 0xFu; }
#define XB_SPIN(cond, bar) do { unsigned _sp = 0; while (cond) { __builtin_amdgcn_s_sleep(1); \
    if ((++_sp & 255u) == 0u) { if (xb_ld(&(bar)[XB_TMO])) break; if (_sp > XB_SPIN_CAP) { atomicAdd(&(bar)[XB_TMO], 1u); break; } } } } while (0)
struct XcdBarrier { unsigned* bar; unsigned x; volatile LAS unsigned* st; };
__device__ __forceinline__ XcdBarrier xcd_barrier_post(unsigned* bar, volatile LAS unsigned* st) {
  XcdBarrier b; b.bar = bar; b.x = xb_xcc_id(); b.st = st;
  if (threadIdx.x == 0) (void)xb_add(&bar[XB_XCNT(b.x)], 1u);
  return b;
}
__device__ __forceinline__ void xcd_barrier_complete(unsigned* bar, unsigned x, unsigned& nloc, unsigned& nx) {
  const unsigned G = gridDim.x * gridDim.y * gridDim.z;
  unsigned sum, cnt, mine, sp = 0u;
  for (;;) {
    sum = 0u; cnt = 0u; mine = 0u;
#pragma unroll
    for (unsigned j = 0; j < 16; ++j) { const unsigned c = xb_ld(&bar[XB_XCNT(j)]); sum += c; cnt += (c > 0u) ? 1u : 0u; mine = (j == x) ? c : mine; }
    if (sum == G) break;
    __builtin_amdgcn_s_sleep(1);
    if ((++sp & 255u) == 0u) { if (xb_ld(&bar[XB_TMO])) break; if (sp > XB_SPIN_CAP) { atomicAdd(&bar[XB_TMO], 1u); break; } }
  }
  nloc = mine > 0u ? mine : 1u; nx = cnt > 0u ? cnt : 1u;
}
__device__ __forceinline__ void xcd_barrier(const XcdBarrier& b) {
  asm volatile("s_waitcnt vmcnt(0)" ::: "memory");
  __syncthreads();
  if (threadIdx.x == 0) {
    unsigned* bar = b.bar;
    __builtin_amdgcn_s_waitcnt(0);
    unsigned nloc = b.st[0], nx = b.st[1];
    if (nloc == 0u) { xcd_barrier_complete(bar, b.x, nloc, nx); b.st[0] = nloc; b.st[1] = nx; }
    const unsigned old = xb_add(&bar[XB_XSUB(b.x)], 1u);
    const unsigned gen = old / nloc;
    if (old + 1u == (gen + 1u) * nloc) {
      __builtin_amdgcn_fence(__ATOMIC_RELEASE, "agent");
      asm volatile("s_waitcnt vmcnt(0)" ::: "memory");
      const unsigned og = xb_add(&bar[XB_TOP], 1u);
      const unsigned tg = og / nx;
      if (og + 1u == (tg + 1u) * nx) xb_add(&bar[XB_TOPGEN], 1u);
      else XB_SPIN(xb_ld(&bar[XB_TOPGEN]) == tg, bar);
      __builtin_amdgcn_fence(__ATOMIC_ACQUIRE, "agent");
      xb_add(&bar[XB_XGEN(b.x)], 1u);
      asm volatile("s_waitcnt vmcnt(0)" ::: "memory");
    } else {
      XB_SPIN(xb_ld(&bar[XB_XGEN(b.x)]) == gen, bar);
      __builtin_amdgcn_fence(__ATOMIC_ACQUIRE, "agent");
      asm volatile("s_waitcnt vmcnt(0)" ::: "memory");
    }
  }
  __syncthreads();
}

__device__ __forceinline__ void phase_init(const Params& p, unsigned char* smem) {
  const int tid = TIDX();
  const int nb = gridDim.x, bid = BIDX();
  {
    float2* seq = (float2*)(p.ws + OFF_ROPE);
    float2* rowt = seq + 8192 * 32;
    float2* colt = rowt + 128 * 16;
    for (int i = bid * 256 + tid; i < 8192 * 32 + 128 * 16 + 64 * 16; i += nb * 256) {
      float ang;
      float2* dst;
      if (i < 8192 * 32) {
        int t = i >> 5, k = i & 31;
        float inv = 1.0f / powf(10000.0f, (float)(2 * k) / 64.0f);
        ang = (float)t * inv;
        dst = seq + i;
      } else {
        int j = i - 8192 * 32;
        int pidx = (j < 128 * 16) ? (j >> 4) : ((j - 128 * 16) >> 4);
        int k = j & 15;
        float inv = 1.0f / powf(10000.0f, (float)(2 * k) / 32.0f);
        ang = (float)pidx * inv;
        dst = rowt + j;
      }
      *dst = make_float2(cosf(ang), sinf(ang));
    }
    (void)colt;
  }
  {
    float* sc = (float*)smem;
    float* red = sc + 5 * 1024;
    for (int item = bid; item < 288; item += nb) {
      const int l = item / 144, cb = item % 144;
      __syncthreads();
      for (int i = tid; i < 5 * 1024; i += 256) {
        int m = i >> 10, k = i & 1023;
        float v = (m < 4) ? p.c[m * 1024 + k] : p.c_ctx[k];
        sc[i] = siluf_(v);
      }
      __syncthreads();
      const int cq = tid & 15, kg = tid >> 4;
      float acc[5][4];
#pragma unroll
      for (int m = 0; m < 5; ++m)
#pragma unroll
        for (int q = 0; q < 4; ++q) acc[m][q] = 0.f;
      const float* wbase = p.w_mod + (size_t)l * 1024 * NMOD + cb * 64 + cq * 4;
      for (int kk = 0; kk < 64; ++kk) {
        int k = kg * 64 + kk;
        float4 w4 = *(const float4*)(wbase + (size_t)k * NMOD);
#pragma unroll
        for (int m = 0; m < 5; ++m) {
          float s = sc[m * 1024 + k];
          acc[m][0] += s * w4.x; acc[m][1] += s * w4.y; acc[m][2] += s * w4.z; acc[m][3] += s * w4.w;
        }
      }
#pragma unroll
      for (int m = 0; m < 5; ++m)
#pragma unroll
        for (int q = 0; q < 4; ++q) red[(kg * 5 + m) * 64 + cq * 4 + q] = acc[m][q];
      __syncthreads();
      float* modp = (float*)(p.ws + OFF_MOD);
      for (int o = tid; o < 320; o += 256) {
        int m = o >> 6, cc = o & 63;
        float s = 0.f;
        for (int g = 0; g < 16; ++g) s += red[(g * 5 + m) * 64 + cc];
        int col = cb * 64 + cc;
        modp[((size_t)l * 5 + m) * NMOD + col] = s + p.b_mod[(size_t)l * NMOD + col];
      }
    }
    __syncthreads();
  }
  {
    float* tile = (float*)smem;
    constexpr int N_FFI = 4 * 16 * 88, N_FFO = 4 * 44 * 16, N_WIN = 2 * 16 * 54, N_WOUT = 2 * 16 * 16;
    for (int item = bid; item < N_FFI + N_FFO + N_WIN + N_WOUT; item += nb) {
      const float* src; u16* dst; int K, N, kt, nt; bool perm = false;
      int it = item;
      if (it < N_FFI) {
        int mtx = it / (16 * 88); it %= (16 * 88);
        K = 1024; N = 5632; kt = it / 88; nt = it % 88; perm = true;
        src = p.ffn_w_in + (size_t)mtx * 1024 * 5632;
        dst = (u16*)(p.ws + OFF_WFFI) + (size_t)mtx * 5632 * 1024;
      } else if (it < N_FFI + N_FFO) {
        it -= N_FFI;
        int mtx = it / (44 * 16); it %= (44 * 16);
        K = 2816; N = 1024; kt = it / 16; nt = it % 16;
        src = p.ffn_w_out + (size_t)mtx * 2816 * 1024;
        dst = (u16*)(p.ws + OFF_WFFO) + (size_t)mtx * 1024 * 2816;
      } else if (it < N_FFI + N_FFO + N_WIN) {
        it -= N_FFI + N_FFO;
        int mtx = it / (16 * 54); it %= (16 * 54);
        K = 1024; N = 3456; kt = it / 54; nt = it % 54;
        src = p.w_in + (size_t)mtx * 1024 * 3456;
        dst = (u16*)(p.ws + OFF_WIN) + (size_t)mtx * 3456 * 1024;
      } else {
        it -= N_FFI + N_FFO + N_WIN;
        int mtx = it / 256; it %= 256;
        K = 1024; N = 1024; kt = it / 16; nt = it % 16;
        src = p.w_out + (size_t)mtx * 1024 * 1024;
        dst = (u16*)(p.ws + OFF_WOUT) + (size_t)mtx * 1024 * 1024;
      }
      __syncthreads();
      {
        const int r = tid >> 4, c4 = tid & 15;
        int np = nt * 64 + c4 * 4;
        int scol = np;
        if (perm) {
          int blk = np >> 7, sub = (np & 127) >> 4, i = np & 15;
          scol = ((sub & 1) ? DFF : 0) + blk * 64 + (sub >> 1) * 16 + i;
        }
#pragma unroll
        for (int ps = 0; ps < 4; ++ps) {
          int k = kt * 64 + ps * 16 + r;
          float4 v = *(const float4*)(src + (size_t)k * N + scol);
          float* tp = tile + (ps * 16 + r) * 65 + c4 * 4;
          tp[0] = v.x; tp[1] = v.y; tp[2] = v.z; tp[3] = v.w;
        }
      }
      __syncthreads();
      {
        const int n = tid >> 2, kq = tid & 3;
        bf16x8 o0, o1;
#pragma unroll
        for (int i = 0; i < 8; ++i) {
          o0[i] = (short)f2bf(tile[(kq * 16 + i) * 65 + n]);
          o1[i] = (short)f2bf(tile[(kq * 16 + 8 + i) * 65 + n]);
        }
        u16* dp = dst + (size_t)(nt * 64 + n) * K + kt * 64 + kq * 16;
        *(bf16x8*)dp = o0;
        *(bf16x8*)(dp + 8) = o1;
      }
    }
    __syncthreads();
  }
}

__device__ __forceinline__ void phase_norm(const Params& p, int l, int which, const float* lat, const float* cx) {
  const int lane = TIDX() & 63, wid = TIDX() >> 6;
  u16* h = (u16*)(p.ws + OFF_H);
  const float* g = p.norm_g + ((size_t)l * 3 + which) * D;
  const float* modp = (const float*)(p.ws + OFF_MOD) + (size_t)l * 5 * NMOD;
  for (int r = BIDX() * 4 + wid; r < TALL; r += gridDim.x * 4) {
    const float* xr = rrow(lat, cx, r);
    const float* mp = modp + (size_t)mod_index(r) * NMOD + which * 3 * D;
    float4 v[4];
    float ss = 0.f;
#pragma unroll
    for (int i = 0; i < 4; ++i) {
      v[i] = *(const float4*)(xr + i * 256 + lane * 4);
      ss += v[i].x * v[i].x + v[i].y * v[i].y + v[i].z * v[i].z + v[i].w * v[i].w;
    }
    ss = wave_sum(ss);
    float rstd = rsqrtf(ss * (1.f / 1024.f) + RMS_EPS);
#pragma unroll
    for (int i = 0; i < 4; ++i) {
      int col = i * 256 + lane * 4;
      float4 gg = *(const float4*)(g + col);
      float4 sh = *(const float4*)(mp + col);
      float4 scl = *(const float4*)(mp + D + col);
      bf16x4 o = pack4(v[i].x * rstd * gg.x * (1.f + scl.x) + sh.x, v[i].y * rstd * gg.y * (1.f + scl.y) + sh.y,
                       v[i].z * rstd * gg.z * (1.f + scl.z) + sh.z, v[i].w * rstd * gg.w * (1.f + scl.w) + sh.w);
      *(bf16x4*)(h + (size_t)r * D + col) = o;
    }
  }
}

__device__ __forceinline__ void phase_final_norm(const Params& p) {
  const int lane = TIDX() & 63, wid = TIDX() >> 6;
  for (int r = BIDX() * 4 + wid; r < TLAT; r += gridDim.x * 4) {
    float* xr = p.out + (size_t)r * D;
    float4 v[4];
    float ss = 0.f;
#pragma unroll
    for (int i = 0; i < 4; ++i) {
      v[i] = *(const float4*)(xr + i * 256 + lane * 4);
      ss += v[i].x * v[i].x + v[i].y * v[i].y + v[i].z * v[i].z + v[i].w * v[i].w;
    }
    ss = wave_sum(ss);
    float rstd = rsqrtf(ss * (1.f / 1024.f) + RMS_EPS);
#pragma unroll
    for (int i = 0; i < 4; ++i) {
      int col = i * 256 + lane * 4;
      float4 gg = *(const float4*)(p.final_g + col);
      float4 o = make_float4(v[i].x * rstd * gg.x, v[i].y * rstd * gg.y, v[i].z * rstd * gg.z, v[i].w * rstd * gg.w);
      *(float4*)(xr + col) = o;
    }
  }
}

template <int MI>
__device__ __forceinline__ void gemm_mainloop(const u16* __restrict__ A, const u16* __restrict__ Bt, int K, int brow,
                                              int bcol, f32x4 (&acc)[MI][4], unsigned char* smem) {
  const int tid = TIDX(), wid = tid >> 6, lane = tid & 63, wr = wid >> 1, wc = wid & 1, fr = lane & 15, fq = lane >> 4;
  constexpr int BM = MI * 32;
  constexpr int ACH = BM * 4 / 256;
  constexpr int STAGE = BM * 64 + 8192;
#pragma unroll
  for (int m = 0; m < MI; ++m)
#pragma unroll
    for (int n = 0; n < 4; ++n) acc[m][n] = f32x4{0.f, 0.f, 0.f, 0.f};
  const int nk = K / 32;
  const int prow = tid >> 2, pq = ((tid & 3) ^ ((0x78 >> (((tid >> 4) & 3) * 2)) & 3)) * 8;
  const u16* ga = A + (size_t)(brow + prow) * K + pq;
  const u16* gb = Bt + (size_t)(bcol + prow) * K + pq;
  auto stage = [&](int t, int buf) {
    unsigned char* base = smem + buf * STAGE;
#pragma unroll
    for (int i = 0; i < ACH; ++i)
      __builtin_amdgcn_global_load_lds((const unsigned*)(ga + (size_t)i * 64 * K + t * 32),
                                       (__attribute__((address_space(3))) unsigned*)(base + (tid + i * 256) * 16), 16, 0, 0);
#pragma unroll
    for (int i = 0; i < 2; ++i)
      __builtin_amdgcn_global_load_lds((const unsigned*)(gb + (size_t)i * 64 * K + t * 32),
                                       (__attribute__((address_space(3))) unsigned*)(base + BM * 64 + (tid + i * 256) * 16), 16, 0, 0);
  };
  const int swz = (fq ^ ((0x78 >> (((fr >> 2) & 3) * 2)) & 3)) * 16;
  __syncthreads();
  stage(0, 0);
  for (int t = 0; t < nk; ++t) {
    __syncthreads();
    if (t + 1 < nk) stage(t + 1, (t + 1) & 1);
    const unsigned char* base = smem + (t & 1) * STAGE;
    bf16x8 af[MI], bfr[4];
#pragma unroll
    for (int m = 0; m < MI; ++m) af[m] = *(const bf16x8*)(base + (wr * MI * 16 + m * 16 + fr) * 64 + swz);
#pragma unroll
    for (int n = 0; n < 4; ++n) bfr[n] = *(const bf16x8*)(base + BM * 64 + (wc * 64 + n * 16 + fr) * 64 + swz);
#pragma unroll
    for (int m = 0; m < MI; ++m)
#pragma unroll
      for (int n = 0; n < 4; ++n) acc[m][n] = __builtin_amdgcn_mfma_f32_16x16x32_bf16(af[m], bfr[n], acc[m][n], 0, 0, 0);
  }
}

__device__ __forceinline__ bool next_tile(int it, int MT, int NT, int& tm, int& tn) {
  const int G = gridDim.x, b = BIDX();
  const int total = MT * NT;
  int id;
  if ((G & 7) == 0) {
    const int per = G >> 3;
    id = it * G + (b & 7) * per + (b >> 3);
  } else {
    id = b + it * G;
  }
  if (id >= total) return false;
  constexpr int GM = 8;
  const int gsz = GM * NT;
  const int g = id / gsz, rem = id - g * gsz;
  const int rows = (MT - g * GM) < GM ? (MT - g * GM) : GM;
  tn = rem / rows;
  tm = g * GM + (rem - tn * rows);
  return true;
}

__device__ __forceinline__ void phase_ffn_in(const Params& p, int l, int f, unsigned char* smem) {
  const u16* A = (const u16*)(p.ws + OFF_H);
  const u16* Bt = (const u16*)(p.ws + OFF_WFFI) + (size_t)(l * 2 + f) * 5632 * 1024;
  u16* act = (u16*)(p.ws + OFF_P2);
  const int tid = TIDX(), wid = tid >> 6, lane = tid & 63, wr = wid >> 1, wc = wid & 1, fr = lane & 15, fq = lane >> 4;
  constexpr int MI = 8, NT = 44, MT = TALL / (MI * 32);
  for (int it = 0;; ++it) {
    int tm, tn;
    if (!next_tile(it, MT, NT, tm, tn)) break;
    f32x4 acc[MI][4];
    gemm_mainloop<MI>(A, Bt, 1024, tm * MI * 32, tn * 128, acc, smem);
#pragma unroll
    for (int m = 0; m < MI; ++m)
#pragma unroll
      for (int q = 0; q < 2; ++q)
#pragma unroll
        for (int j = 0; j < 4; ++j) {
          int row = tm * MI * 32 + wr * MI * 16 + m * 16 + fq * 4 + j;
          int col = tn * 64 + wc * 32 + q * 16 + fr;
          float u1 = acc[m][2 * q][j], u2 = acc[m][2 * q + 1][j];
          act[(size_t)row * DFF + col] = f2bf(siluf_(u1) * u2);
        }
  }
}

__device__ __forceinline__ void phase_resid_gemm(const Params& p, int l, const u16* A, const u16* Bt, int K, int gate, float gscale,
                                 const float* lat_in, const float* cx_in, float* lat_out, float* cx_out,
                                 unsigned char* smem) {
  const int tid = TIDX(), wid = tid >> 6, lane = tid & 63, wr = wid >> 1, wc = wid & 1, fr = lane & 15, fq = lane >> 4;
  constexpr int MI = 6, NT = 8, MT = TALL / (MI * 32);
  const float* modp = (const float*)(p.ws + OFF_MOD) + (size_t)l * 5 * NMOD + gate * D;
  for (int it = 0;; ++it) {
    int tm, tn;
    if (!next_tile(it, MT, NT, tm, tn)) break;
    f32x4 acc[MI][4];
    gemm_mainloop<MI>(A, Bt, K, tm * MI * 32, tn * 128, acc, smem);
#pragma unroll
    for (int m = 0; m < MI; ++m)
#pragma unroll
      for (int j = 0; j < 4; ++j) {
        int row = tm * MI * 32 + wr * MI * 16 + m * 16 + fq * 4 + j;
        const float* mp = modp + (size_t)mod_index(row) * NMOD;
        const float* xi = rrow(lat_in, cx_in, row);
        float* xo = wrow(lat_out, cx_out, row);
#pragma unroll
        for (int n = 0; n < 4; ++n) {
          int col = tn * 128 + wc * 64 + n * 16 + fr;
          xo[col] = xi[col] + gscale * mp[col] * acc[m][n][j];
        }
      }
  }
}

__device__ __forceinline__ void phase_inproj(const Params& p, int l, unsigned char* smem) {
  const u16* A = (const u16*)(p.ws + OFF_H);
  const u16* Bt = (const u16*)(p.ws + OFF_WIN) + (size_t)l * PC * 1024;
  const int tid = TIDX(), wid = tid >> 6, lane = tid & 63, wr = wid >> 1, wc = wid & 1, fr = lane & 15, fq = lane >> 4;
  constexpr int MI = 8, NT = 27, MT = TALL / (MI * 32);
  const float2* ropeseq = (const float2*)(p.ws + OFF_ROPE);
  const float2* roperow = ropeseq + 8192 * 32;
  const float2* ropecol = roperow + 128 * 16;
  u16* QA = (u16*)(p.ws + OFF_QA); u16* QB = (u16*)(p.ws + OFF_QB); u16* QR = (u16*)(p.ws + OFF_QR);
  u16* KA = (u16*)(p.ws + OFF_KA); u16* VA = (u16*)(p.ws + OFF_VA);
  u16* KB = (u16*)(p.ws + OFF_KB); u16* VB = (u16*)(p.ws + OFF_VB);
  u16* KR = (u16*)(p.ws + OFF_KR); u16* VR = (u16*)(p.ws + OFF_VR);
  u16* P2 = (u16*)(p.ws + OFF_P2);
  for (int it = 0;; ++it) {
    int tm, tn;
    if (!next_tile(it, MT, NT, tm, tn)) break;
    f32x4 acc[MI][4];
    gemm_mainloop<MI>(A, Bt, 1024, tm * MI * 32, tn * 128, acc, smem);
    const int r0 = tm * MI * 32 + wr * MI * 16;
    const int c0 = tn * 128 + wc * 64;
    const bool latent = r0 < TLAT;
    if (c0 >= 1792) {
#pragma unroll
      for (int m = 0; m < MI; ++m)
#pragma unroll
        for (int n = 0; n < 4; ++n)
#pragma unroll
          for (int j = 0; j < 4; ++j) {
            int row = r0 + m * 16 + fq * 4 + j;
            P2[(size_t)row * P2C + (c0 - 1792) + n * 16 + fr] = f2bf(acc[m][n][j]);
          }
      continue;
    }
    int kind;
    int ropek;
    int normk;
    float scale = 1.f;
    u16* dst; int hh, nh;
    if (c0 < 256) { kind = 0; ropek = 1; normk = -1; scale = 0.125f * LOG2E; dst = QA; hh = c0 >> 6; nh = 4; }
    else if (c0 < 384) { kind = 1; ropek = 1; normk = -1; dst = KA; hh = (c0 - 256) >> 6; nh = 2; }
    else if (c0 < 512) { kind = 2; ropek = 0; normk = -1; dst = VA; hh = (c0 - 384) >> 6; nh = 2; }
    else if (c0 < 768) { kind = 0; ropek = 1; normk = 0; scale = 0.125f * LOG2E; dst = QB; hh = (c0 - 512) >> 6; nh = 4; }
    else if (c0 < 896) { kind = 1; ropek = 1; normk = 1; dst = KB; hh = (c0 - 768) >> 6; nh = 2; }
    else if (c0 < 1024) { kind = 2; ropek = 0; normk = -1; dst = VB; hh = (c0 - 896) >> 6; nh = 2; }
    else if (c0 < 1280) { kind = 0; ropek = 2; normk = -1; dst = QR; hh = (c0 - 1024) >> 6; nh = 4; }
    else if (c0 < 1536) { kind = 1; ropek = 2; normk = -1; scale = 0.125f; dst = KR; hh = (c0 - 1280) >> 6; nh = 4; }
    else { kind = 2; ropek = 0; normk = -1; dst = VR; hh = (c0 - 1536) >> 6; nh = 4; }
    if (!latent) ropek = 0;
    if (kind == 2) {
#pragma unroll
      for (int m = 0; m < MI; ++m) {
        int b, pos;
        row_bpos(r0 + m * 16 + fq * 4, b, pos);
#pragma unroll
        for (int n = 0; n < 4; ++n) {
          int d = n * 16 + fr;
          bf16x4 o = pack4(acc[m][n][0], acc[m][n][1], acc[m][n][2], acc[m][n][3]);
          *(bf16x4*)(dst + ((size_t)(b * nh + hh) * 64 + d) * STOT + pos) = o;
        }
      }
      continue;
    }
    float gq[4] = {1.f, 1.f, 1.f, 1.f};
    if (normk >= 0) {
#pragma unroll
      for (int n = 0; n < 4; ++n) gq[n] = p.qk_g[((size_t)l * 2 + normk) * 64 + n * 16 + fr];
    }
#pragma unroll
    for (int m = 0; m < MI; ++m)
#pragma unroll
      for (int j = 0; j < 4; ++j) {
        int row = r0 + m * 16 + fq * 4 + j;
        float v0 = acc[m][0][j], v1 = acc[m][1][j], v2 = acc[m][2][j], v3 = acc[m][3][j];
        if (normk >= 0) {
          float ss = v0 * v0 + v1 * v1 + v2 * v2 + v3 * v3;
          ss += __shfl_xor(ss, 1); ss += __shfl_xor(ss, 2); ss += __shfl_xor(ss, 4); ss += __shfl_xor(ss, 8);
          float rstd = rsqrtf(ss * (1.f / 64.f) + RMS_EPS);
          v0 *= rstd * gq[0]; v1 *= rstd * gq[1]; v2 *= rstd * gq[2]; v3 *= rstd * gq[3];
        }
        int b, pos;
        row_bpos(row, b, pos);
        if (ropek == 1) {
          float2 cr = roperow[(pos >> 6) * 16 + fr];
          float2 cc = ropecol[(pos & 63) * 16 + fr];
          float o0 = v0 * cr.x - v1 * cr.y, o1 = v1 * cr.x + v0 * cr.y;
          float o2 = v2 * cc.x - v3 * cc.y, o3 = v3 * cc.x + v2 * cc.y;
          v0 = o0; v1 = o1; v2 = o2; v3 = o3;
        } else if (ropek == 2) {
          float2 ca = ropeseq[pos * 32 + fr];
          float2 cb = ropeseq[pos * 32 + 16 + fr];
          float o0 = v0 * ca.x - v2 * ca.y, o2 = v2 * ca.x + v0 * ca.y;
          float o1 = v1 * cb.x - v3 * cb.y, o3 = v3 * cb.x + v1 * cb.y;
          v0 = o0; v1 = o1; v2 = o2; v3 = o3;
        }
        v0 *= scale; v1 *= scale; v2 *= scale; v3 *= scale;
        u16* dp;
        if (kind == 0) dp = dst + (size_t)row * 256 + hh * 64 + fr;
        else dp = dst + ((size_t)(b * nh + hh) * STOT + pos) * 64 + fr;
        dp[0] = f2bf(v0); dp[16] = f2bf(v1); dp[32] = f2bf(v2); dp[48] = f2bf(v3);
      }
  }
}

__device__ __forceinline__ void attn_item(const u16* __restrict__ Q, const u16* __restrict__ Kb, const u16* __restrict__ Vt,
                          u16* __restrict__ concat, int ccol0, int b, int kvh, int qrow0, int qpos0, int t0, int t1,
                          int c0, int c1, bool masked, const float* sink, unsigned char* smem) {
  const int tid = TIDX(), w = tid >> 6, lane = tid & 63, fr = lane & 15, fq = lane >> 4;
  const int head = kvh * 2 + (w & 1);
  const int qoff = (w >> 1) * 32;
  bf16x8 qf[2][2];
#pragma unroll
  for (int qg = 0; qg < 2; ++qg)
#pragma unroll
    for (int ks = 0; ks < 2; ++ks)
      qf[qg][ks] = *(const bf16x8*)(Q + (size_t)(qrow0 + qoff + qg * 16 + fr) * 256 + head * 64 + ks * 32 + fq * 8);
  f32x4 O[2][4];
  float mrow[2], lrow[2];
#pragma unroll
  for (int qg = 0; qg < 2; ++qg) {
    mrow[qg] = -1e30f; lrow[qg] = 0.f;
#pragma unroll
    for (int dt = 0; dt < 4; ++dt) O[qg][dt] = f32x4{0.f, 0.f, 0.f, 0.f};
  }
  const u16* Kbase = Kb + (size_t)(b * 2 + kvh) * STOT * 64;
  const u16* Vbase = Vt + (size_t)(b * 2 + kvh) * 64 * STOT;
  const int n1 = t1 - t0, total = n1 + (c1 - c0);
  bf16x8 kreg[2], vreg[2];
  auto gload = [&](int i) {
    int tile = i < n1 ? t0 + i : c0 + (i - n1);
#pragma unroll
    for (int ps = 0; ps < 2; ++ps) {
      int idx = tid + ps * 256;
      kreg[ps] = *(const bf16x8*)(Kbase + (size_t)tile * 4096 + idx * 8);
      int d = idx >> 3, ch = idx & 7;
      vreg[ps] = *(const bf16x8*)(Vbase + (size_t)d * STOT + tile * 64 + ch * 8);
    }
  };
  auto lstore = [&](int buf) {
    u16* Ks = (u16*)(smem + buf * 18432);
    u16* Vs = Ks + 64 * 72;
#pragma unroll
    for (int ps = 0; ps < 2; ++ps) {
      int idx = tid + ps * 256;
      int r = idx >> 3, ch = idx & 7;
      *(bf16x8*)(Ks + r * 72 + ch * 8) = kreg[ps];
      *(bf16x8*)(Vs + r * 72 + ch * 8) = vreg[ps];
    }
  };
  __syncthreads();
  gload(0);
  lstore(0);
  __syncthreads();
#pragma unroll 1
  for (int i = 0; i < total; ++i) {
    const int tile = i < n1 ? t0 + i : c0 + (i - n1);
    if (i + 1 < total) gload(i + 1);
    const u16* Ks = (const u16*)(smem + (i & 1) * 18432);
    const u16* Vs = Ks + 64 * 72;
    f32x4 s[2][4];
#pragma unroll
    for (int qg = 0; qg < 2; ++qg)
#pragma unroll
      for (int sub = 0; sub < 4; ++sub) s[qg][sub] = f32x4{0.f, 0.f, 0.f, 0.f};
#pragma unroll
    for (int sub = 0; sub < 4; ++sub)
#pragma unroll
      for (int ks = 0; ks < 2; ++ks) {
        bf16x8 a = *(const bf16x8*)(Ks + (sub * 16 + fr) * 72 + ks * 32 + fq * 8);
#pragma unroll
        for (int qg = 0; qg < 2; ++qg) s[qg][sub] = __builtin_amdgcn_mfma_f32_16x16x32_bf16(a, qf[qg][ks], s[qg][sub], 0, 0, 0);
      }
    __builtin_amdgcn_sched_barrier(0);
    const bool domask = masked && (tile < 128);
    bf16x8 pb[2][2];
#pragma unroll
    for (int qg = 0; qg < 2; ++qg) {
      if (domask) {
        int qpos = qpos0 + qoff + qg * 16 + fr;
#pragma unroll
        for (int sub = 0; sub < 4; ++sub)
#pragma unroll
          for (int j = 0; j < 4; ++j) {
            int kpos = tile * 64 + sub * 16 + fq * 4 + j;
            int dd = kpos - qpos;
            if (dd > 128 || dd < -128) s[qg][sub][j] = -INFINITY;
          }
      }
      float mx = -INFINITY;
#pragma unroll
      for (int sub = 0; sub < 4; ++sub)
#pragma unroll
        for (int j = 0; j < 4; ++j) mx = fmaxf(mx, s[qg][sub][j]);
      mx = fmaxf(mx, __shfl_xor(mx, 16));
      mx = fmaxf(mx, __shfl_xor(mx, 32));
      float mnew = fmaxf(mrow[qg], mx);
      const bool changed = mnew > mrow[qg];
      float alpha = __builtin_amdgcn_exp2f(mrow[qg] - mnew);
      mrow[qg] = mnew;
      float ps = 0.f;
#pragma unroll
      for (int sub = 0; sub < 4; ++sub)
#pragma unroll
        for (int j = 0; j < 4; ++j) {
          float pv = __builtin_amdgcn_exp2f(s[qg][sub][j] - mnew);
          s[qg][sub][j] = pv;
          ps += pv;
        }
      lrow[qg] = lrow[qg] * alpha + ps;
      if (__builtin_amdgcn_ballot_w64(changed) != 0ull) {
#pragma unroll
        for (int dt = 0; dt < 4; ++dt) O[qg][dt] *= alpha;
      }
#pragma unroll
      for (int ks = 0; ks < 2; ++ks)
        pb[qg][ks] = cat8(pack4(s[qg][2 * ks][0], s[qg][2 * ks][1], s[qg][2 * ks][2], s[qg][2 * ks][3]),
                          pack4(s[qg][2 * ks + 1][0], s[qg][2 * ks + 1][1], s[qg][2 * ks + 1][2], s[qg][2 * ks + 1][3]));
      __builtin_amdgcn_sched_barrier(0);
    }
#pragma unroll
    for (int dt = 0; dt < 4; ++dt)
#pragma unroll
      for (int ks = 0; ks < 2; ++ks) {
        const u16* vp = Vs + (dt * 16 + fr) * 72 + ks * 32 + fq * 4;
        bf16x8 va = cat8(*(const bf16x4*)vp, *(const bf16x4*)(vp + 16));
#pragma unroll
        for (int qg = 0; qg < 2; ++qg) O[qg][dt] = __builtin_amdgcn_mfma_f32_16x16x32_bf16(va, pb[qg][ks], O[qg][dt], 0, 0, 0);
      }
    __builtin_amdgcn_sched_barrier(0);
    if (i + 1 < total) lstore((i + 1) & 1);
    __syncthreads();
  }
#pragma unroll
  for (int qg = 0; qg < 2; ++qg) {
    float lt = lrow[qg];
    lt += __shfl_xor(lt, 16);
    lt += __shfl_xor(lt, 32);
    if (sink) lt += __builtin_amdgcn_exp2f(sink[head] * LOG2E - mrow[qg]);
    float inv = 1.f / lt;
    int row = qrow0 + qoff + qg * 16 + fr;
#pragma unroll
    for (int dt = 0; dt < 4; ++dt) {
      bf16x4 o = pack4(O[qg][dt][0] * inv, O[qg][dt][1] * inv, O[qg][dt][2] * inv, O[qg][dt][3] * inv);
      *(bf16x4*)(concat + (size_t)row * D + ccol0 + head * 64 + dt * 16 + fq * 4) = o;
    }
  }
}

__device__ __forceinline__ float ret_lg(int h) {
  return log2f(1.0f - exp2f(-5.0f - (float)h));
}

__device__ __forceinline__ void retU_item(const Params& p, int bh, int c, unsigned char* smem) {
  const int tid = TIDX();
  const int b = bh >> 2, h = bh & 3;
  const u16* KR = (const u16*)(p.ws + OFF_KR) + (size_t)bh * STOT * 64;
  const u16* VR = (const u16*)(p.ws + OFF_VR) + (size_t)bh * 64 * STOT;
  (void)b;
  const int pos0 = c < 64 ? c * 128 : SEQ + (c - 64) * 128;
  u16* Kc = (u16*)smem;
  u16* Vj = Kc + 128 * 64;
  __syncthreads();
#pragma unroll
  for (int ps = 0; ps < 4; ++ps) {
    int idx = tid + ps * 256;
    *(bf16x8*)(Kc + idx * 8) = *(const bf16x8*)(KR + (size_t)pos0 * 64 + idx * 8);
    int d = idx >> 4, ch = idx & 15;
    bf16x8 v = *(const bf16x8*)(VR + (size_t)d * STOT + pos0 + ch * 8);
#pragma unroll
    for (int e = 0; e < 8; ++e) Vj[(ch * 8 + e) * 72 + d] = (u16)v[e];
  }
  __syncthreads();
  const int dk = tid >> 2, dv0 = (tid & 3) * 16;
  const float lg = ret_lg(h);
  float af[16], ab[16];
#pragma unroll
  for (int q = 0; q < 16; ++q) { af[q] = 0.f; ab[q] = 0.f; }
  for (int j = 0; j < 128; ++j) {
    float kf = bf2f(Kc[j * 64 + dk]);
    float kfw = kf * exp2f(lg * (float)(127 - j));
    float kbw = kf * exp2f(lg * (float)j);
    bf16x8 v0 = *(const bf16x8*)(Vj + j * 72 + dv0);
    bf16x8 v1 = *(const bf16x8*)(Vj + j * 72 + dv0 + 8);
#pragma unroll
    for (int q = 0; q < 8; ++q) {
      float a = bf2f((u16)v0[q]), bb = bf2f((u16)v1[q]);
      af[q] += kfw * a; ab[q] += kbw * a;
      af[8 + q] += kfw * bb; ab[8 + q] += kbw * bb;
    }
  }
  float* U = (float*)(p.ws + OFF_U) + ((size_t)bh * 66 + c) * 2 * 4096;
#pragma unroll
  for (int q = 0; q < 16; ++q) {
    U[(dv0 + q) * 64 + dk] = af[q];
    U[4096 + (dv0 + q) * 64 + dk] = ab[q];
  }
}

__device__ __forceinline__ void phase_attn(const Params& p, int l, unsigned char* smem) {
  const u16* QA = (const u16*)(p.ws + OFF_QA); const u16* QB = (const u16*)(p.ws + OFF_QB);
  const u16* KA = (const u16*)(p.ws + OFF_KA); const u16* VA = (const u16*)(p.ws + OFF_VA);
  const u16* KB = (const u16*)(p.ws + OFF_KB); const u16* VB = (const u16*)(p.ws + OFF_VB);
  u16* concat = (u16*)(p.ws + OFF_H);
  const float* sink = p.attn_sink + l * 4;
  for (int item = BIDX(); item < 2112 + 1056; item += gridDim.x) {
    if (item >= 2112) {
      int it = item - 2112;
      retU_item(p, it / 66, it % 66, smem);
      continue;
    }
    const bool isB = item < 1024 || (item >= 2048 && item < 2080);
    const bool isctx = item >= 2048;
    int it = item < 1024 ? item : item < 2048 ? item - 1024 : item < 2080 ? item - 2048 : item - 2080;
    int qt, kvh, b, qrow0, qpos0, t0, t1;
    if (!isctx) {
      qt = it & 127; kvh = (it >> 7) & 1; b = it >> 8;
      qrow0 = b * SEQ + qt * 64; qpos0 = qt * 64;
      if (isB) { t0 = 0; t1 = 128; }
      else { t0 = qt - 2 < 0 ? 0 : qt - 2; t1 = qt + 3 > 128 ? 128 : qt + 3; }
    } else {
      qt = it & 3; kvh = (it >> 2) & 1; b = it >> 3;
      qrow0 = TLAT + b * CTXL + qt * 64; qpos0 = 0; t0 = 0; t1 = 0;
    }
    attn_item(isB ? QB : QA, isB ? KB : KA, isB ? VB : VA, concat, isB ? 256 : 0, b, kvh, qrow0, qpos0, t0, t1, 128, 132,
              (!isB) && (!isctx), isB ? nullptr : sink, smem);
  }
}

__device__ __forceinline__ void phase_retscan(const Params& p) {
  const float* U = (const float*)(p.ws + OFF_U);
  u16* SP = (u16*)(p.ws + OFF_SP);
  for (int gid = BIDX() * 256 + TIDX(); gid < 16 * 2 * 4096; gid += gridDim.x * 256) {
    int e = gid & 4095, dir = (gid >> 12) & 1, bh = gid >> 13;
    float g128 = exp2f(128.f * ret_lg(bh & 3));
    float S = 0.f;
#pragma unroll 1
    for (int n0 = 0; n0 < 66; n0 += 11) {
      float u[11];
      size_t offs[11];
#pragma unroll
      for (int k = 0; k < 11; ++k) {
        int n = n0 + k;
        int c = dir == 0 ? (n < 2 ? 64 + n : n - 2) : 65 - n;
        offs[k] = (((size_t)bh * 66 + c) * 2 + dir) * 4096 + e;
        u[k] = U[offs[k]];
      }
#pragma unroll
      for (int k = 0; k < 11; ++k) {
        SP[offs[k]] = f2bf(S);
        S = g128 * S + u[k];
      }
    }
  }
}

__device__ __forceinline__ void retout_item(const Params& p, int l, int bh, int c, unsigned char* smem) {
  const int tid = TIDX(), w = tid >> 6, lane = tid & 63, fr = lane & 15, fq = lane >> 4;
  const int b = bh >> 2, h = bh & 3;
  const u16* QR = (const u16*)(p.ws + OFF_QR);
  const u16* KR = (const u16*)(p.ws + OFF_KR) + (size_t)bh * STOT * 64;
  const u16* VR = (const u16*)(p.ws + OFF_VR) + (size_t)bh * 64 * STOT;
  const u16* SP = (const u16*)(p.ws + OFF_SP) + ((size_t)bh * 66 + c) * 2 * 4096;
  const u16* P2 = (const u16*)(p.ws + OFF_P2);
  u16* concat = (u16*)(p.ws + OFF_H);
  const int pos0 = c < 64 ? c * 128 : SEQ + (c - 64) * 128;
  const int row0 = bpos_row(b, pos0);
  u16* Kc = (u16*)smem;
  u16* Vs = Kc + 128 * 72;
  __syncthreads();
#pragma unroll
  for (int ps = 0; ps < 4; ++ps) {
    int idx = tid + ps * 256;
    int r = idx >> 3, ch = idx & 7;
    *(bf16x8*)(Kc + r * 72 + ch * 8) = *(const bf16x8*)(KR + (size_t)(pos0 + r) * 64 + ch * 8);
    int d = idx >> 4, c16 = idx & 15;
    *(bf16x8*)(Vs + d * 136 + c16 * 8) = *(const bf16x8*)(VR + (size_t)d * STOT + pos0 + c16 * 8);
  }
  __syncthreads();
  const float lg = ret_lg(h);
#pragma unroll 1
  for (int qg = 0; qg < 2; ++qg) {
    const int i = w * 32 + qg * 16 + fr;
    const int row = row0 + i;
    bf16x8 qf[2];
#pragma unroll
    for (int ks = 0; ks < 2; ++ks) qf[ks] = *(const bf16x8*)(QR + (size_t)row * 256 + h * 64 + ks * 32 + fq * 8);
    f32x4 s[8];
#pragma unroll
    for (int sub = 0; sub < 8; ++sub) {
      s[sub] = f32x4{0.f, 0.f, 0.f, 0.f};
#pragma unroll
      for (int ks = 0; ks < 2; ++ks) {
        bf16x8 a = *(const bf16x8*)(Kc + (sub * 16 + fr) * 72 + ks * 32 + fq * 8);
        s[sub] = __builtin_amdgcn_mfma_f32_16x16x32_bf16(a, qf[ks], s[sub], 0, 0, 0);
      }
    }
    float res[4][4];
#pragma unroll
    for (int dt = 0; dt < 4; ++dt)
#pragma unroll
      for (int j = 0; j < 4; ++j) res[dt][j] = 0.f;
#pragma unroll 1
    for (int dir = 0; dir < 2; ++dir) {
      f32x4 O[4];
      const float qw = dir == 0 ? __builtin_amdgcn_exp2f(lg * (float)(i + 1)) : __builtin_amdgcn_exp2f(lg * (float)(128 - i));
#pragma unroll
      for (int dt = 0; dt < 4; ++dt) {
        O[dt] = f32x4{0.f, 0.f, 0.f, 0.f};
#pragma unroll
        for (int ks = 0; ks < 2; ++ks) {
          bf16x8 a = *(const bf16x8*)(SP + dir * 4096 + (dt * 16 + fr) * 64 + ks * 32 + fq * 8);
          O[dt] = __builtin_amdgcn_mfma_f32_16x16x32_bf16(a, qf[ks], O[dt], 0, 0, 0);
        }
        O[dt] *= qw;
      }
      int fqo = fq;
      asm volatile("" : "+v"(fqo));
#pragma unroll
      for (int ks = 0; ks < 4; ++ks) {
        float pv[8];
#pragma unroll
        for (int e = 0; e < 8; ++e) {
          const int sub = 2 * ks + (e >> 2), j = e & 3;
          const int jk = sub * 16 + fqo * 4 + j;
          const int dd = dir == 0 ? i - jk : jk - i;
          pv[e] = dd >= 0 ? s[sub][j] * __builtin_amdgcn_exp2f(lg * (float)dd) : 0.f;
        }
        bf16x8 pb = cat8(pack4(pv[0], pv[1], pv[2], pv[3]), pack4(pv[4], pv[5], pv[6], pv[7]));
#pragma unroll
        for (int dt = 0; dt < 4; ++dt) {
          const u16* vp = Vs + (dt * 16 + fr) * 136 + ks * 32 + fq * 4;
          bf16x8 va = cat8(*(const bf16x4*)vp, *(const bf16x4*)(vp + 16));
          O[dt] = __builtin_amdgcn_mfma_f32_16x16x32_bf16(va, pb, O[dt], 0, 0, 0);
        }
      }
      float sm = 0.f;
#pragma unroll
      for (int dt = 0; dt < 4; ++dt)
#pragma unroll
        for (int j = 0; j < 4; ++j) sm += O[dt][j];
      sm += __shfl_xor(sm, 16); sm += __shfl_xor(sm, 32);
      const float mu = sm * (1.f / 64.f);
      float vs = 0.f;
#pragma unroll
      for (int dt = 0; dt < 4; ++dt)
#pragma unroll
        for (int j = 0; j < 4; ++j) { float dlt = O[dt][j] - mu; vs += dlt * dlt; }
      vs += __shfl_xor(vs, 16); vs += __shfl_xor(vs, 32);
      const float rstd = rsqrtf(vs * (1.f / 64.f) + GN_EPS);
#pragma unroll
      for (int dt = 0; dt < 4; ++dt) {
        const int d = dt * 16 + fq * 4;
        bf16x4 gt = *(const bf16x4*)(P2 + (size_t)row * P2C + dir * 256 + h * 64 + d);
        float4 rg = *(const float4*)(p.ret_g + (size_t)l * 256 + h * 64 + d);
        res[dt][0] += (O[dt][0] - mu) * rstd * rg.x * siluf_(bf2f((u16)gt[0]));
        res[dt][1] += (O[dt][1] - mu) * rstd * rg.y * siluf_(bf2f((u16)gt[1]));
        res[dt][2] += (O[dt][2] - mu) * rstd * rg.z * siluf_(bf2f((u16)gt[2]));
        res[dt][3] += (O[dt][3] - mu) * rstd * rg.w * siluf_(bf2f((u16)gt[3]));
      }
    }
#pragma unroll
    for (int dt = 0; dt < 4; ++dt)
      *(bf16x4*)(concat + (size_t)row * D + 512 + h * 64 + dt * 16 + fq * 4) = pack4(res[dt][0], res[dt][1], res[dt][2], res[dt][3]);
  }
}

__device__ __forceinline__ void phase_retout(const Params& p, int l, unsigned char* smem) {
  for (int item = BIDX(); item < 16 * 66; item += gridDim.x) retout_item(p, l, item / 66, item % 66, smem);
}

__device__ __forceinline__ void phase_wprep(const Params& p, int l, unsigned char* smem) {
  const int tid = TIDX(), lane = tid & 63, h = tid >> 6;
  const u16* P2 = (const u16*)(p.ws + OFF_P2);
  u16* prep = (u16*)(p.ws + OFF_PREP);
  float* twT = (float*)smem;
  float* amT = twT + 64 * 32;
  for (int item = BIDX(); item < (TALL / 32) * 2; item += gridDim.x) {
    const int dir = item & 1, row0 = (item >> 1) * 32;
    const float* mu = p.mu + ((size_t)l * 2 + dir) * 896;
    __syncthreads();
    {
      const int tok = tid >> 3, e0 = (tid & 7) * 8;
      const int row = row0 + tok;
      int b, pos;
      row_bpos(row, b, pos);
      bool has;
      int nrow;
      if (dir == 0) { has = (pos != 0) && (pos != SEQ); nrow = row - 1; }
      else { has = (pos != SEQ - 1) && (pos != STOT - 1); nrow = row + 1; }
      const u16* cw = P2 + (size_t)row * P2C + 1408 + dir * 64 + e0;
      const u16* ca = P2 + (size_t)row * P2C + 1536 + dir * 64 + e0;
      bf16x8 zw = *(const bf16x8*)cw, za = *(const bf16x8*)ca;
      bf16x8 sw = zw, sa = za;
      if (has) {
        sw = *(const bf16x8*)(P2 + (size_t)nrow * P2C + 1408 + dir * 64 + e0);
        sa = *(const bf16x8*)(P2 + (size_t)nrow * P2C + 1536 + dir * 64 + e0);
      }
#pragma unroll
      for (int e = 0; e < 8; ++e) {
        float z = bf2f((u16)zw[e]), zs = has ? bf2f((u16)sw[e]) : 0.f;
        float m = mu[768 + e0 + e];
        twT[(e0 + e) * 32 + tok] = tanhf(z + m * (zs - z));
        float z2 = bf2f((u16)za[e]), zs2 = has ? bf2f((u16)sa[e]) : 0.f;
        float m2 = mu[832 + e0 + e];
        amT[(e0 + e) * 32 + tok] = z2 + m2 * (zs2 - z2);
      }
    }
    __syncthreads();
    const int col = tid;
    float accw[32], acca[32];
#pragma unroll
    for (int t = 0; t < 32; ++t) { accw[t] = 0.f; acca[t] = 0.f; }
    const float* w2 = p.w2 + ((size_t)l * 2 + dir) * 64 * 256 + col;
    const float* a2 = p.a2 + ((size_t)l * 2 + dir) * 64 * 256 + col;
    for (int kq = 0; kq < 64; ++kq) {
      float wv = w2[kq * 256], av = a2[kq * 256];
#pragma unroll
      for (int t4 = 0; t4 < 8; ++t4) {
        float4 a = *(const float4*)(twT + kq * 32 + t4 * 4);
        float4 bq = *(const float4*)(amT + kq * 32 + t4 * 4);
        accw[t4 * 4 + 0] += a.x * wv; accw[t4 * 4 + 1] += a.y * wv; accw[t4 * 4 + 2] += a.z * wv; accw[t4 * 4 + 3] += a.w * wv;
        acca[t4 * 4 + 0] += bq.x * av; acca[t4 * 4 + 1] += bq.y * av; acca[t4 * 4 + 2] += bq.z * av; acca[t4 * 4 + 3] += bq.w * av;
      }
    }
    const float w0v = p.w0[((size_t)l * 2 + dir) * 256 + col], a0v = p.a0[((size_t)l * 2 + dir) * 256 + col];
    const float kkv = p.k_k[(size_t)l * 256 + col], kav = p.k_a[(size_t)l * 256 + col];
    const float mur = mu[col], muk = mu[256 + col], muv = mu[512 + col];
#pragma unroll
    for (int t = 0; t < 32; ++t) {
      const int row = row0 + t;
      int b, pos;
      row_bpos(row, b, pos);
      bool has;
      int nrow;
      if (dir == 0) { has = (pos != 0) && (pos != SEQ); nrow = row - 1; }
      else { has = (pos != SEQ - 1) && (pos != STOT - 1); nrow = row + 1; }
      const u16* cp = P2 + (size_t)row * P2C + 512 + col;
      const u16* np = P2 + (size_t)(has ? nrow : row) * P2C + 512 + col;
      float zr = bf2f(cp[0]), zk = bf2f(cp[256]), zv = bf2f(cp[512]);
      float sr = has ? bf2f(np[0]) : 0.f, sk = has ? bf2f(np[256]) : 0.f, sv = has ? bf2f(np[512]) : 0.f;
      float r = zr + mur * (sr - zr), k = zk + muk * (sk - zk), v = zv + muv * (sv - zv);
      float lw2 = -0.6065306597126334f * sigmoidf_(w0v + accw[t]) * LOG2E;
      float av = sigmoidf_(a0v + acca[t]);
      float kkr = k * kkv;
      float ss = wave_sum(kkr * kkr);
      float kk = kkr / fmaxf(sqrtf(ss), 1e-12f);
      float kt = k * (1.f + (av - 1.f) * kav);
      u16* dp = prep + (((size_t)(b * 4 + h) * 2 + dir) * STOT + pos) * 384 + lane;
      dp[0] = f2bf(lw2); dp[64] = f2bf(kt); dp[128] = f2bf(kk); dp[192] = f2bf(kk * av); dp[256] = f2bf(r); dp[320] = f2bf(v);
    }
  }
}

typedef float f32x2 __attribute__((ext_vector_type(2)));
__device__ __forceinline__ void phase_wscan(const Params& p, unsigned char* smem) {
  const int tid = TIDX(), w = tid >> 6, lane = tid & 63;
  const int jl4 = (lane & 15) * 4, rsub = lane >> 4;
  const u16* prep = (const u16*)(p.ws + OFF_PREP);
  u16* yraw = (u16*)(p.ws + OFF_YRAW);
  float* bufs = (float*)smem;
  for (int item = BIDX(); item < 128; item += gridDim.x) {
    const int rq = item & 3, seq = item >> 2;
    const int dir = seq & 1, h = (seq >> 1) & 3, b = seq >> 3;
    const int irow = rq * 16 + w * 4 + rsub;
    const u16* base = prep + (size_t)seq * STOT * 384;
    uint4 lreg[3];
    auto gload = [&](int ch) {
#pragma unroll
      for (int ps = 0; ps < 3; ++ps) {
        int q = tid + ps * 256;
        int sidx = q / 48, within = q % 48;
        int n = ch * 16 + sidx;
        int pos = dir == 0 ? (n < CTXL ? SEQ + n : n - CTXL) : (STOT - 1 - n);
        lreg[ps] = *(const uint4*)(base + (size_t)pos * 384 + within * 8);
      }
    };
    auto lstore = [&](int buf) {
#pragma unroll
      for (int ps = 0; ps < 3; ++ps) {
        int q = tid + ps * 256;
        int sidx = q / 48, within = q % 48;
        float* dp = bufs + buf * 6144 + sidx * 384 + within * 8;
        uint4 u = lreg[ps];
        float4 lo = make_float4(__uint_as_float(u.x << 16), __uint_as_float(u.x & 0xffff0000u), __uint_as_float(u.y << 16), __uint_as_float(u.y & 0xffff0000u));
        float4 hi = make_float4(__uint_as_float(u.z << 16), __uint_as_float(u.z & 0xffff0000u), __uint_as_float(u.w << 16), __uint_as_float(u.w & 0xffff0000u));
        if (within < 8) {
          lo.x = __builtin_amdgcn_exp2f(lo.x); lo.y = __builtin_amdgcn_exp2f(lo.y); lo.z = __builtin_amdgcn_exp2f(lo.z); lo.w = __builtin_amdgcn_exp2f(lo.w);
          hi.x = __builtin_amdgcn_exp2f(hi.x); hi.y = __builtin_amdgcn_exp2f(hi.y); hi.z = __builtin_amdgcn_exp2f(hi.z); hi.w = __builtin_amdgcn_exp2f(hi.w);
        }
        *(float4*)dp = lo;
        *(float4*)(dp + 4) = hi;
      }
    };
    f32x2 S01 = {0.f, 0.f}, S23 = {0.f, 0.f};
    __syncthreads();
    gload(0);
    lstore(0);
    __syncthreads();
    constexpr int NCH = STOT / 16;
    for (int ch = 0; ch < NCH; ++ch) {
      if (ch + 1 < NCH) gload(ch + 1);
      const float* bp = bufs + (ch & 1) * 6144;
      const int n0 = ch * 16;
      const int pos0 = dir == 0 ? (n0 < CTXL ? SEQ + n0 : n0 - CTXL) : (STOT - 1 - n0);
      u16* yp = yraw + ((size_t)dir * TALL + bpos_row(b, pos0)) * 256 + h * 64 + irow;
      const int ystride = dir == 0 ? 256 : -256;
      float4 Wq[3], Kq[3], Nq[3], Bq[3], Rq[3];
      float Vq[3];
#define SCAN_LD(slot, st)                                        \
      do {                                                         \
        const float* sp_ = bp + (st) * 384;                        \
        Wq[slot] = *(const float4*)(sp_ + jl4);                    \
        Kq[slot] = *(const float4*)(sp_ + 64 + jl4);               \
        Nq[slot] = *(const float4*)(sp_ + 128 + jl4);              \
        Bq[slot] = *(const float4*)(sp_ + 192 + jl4);              \
        Rq[slot] = *(const float4*)(sp_ + 256 + jl4);              \
        Vq[slot] = sp_[320 + irow];                                \
      } while (0)
      SCAN_LD(0, 0);
      SCAN_LD(1, 1);
      SCAN_LD(2, 2);
      float ypart = 0.f;
#pragma unroll
      for (int s = 0; s < 16; ++s) {
        const int sl = s % 3;
        const float4 wv = Wq[sl], kt = Kq[sl], kk = Nq[sl], bb = Bq[sl], rr = Rq[sl];
        const float v = Vq[sl];
        if (s + 3 < 16) SCAN_LD(sl, s + 3);
        const f32x2 vv = {v, v};
        f32x2 A01 = S01 * f32x2{wv.x, wv.y} + vv * f32x2{kt.x, kt.y};
        f32x2 A23 = S23 * f32x2{wv.z, wv.w} + vv * f32x2{kt.z, kt.w};
        f32x2 pp = S01 * f32x2{kk.x, kk.y} + S23 * f32x2{kk.z, kk.w};
        float sa = pp.x + pp.y;
        float yprev = ypart;
        row16_sum2(sa, yprev);
        if (s > 0) { if ((lane & 15) == 0) yp[(s - 1) * ystride] = f2bf(yprev); }
        const f32x2 nsa = {-sa, -sa};
        S01 = nsa * f32x2{bb.x, bb.y} + A01;
        S23 = nsa * f32x2{bb.z, bb.w} + A23;
        f32x2 yy = S01 * f32x2{rr.x, rr.y} + S23 * f32x2{rr.z, rr.w};
        ypart = yy.x + yy.y;
      }
      {
        float ylast = row16_sum(ypart);
        if ((lane & 15) == 0) yp[15 * ystride] = f2bf(ylast);
      }
#undef SCAN_LD
      if (ch + 1 < NCH) lstore((ch + 1) & 1);
      __syncthreads();
    }
  }
}

__device__ __forceinline__ void phase_wfin(const Params& p, int l, unsigned char* smem) {
  const int tid = TIDX(), lane = tid & 63, h = tid >> 6, col = tid;
  const u16* P2 = (const u16*)(p.ws + OFF_P2);
  const u16* prep = (const u16*)(p.ws + OFF_PREP);
  const u16* yraw = (const u16*)(p.ws + OFF_YRAW);
  u16* concat = (u16*)(p.ws + OFF_H);
  float* sgT = (float*)smem;
  const float lng = p.ln_g[(size_t)l * 256 + col], lnb = p.ln_b[(size_t)l * 256 + col];
  const float rho0 = p.rho[((size_t)l * 2 + 0) * 256 + col], rho1 = p.rho[((size_t)l * 2 + 1) * 256 + col];
  const float* g2 = p.g2 + (size_t)l * 128 * 256 + col;
  for (int item = BIDX(); item < TALL / 16; item += gridDim.x) {
    const int row0 = item * 16;
    __syncthreads();
    {
      const int tok = tid >> 4, k0 = (tid & 15) * 8;
      bf16x8 g = *(const bf16x8*)(P2 + (size_t)(row0 + tok) * P2C + 1280 + k0);
#pragma unroll
      for (int e = 0; e < 8; ++e) sgT[(k0 + e) * 16 + tok] = sigmoidf_(bf2f((u16)g[e]));
    }
    __syncthreads();
    float acc[16];
#pragma unroll
    for (int t = 0; t < 16; ++t) acc[t] = 0.f;
    for (int k = 0; k < 128; ++k) {
      float gv = g2[k * 256];
#pragma unroll
      for (int t4 = 0; t4 < 4; ++t4) {
        float4 a = *(const float4*)(sgT + k * 16 + t4 * 4);
        acc[t4 * 4 + 0] += a.x * gv; acc[t4 * 4 + 1] += a.y * gv; acc[t4 * 4 + 2] += a.z * gv; acc[t4 * 4 + 3] += a.w * gv;
      }
    }
#pragma unroll
    for (int t = 0; t < 16; ++t) {
      const int row = row0 + t;
      int b, pos;
      row_bpos(row, b, pos);
      float tot = 0.f;
#pragma unroll
      for (int dir = 0; dir < 2; ++dir) {
        float y = bf2f(yraw[((size_t)dir * TALL + row) * 256 + col]);
        float mu = wave_sum(y) * (1.f / 64.f);
        float dl = y - mu;
        float var = wave_sum(dl * dl) * (1.f / 64.f);
        float yn = dl * rsqrtf(var + GN_EPS) * lng + lnb;
        const u16* pp = prep + (((size_t)(b * 4 + h) * 2 + dir) * STOT + pos) * 384 + lane;
        float kt = bf2f(pp[64]), r = bf2f(pp[256]), v = bf2f(pp[320]);
        float bs = wave_sum(r * kt * (dir == 0 ? rho0 : rho1));
        tot += yn + bs * v;
      }
      concat[(size_t)row * D + 768 + col] = f2bf(tot * acc[t]);
    }
  }
}

constexpr int N_PHASES = 1 + 2 * 16 + 1;
__device__ __forceinline__ void run_phase(const Params& p, int ph, unsigned char* smem) {
  if (ph == 0) { phase_init(p, smem); return; }
  if (ph == N_PHASES - 1) { phase_final_norm(p); return; }
  const int l = (ph - 1) / 16, s = (ph - 1) % 16;
  float* xc = (float*)(p.ws + OFF_XC);
  const float* lat_in = (l == 0 && s < 3) ? p.x : p.out;
  const float* cx_in = (l == 0 && s < 3) ? p.ctx : xc;
  const u16* H = (const u16*)(p.ws + OFF_H);
  const u16* ACT = (const u16*)(p.ws + OFF_P2);
  switch (s) {
    case 0: phase_norm(p, l, 0, lat_in, cx_in); break;
    case 1: phase_ffn_in(p, l, 0, smem); break;
    case 2: phase_resid_gemm(p, l, ACT, (const u16*)(p.ws + OFF_WFFO) + (size_t)(l * 2 + 0) * 1024 * DFF, DFF, 2, 0.5f, lat_in, cx_in, p.out, xc, smem); break;
    case 3: phase_norm(p, l, 1, p.out, xc); break;
    case 4: phase_inproj(p, l, smem); break;
    case 5: phase_attn(p, l, smem); break;
    case 6: phase_retscan(p); break;
    case 7: phase_retout(p, l, smem); break;
    case 8: phase_wprep(p, l, smem); break;
    case 9: phase_wscan(p, smem); break;
    case 10: phase_wfin(p, l, smem); break;
    case 11: phase_resid_gemm(p, l, H, (const u16*)(p.ws + OFF_WOUT) + (size_t)l * 1024 * 1024, 1024, 5, 1.0f, p.out, xc, p.out, xc, smem); break;
    case 12: phase_norm(p, l, 2, p.out, xc); break;
    case 13: phase_ffn_in(p, l, 1, smem); break;
    case 14: phase_resid_gemm(p, l, ACT, (const u16*)(p.ws + OFF_WFFO) + (size_t)(l * 2 + 1) * 1024 * DFF, DFF, 8, 0.5f, p.out, xc, p.out, xc, smem); break;
    default: break;
  }
}

#if MULTI_LAUNCH
__global__ void __launch_bounds__(256, 2) k_phase(Params p, int ph) {
  __shared__ __attribute__((aligned(16))) unsigned char smem[49152];
  run_phase(p, ph, smem);
}
#else
constexpr int SMEM_BYTES = 65536;
__global__ void __launch_bounds__(256, 2) k_mega(Params p) {
  __shared__ __attribute__((aligned(16))) unsigned char smem[SMEM_BYTES];
  cg::grid_group grid = cg::this_grid();
  volatile LAS unsigned* st = (volatile LAS unsigned*)(smem + SMEM_BYTES - 16);
  if (threadIdx.x == 0) { st[0] = 0u; st[1] = 0u; }
  __syncthreads();
  {
    unsigned* bw = (unsigned*)(p.ws + OFF_BAR);
    for (int i = blockIdx.x * 256 + threadIdx.x; i < XCD_BAR_WORDS; i += gridDim.x * 256) bw[i] = 0u;
  }
  grid.sync();
  XcdBarrier xb = xcd_barrier_post((unsigned*)(p.ws + OFF_BAR), st);
  run_phase(p, 0, smem);
  xcd_barrier(xb);
#pragma unroll 1
  for (int l = 0; l < 2; ++l) {
#pragma unroll 1
    for (int s = 0; s < 15; ++s) {
      run_phase(p, 1 + l * 16 + s, smem);
      xcd_barrier(xb);
#ifdef PROBE_REPEAT
      if ((PROBE_REPEAT >> s) & 1) {
        run_phase(p, 1 + l * 16 + s, smem);
        xcd_barrier(xb);
      }
#endif
    }
  }
  run_phase(p, N_PHASES - 1, smem);
}
#endif

extern "C" void kernel_launch(void* const* d_in, const int* in_sizes, int n_in, void* d_out, int out_size, void* d_ws,
                              size_t ws_size, hipStream_t stream) {
  Params p{};
  const float** pp = (const float**)&p;
  for (int i = 0; i < 26; ++i) pp[i] = (const float*)d_in[i];
  p.out = (float*)d_out;
  p.ws = (unsigned char*)d_ws;
#if MULTI_LAUNCH
  for (int ph = 0; ph < N_PHASES; ++ph) {
    if (ph > 0 && ((ph - 1) % 16) == 15 && ph != N_PHASES - 1) continue;
    k_phase<<<dim3(512), dim3(256), 0, stream>>>(p, ph);
  }
#else
  static int grid_blocks = 0;
  if (!grid_blocks) {
    int dev = 0, cus = 0, per_cu = 0;
    hipGetDevice(&dev);
    hipDeviceGetAttribute(&cus, hipDeviceAttributeMultiprocessorCount, dev);
    hipOccupancyMaxActiveBlocksPerMultiprocessor(&per_cu, k_mega, 256, 0);
    if (per_cu > 2) per_cu = 2;
    grid_blocks = cus * per_cu;
  }
  void* args[] = {&p};
  hipError_t e = hipLaunchCooperativeKernel((void*)k_mega, dim3(grid_blocks), dim3(256), args, 0, stream);
  if (e != hipSuccess) fprintf(stderr, "cooperative launch failed: %s (grid %d)\n", hipGetErrorString(e), grid_blocks);
#endif
}
```

```cpp
#include <hip/hip_runtime.h>
#include <hip/hip_bf16.h>
#include <hip/hip_cooperative_groups.h>
#include <cstdio>
namespace cg = cooperative_groups;

#ifndef MULTI_LAUNCH
#define MULTI_LAUNCH 0
#endif

typedef unsigned short u16;
using bf16x8 = __attribute__((ext_vector_type(8))) short;
using bf16x4 = __attribute__((ext_vector_type(4))) short;
using f32x4 = __attribute__((ext_vector_type(4))) float;

constexpr int D = 1024;
constexpr int TLAT = 32768;
constexpr int TCTX = 1024;
constexpr int TALL = TLAT + TCTX;
constexpr int SEQ = 8192;
constexpr int CTXL = 256;
constexpr int STOT = SEQ + CTXL;
constexpr int DFF = 2816;
constexpr int PC = 3456;
constexpr int P2C = 1664;
constexpr int NMOD = 9 * D;
constexpr float LOG2E = 1.4426950408889634f;
constexpr float RMS_EPS = 1e-6f;
constexpr float GN_EPS = 64e-5f;

constexpr size_t MiB = 1ull << 20;
constexpr size_t OFF_WFFI = 0;
constexpr size_t OFF_WFFO = 22 * MiB;
constexpr size_t OFF_WIN = 33 * MiB;
constexpr size_t OFF_WOUT = OFF_WIN + 27 * MiB / 4;
constexpr size_t OFF_MOD = OFF_WOUT + 2 * MiB;
constexpr size_t OFF_BAR = OFF_MOD + 384 * 1024;
constexpr size_t OFF_QCTR = OFF_MOD + 400 * 1024;
constexpr size_t OFF_CUTAB = OFF_QCTR + 256;
constexpr size_t OFF_ROPE = OFF_MOD + MiB / 2;
constexpr size_t OFF_XC = OFF_ROPE + 5 * MiB / 2;
constexpr size_t OFF_H = OFF_XC + 4 * MiB;
constexpr size_t OFF_P2 = OFF_H + 66 * MiB;
constexpr size_t OFF_BIG = OFF_P2 + 429 * MiB / 4;
constexpr size_t SZ_Q = (size_t)TALL * 256 * 2;
constexpr size_t SZ_KV2 = (size_t)4 * 2 * STOT * 64 * 2;
constexpr size_t SZ_KV4 = (size_t)4 * 4 * STOT * 64 * 2;
constexpr size_t OFF_QA = OFF_BIG;
constexpr size_t OFF_QB = OFF_QA + SZ_Q;
constexpr size_t OFF_KA = OFF_QB + SZ_Q;
constexpr size_t OFF_VA = OFF_KA + SZ_KV2;
constexpr size_t OFF_KB = OFF_VA + SZ_KV2;
constexpr size_t OFF_VB = OFF_KB + SZ_KV2;
constexpr size_t OFF_R0 = OFF_VB + SZ_KV2;
constexpr size_t OFF_QR = OFF_R0;
constexpr size_t OFF_KR = OFF_QR + SZ_Q;
constexpr size_t OFF_VR = OFF_KR + SZ_KV4;
constexpr size_t OFF_U = OFF_VR + SZ_KV4;
constexpr size_t OFF_SP = OFF_U + (size_t)16 * 66 * 2 * 4096 * 4;
constexpr size_t OFF_PREP = OFF_R0;
constexpr size_t WS_END = OFF_PREP + (size_t)32 * STOT * 384 * 2;
constexpr int YCOL0 = 768, YCOL1 = 1408;
static_assert(WS_END <= 512 * MiB, "workspace overflow");
static_assert(OFF_SP + (size_t)16 * 66 * 2 * 4096 * 2 <= 512 * MiB, "workspace overflow");
static_assert(OFF_P2 + (size_t)TALL * DFF * 2 <= 512 * MiB, "act overflow");

struct Params {
  const float *x, *c, *ctx, *c_ctx, *w_mod, *b_mod, *norm_g, *ffn_w_in, *ffn_w_out, *w_in, *w_out, *attn_sink, *qk_g,
      *ret_g, *mu, *w0, *w2, *a0, *a2, *rho, *k_k, *k_a, *g2, *ln_g, *ln_b, *final_g;
  float* out;
  unsigned char* ws;
};

__device__ __forceinline__ int TIDX() { int t = threadIdx.x; asm volatile("" : "+v"(t)); return t & 255; }
__device__ __forceinline__ int BIDX() { int t = blockIdx.x; asm volatile("" : "+s"(t)); return t; }
typedef float f32x2_t __attribute__((ext_vector_type(2)));
typedef __bf16 bf16x2_t __attribute__((ext_vector_type(2)));
__device__ __forceinline__ unsigned pk2bf(float a, float b) {
  f32x2_t v = {a, b};
  return __builtin_bit_cast(unsigned, __builtin_convertvector(v, bf16x2_t));
}
__device__ __forceinline__ u16 f2bf(float f) { return (u16)(pk2bf(f, 0.f) & 0xffffu); }
__device__ __forceinline__ float bf2f(u16 h) { return __uint_as_float(((unsigned)h) << 16); }
__device__ __forceinline__ float sigmoidf_(float x) { return 1.f / (1.f + __expf(-x)); }
__device__ __forceinline__ float siluf_(float x) { return x / (1.f + __expf(-x)); }
__device__ __forceinline__ float wave_sum(float v) {
#pragma unroll
  for (int o = 32; o >= 1; o >>= 1) v += __shfl_xor(v, o);
  return v;
}
template <int CTRL>
__device__ __forceinline__ float dpp_f(float x) {
  return __builtin_bit_cast(float, __builtin_amdgcn_update_dpp(0, __builtin_bit_cast(int, x), CTRL, 0xf, 0xf, true));
}
__device__ __forceinline__ float row16_sum(float x) {
  x += dpp_f<0xB1>(x);
  x += dpp_f<0x4E>(x);
  x += dpp_f<0x141>(x);
  x += dpp_f<0x140>(x);
  return x;
}
__device__ __forceinline__ void row16_sum2(float& a, float& b) {
  a += dpp_f<0xB1>(a);  b += dpp_f<0xB1>(b);
  a += dpp_f<0x4E>(a);  b += dpp_f<0x4E>(b);
  a += dpp_f<0x141>(a); b += dpp_f<0x141>(b);
  a += dpp_f<0x140>(a); b += dpp_f<0x140>(b);
}
__device__ __forceinline__ bf16x4 pack4(float a, float b, float c, float d) {
  uint2 u = make_uint2(pk2bf(a, b), pk2bf(c, d));
  return __builtin_bit_cast(bf16x4, u);
}
__device__ __forceinline__ bf16x8 cat8(bf16x4 a, bf16x4 b) {
  bf16x8 r;
  r[0] = a[0]; r[1] = a[1]; r[2] = a[2]; r[3] = a[3]; r[4] = b[0]; r[5] = b[1]; r[6] = b[2]; r[7] = b[3];
  return r;
}
__device__ __forceinline__ const float* rrow(const float* lat, const float* cx, int r) {
  return r < TLAT ? lat + (size_t)r * D : cx + (size_t)(r - TLAT) * D;
}
__device__ __forceinline__ float* wrow(float* lat, float* cx, int r) {
  return r < TLAT ? lat + (size_t)r * D : cx + (size_t)(r - TLAT) * D;
}
__device__ __forceinline__ int mod_index(int r) { return r < TLAT ? (r >> 13) : 4; }
__device__ __forceinline__ void row_bpos(int r, int& b, int& pos) {
  if (r < TLAT) { b = r >> 13; pos = r & 8191; }
  else { int rc = r - TLAT; b = rc >> 8; pos = SEQ + (rc & 255); }
}
__device__ __forceinline__ int bpos_row(int b, int pos) {
  return pos < SEQ ? b * SEQ + pos : TLAT + b * CTXL + (pos - SEQ);
}


#define XB_TMO      128
#define XB_XCNT(j)  (256  + 64 * (j))
#define XB_XSUB(j)  (1280 + 64 * (j))
#define XB_XGEN(j)  (2304 + 64 * (j))
#define XB_TOP      3328
#define XB_TOPGEN   3392
#define XCD_BAR_WORDS 3456
#define XB_SPIN_CAP (1u << 18)
#define LAS __attribute__((address_space(3)))
__device__ __forceinline__ unsigned xb_ld(unsigned* p) { return __hip_atomic_load(p, __ATOMIC_RELAXED, __HIP_MEMORY_SCOPE_AGENT); }
__device__ __forceinline__ unsigned xb_add(unsigned* p, unsigned v) { return __hip_atomic_fetch_add(p, v, __ATOMIC_RELAXED, __HIP_MEMORY_SCOPE_AGENT); }
__device__ __forceinline__ unsigned xb_xcc_id() { return (unsigned)__builtin_amdgcn_s_getreg((3 << 11) | 20) & 0xFu; }
#define XB_SPIN(cond, bar) do { unsigned _sp = 0; while (cond) { __builtin_amdgcn_s_sleep(1); \
    if ((++_sp & 255u) == 0u) { if (xb_ld(&(bar)[XB_TMO])) break; if (_sp > XB_SPIN_CAP) { atomicAdd(&(bar)[XB_TMO], 1u); break; } } } } while (0)
struct XcdBarrier { unsigned* bar; unsigned x; volatile LAS unsigned* st; };
__device__ __forceinline__ XcdBarrier xcd_barrier_post(unsigned* bar, volatile LAS unsigned* st) {
  XcdBarrier b; b.bar = bar; b.x = xb_xcc_id(); b.st = st;
  if (threadIdx.x == 0) (void)xb_add(&bar[XB_XCNT(b.x)], 1u);
  return b;
}
__device__ __forceinline__ void xcd_barrier_complete(unsigned* bar, unsigned x, unsigned& nloc, unsigned& nx) {
  const unsigned G = gridDim.x * gridDim.y * gridDim.z;
  unsigned sum, cnt, mine, sp = 0u;
  for (;;) {
    sum = 0u; cnt = 0u; mine = 0u;
#pragma unroll
    for (unsigned j = 0; j < 16; ++j) { const unsigned c = xb_ld(&bar[XB_XCNT(j)]); sum += c; cnt += (c > 0u) ? 1u : 0u; mine = (j == x) ? c : mine; }
    if (sum == G) break;
    __builtin_amdgcn_s_sleep(1);
    if ((++sp & 255u) == 0u) { if (xb_ld(&bar[XB_TMO])) break; if (sp > XB_SPIN_CAP) { atomicAdd(&bar[XB_TMO], 1u); break; } }
  }
  nloc = mine > 0u ? mine : 1u; nx = cnt > 0u ? cnt : 1u;
}
__device__ __forceinline__ void xcd_barrier(const XcdBarrier& b) {
  asm volatile("s_waitcnt vmcnt(0)" ::: "memory");
  __syncthreads();
  if (threadIdx.x == 0) {
    unsigned* bar = b.bar;
    __builtin_amdgcn_s_waitcnt(0);
    unsigned nloc = b.st[0], nx = b.st[1];
    if (nloc == 0u) { xcd_barrier_complete(bar, b.x, nloc, nx); b.st[0] = nloc; b.st[1] = nx; }
    const unsigned old = xb_add(&bar[XB_XSUB(b.x)], 1u);
    const unsigned gen = old / nloc;
    if (old + 1u == (gen + 1u) * nloc) {
      __builtin_amdgcn_fence(__ATOMIC_RELEASE, "agent");
      asm volatile("s_waitcnt vmcnt(0)" ::: "memory");
      const unsigned og = xb_add(&bar[XB_TOP], 1u);
      const unsigned tg = og / nx;
      if (og + 1u == (tg + 1u) * nx) xb_add(&bar[XB_TOPGEN], 1u);
      else XB_SPIN(xb_ld(&bar[XB_TOPGEN]) == tg, bar);
      __builtin_amdgcn_fence(__ATOMIC_ACQUIRE, "agent");
      xb_add(&bar[XB_XGEN(b.x)], 1u);
      asm volatile("s_waitcnt vmcnt(0)" ::: "memory");
    } else {
      XB_SPIN(xb_ld(&bar[XB_XGEN(b.x)]) == gen, bar);
      __builtin_amdgcn_fence(__ATOMIC_ACQUIRE, "agent");
      asm volatile("s_waitcnt vmcnt(0)" ::: "memory");
    }
  }
  __syncthreads();
}

__device__ __forceinline__ void convert_weights(const Params& p, int layer, unsigned char* smem) {
  const int tid = TIDX();
  const int nb = gridDim.x, bid = BIDX();
  {
    float* tile = (float*)smem;
    constexpr int N_FFI = 2 * 16 * 88, N_FFO = 2 * 44 * 16, N_WIN = 16 * 54, N_WOUT = 16 * 16;
    for (int item = bid; item < N_FFI + N_FFO + N_WIN + N_WOUT; item += nb) {
      const float* src; u16* dst; int K, N, kt, nt; bool perm = false;
      int it = item;
      if (it < N_FFI) {
        int f = it / (16 * 88); it %= (16 * 88);
        K = 1024; N = 5632; kt = it / 88; nt = it % 88; perm = true;
        src = p.ffn_w_in + (size_t)(layer * 2 + f) * 1024 * 5632;
        dst = (u16*)(p.ws + OFF_WFFI) + (size_t)f * 5632 * 1024;
      } else if (it < N_FFI + N_FFO) {
        it -= N_FFI;
        int f = it / (44 * 16); it %= (44 * 16);
        K = 2816; N = 1024; kt = it / 16; nt = it % 16;
        src = p.ffn_w_out + (size_t)(layer * 2 + f) * 2816 * 1024;
        dst = (u16*)(p.ws + OFF_WFFO) + (size_t)f * 1024 * 2816;
      } else if (it < N_FFI + N_FFO + N_WIN) {
        it -= N_FFI + N_FFO;
        K = 1024; N = 3456; kt = it / 54; nt = it % 54;
        src = p.w_in + (size_t)layer * 1024 * 3456;
        dst = (u16*)(p.ws + OFF_WIN);
      } else {
        it -= N_FFI + N_FFO + N_WIN;
        K = 1024; N = 1024; kt = it / 16; nt = it % 16;
        src = p.w_out + (size_t)layer * 1024 * 1024;
        dst = (u16*)(p.ws + OFF_WOUT);
      }
      __syncthreads();
      {
        const int r = tid >> 4, c4 = tid & 15;
        int np = nt * 64 + c4 * 4;
        int scol = np;
        if (perm) {
          int blk = np >> 7, sub = (np & 127) >> 4, i = np & 15;
          scol = ((sub & 1) ? DFF : 0) + blk * 64 + (sub >> 1) * 16 + i;
        }
#pragma unroll
        for (int ps = 0; ps < 4; ++ps) {
          int k = kt * 64 + ps * 16 + r;
          float4 v = *(const float4*)(src + (size_t)k * N + scol);
          float* tp = tile + (ps * 16 + r) * 65 + c4 * 4;
          tp[0] = v.x; tp[1] = v.y; tp[2] = v.z; tp[3] = v.w;
        }
      }
      __syncthreads();
      {
        const int n = tid >> 2, kq = tid & 3;
        bf16x8 o0, o1;
#pragma unroll
        for (int i = 0; i < 8; ++i) {
          o0[i] = (short)f2bf(tile[(kq * 16 + i) * 65 + n]);
          o1[i] = (short)f2bf(tile[(kq * 16 + 8 + i) * 65 + n]);
        }
        u16* dp = dst + (size_t)(nt * 64 + n) * K + kt * 64 + kq * 16;
        *(bf16x8*)dp = o0;
        *(bf16x8*)(dp + 8) = o1;
      }
    }
    __syncthreads();
  }
}

__device__ __forceinline__ void phase_init(const Params& p, unsigned char* smem) {
  const int tid = TIDX();
  const int nb = gridDim.x, bid = BIDX();
  if (bid == 0 && tid < 2) ((int*)(p.ws + OFF_QCTR))[tid] = 0;
  if (tid == 0) {
    const int hw = __builtin_amdgcn_s_getreg((7 << 11) | (8 << 6) | 4);
    const int xcc = __builtin_amdgcn_s_getreg((3 << 11) | 20) & 0xF;
    ((int*)(p.ws + OFF_CUTAB))[bid] = (xcc << 8) | (hw & 0xFF);
  }
  {
    float2* seq = (float2*)(p.ws + OFF_ROPE);
    float2* rowt = seq + 8192 * 32;
    float2* colt = rowt + 128 * 16;
    for (int i = bid * 256 + tid; i < 8192 * 32 + 128 * 16 + 64 * 16; i += nb * 256) {
      float ang;
      float2* dst;
      if (i < 8192 * 32) {
        int t = i >> 5, k = i & 31;
        float inv = 1.0f / powf(10000.0f, (float)(2 * k) / 64.0f);
        ang = (float)t * inv;
        dst = seq + i;
      } else {
        int j = i - 8192 * 32;
        int pidx = (j < 128 * 16) ? (j >> 4) : ((j - 128 * 16) >> 4);
        int k = j & 15;
        float inv = 1.0f / powf(10000.0f, (float)(2 * k) / 32.0f);
        ang = (float)pidx * inv;
        dst = rowt + j;
      }
      *dst = make_float2(cosf(ang), sinf(ang));
    }
    (void)colt;
  }
  {
    float* sc = (float*)smem;
    float* red = sc + 5 * 1024;
    for (int item = bid; item < 288; item += nb) {
      const int l = item / 144, cb = item % 144;
      __syncthreads();
      for (int i = tid; i < 5 * 1024; i += 256) {
        int m = i >> 10, k = i & 1023;
        float v = (m < 4) ? p.c[m * 1024 + k] : p.c_ctx[k];
        sc[i] = siluf_(v);
      }
      __syncthreads();
      const int cq = tid & 15, kg = tid >> 4;
      float acc[5][4];
#pragma unroll
      for (int m = 0; m < 5; ++m)
#pragma unroll
        for (int q = 0; q < 4; ++q) acc[m][q] = 0.f;
      const float* wbase = p.w_mod + (size_t)l * 1024 * NMOD + cb * 64 + cq * 4;
      for (int kk = 0; kk < 64; ++kk) {
        int k = kg * 64 + kk;
        float4 w4 = *(const float4*)(wbase + (size_t)k * NMOD);
#pragma unroll
        for (int m = 0; m < 5; ++m) {
          float s = sc[m * 1024 + k];
          acc[m][0] += s * w4.x; acc[m][1] += s * w4.y; acc[m][2] += s * w4.z; acc[m][3] += s * w4.w;
        }
      }
#pragma unroll
      for (int m = 0; m < 5; ++m)
#pragma unroll
        for (int q = 0; q < 4; ++q) red[(kg * 5 + m) * 64 + cq * 4 + q] = acc[m][q];
      __syncthreads();
      float* modp = (float*)(p.ws + OFF_MOD);
      for (int o = tid; o < 320; o += 256) {
        int m = o >> 6, cc = o & 63;
        float s = 0.f;
        for (int g = 0; g < 16; ++g) s += red[(g * 5 + m) * 64 + cc];
        int col = cb * 64 + cc;
        modp[((size_t)l * 5 + m) * NMOD + col] = s + p.b_mod[(size_t)l * NMOD + col];
      }
    }
    __syncthreads();
  }
  convert_weights(p, 0, smem);
}

__device__ __forceinline__ void phase_norm(const Params& p, int l, int which, const float* lat, const float* cx) {
  const int lane = TIDX() & 63, wid = TIDX() >> 6;
  u16* h = (u16*)(p.ws + OFF_H);
  const float* g = p.norm_g + ((size_t)l * 3 + which) * D;
  const float* modp = (const float*)(p.ws + OFF_MOD) + (size_t)l * 5 * NMOD;
  for (int r = BIDX() * 4 + wid; r < TALL; r += gridDim.x * 4) {
    const float* xr = rrow(lat, cx, r);
    const float* mp = modp + (size_t)mod_index(r) * NMOD + which * 3 * D;
    float4 v[4];
    float ss = 0.f;
#pragma unroll
    for (int i = 0; i < 4; ++i) {
      v[i] = *(const float4*)(xr + i * 256 + lane * 4);
      ss += v[i].x * v[i].x + v[i].y * v[i].y + v[i].z * v[i].z + v[i].w * v[i].w;
    }
    ss = wave_sum(ss);
    float rstd = rsqrtf(ss * (1.f / 1024.f) + RMS_EPS);
#pragma unroll
    for (int i = 0; i < 4; ++i) {
      int col = i * 256 + lane * 4;
      float4 gg = *(const float4*)(g + col);
      float4 sh = *(const float4*)(mp + col);
      float4 scl = *(const float4*)(mp + D + col);
      bf16x4 o = pack4(v[i].x * rstd * gg.x * (1.f + scl.x) + sh.x, v[i].y * rstd * gg.y * (1.f + scl.y) + sh.y,
                       v[i].z * rstd * gg.z * (1.f + scl.z) + sh.z, v[i].w * rstd * gg.w * (1.f + scl.w) + sh.w);
      *(bf16x4*)(h + (size_t)r * D + col) = o;
    }
  }
}

__device__ __forceinline__ void phase_final_norm(const Params& p) {
  const int lane = TIDX() & 63, wid = TIDX() >> 6;
  for (int r = BIDX() * 4 + wid; r < TLAT; r += gridDim.x * 4) {
    float* xr = p.out + (size_t)r * D;
    float4 v[4];
    float ss = 0.f;
#pragma unroll
    for (int i = 0; i < 4; ++i) {
      v[i] = *(const float4*)(xr + i * 256 + lane * 4);
      ss += v[i].x * v[i].x + v[i].y * v[i].y + v[i].z * v[i].z + v[i].w * v[i].w;
    }
    ss = wave_sum(ss);
    float rstd = rsqrtf(ss * (1.f / 1024.f) + RMS_EPS);
#pragma unroll
    for (int i = 0; i < 4; ++i) {
      int col = i * 256 + lane * 4;
      float4 gg = *(const float4*)(p.final_g + col);
      float4 o = make_float4(v[i].x * rstd * gg.x, v[i].y * rstd * gg.y, v[i].z * rstd * gg.z, v[i].w * rstd * gg.w);
      *(float4*)(xr + col) = o;
    }
  }
}

template <int MI>
__device__ __forceinline__ void gemm_mainloop(const u16* __restrict__ A, const u16* __restrict__ Bt, int K, int brow,
                                              int bcol, f32x4 (&acc)[MI][4], unsigned char* smem) {
  const int tid = TIDX(), wid = tid >> 6, lane = tid & 63, wr = wid >> 1, wc = wid & 1, fr = lane & 15, fq = lane >> 4;
  constexpr int BM = MI * 32;
  constexpr int ACH = BM * 4 / 256;
  constexpr int STAGE = BM * 64 + 8192;
#pragma unroll
  for (int m = 0; m < MI; ++m)
#pragma unroll
    for (int n = 0; n < 4; ++n) acc[m][n] = f32x4{0.f, 0.f, 0.f, 0.f};
  const int nk = K / 32;
  const int prow = tid >> 2, pq = ((tid & 3) ^ ((0x78 >> (((tid >> 4) & 3) * 2)) & 3)) * 8;
  const u16* ga = A + (size_t)(brow + prow) * K + pq;
  const u16* gb = Bt + (size_t)(bcol + prow) * K + pq;
  auto stage = [&](int t, int buf) {
    unsigned char* base = smem + buf * STAGE;
#pragma unroll
    for (int i = 0; i < ACH; ++i)
      __builtin_amdgcn_global_load_lds((const unsigned*)(ga + (size_t)i * 64 * K + t * 32),
                                       (__attribute__((address_space(3))) unsigned*)(base + (tid + i * 256) * 16), 16, 0, 0);
#pragma unroll
    for (int i = 0; i < 2; ++i)
      __builtin_amdgcn_global_load_lds((const unsigned*)(gb + (size_t)i * 64 * K + t * 32),
                                       (__attribute__((address_space(3))) unsigned*)(base + BM * 64 + (tid + i * 256) * 16), 16, 0, 0);
  };
  const int swz = (fq ^ ((0x78 >> (((fr >> 2) & 3) * 2)) & 3)) * 16;
  __syncthreads();
  stage(0, 0);
  for (int t = 0; t < nk; ++t) {
    __syncthreads();
    if (t + 1 < nk) stage(t + 1, (t + 1) & 1);
    const unsigned char* base = smem + (t & 1) * STAGE;
    bf16x8 af[MI], bfr[4];
#pragma unroll
    for (int m = 0; m < MI; ++m) af[m] = *(const bf16x8*)(base + (wr * MI * 16 + m * 16 + fr) * 64 + swz);
#pragma unroll
    for (int n = 0; n < 4; ++n) bfr[n] = *(const bf16x8*)(base + BM * 64 + (wc * 64 + n * 16 + fr) * 64 + swz);
#pragma unroll
    for (int m = 0; m < MI; ++m)
#pragma unroll
      for (int n = 0; n < 4; ++n) acc[m][n] = __builtin_amdgcn_mfma_f32_16x16x32_bf16(af[m], bfr[n], acc[m][n], 0, 0, 0);
  }
}

__device__ __forceinline__ bool next_tile(int it, int MT, int NT, int& tm, int& tn) {
  const int G = gridDim.x, b = BIDX();
  const int total = MT * NT;
  int id;
  if ((G & 7) == 0) {
    const int per = G >> 3;
    id = it * G + (b & 7) * per + (b >> 3);
  } else {
    id = b + it * G;
  }
  if (id >= total) return false;
  constexpr int GM = 8;
  const int gsz = GM * NT;
  const int g = id / gsz, rem = id - g * gsz;
  const int rows = (MT - g * GM) < GM ? (MT - g * GM) : GM;
  tn = rem / rows;
  tm = g * GM + (rem - tn * rows);
  return true;
}

__device__ __forceinline__ void phase_ffn_in(const Params& p, int l, int f, unsigned char* smem) {
  const u16* A = (const u16*)(p.ws + OFF_H);
  const u16* Bt = (const u16*)(p.ws + OFF_WFFI) + (size_t)f * 5632 * 1024;
  u16* act = (u16*)(p.ws + OFF_P2);
  const int tid = TIDX(), wid = tid >> 6, lane = tid & 63, wr = wid >> 1, wc = wid & 1, fr = lane & 15, fq = lane >> 4;
  constexpr int MI = 8, NT = 44, MT = TALL / (MI * 32);
  for (int it = 0;; ++it) {
    int tm, tn;
    if (!next_tile(it, MT, NT, tm, tn)) break;
    f32x4 acc[MI][4];
    gemm_mainloop<MI>(A, Bt, 1024, tm * MI * 32, tn * 128, acc, smem);
#pragma unroll
    for (int m = 0; m < MI; ++m)
#pragma unroll
      for (int q = 0; q < 2; ++q)
#pragma unroll
        for (int j = 0; j < 4; ++j) {
          int row = tm * MI * 32 + wr * MI * 16 + m * 16 + fq * 4 + j;
          int col = tn * 64 + wc * 32 + q * 16 + fr;
          float u1 = acc[m][2 * q][j], u2 = acc[m][2 * q + 1][j];
          act[(size_t)row * DFF + col] = f2bf(siluf_(u1) * u2);
        }
  }
}

__device__ __forceinline__ void phase_resid_gemm(const Params& p, int l, const u16* A, const u16* Bt, int K, int gate, float gscale,
                                 const float* lat_in, const float* cx_in, float* lat_out, float* cx_out,
                                 unsigned char* smem) {
  const int tid = TIDX(), wid = tid >> 6, lane = tid & 63, wr = wid >> 1, wc = wid & 1, fr = lane & 15, fq = lane >> 4;
  constexpr int MI = 6, NT = 8, MT = TALL / (MI * 32);
  const float* modp = (const float*)(p.ws + OFF_MOD) + (size_t)l * 5 * NMOD + gate * D;
  for (int it = 0;; ++it) {
    int tm, tn;
    if (!next_tile(it, MT, NT, tm, tn)) break;
    f32x4 acc[MI][4];
    gemm_mainloop<MI>(A, Bt, K, tm * MI * 32, tn * 128, acc, smem);
#pragma unroll
    for (int m = 0; m < MI; ++m)
#pragma unroll
      for (int j = 0; j < 4; ++j) {
        int row = tm * MI * 32 + wr * MI * 16 + m * 16 + fq * 4 + j;
        const float* mp = modp + (size_t)mod_index(row) * NMOD;
        const float* xi = rrow(lat_in, cx_in, row);
        float* xo = wrow(lat_out, cx_out, row);
#pragma unroll
        for (int n = 0; n < 4; ++n) {
          int col = tn * 128 + wc * 64 + n * 16 + fr;
          xo[col] = xi[col] + gscale * mp[col] * acc[m][n][j];
        }
      }
  }
}

__device__ __forceinline__ void phase_inproj(const Params& p, int l, unsigned char* smem) {
  const u16* A = (const u16*)(p.ws + OFF_H);
  const u16* Bt = (const u16*)(p.ws + OFF_WIN);
  const int tid = TIDX(), wid = tid >> 6, lane = tid & 63, wr = wid >> 1, wc = wid & 1, fr = lane & 15, fq = lane >> 4;
  constexpr int MI = 8, NT = 27, MT = TALL / (MI * 32);
  const float2* ropeseq = (const float2*)(p.ws + OFF_ROPE);
  const float2* roperow = ropeseq + 8192 * 32;
  const float2* ropecol = roperow + 128 * 16;
  u16* QA = (u16*)(p.ws + OFF_QA); u16* QB = (u16*)(p.ws + OFF_QB); u16* QR = (u16*)(p.ws + OFF_QR);
  u16* KA = (u16*)(p.ws + OFF_KA); u16* VA = (u16*)(p.ws + OFF_VA);
  u16* KB = (u16*)(p.ws + OFF_KB); u16* VB = (u16*)(p.ws + OFF_VB);
  u16* KR = (u16*)(p.ws + OFF_KR); u16* VR = (u16*)(p.ws + OFF_VR);
  u16* P2 = (u16*)(p.ws + OFF_P2);
  for (int it = 0;; ++it) {
    int tm, tn;
    if (!next_tile(it, MT, NT, tm, tn)) break;
    f32x4 acc[MI][4];
    gemm_mainloop<MI>(A, Bt, 1024, tm * MI * 32, tn * 128, acc, smem);
    const int r0 = tm * MI * 32 + wr * MI * 16;
    const int c0 = tn * 128 + wc * 64;
    const bool latent = r0 < TLAT;
    if (c0 >= 1792) {
#pragma unroll
      for (int m = 0; m < MI; ++m)
#pragma unroll
        for (int n = 0; n < 4; ++n)
#pragma unroll
          for (int j = 0; j < 4; ++j) {
            int row = r0 + m * 16 + fq * 4 + j;
            P2[(size_t)row * P2C + (c0 - 1792) + n * 16 + fr] = f2bf(acc[m][n][j]);
          }
      continue;
    }
    int kind;
    int ropek;
    int normk;
    float scale = 1.f;
    u16* dst; int hh, nh;
    if (c0 < 256) { kind = 0; ropek = 1; normk = -1; scale = 0.125f * LOG2E; dst = QA; hh = c0 >> 6; nh = 4; }
    else if (c0 < 384) { kind = 1; ropek = 1; normk = -1; dst = KA; hh = (c0 - 256) >> 6; nh = 2; }
    else if (c0 < 512) { kind = 2; ropek = 0; normk = -1; dst = VA; hh = (c0 - 384) >> 6; nh = 2; }
    else if (c0 < 768) { kind = 0; ropek = 1; normk = 0; scale = 0.125f * LOG2E; dst = QB; hh = (c0 - 512) >> 6; nh = 4; }
    else if (c0 < 896) { kind = 1; ropek = 1; normk = 1; dst = KB; hh = (c0 - 768) >> 6; nh = 2; }
    else if (c0 < 1024) { kind = 2; ropek = 0; normk = -1; dst = VB; hh = (c0 - 896) >> 6; nh = 2; }
    else if (c0 < 1280) { kind = 0; ropek = 2; normk = -1; dst = QR; hh = (c0 - 1024) >> 6; nh = 4; }
    else if (c0 < 1536) { kind = 1; ropek = 2; normk = -1; scale = 0.125f; dst = KR; hh = (c0 - 1280) >> 6; nh = 4; }
    else { kind = 2; ropek = 0; normk = -1; dst = VR; hh = (c0 - 1536) >> 6; nh = 4; }
    if (!latent) ropek = 0;
    if (kind == 2) {
#pragma unroll
      for (int m = 0; m < MI; ++m) {
        int b, pos;
        row_bpos(r0 + m * 16 + fq * 4, b, pos);
#pragma unroll
        for (int n = 0; n < 4; ++n) {
          int d = n * 16 + fr;
          bf16x4 o = pack4(acc[m][n][0], acc[m][n][1], acc[m][n][2], acc[m][n][3]);
          *(bf16x4*)(dst + ((size_t)(b * nh + hh) * 64 + d) * STOT + pos) = o;
        }
      }
      continue;
    }
    float gq[4] = {1.f, 1.f, 1.f, 1.f};
    if (normk >= 0) {
#pragma unroll
      for (int n = 0; n < 4; ++n) gq[n] = p.qk_g[((size_t)l * 2 + normk) * 64 + n * 16 + fr];
    }
#pragma unroll
    for (int m = 0; m < MI; ++m)
#pragma unroll
      for (int j = 0; j < 4; ++j) {
        int row = r0 + m * 16 + fq * 4 + j;
        float v0 = acc[m][0][j], v1 = acc[m][1][j], v2 = acc[m][2][j], v3 = acc[m][3][j];
        if (normk >= 0) {
          float ss = v0 * v0 + v1 * v1 + v2 * v2 + v3 * v3;
          ss += __shfl_xor(ss, 1); ss += __shfl_xor(ss, 2); ss += __shfl_xor(ss, 4); ss += __shfl_xor(ss, 8);
          float rstd = rsqrtf(ss * (1.f / 64.f) + RMS_EPS);
          v0 *= rstd * gq[0]; v1 *= rstd * gq[1]; v2 *= rstd * gq[2]; v3 *= rstd * gq[3];
        }
        int b, pos;
        row_bpos(row, b, pos);
        if (ropek == 1) {
          float2 cr = roperow[(pos >> 6) * 16 + fr];
          float2 cc = ropecol[(pos & 63) * 16 + fr];
          float o0 = v0 * cr.x - v1 * cr.y, o1 = v1 * cr.x + v0 * cr.y;
          float o2 = v2 * cc.x - v3 * cc.y, o3 = v3 * cc.x + v2 * cc.y;
          v0 = o0; v1 = o1; v2 = o2; v3 = o3;
        } else if (ropek == 2) {
          float2 ca = ropeseq[pos * 32 + fr];
          float2 cb = ropeseq[pos * 32 + 16 + fr];
          float o0 = v0 * ca.x - v2 * ca.y, o2 = v2 * ca.x + v0 * ca.y;
          float o1 = v1 * cb.x - v3 * cb.y, o3 = v3 * cb.x + v1 * cb.y;
          v0 = o0; v1 = o1; v2 = o2; v3 = o3;
        }
        v0 *= scale; v1 *= scale; v2 *= scale; v3 *= scale;
        u16* dp;
        if (kind == 0) dp = dst + (size_t)row * 256 + hh * 64 + fr;
        else dp = dst + ((size_t)(b * nh + hh) * STOT + pos) * 64 + fr;
        dp[0] = f2bf(v0); dp[16] = f2bf(v1); dp[32] = f2bf(v2); dp[48] = f2bf(v3);
      }
  }
}

__device__ __forceinline__ void attn_item(const u16* __restrict__ Q, const u16* __restrict__ Kb, const u16* __restrict__ Vt,
                          u16* __restrict__ concat, int ccol0, int b, int kvh, int qrow0, int qpos0, int t0, int t1,
                          int c0, int c1, bool masked, const float* sink, unsigned char* smem) {
  const int tid = TIDX(), w = tid >> 6, lane = tid & 63, fr = lane & 15, fq = lane >> 4;
  const int head = kvh * 2 + (w & 1);
  const int qoff = (w >> 1) * 32;
  bf16x8 qf[2][2];
#pragma unroll
  for (int qg = 0; qg < 2; ++qg)
#pragma unroll
    for (int ks = 0; ks < 2; ++ks)
      qf[qg][ks] = *(const bf16x8*)(Q + (size_t)(qrow0 + qoff + qg * 16 + fr) * 256 + head * 64 + ks * 32 + fq * 8);
  f32x4 O[2][4];
  float mrow[2], lrow[2];
#pragma unroll
  for (int qg = 0; qg < 2; ++qg) {
    mrow[qg] = -1e30f; lrow[qg] = 0.f;
#pragma unroll
    for (int dt = 0; dt < 4; ++dt) O[qg][dt] = f32x4{0.f, 0.f, 0.f, 0.f};
  }
  const u16* Kbase = Kb + (size_t)(b * 2 + kvh) * STOT * 64;
  const u16* Vbase = Vt + (size_t)(b * 2 + kvh) * 64 * STOT;
  const int n1 = t1 - t0, total = n1 + (c1 - c0);
  bf16x8 kreg[2], vreg[2];
  auto gload = [&](int i) {
    int tile = i < n1 ? t0 + i : c0 + (i - n1);
#pragma unroll
    for (int ps = 0; ps < 2; ++ps) {
      int idx = tid + ps * 256;
      kreg[ps] = *(const bf16x8*)(Kbase + (size_t)tile * 4096 + idx * 8);
      int d = idx >> 3, ch = idx & 7;
      vreg[ps] = *(const bf16x8*)(Vbase + (size_t)d * STOT + tile * 64 + ch * 8);
    }
  };
  auto lstore = [&](int buf) {
    u16* Ks = (u16*)(smem + buf * 18432);
    u16* Vs = Ks + 64 * 72;
#pragma unroll
    for (int ps = 0; ps < 2; ++ps) {
      int idx = tid + ps * 256;
      int r = idx >> 3, ch = idx & 7;
      *(bf16x8*)(Ks + r * 72 + ch * 8) = kreg[ps];
      *(bf16x8*)(Vs + r * 72 + ch * 8) = vreg[ps];
    }
  };
  __syncthreads();
  gload(0);
  lstore(0);
  __syncthreads();
#pragma unroll 1
  for (int i = 0; i < total; ++i) {
    const int tile = i < n1 ? t0 + i : c0 + (i - n1);
    if (i + 1 < total) gload(i + 1);
    const u16* Ks = (const u16*)(smem + (i & 1) * 18432);
    const u16* Vs = Ks + 64 * 72;
    f32x4 s[2][4];
#pragma unroll
    for (int qg = 0; qg < 2; ++qg)
#pragma unroll
      for (int sub = 0; sub < 4; ++sub) s[qg][sub] = f32x4{0.f, 0.f, 0.f, 0.f};
#pragma unroll
    for (int sub = 0; sub < 4; ++sub)
#pragma unroll
      for (int ks = 0; ks < 2; ++ks) {
        bf16x8 a = *(const bf16x8*)(Ks + (sub * 16 + fr) * 72 + ks * 32 + fq * 8);
#pragma unroll
        for (int qg = 0; qg < 2; ++qg) s[qg][sub] = __builtin_amdgcn_mfma_f32_16x16x32_bf16(a, qf[qg][ks], s[qg][sub], 0, 0, 0);
      }
    __builtin_amdgcn_sched_barrier(0);
    const bool domask = masked && (tile < 128);
    bf16x8 pb[2][2];
#pragma unroll
    for (int qg = 0; qg < 2; ++qg) {
      if (domask) {
        int qpos = qpos0 + qoff + qg * 16 + fr;
#pragma unroll
        for (int sub = 0; sub < 4; ++sub)
#pragma unroll
          for (int j = 0; j < 4; ++j) {
            int kpos = tile * 64 + sub * 16 + fq * 4 + j;
            int dd = kpos - qpos;
            if (dd > 128 || dd < -128) s[qg][sub][j] = -INFINITY;
          }
      }
      float mx = -INFINITY;
#pragma unroll
      for (int sub = 0; sub < 4; ++sub)
#pragma unroll
        for (int j = 0; j < 4; ++j) mx = fmaxf(mx, s[qg][sub][j]);
      mx = fmaxf(mx, __shfl_xor(mx, 16));
      mx = fmaxf(mx, __shfl_xor(mx, 32));
      float mnew = fmaxf(mrow[qg], mx);
      const bool changed = mnew > mrow[qg];
      float alpha = __builtin_amdgcn_exp2f(mrow[qg] - mnew);
      mrow[qg] = mnew;
      float ps = 0.f;
#pragma unroll
      for (int sub = 0; sub < 4; ++sub)
#pragma unroll
        for (int j = 0; j < 4; ++j) {
          float pv = __builtin_amdgcn_exp2f(s[qg][sub][j] - mnew);
          s[qg][sub][j] = pv;
          ps += pv;
        }
      lrow[qg] = lrow[qg] * alpha + ps;
      if (__builtin_amdgcn_ballot_w64(changed) != 0ull) {
#pragma unroll
        for (int dt = 0; dt < 4; ++dt) O[qg][dt] *= alpha;
      }
#pragma unroll
      for (int ks = 0; ks < 2; ++ks)
        pb[qg][ks] = cat8(pack4(s[qg][2 * ks][0], s[qg][2 * ks][1], s[qg][2 * ks][2], s[qg][2 * ks][3]),
                          pack4(s[qg][2 * ks + 1][0], s[qg][2 * ks + 1][1], s[qg][2 * ks + 1][2], s[qg][2 * ks + 1][3]));
      __builtin_amdgcn_sched_barrier(0);
    }
#pragma unroll
    for (int dt = 0; dt < 4; ++dt)
#pragma unroll
      for (int ks = 0; ks < 2; ++ks) {
        const u16* vp = Vs + (dt * 16 + fr) * 72 + ks * 32 + fq * 4;
        bf16x8 va = cat8(*(const bf16x4*)vp, *(const bf16x4*)(vp + 16));
#pragma unroll
        for (int qg = 0; qg < 2; ++qg) O[qg][dt] = __builtin_amdgcn_mfma_f32_16x16x32_bf16(va, pb[qg][ks], O[qg][dt], 0, 0, 0);
      }
    __builtin_amdgcn_sched_barrier(0);
    if (i + 1 < total) lstore((i + 1) & 1);
    __syncthreads();
  }
#pragma unroll
  for (int qg = 0; qg < 2; ++qg) {
    float lt = lrow[qg];
    lt += __shfl_xor(lt, 16);
    lt += __shfl_xor(lt, 32);
    if (sink) lt += __builtin_amdgcn_exp2f(sink[head] * LOG2E - mrow[qg]);
    float inv = 1.f / lt;
    int row = qrow0 + qoff + qg * 16 + fr;
#pragma unroll
    for (int dt = 0; dt < 4; ++dt) {
      bf16x4 o = pack4(O[qg][dt][0] * inv, O[qg][dt][1] * inv, O[qg][dt][2] * inv, O[qg][dt][3] * inv);
      *(bf16x4*)(concat + (size_t)row * D + ccol0 + head * 64 + dt * 16 + fq * 4) = o;
    }
  }
}

__device__ __forceinline__ float ret_lg(int h) {
  return log2f(1.0f - exp2f(-5.0f - (float)h));
}

__device__ __forceinline__ void retU_item(const Params& p, int bh, int c, unsigned char* smem) {
  const int tid = TIDX();
  const int b = bh >> 2, h = bh & 3;
  const u16* KR = (const u16*)(p.ws + OFF_KR) + (size_t)bh * STOT * 64;
  const u16* VR = (const u16*)(p.ws + OFF_VR) + (size_t)bh * 64 * STOT;
  (void)b;
  const int pos0 = c < 64 ? c * 128 : SEQ + (c - 64) * 128;
  u16* Kc = (u16*)smem;
  u16* Vj = Kc + 128 * 64;
  __syncthreads();
#pragma unroll
  for (int ps = 0; ps < 4; ++ps) {
    int idx = tid + ps * 256;
    *(bf16x8*)(Kc + idx * 8) = *(const bf16x8*)(KR + (size_t)pos0 * 64 + idx * 8);
    int d = idx >> 4, ch = idx & 15;
    bf16x8 v = *(const bf16x8*)(VR + (size_t)d * STOT + pos0 + ch * 8);
#pragma unroll
    for (int e = 0; e < 8; ++e) Vj[(ch * 8 + e) * 72 + d] = (u16)v[e];
  }
  __syncthreads();
  const int dk = tid >> 2, dv0 = (tid & 3) * 16;
  const float lg = ret_lg(h);
  float af[16], ab[16];
#pragma unroll
  for (int q = 0; q < 16; ++q) { af[q] = 0.f; ab[q] = 0.f; }
  for (int j = 0; j < 128; ++j) {
    float kf = bf2f(Kc[j * 64 + dk]);
    float kfw = kf * exp2f(lg * (float)(127 - j));
    float kbw = kf * exp2f(lg * (float)j);
    bf16x8 v0 = *(const bf16x8*)(Vj + j * 72 + dv0);
    bf16x8 v1 = *(const bf16x8*)(Vj + j * 72 + dv0 + 8);
#pragma unroll
    for (int q = 0; q < 8; ++q) {
      float a = bf2f((u16)v0[q]), bb = bf2f((u16)v1[q]);
      af[q] += kfw * a; ab[q] += kbw * a;
      af[8 + q] += kfw * bb; ab[8 + q] += kbw * bb;
    }
  }
  float* U = (float*)(p.ws + OFF_U) + ((size_t)bh * 66 + c) * 2 * 4096;
#pragma unroll
  for (int q = 0; q < 16; ++q) {
    U[(dv0 + q) * 64 + dk] = af[q];
    U[4096 + (dv0 + q) * 64 + dk] = ab[q];
  }
}

__device__ __forceinline__ void phase_retU(const Params& p, unsigned char* smem) {
  for (int item = BIDX(); item < 16 * 66; item += gridDim.x) retU_item(p, item / 66, item % 66, smem);
}

__device__ __forceinline__ void attn_worker(const Params& p, int l, unsigned char* smem) {
  const u16* QA = (const u16*)(p.ws + OFF_QA); const u16* QB = (const u16*)(p.ws + OFF_QB);
  const u16* KA = (const u16*)(p.ws + OFF_KA); const u16* VA = (const u16*)(p.ws + OFF_VA);
  const u16* KB = (const u16*)(p.ws + OFF_KB); const u16* VB = (const u16*)(p.ws + OFF_VB);
  u16* concat = (u16*)(p.ws + OFF_H);
  const float* sink = p.attn_sink + l * 4;
  int* qctr = (int*)(p.ws + OFF_QCTR) + l;
  volatile int* slot = (volatile int*)(smem + 65536 - 32);
  for (;;) {
    __syncthreads();
    if (TIDX() == 0) *slot = atomicAdd(qctr, 1);
    __syncthreads();
    const int item = *slot;
    if (item >= 2112) break;
    const bool isB = item < 1024 || (item >= 2048 && item < 2080);
    const bool isctx = item >= 2048;
    int ii = item < 1024 ? item : item < 2048 ? item - 1024 : item < 2080 ? item - 2048 : item - 2080;
    int qt, kvh, b, qrow0, qpos0, t0, t1;
    if (!isctx) {
      qt = ii & 127; kvh = (ii >> 7) & 1; b = ii >> 8;
      qrow0 = b * SEQ + qt * 64; qpos0 = qt * 64;
      if (isB) { t0 = 0; t1 = 128; }
      else { t0 = qt - 2 < 0 ? 0 : qt - 2; t1 = qt + 3 > 128 ? 128 : qt + 3; }
    } else {
      qt = ii & 3; kvh = (ii >> 2) & 1; b = ii >> 3;
      qrow0 = TLAT + b * CTXL + qt * 64; qpos0 = 0; t0 = 0; t1 = 0;
    }
    attn_item(isB ? QB : QA, isB ? KB : KA, isB ? VB : VA, concat, isB ? 256 : 0, b, kvh, qrow0, qpos0, t0, t1, 128, 132,
              (!isB) && (!isctx), isB ? nullptr : sink, smem);
  }
}

__device__ __forceinline__ void phase_retscan(const Params& p) {
  const float* U = (const float*)(p.ws + OFF_U);
  u16* SP = (u16*)(p.ws + OFF_SP);
  for (int gid = BIDX() * 256 + TIDX(); gid < 16 * 2 * 4096; gid += gridDim.x * 256) {
    int e = gid & 4095, dir = (gid >> 12) & 1, bh = gid >> 13;
    float g128 = exp2f(128.f * ret_lg(bh & 3));
    float S = 0.f;
#pragma unroll 1
    for (int n0 = 0; n0 < 66; n0 += 11) {
      float u[11];
      size_t offs[11];
#pragma unroll
      for (int k = 0; k < 11; ++k) {
        int n = n0 + k;
        int c = dir == 0 ? (n < 2 ? 64 + n : n - 2) : 65 - n;
        offs[k] = (((size_t)bh * 66 + c) * 2 + dir) * 4096 + e;
        u[k] = U[offs[k]];
      }
#pragma unroll
      for (int k = 0; k < 11; ++k) {
        SP[offs[k]] = f2bf(S);
        S = g128 * S + u[k];
      }
    }
  }
}

__device__ __forceinline__ void retout_item(const Params& p, int l, int bh, int c, unsigned char* smem) {
  const int tid = TIDX(), w = tid >> 6, lane = tid & 63, fr = lane & 15, fq = lane >> 4;
  const int b = bh >> 2, h = bh & 3;
  const u16* QR = (const u16*)(p.ws + OFF_QR);
  const u16* KR = (const u16*)(p.ws + OFF_KR) + (size_t)bh * STOT * 64;
  const u16* VR = (const u16*)(p.ws + OFF_VR) + (size_t)bh * 64 * STOT;
  const u16* SP = (const u16*)(p.ws + OFF_SP) + ((size_t)bh * 66 + c) * 2 * 4096;
  const u16* P2 = (const u16*)(p.ws + OFF_P2);
  u16* concat = (u16*)(p.ws + OFF_H);
  const int pos0 = c < 64 ? c * 128 : SEQ + (c - 64) * 128;
  const int row0 = bpos_row(b, pos0);
  u16* Kc = (u16*)smem;
  u16* Vs = Kc + 128 * 72;
  __syncthreads();
#pragma unroll
  for (int ps = 0; ps < 4; ++ps) {
    int idx = tid + ps * 256;
    int r = idx >> 3, ch = idx & 7;
    *(bf16x8*)(Kc + r * 72 + ch * 8) = *(const bf16x8*)(KR + (size_t)(pos0 + r) * 64 + ch * 8);
    int d = idx >> 4, c16 = idx & 15;
    *(bf16x8*)(Vs + d * 136 + c16 * 8) = *(const bf16x8*)(VR + (size_t)d * STOT + pos0 + c16 * 8);
  }
  __syncthreads();
  const float lg = ret_lg(h);
#pragma unroll 1
  for (int qg = 0; qg < 2; ++qg) {
    const int i = w * 32 + qg * 16 + fr;
    const int row = row0 + i;
    bf16x8 qf[2];
#pragma unroll
    for (int ks = 0; ks < 2; ++ks) qf[ks] = *(const bf16x8*)(QR + (size_t)row * 256 + h * 64 + ks * 32 + fq * 8);
    f32x4 s[8];
#pragma unroll
    for (int sub = 0; sub < 8; ++sub) {
      s[sub] = f32x4{0.f, 0.f, 0.f, 0.f};
#pragma unroll
      for (int ks = 0; ks < 2; ++ks) {
        bf16x8 a = *(const bf16x8*)(Kc + (sub * 16 + fr) * 72 + ks * 32 + fq * 8);
        s[sub] = __builtin_amdgcn_mfma_f32_16x16x32_bf16(a, qf[ks], s[sub], 0, 0, 0);
      }
    }
    float res[4][4];
#pragma unroll
    for (int dt = 0; dt < 4; ++dt)
#pragma unroll
      for (int j = 0; j < 4; ++j) res[dt][j] = 0.f;
#pragma unroll 1
    for (int dir = 0; dir < 2; ++dir) {
      f32x4 O[4];
      const float qw = dir == 0 ? __builtin_amdgcn_exp2f(lg * (float)(i + 1)) : __builtin_amdgcn_exp2f(lg * (float)(128 - i));
#pragma unroll
      for (int dt = 0; dt < 4; ++dt) {
        O[dt] = f32x4{0.f, 0.f, 0.f, 0.f};
#pragma unroll
        for (int ks = 0; ks < 2; ++ks) {
          bf16x8 a = *(const bf16x8*)(SP + dir * 4096 + (dt * 16 + fr) * 64 + ks * 32 + fq * 8);
          O[dt] = __builtin_amdgcn_mfma_f32_16x16x32_bf16(a, qf[ks], O[dt], 0, 0, 0);
        }
        O[dt] *= qw;
      }
      int fqo = fq;
      asm volatile("" : "+v"(fqo));
#pragma unroll
      for (int ks = 0; ks < 4; ++ks) {
        float pv[8];
#pragma unroll
        for (int e = 0; e < 8; ++e) {
          const int sub = 2 * ks + (e >> 2), j = e & 3;
          const int jk = sub * 16 + fqo * 4 + j;
          const int dd = dir == 0 ? i - jk : jk - i;
          pv[e] = dd >= 0 ? s[sub][j] * __builtin_amdgcn_exp2f(lg * (float)dd) : 0.f;
        }
        bf16x8 pb = cat8(pack4(pv[0], pv[1], pv[2], pv[3]), pack4(pv[4], pv[5], pv[6], pv[7]));
#pragma unroll
        for (int dt = 0; dt < 4; ++dt) {
          const u16* vp = Vs + (dt * 16 + fr) * 136 + ks * 32 + fq * 4;
          bf16x8 va = cat8(*(const bf16x4*)vp, *(const bf16x4*)(vp + 16));
          O[dt] = __builtin_amdgcn_mfma_f32_16x16x32_bf16(va, pb, O[dt], 0, 0, 0);
        }
      }
      float sm = 0.f;
#pragma unroll
      for (int dt = 0; dt < 4; ++dt)
#pragma unroll
        for (int j = 0; j < 4; ++j) sm += O[dt][j];
      sm += __shfl_xor(sm, 16); sm += __shfl_xor(sm, 32);
      const float mu = sm * (1.f / 64.f);
      float vs = 0.f;
#pragma unroll
      for (int dt = 0; dt < 4; ++dt)
#pragma unroll
        for (int j = 0; j < 4; ++j) { float dlt = O[dt][j] - mu; vs += dlt * dlt; }
      vs += __shfl_xor(vs, 16); vs += __shfl_xor(vs, 32);
      const float rstd = rsqrtf(vs * (1.f / 64.f) + GN_EPS);
#pragma unroll
      for (int dt = 0; dt < 4; ++dt) {
        const int d = dt * 16 + fq * 4;
        bf16x4 gt = *(const bf16x4*)(P2 + (size_t)row * P2C + dir * 256 + h * 64 + d);
        float4 rg = *(const float4*)(p.ret_g + (size_t)l * 256 + h * 64 + d);
        res[dt][0] += (O[dt][0] - mu) * rstd * rg.x * siluf_(bf2f((u16)gt[0]));
        res[dt][1] += (O[dt][1] - mu) * rstd * rg.y * siluf_(bf2f((u16)gt[1]));
        res[dt][2] += (O[dt][2] - mu) * rstd * rg.z * siluf_(bf2f((u16)gt[2]));
        res[dt][3] += (O[dt][3] - mu) * rstd * rg.w * siluf_(bf2f((u16)gt[3]));
      }
    }
#pragma unroll
    for (int dt = 0; dt < 4; ++dt)
      *(bf16x4*)(concat + (size_t)row * D + 512 + h * 64 + dt * 16 + fq * 4) = pack4(res[dt][0], res[dt][1], res[dt][2], res[dt][3]);
  }
}

__device__ __forceinline__ void phase_retout(const Params& p, int l, unsigned char* smem) {
  for (int item = BIDX(); item < 16 * 66; item += gridDim.x) retout_item(p, l, item / 66, item % 66, smem);
}

__device__ __forceinline__ void phase_wprep(const Params& p, int l, unsigned char* smem) {
  const int tid = TIDX(), lane = tid & 63, h = tid >> 6;
  const u16* P2 = (const u16*)(p.ws + OFF_P2);
  u16* prep = (u16*)(p.ws + OFF_PREP);
  float* twT = (float*)smem;
  float* amT = twT + 64 * 32;
  for (int item = BIDX(); item < (TALL / 32) * 2; item += gridDim.x) {
    const int dir = item & 1, row0 = (item >> 1) * 32;
    const float* mu = p.mu + ((size_t)l * 2 + dir) * 896;
    __syncthreads();
    {
      const int tok = tid >> 3, e0 = (tid & 7) * 8;
      const int row = row0 + tok;
      int b, pos;
      row_bpos(row, b, pos);
      bool has;
      int nrow;
      if (dir == 0) { has = (pos != 0) && (pos != SEQ); nrow = row - 1; }
      else { has = (pos != SEQ - 1) && (pos != STOT - 1); nrow = row + 1; }
      const u16* cw = P2 + (size_t)row * P2C + 1408 + dir * 64 + e0;
      const u16* ca = P2 + (size_t)row * P2C + 1536 + dir * 64 + e0;
      bf16x8 zw = *(const bf16x8*)cw, za = *(const bf16x8*)ca;
      bf16x8 sw = zw, sa = za;
      if (has) {
        sw = *(const bf16x8*)(P2 + (size_t)nrow * P2C + 1408 + dir * 64 + e0);
        sa = *(const bf16x8*)(P2 + (size_t)nrow * P2C + 1536 + dir * 64 + e0);
      }
#pragma unroll
      for (int e = 0; e < 8; ++e) {
        float z = bf2f((u16)zw[e]), zs = has ? bf2f((u16)sw[e]) : 0.f;
        float m = mu[768 + e0 + e];
        twT[(e0 + e) * 32 + tok] = tanhf(z + m * (zs - z));
        float z2 = bf2f((u16)za[e]), zs2 = has ? bf2f((u16)sa[e]) : 0.f;
        float m2 = mu[832 + e0 + e];
        amT[(e0 + e) * 32 + tok] = z2 + m2 * (zs2 - z2);
      }
    }
    __syncthreads();
    const int col = tid;
    float accw[32], acca[32];
#pragma unroll
    for (int t = 0; t < 32; ++t) { accw[t] = 0.f; acca[t] = 0.f; }
    const float* w2 = p.w2 + ((size_t)l * 2 + dir) * 64 * 256 + col;
    const float* a2 = p.a2 + ((size_t)l * 2 + dir) * 64 * 256 + col;
    for (int kq = 0; kq < 64; ++kq) {
      float wv = w2[kq * 256], av = a2[kq * 256];
#pragma unroll
      for (int t4 = 0; t4 < 8; ++t4) {
        float4 a = *(const float4*)(twT + kq * 32 + t4 * 4);
        float4 bq = *(const float4*)(amT + kq * 32 + t4 * 4);
        accw[t4 * 4 + 0] += a.x * wv; accw[t4 * 4 + 1] += a.y * wv; accw[t4 * 4 + 2] += a.z * wv; accw[t4 * 4 + 3] += a.w * wv;
        acca[t4 * 4 + 0] += bq.x * av; acca[t4 * 4 + 1] += bq.y * av; acca[t4 * 4 + 2] += bq.z * av; acca[t4 * 4 + 3] += bq.w * av;
      }
    }
    const float w0v = p.w0[((size_t)l * 2 + dir) * 256 + col], a0v = p.a0[((size_t)l * 2 + dir) * 256 + col];
    const float kkv = p.k_k[(size_t)l * 256 + col], kav = p.k_a[(size_t)l * 256 + col];
    const float mur = mu[col], muk = mu[256 + col], muv = mu[512 + col];
#pragma unroll
    for (int t = 0; t < 32; ++t) {
      const int row = row0 + t;
      int b, pos;
      row_bpos(row, b, pos);
      bool has;
      int nrow;
      if (dir == 0) { has = (pos != 0) && (pos != SEQ); nrow = row - 1; }
      else { has = (pos != SEQ - 1) && (pos != STOT - 1); nrow = row + 1; }
      const u16* cp = P2 + (size_t)row * P2C + 512 + col;
      const u16* np = P2 + (size_t)(has ? nrow : row) * P2C + 512 + col;
      float zr = bf2f(cp[0]), zk = bf2f(cp[256]), zv = bf2f(cp[512]);
      float sr = has ? bf2f(np[0]) : 0.f, sk = has ? bf2f(np[256]) : 0.f, sv = has ? bf2f(np[512]) : 0.f;
      float r = zr + mur * (sr - zr), k = zk + muk * (sk - zk), v = zv + muv * (sv - zv);
      float lw2 = -0.6065306597126334f * sigmoidf_(w0v + accw[t]) * LOG2E;
      float av = sigmoidf_(a0v + acca[t]);
      float kkr = k * kkv;
      float ss = wave_sum(kkr * kkr);
      float kk = kkr / fmaxf(sqrtf(ss), 1e-12f);
      float kt = k * (1.f + (av - 1.f) * kav);
      u16* dp = prep + (((size_t)(b * 4 + h) * 2 + dir) * STOT + pos) * 384 + lane;
      dp[0] = f2bf(lw2); dp[64] = f2bf(kt); dp[128] = f2bf(kk); dp[192] = f2bf(kk * av); dp[256] = f2bf(r); dp[320] = f2bf(v);
    }
  }
}

typedef float f32x2 __attribute__((ext_vector_type(2)));
__device__ __forceinline__ void wscan_item(const Params& p, int item, unsigned char* smem) {
  const int tid = TIDX(), w = tid >> 6, lane = tid & 63;
  const int jl4 = (lane & 15) * 4, rsub = lane >> 4;
  const u16* prep = (const u16*)(p.ws + OFF_PREP);
  u16* P2w = (u16*)(p.ws + OFF_P2);
  float* bufs = (float*)smem;
  {
    const int rq = item & 3, seq = item >> 2;
    const int dir = seq & 1, h = (seq >> 1) & 3, b = seq >> 3;
    const int irow = rq * 16 + w * 4 + rsub;
    const u16* base = prep + (size_t)seq * STOT * 384;
    uint4 lreg[3];
    auto gload = [&](int ch) {
#pragma unroll
      for (int ps = 0; ps < 3; ++ps) {
        int q = tid + ps * 256;
        int sidx = q / 48, within = q % 48;
        int n = ch * 16 + sidx;
        int pos = dir == 0 ? (n < CTXL ? SEQ + n : n - CTXL) : (STOT - 1 - n);
        lreg[ps] = *(const uint4*)(base + (size_t)pos * 384 + within * 8);
      }
    };
    auto lstore = [&](int buf) {
#pragma unroll
      for (int ps = 0; ps < 3; ++ps) {
        int q = tid + ps * 256;
        int sidx = q / 48, within = q % 48;
        float* dp = bufs + buf * 6144 + sidx * 384 + within * 8;
        uint4 u = lreg[ps];
        float4 lo = make_float4(__uint_as_float(u.x << 16), __uint_as_float(u.x & 0xffff0000u), __uint_as_float(u.y << 16), __uint_as_float(u.y & 0xffff0000u));
        float4 hi = make_float4(__uint_as_float(u.z << 16), __uint_as_float(u.z & 0xffff0000u), __uint_as_float(u.w << 16), __uint_as_float(u.w & 0xffff0000u));
        if (within < 8) {
          lo.x = __builtin_amdgcn_exp2f(lo.x); lo.y = __builtin_amdgcn_exp2f(lo.y); lo.z = __builtin_amdgcn_exp2f(lo.z); lo.w = __builtin_amdgcn_exp2f(lo.w);
          hi.x = __builtin_amdgcn_exp2f(hi.x); hi.y = __builtin_amdgcn_exp2f(hi.y); hi.z = __builtin_amdgcn_exp2f(hi.z); hi.w = __builtin_amdgcn_exp2f(hi.w);
        }
        *(float4*)dp = lo;
        *(float4*)(dp + 4) = hi;
      }
    };
    f32x2 S01 = {0.f, 0.f}, S23 = {0.f, 0.f};
    __syncthreads();
    gload(0);
    lstore(0);
    __syncthreads();
    constexpr int NCH = STOT / 16;
    for (int ch = 0; ch < NCH; ++ch) {
      if (ch + 1 < NCH) gload(ch + 1);
      const float* bp = bufs + (ch & 1) * 6144;
      const int n0 = ch * 16;
      const int pos0 = dir == 0 ? (n0 < CTXL ? SEQ + n0 : n0 - CTXL) : (STOT - 1 - n0);
      u16* yp = P2w + (size_t)bpos_row(b, pos0) * P2C + (dir == 0 ? YCOL0 : YCOL1) + h * 64 + irow;
      const int ystride = dir == 0 ? P2C : -P2C;
      float4 Wq[3], Kq[3], Nq[3], Bq[3], Rq[3];
      float Vq[3];
#define SCAN_LD(slot, st)                                        \
      do {                                                         \
        const float* sp_ = bp + (st) * 384;                        \
        Wq[slot] = *(const float4*)(sp_ + jl4);                    \
        Kq[slot] = *(const float4*)(sp_ + 64 + jl4);               \
        Nq[slot] = *(const float4*)(sp_ + 128 + jl4);              \
        Bq[slot] = *(const float4*)(sp_ + 192 + jl4);              \
        Rq[slot] = *(const float4*)(sp_ + 256 + jl4);              \
        Vq[slot] = sp_[320 + irow];                                \
      } while (0)
      SCAN_LD(0, 0);
      SCAN_LD(1, 1);
      SCAN_LD(2, 2);
      float ypart = 0.f;
#pragma unroll
      for (int s = 0; s < 16; ++s) {
        const int sl = s % 3;
        const float4 wv = Wq[sl], kt = Kq[sl], kk = Nq[sl], bb = Bq[sl], rr = Rq[sl];
        const float v = Vq[sl];
        if (s + 3 < 16) SCAN_LD(sl, s + 3);
        const f32x2 vv = {v, v};
        f32x2 A01 = S01 * f32x2{wv.x, wv.y} + vv * f32x2{kt.x, kt.y};
        f32x2 A23 = S23 * f32x2{wv.z, wv.w} + vv * f32x2{kt.z, kt.w};
        f32x2 pp = S01 * f32x2{kk.x, kk.y} + S23 * f32x2{kk.z, kk.w};
        float sa = pp.x + pp.y;
        float yprev = ypart;
        row16_sum2(sa, yprev);
        if (s > 0) { if ((lane & 15) == 0) yp[(s - 1) * ystride] = f2bf(yprev); }
        const f32x2 nsa = {-sa, -sa};
        S01 = nsa * f32x2{bb.x, bb.y} + A01;
        S23 = nsa * f32x2{bb.z, bb.w} + A23;
        f32x2 yy = S01 * f32x2{rr.x, rr.y} + S23 * f32x2{rr.z, rr.w};
        ypart = yy.x + yy.y;
      }
      {
        float ylast = row16_sum(ypart);
        if ((lane & 15) == 0) yp[15 * ystride] = f2bf(ylast);
      }
#undef SCAN_LD
      if (ch + 1 < NCH) lstore((ch + 1) & 1);
      __syncthreads();
    }
  }
}

__device__ __forceinline__ void phase_scan_attn(const Params& p, int l, unsigned char* smem) {
  const int G = gridDim.x, tid = TIDX(), bid = BIDX();
  if (G > 128 && G <= 2048) {
    int* keys = (int*)smem;
    int* red = keys + 2048;
    const int* cutab = (const int*)(p.ws + OFF_CUTAB);
    __syncthreads();
    for (int i = tid; i < G; i += 256) keys[i] = cutab[i];
    if (tid == 0) { red[0] = 0; red[1] = 0; }
    __syncthreads();
    for (int i = 128 + tid; i < G; i += 256) {
      const int ki = keys[i];
      bool m = false;
      for (int j = 0; j < 128; ++j) m = m || (keys[j] == ki);
      if (!m) atomicAdd(&red[0], 1);
      if (m && i == bid) red[1] = 1;
    }
    __syncthreads();
    const int eligible = red[0], mine = red[1];
    __syncthreads();
    if (bid < 128) {
      __builtin_amdgcn_s_setprio(3);
      wscan_item(p, bid, smem);
      __builtin_amdgcn_s_setprio(0);
    } else if (eligible < 64 || !mine) {
      attn_worker(p, l, smem);
    }
  } else {
    for (int item = bid; item < 128; item += G) wscan_item(p, item, smem);
    attn_worker(p, l, smem);
  }
}

__device__ __forceinline__ void phase_wfin(const Params& p, int l, unsigned char* smem) {
  const int tid = TIDX(), lane = tid & 63, h = tid >> 6, col = tid;
  const u16* P2 = (const u16*)(p.ws + OFF_P2);
  const u16* prep = (const u16*)(p.ws + OFF_PREP);
  u16* concat = (u16*)(p.ws + OFF_H);
  float* sgT = (float*)smem;
  const float lng = p.ln_g[(size_t)l * 256 + col], lnb = p.ln_b[(size_t)l * 256 + col];
  const float rho0 = p.rho[((size_t)l * 2 + 0) * 256 + col], rho1 = p.rho[((size_t)l * 2 + 1) * 256 + col];
  const float* g2 = p.g2 + (size_t)l * 128 * 256 + col;
  for (int item = BIDX(); item < TALL / 16; item += gridDim.x) {
    const int row0 = item * 16;
    __syncthreads();
    {
      const int tok = tid >> 4, k0 = (tid & 15) * 8;
      bf16x8 g = *(const bf16x8*)(P2 + (size_t)(row0 + tok) * P2C + 1280 + k0);
#pragma unroll
      for (int e = 0; e < 8; ++e) sgT[(k0 + e) * 16 + tok] = sigmoidf_(bf2f((u16)g[e]));
    }
    __syncthreads();
    float acc[16];
#pragma unroll
    for (int t = 0; t < 16; ++t) acc[t] = 0.f;
    for (int k = 0; k < 128; ++k) {
      float gv = g2[k * 256];
#pragma unroll
      for (int t4 = 0; t4 < 4; ++t4) {
        float4 a = *(const float4*)(sgT + k * 16 + t4 * 4);
        acc[t4 * 4 + 0] += a.x * gv; acc[t4 * 4 + 1] += a.y * gv; acc[t4 * 4 + 2] += a.z * gv; acc[t4 * 4 + 3] += a.w * gv;
      }
    }
#pragma unroll
    for (int t = 0; t < 16; ++t) {
      const int row = row0 + t;
      int b, pos;
      row_bpos(row, b, pos);
      float tot = 0.f;
#pragma unroll
      for (int dir = 0; dir < 2; ++dir) {
        float y = bf2f(P2[(size_t)row * P2C + (dir == 0 ? YCOL0 : YCOL1) + col]);
        float mu = wave_sum(y) * (1.f / 64.f);
        float dl = y - mu;
        float var = wave_sum(dl * dl) * (1.f / 64.f);
        float yn = dl * rsqrtf(var + GN_EPS) * lng + lnb;
        const u16* pp = prep + (((size_t)(b * 4 + h) * 2 + dir) * STOT + pos) * 384 + lane;
        float kt = bf2f(pp[64]), r = bf2f(pp[256]), v = bf2f(pp[320]);
        float bs = wave_sum(r * kt * (dir == 0 ? rho0 : rho1));
        tot += yn + bs * v;
      }
      concat[(size_t)row * D + 768 + col] = f2bf(tot * acc[t]);
    }
  }
}

constexpr int N_PHASES = 1 + 2 * 16 + 1;
__device__ __forceinline__ void run_phase(const Params& p, int ph, unsigned char* smem) {
  if (ph == 0) { phase_init(p, smem); return; }
  if (ph == N_PHASES - 1) { phase_final_norm(p); return; }
  const int l = (ph - 1) / 16, s = (ph - 1) % 16;
  float* xc = (float*)(p.ws + OFF_XC);
  const float* lat_in = (l == 0 && s < 3) ? p.x : p.out;
  const float* cx_in = (l == 0 && s < 3) ? p.ctx : xc;
  const u16* H = (const u16*)(p.ws + OFF_H);
  const u16* ACT = (const u16*)(p.ws + OFF_P2);
  switch (s) {
    case 0: phase_norm(p, l, 0, lat_in, cx_in); break;
    case 1: phase_ffn_in(p, l, 0, smem); break;
    case 2: phase_resid_gemm(p, l, ACT, (const u16*)(p.ws + OFF_WFFO) + (size_t)0 * 1024 * DFF, DFF, 2, 0.5f, lat_in, cx_in, p.out, xc, smem); break;
    case 3: phase_norm(p, l, 1, p.out, xc); break;
    case 4: phase_inproj(p, l, smem); break;
    case 5: phase_retU(p, smem); break;
    case 6: phase_retscan(p); break;
    case 7: phase_retout(p, l, smem); break;
    case 8: phase_wprep(p, l, smem); break;
    case 9: phase_scan_attn(p, l, smem); break;
    case 10: phase_wfin(p, l, smem); break;
    case 11: phase_resid_gemm(p, l, H, (const u16*)(p.ws + OFF_WOUT), 1024, 5, 1.0f, p.out, xc, p.out, xc, smem); break;
    case 12: phase_norm(p, l, 2, p.out, xc); break;
    case 13: phase_ffn_in(p, l, 1, smem); break;
    case 14: phase_resid_gemm(p, l, ACT, (const u16*)(p.ws + OFF_WFFO) + (size_t)1 * 1024 * DFF, DFF, 8, 0.5f, p.out, xc, p.out, xc, smem); break;
    default: if (l == 0) convert_weights(p, 1, smem); break;
  }
}

#if MULTI_LAUNCH
__global__ void __launch_bounds__(256, 2) k_phase(Params p, int ph) {
  __shared__ __attribute__((aligned(16))) unsigned char smem[49152];
  run_phase(p, ph, smem);
}
#else
constexpr int SMEM_BYTES = 65536;
__global__ void __launch_bounds__(256, 2) k_mega(Params p) {
  __shared__ __attribute__((aligned(16))) unsigned char smem[SMEM_BYTES];
  cg::grid_group grid = cg::this_grid();
  volatile LAS unsigned* st = (volatile LAS unsigned*)(smem + SMEM_BYTES - 16);
  if (threadIdx.x == 0) { st[0] = 0u; st[1] = 0u; }
  __syncthreads();
  {
    unsigned* bw = (unsigned*)(p.ws + OFF_BAR);
    for (int i = blockIdx.x * 256 + threadIdx.x; i < XCD_BAR_WORDS; i += gridDim.x * 256) bw[i] = 0u;
  }
  grid.sync();
  XcdBarrier xb = xcd_barrier_post((unsigned*)(p.ws + OFF_BAR), st);
  run_phase(p, 0, smem);
  xcd_barrier(xb);
#pragma unroll 1
  for (int l = 0; l < 2; ++l) {
#pragma unroll 1
    for (int s = 0; s < 16 - l; ++s) {
      run_phase(p, 1 + l * 16 + s, smem);
      xcd_barrier(xb);
#ifdef PROBE_REPEAT
      if ((PROBE_REPEAT >> s) & 1) {
        run_phase(p, 1 + l * 16 + s, smem);
        xcd_barrier(xb);
      }
#endif
    }
  }
  run_phase(p, N_PHASES - 1, smem);
}
#endif

extern "C" void kernel_launch(void* const* d_in, const int* in_sizes, int n_in, void* d_out, int out_size, void* d_ws,
                              size_t ws_size, hipStream_t stream) {
  Params p{};
  const float** pp = (const float**)&p;
  for (int i = 0; i < 26; ++i) pp[i] = (const float*)d_in[i];
  p.out = (float*)d_out;
  p.ws = (unsigned char*)d_ws;
#if MULTI_LAUNCH
  for (int ph = 0; ph < N_PHASES; ++ph) {
    if (ph > 0 && ((ph - 1) % 16) == 15 && ph != N_PHASES - 1) continue;
    k_phase<<<dim3(512), dim3(256), 0, stream>>>(p, ph);
  }
#else
  static int grid_blocks = 0;
  if (!grid_blocks) {
    int dev = 0, cus = 0, per_cu = 0;
    hipGetDevice(&dev);
    hipDeviceGetAttribute(&cus, hipDeviceAttributeMultiprocessorCount, dev);
    hipOccupancyMaxActiveBlocksPerMultiprocessor(&per_cu, k_mega, 256, 0);
    if (per_cu > 2) per_cu = 2;
    grid_blocks = cus * per_cu;
  }
  void* args[] = {&p};
  hipError_t e = hipLaunchCooperativeKernel((void*)k_mega, dim3(grid_blocks), dim3(256), args, 0, stream);
  if (e != hipSuccess) fprintf(stderr, "cooperative launch failed: %s (grid %d)\n", hipGetErrorString(e), grid_blocks);
#endif
}
```

```cpp
#include <hip/hip_runtime.h>
#include <hip/hip_bf16.h>
#include <hip/hip_cooperative_groups.h>
#include <cstdio>
namespace cg = cooperative_groups;

#ifndef MULTI_LAUNCH
#define MULTI_LAUNCH 0
#endif

typedef unsigned short u16;
using bf16x8 = __attribute__((ext_vector_type(8))) short;
using bf16x4 = __attribute__((ext_vector_type(4))) short;
using f32x4 = __attribute__((ext_vector_type(4))) float;

constexpr int D = 1024;
constexpr int TLAT = 32768;
constexpr int TCTX = 1024;
constexpr int TALL = TLAT + TCTX;
constexpr int SEQ = 8192;
constexpr int CTXL = 256;
constexpr int STOT = SEQ + CTXL;
constexpr int DFF = 2816;
constexpr int PC = 3456;
constexpr int P2C = 1664;
constexpr int NMOD = 9 * D;
constexpr float LOG2E = 1.4426950408889634f;
constexpr float RMS_EPS = 1e-6f;
constexpr float GN_EPS = 64e-5f;

constexpr size_t MiB = 1ull << 20;
constexpr size_t OFF_WFFI = 0;
constexpr size_t OFF_WFFO = 22 * MiB;
constexpr size_t OFF_WIN = 33 * MiB;
constexpr size_t OFF_WOUT = OFF_WIN + 27 * MiB / 4;
constexpr size_t OFF_MOD = OFF_WOUT + 2 * MiB;
constexpr size_t OFF_BAR = OFF_MOD + 384 * 1024;
constexpr size_t OFF_QCTR = OFF_MOD + 400 * 1024;
constexpr size_t OFF_CUTAB = OFF_QCTR + 256;
constexpr size_t OFF_ROPE = OFF_MOD + MiB / 2;
constexpr size_t OFF_XC = OFF_ROPE + 5 * MiB / 2;
constexpr size_t OFF_H = OFF_XC + 4 * MiB;
constexpr size_t OFF_P2 = OFF_H + 66 * MiB;
constexpr size_t OFF_BIG = OFF_P2 + 429 * MiB / 4;
constexpr size_t SZ_Q = (size_t)TALL * 256 * 2;
constexpr size_t SZ_KV2 = (size_t)4 * 2 * STOT * 64 * 2;
constexpr size_t SZ_KV4 = (size_t)4 * 4 * STOT * 64 * 2;
constexpr size_t OFF_QA = OFF_BIG;
constexpr size_t OFF_QB = OFF_QA + SZ_Q;
constexpr size_t OFF_KA = OFF_QB + SZ_Q;
constexpr size_t OFF_VA = OFF_KA + SZ_KV2;
constexpr size_t OFF_KB = OFF_VA + SZ_KV2;
constexpr size_t OFF_VB = OFF_KB + SZ_KV2;
constexpr size_t OFF_R0 = OFF_VB + SZ_KV2;
constexpr size_t OFF_QR = OFF_R0;
constexpr size_t OFF_KR = OFF_QR + SZ_Q;
constexpr size_t OFF_VR = OFF_KR + SZ_KV4;
constexpr size_t OFF_U = OFF_VR + SZ_KV4;
constexpr size_t OFF_SP = OFF_U + (size_t)16 * 66 * 2 * 4096 * 4;
constexpr size_t OFF_PREP = OFF_R0;
constexpr size_t WS_END = OFF_PREP + (size_t)32 * STOT * 384 * 2;
constexpr int YCOL0 = 768, YCOL1 = 1408;
static_assert(WS_END <= 512 * MiB, "workspace overflow");
static_assert(OFF_SP + (size_t)16 * 66 * 2 * 4096 * 2 <= 512 * MiB, "workspace overflow");
static_assert(OFF_P2 + (size_t)TALL * DFF * 2 <= 512 * MiB, "act overflow");

struct Params {
  const float *x, *c, *ctx, *c_ctx, *w_mod, *b_mod, *norm_g, *ffn_w_in, *ffn_w_out, *w_in, *w_out, *attn_sink, *qk_g,
      *ret_g, *mu, *w0, *w2, *a0, *a2, *rho, *k_k, *k_a, *g2, *ln_g, *ln_b, *final_g;
  float* out;
  unsigned char* ws;
};

__device__ __forceinline__ int TIDX() { int t = threadIdx.x; asm volatile("" : "+v"(t)); return t & 255; }
__device__ __forceinline__ int BIDX() { int t = blockIdx.x; asm volatile("" : "+s"(t)); return t; }
typedef float f32x2_t __attribute__((ext_vector_type(2)));
typedef __bf16 bf16x2_t __attribute__((ext_vector_type(2)));
__device__ __forceinline__ unsigned pk2bf(float a, float b) {
  f32x2_t v = {a, b};
  return __builtin_bit_cast(unsigned, __builtin_convertvector(v, bf16x2_t));
}
__device__ __forceinline__ u16 f2bf(float f) { return (u16)(pk2bf(f, 0.f) & 0xffffu); }
__device__ __forceinline__ float bf2f(u16 h) { return __uint_as_float(((unsigned)h) << 16); }
__device__ __forceinline__ float sigmoidf_(float x) { return __builtin_amdgcn_rcpf(1.f + __expf(-x)); }
__device__ __forceinline__ float siluf_(float x) { return x * __builtin_amdgcn_rcpf(1.f + __expf(-x)); }
__device__ __forceinline__ float tanhf_(float x) { return 1.f - 2.f * __builtin_amdgcn_rcpf(__expf(2.f * x) + 1.f); }
template <int CTRL>
__device__ __forceinline__ float dpp_f(float x) {
  return __builtin_bit_cast(float, __builtin_amdgcn_update_dpp(0, __builtin_bit_cast(int, x), CTRL, 0xf, 0xf, true));
}
__device__ __forceinline__ float row16_sum(float x) {
  x += dpp_f<0xB1>(x);
  x += dpp_f<0x4E>(x);
  x += dpp_f<0x141>(x);
  x += dpp_f<0x140>(x);
  return x;
}
__device__ __forceinline__ float wave_sum(float x) {
  x = row16_sum(x);
  x += __builtin_bit_cast(float, __builtin_amdgcn_update_dpp(0, __builtin_bit_cast(int, x), 0x142, 0xa, 0xf, false));
  x += __builtin_bit_cast(float, __builtin_amdgcn_update_dpp(0, __builtin_bit_cast(int, x), 0x143, 0xc, 0xf, false));
  return __builtin_bit_cast(float, __builtin_amdgcn_readlane(__builtin_bit_cast(int, x), 63));
}
__device__ __forceinline__ void row16_sum2(float& a, float& b) {
  a += dpp_f<0xB1>(a);  b += dpp_f<0xB1>(b);
  a += dpp_f<0x4E>(a);  b += dpp_f<0x4E>(b);
  a += dpp_f<0x141>(a); b += dpp_f<0x141>(b);
  a += dpp_f<0x140>(a); b += dpp_f<0x140>(b);
}
__device__ __forceinline__ bf16x4 pack4(float a, float b, float c, float d) {
  uint2 u = make_uint2(pk2bf(a, b), pk2bf(c, d));
  return __builtin_bit_cast(bf16x4, u);
}
__device__ __forceinline__ bf16x8 cat8(bf16x4 a, bf16x4 b) {
  bf16x8 r;
  r[0] = a[0]; r[1] = a[1]; r[2] = a[2]; r[3] = a[3]; r[4] = b[0]; r[5] = b[1]; r[6] = b[2]; r[7] = b[3];
  return r;
}
__device__ __forceinline__ const float* rrow(const float* lat, const float* cx, int r) {
  return r < TLAT ? lat + (size_t)r * D : cx + (size_t)(r - TLAT) * D;
}
__device__ __forceinline__ float* wrow(float* lat, float* cx, int r) {
  return r < TLAT ? lat + (size_t)r * D : cx + (size_t)(r - TLAT) * D;
}
__device__ __forceinline__ int mod_index(int r) { return r < TLAT ? (r >> 13) : 4; }
__device__ __forceinline__ void row_bpos(int r, int& b, int& pos) {
  if (r < TLAT) { b = r >> 13; pos = r & 8191; }
  else { int rc = r - TLAT; b = rc >> 8; pos = SEQ + (rc & 255); }
}
__device__ __forceinline__ int bpos_row(int b, int pos) {
  return pos < SEQ ? b * SEQ + pos : TLAT + b * CTXL + (pos - SEQ);
}


#define XB_TMO      128
#define XB_XCNT(j)  (256  + 64 * (j))
#define XB_XSUB(j)  (1280 + 64 * (j))
#define XB_XGEN(j)  (2304 + 64 * (j))
#define XB_TOP      3328
#define XB_TOPGEN   3392
#define XCD_BAR_WORDS 3456
#define XB_SPIN_CAP (1u << 18)
#define LAS __attribute__((address_space(3)))
__device__ __forceinline__ unsigned xb_ld(unsigned* p) { return __hip_atomic_load(p, __ATOMIC_RELAXED, __HIP_MEMORY_SCOPE_AGENT); }
__device__ __forceinline__ unsigned xb_add(unsigned* p, unsigned v) { return __hip_atomic_fetch_add(p, v, __ATOMIC_RELAXED, __HIP_MEMORY_SCOPE_AGENT); }
__device__ __forceinline__ unsigned xb_xcc_id() { return (unsigned)__builtin_amdgcn_s_getreg((3 << 11) | 20) & 0xFu; }
#define XB_SPIN(cond, bar) do { unsigned _sp = 0; while (cond) { __builtin_amdgcn_s_sleep(1); \
    if ((++_sp & 255u) == 0u) { if (xb_ld(&(bar)[XB_TMO])) break; if (_sp > XB_SPIN_CAP) { atomicAdd(&(bar)[XB_TMO], 1u); break; } } } } while (0)
struct XcdBarrier { unsigned* bar; unsigned x; volatile LAS unsigned* st; };
__device__ __forceinline__ XcdBarrier xcd_barrier_post(unsigned* bar, volatile LAS unsigned* st) {
  XcdBarrier b; b.bar = bar; b.x = xb_xcc_id(); b.st = st;
  if (threadIdx.x == 0) (void)xb_add(&bar[XB_XCNT(b.x)], 1u);
  return b;
}
__device__ __forceinline__ void xcd_barrier_complete(unsigned* bar, unsigned x, unsigned& nloc, unsigned& nx) {
  const unsigned G = gridDim.x * gridDim.y * gridDim.z;
  unsigned sum, cnt, mine, sp = 0u;
  for (;;) {
    sum = 0u; cnt = 0u; mine = 0u;
#pragma unroll
    for (unsigned j = 0; j < 16; ++j) { const unsigned c = xb_ld(&bar[XB_XCNT(j)]); sum += c; cnt += (c > 0u) ? 1u : 0u; mine = (j == x) ? c : mine; }
    if (sum == G) break;
    __builtin_amdgcn_s_sleep(1);
    if ((++sp & 255u) == 0u) { if (xb_ld(&bar[XB_TMO])) break; if (sp > XB_SPIN_CAP) { atomicAdd(&bar[XB_TMO], 1u); break; } }
  }
  nloc = mine > 0u ? mine : 1u; nx = cnt > 0u ? cnt : 1u;
}
__device__ __forceinline__ void xcd_barrier(const XcdBarrier& b) {
  asm volatile("s_waitcnt vmcnt(0)" ::: "memory");
  __syncthreads();
  if (threadIdx.x == 0) {
    unsigned* bar = b.bar;
    __builtin_amdgcn_s_waitcnt(0);
    unsigned nloc = b.st[0], nx = b.st[1];
    if (nloc == 0u) { xcd_barrier_complete(bar, b.x, nloc, nx); b.st[0] = nloc; b.st[1] = nx; }
    const unsigned old = xb_add(&bar[XB_XSUB(b.x)], 1u);
    const unsigned gen = old / nloc;
    if (old + 1u == (gen + 1u) * nloc) {
      __builtin_amdgcn_fence(__ATOMIC_RELEASE, "agent");
      asm volatile("s_waitcnt vmcnt(0)" ::: "memory");
      const unsigned og = xb_add(&bar[XB_TOP], 1u);
      const unsigned tg = og / nx;
      if (og + 1u == (tg + 1u) * nx) xb_add(&bar[XB_TOPGEN], 1u);
      else XB_SPIN(xb_ld(&bar[XB_TOPGEN]) == tg, bar);
      __builtin_amdgcn_fence(__ATOMIC_ACQUIRE, "agent");
      xb_add(&bar[XB_XGEN(b.x)], 1u);
      asm volatile("s_waitcnt vmcnt(0)" ::: "memory");
    } else {
      XB_SPIN(xb_ld(&bar[XB_XGEN(b.x)]) == gen, bar);
      __builtin_amdgcn_fence(__ATOMIC_ACQUIRE, "agent");
      asm volatile("s_waitcnt vmcnt(0)" ::: "memory");
    }
  }
  __syncthreads();
}

__device__ __forceinline__ void convert_weights(const Params& p, int layer, unsigned char* smem) {
  const int tid = TIDX();
  const int nb = gridDim.x, bid = BIDX();
  {
    float* tile = (float*)smem;
    constexpr int N_FFI = 2 * 16 * 88, N_FFO = 2 * 44 * 16, N_WIN = 16 * 54, N_WOUT = 16 * 16;
    for (int item = bid; item < N_FFI + N_FFO + N_WIN + N_WOUT; item += nb) {
      const float* src; u16* dst; int K, N, kt, nt; bool perm = false;
      int it = item;
      if (it < N_FFI) {
        int f = it / (16 * 88); it %= (16 * 88);
        K = 1024; N = 5632; kt = it / 88; nt = it % 88; perm = true;
        src = p.ffn_w_in + (size_t)(layer * 2 + f) * 1024 * 5632;
        dst = (u16*)(p.ws + OFF_WFFI) + (size_t)f * 5632 * 1024;
      } else if (it < N_FFI + N_FFO) {
        it -= N_FFI;
        int f = it / (44 * 16); it %= (44 * 16);
        K = 2816; N = 1024; kt = it / 16; nt = it % 16;
        src = p.ffn_w_out + (size_t)(layer * 2 + f) * 2816 * 1024;
        dst = (u16*)(p.ws + OFF_WFFO) + (size_t)f * 1024 * 2816;
      } else if (it < N_FFI + N_FFO + N_WIN) {
        it -= N_FFI + N_FFO;
        K = 1024; N = 3456; kt = it / 54; nt = it % 54;
        src = p.w_in + (size_t)layer * 1024 * 3456;
        dst = (u16*)(p.ws + OFF_WIN);
      } else {
        it -= N_FFI + N_FFO + N_WIN;
        K = 1024; N = 1024; kt = it / 16; nt = it % 16;
        src = p.w_out + (size_t)layer * 1024 * 1024;
        dst = (u16*)(p.ws + OFF_WOUT);
      }
      __syncthreads();
      {
        const int r = tid >> 4, c4 = tid & 15;
        int np = nt * 64 + c4 * 4;
        int scol = np;
        if (perm) {
          int blk = np >> 7, sub = (np & 127) >> 4, i = np & 15;
          scol = ((sub & 1) ? DFF : 0) + blk * 64 + (sub >> 1) * 16 + i;
        }
#pragma unroll
        for (int ps = 0; ps < 4; ++ps) {
          int k = kt * 64 + ps * 16 + r;
          float4 v = *(const float4*)(src + (size_t)k * N + scol);
          float* tp = tile + (ps * 16 + r) * 65 + c4 * 4;
          tp[0] = v.x; tp[1] = v.y; tp[2] = v.z; tp[3] = v.w;
        }
      }
      __syncthreads();
      {
        const int n = tid >> 2, kq = tid & 3;
        bf16x8 o0, o1;
#pragma unroll
        for (int i = 0; i < 8; ++i) {
          o0[i] = (short)f2bf(tile[(kq * 16 + i) * 65 + n]);
          o1[i] = (short)f2bf(tile[(kq * 16 + 8 + i) * 65 + n]);
        }
        u16* dp = dst + (size_t)(nt * 64 + n) * K + kt * 64 + kq * 16;
        *(bf16x8*)dp = o0;
        *(bf16x8*)(dp + 8) = o1;
      }
    }
    __syncthreads();
  }
}

__device__ __forceinline__ void phase_init(const Params& p, unsigned char* smem) {
  const int tid = TIDX();
  const int nb = gridDim.x, bid = BIDX();
  if (bid == 0 && tid < 2) ((int*)(p.ws + OFF_QCTR))[tid] = 0;
  if (tid == 0) {
    const int hw = __builtin_amdgcn_s_getreg((7 << 11) | (8 << 6) | 4);
    const int xcc = __builtin_amdgcn_s_getreg((3 << 11) | 20) & 0xF;
    ((int*)(p.ws + OFF_CUTAB))[bid] = (xcc << 8) | (hw & 0xFF);
  }
  {
    float2* seq = (float2*)(p.ws + OFF_ROPE);
    float2* rowt = seq + 8192 * 32;
    float2* colt = rowt + 128 * 16;
    for (int i = bid * 256 + tid; i < 8192 * 32 + 128 * 16 + 64 * 16; i += nb * 256) {
      float ang;
      float2* dst;
      if (i < 8192 * 32) {
        int t = i >> 5, k = i & 31;
        float inv = 1.0f / powf(10000.0f, (float)(2 * k) / 64.0f);
        ang = (float)t * inv;
        dst = seq + i;
      } else {
        int j = i - 8192 * 32;
        int pidx = (j < 128 * 16) ? (j >> 4) : ((j - 128 * 16) >> 4);
        int k = j & 15;
        float inv = 1.0f / powf(10000.0f, (float)(2 * k) / 32.0f);
        ang = (float)pidx * inv;
        dst = rowt + j;
      }
      *dst = make_float2(cosf(ang), sinf(ang));
    }
    (void)colt;
  }
  {
    float* sc = (float*)smem;
    float* red = sc + 5 * 1024;
    for (int item = bid; item < 288; item += nb) {
      const int l = item / 144, cb = item % 144;
      __syncthreads();
      for (int i = tid; i < 5 * 1024; i += 256) {
        int m = i >> 10, k = i & 1023;
        float v = (m < 4) ? p.c[m * 1024 + k] : p.c_ctx[k];
        sc[i] = siluf_(v);
      }
      __syncthreads();
      const int cq = tid & 15, kg = tid >> 4;
      float acc[5][4];
#pragma unroll
      for (int m = 0; m < 5; ++m)
#pragma unroll
        for (int q = 0; q < 4; ++q) acc[m][q] = 0.f;
      const float* wbase = p.w_mod + (size_t)l * 1024 * NMOD + cb * 64 + cq * 4;
      for (int kk = 0; kk < 64; ++kk) {
        int k = kg * 64 + kk;
        float4 w4 = *(const float4*)(wbase + (size_t)k * NMOD);
#pragma unroll
        for (int m = 0; m < 5; ++m) {
          float s = sc[m * 1024 + k];
          acc[m][0] += s * w4.x; acc[m][1] += s * w4.y; acc[m][2] += s * w4.z; acc[m][3] += s * w4.w;
        }
      }
#pragma unroll
      for (int m = 0; m < 5; ++m)
#pragma unroll
        for (int q = 0; q < 4; ++q) red[(kg * 5 + m) * 64 + cq * 4 + q] = acc[m][q];
      __syncthreads();
      float* modp = (float*)(p.ws + OFF_MOD);
      for (int o = tid; o < 320; o += 256) {
        int m = o >> 6, cc = o & 63;
        float s = 0.f;
        for (int g = 0; g < 16; ++g) s += red[(g * 5 + m) * 64 + cc];
        int col = cb * 64 + cc;
        modp[((size_t)l * 5 + m) * NMOD + col] = s + p.b_mod[(size_t)l * NMOD + col];
      }
    }
    __syncthreads();
  }
  convert_weights(p, 0, smem);
}

__device__ __forceinline__ void phase_norm(const Params& p, int l, int which, const float* lat, const float* cx) {
  const int lane = TIDX() & 63, wid = TIDX() >> 6;
  u16* h = (u16*)(p.ws + OFF_H);
  const float* g = p.norm_g + ((size_t)l * 3 + which) * D;
  const float* modp = (const float*)(p.ws + OFF_MOD) + (size_t)l * 5 * NMOD;
  for (int r = BIDX() * 4 + wid; r < TALL; r += gridDim.x * 4) {
    const float* xr = rrow(lat, cx, r);
    const float* mp = modp + (size_t)mod_index(r) * NMOD + which * 3 * D;
    float4 v[4];
    float ss = 0.f;
#pragma unroll
    for (int i = 0; i < 4; ++i) {
      v[i] = *(const float4*)(xr + i * 256 + lane * 4);
      ss += v[i].x * v[i].x + v[i].y * v[i].y + v[i].z * v[i].z + v[i].w * v[i].w;
    }
    ss = wave_sum(ss);
    float rstd = rsqrtf(ss * (1.f / 1024.f) + RMS_EPS);
#pragma unroll
    for (int i = 0; i < 4; ++i) {
      int col = i * 256 + lane * 4;
      float4 gg = *(const float4*)(g + col);
      float4 sh = *(const float4*)(mp + col);
      float4 scl = *(const float4*)(mp + D + col);
      bf16x4 o = pack4(v[i].x * rstd * gg.x * (1.f + scl.x) + sh.x, v[i].y * rstd * gg.y * (1.f + scl.y) + sh.y,
                       v[i].z * rstd * gg.z * (1.f + scl.z) + sh.z, v[i].w * rstd * gg.w * (1.f + scl.w) + sh.w);
      *(bf16x4*)(h + (size_t)r * D + col) = o;
    }
  }
}

__device__ __forceinline__ void phase_final_norm(const Params& p) {
  const int lane = TIDX() & 63, wid = TIDX() >> 6;
  for (int r = BIDX() * 4 + wid; r < TLAT; r += gridDim.x * 4) {
    float* xr = p.out + (size_t)r * D;
    float4 v[4];
    float ss = 0.f;
#pragma unroll
    for (int i = 0; i < 4; ++i) {
      v[i] = *(const float4*)(xr + i * 256 + lane * 4);
      ss += v[i].x * v[i].x + v[i].y * v[i].y + v[i].z * v[i].z + v[i].w * v[i].w;
    }
    ss = wave_sum(ss);
    float rstd = rsqrtf(ss * (1.f / 1024.f) + RMS_EPS);
#pragma unroll
    for (int i = 0; i < 4; ++i) {
      int col = i * 256 + lane * 4;
      float4 gg = *(const float4*)(p.final_g + col);
      float4 o = make_float4(v[i].x * rstd * gg.x, v[i].y * rstd * gg.y, v[i].z * rstd * gg.z, v[i].w * rstd * gg.w);
      *(float4*)(xr + col) = o;
    }
  }
}

template <int MI>
__device__ __forceinline__ void gemm_mainloop(const u16* __restrict__ A, const u16* __restrict__ Bt, int K, int brow,
                                              int bcol, f32x4 (&acc)[MI][4], unsigned char* smem) {
  const int tid = TIDX(), wid = tid >> 6, lane = tid & 63, wr = wid >> 1, wc = wid & 1, fr = lane & 15, fq = lane >> 4;
  constexpr int BM = MI * 32;
  constexpr int ACH = BM * 4 / 256;
  constexpr int STAGE = BM * 64 + 8192;
#pragma unroll
  for (int m = 0; m < MI; ++m)
#pragma unroll
    for (int n = 0; n < 4; ++n) acc[m][n] = f32x4{0.f, 0.f, 0.f, 0.f};
  const int nk = K / 32;
  const int prow = tid >> 2, pq = ((tid & 3) ^ ((0x78 >> (((tid >> 4) & 3) * 2)) & 3)) * 8;
  const u16* ga = A + (size_t)(brow + prow) * K + pq;
  const u16* gb = Bt + (size_t)(bcol + prow) * K + pq;
  auto stage = [&](int t, int buf) {
    unsigned char* base = smem + buf * STAGE;
#pragma unroll
    for (int i = 0; i < ACH; ++i)
      __builtin_amdgcn_global_load_lds((const unsigned*)(ga + (size_t)i * 64 * K + t * 32),
                                       (__attribute__((address_space(3))) unsigned*)(base + (tid + i * 256) * 16), 16, 0, 0);
#pragma unroll
    for (int i = 0; i < 2; ++i)
      __builtin_amdgcn_global_load_lds((const unsigned*)(gb + (size_t)i * 64 * K + t * 32),
                                       (__attribute__((address_space(3))) unsigned*)(base + BM * 64 + (tid + i * 256) * 16), 16, 0, 0);
  };
  const int swz = (fq ^ ((0x78 >> (((fr >> 2) & 3) * 2)) & 3)) * 16;
  __syncthreads();
  stage(0, 0);
  for (int t = 0; t < nk; ++t) {
    __syncthreads();
    if (t + 1 < nk) stage(t + 1, (t + 1) & 1);
    const unsigned char* base = smem + (t & 1) * STAGE;
    bf16x8 af[MI], bfr[4];
#pragma unroll
    for (int m = 0; m < MI; ++m) af[m] = *(const bf16x8*)(base + (wr * MI * 16 + m * 16 + fr) * 64 + swz);
#pragma unroll
    for (int n = 0; n < 4; ++n) bfr[n] = *(const bf16x8*)(base + BM * 64 + (wc * 64 + n * 16 + fr) * 64 + swz);
#pragma unroll
    for (int m = 0; m < MI; ++m)
#pragma unroll
      for (int n = 0; n < 4; ++n) acc[m][n] = __builtin_amdgcn_mfma_f32_16x16x32_bf16(af[m], bfr[n], acc[m][n], 0, 0, 0);
  }
}

__device__ __forceinline__ bool next_tile(int it, int MT, int NT, int& tm, int& tn) {
  const int G = gridDim.x, b = BIDX();
  const int total = MT * NT;
  int id;
  if ((G & 7) == 0) {
    const int per = G >> 3;
    id = it * G + (b & 7) * per + (b >> 3);
  } else {
    id = b + it * G;
  }
  if (id >= total) return false;
  constexpr int GM = 8;
  const int gsz = GM * NT;
  const int g = id / gsz, rem = id - g * gsz;
  const int rows = (MT - g * GM) < GM ? (MT - g * GM) : GM;
  tn = rem / rows;
  tm = g * GM + (rem - tn * rows);
  return true;
}

__device__ __forceinline__ void phase_ffn_in(const Params& p, int l, int f, unsigned char* smem) {
  const u16* A = (const u16*)(p.ws + OFF_H);
  const u16* Bt = (const u16*)(p.ws + OFF_WFFI) + (size_t)f * 5632 * 1024;
  u16* act = (u16*)(p.ws + OFF_P2);
  const int tid = TIDX(), wid = tid >> 6, lane = tid & 63, wr = wid >> 1, wc = wid & 1, fr = lane & 15, fq = lane >> 4;
  constexpr int MI = 8, NT = 44, MT = TALL / (MI * 32);
  for (int it = 0;; ++it) {
    int tm, tn;
    if (!next_tile(it, MT, NT, tm, tn)) break;
    f32x4 acc[MI][4];
    gemm_mainloop<MI>(A, Bt, 1024, tm * MI * 32, tn * 128, acc, smem);
#pragma unroll
    for (int m = 0; m < MI; ++m)
#pragma unroll
      for (int q = 0; q < 2; ++q)
#pragma unroll
        for (int j = 0; j < 4; ++j) {
          int row = tm * MI * 32 + wr * MI * 16 + m * 16 + fq * 4 + j;
          int col = tn * 64 + wc * 32 + q * 16 + fr;
          float u1 = acc[m][2 * q][j], u2 = acc[m][2 * q + 1][j];
          act[(size_t)row * DFF + col] = f2bf(siluf_(u1) * u2);
        }
  }
}

__device__ __forceinline__ void phase_resid_gemm(const Params& p, int l, const u16* A, const u16* Bt, int K, int gate, float gscale,
                                 const float* lat_in, const float* cx_in, float* lat_out, float* cx_out,
                                 unsigned char* smem) {
  const int tid = TIDX(), wid = tid >> 6, lane = tid & 63, wr = wid >> 1, wc = wid & 1, fr = lane & 15, fq = lane >> 4;
  constexpr int MI = 6, NT = 8, MT = TALL / (MI * 32);
  const float* modp = (const float*)(p.ws + OFF_MOD) + (size_t)l * 5 * NMOD + gate * D;
  for (int it = 0;; ++it) {
    int tm, tn;
    if (!next_tile(it, MT, NT, tm, tn)) break;
    f32x4 acc[MI][4];
    gemm_mainloop<MI>(A, Bt, K, tm * MI * 32, tn * 128, acc, smem);
#pragma unroll
    for (int m = 0; m < MI; ++m)
#pragma unroll
      for (int j = 0; j < 4; ++j) {
        int row = tm * MI * 32 + wr * MI * 16 + m * 16 + fq * 4 + j;
        const float* mp = modp + (size_t)mod_index(row) * NMOD;
        const float* xi = rrow(lat_in, cx_in, row);
        float* xo = wrow(lat_out, cx_out, row);
#pragma unroll
        for (int n = 0; n < 4; ++n) {
          int col = tn * 128 + wc * 64 + n * 16 + fr;
          xo[col] = xi[col] + gscale * mp[col] * acc[m][n][j];
        }
      }
  }
}

__device__ __forceinline__ void phase_inproj(const Params& p, int l, unsigned char* smem) {
  const u16* A = (const u16*)(p.ws + OFF_H);
  const u16* Bt = (const u16*)(p.ws + OFF_WIN);
  const int tid = TIDX(), wid = tid >> 6, lane = tid & 63, wr = wid >> 1, wc = wid & 1, fr = lane & 15, fq = lane >> 4;
  constexpr int MI = 8, NT = 27, MT = TALL / (MI * 32);
  const float2* ropeseq = (const float2*)(p.ws + OFF_ROPE);
  const float2* roperow = ropeseq + 8192 * 32;
  const float2* ropecol = roperow + 128 * 16;
  u16* QA = (u16*)(p.ws + OFF_QA); u16* QB = (u16*)(p.ws + OFF_QB); u16* QR = (u16*)(p.ws + OFF_QR);
  u16* KA = (u16*)(p.ws + OFF_KA); u16* VA = (u16*)(p.ws + OFF_VA);
  u16* KB = (u16*)(p.ws + OFF_KB); u16* VB = (u16*)(p.ws + OFF_VB);
  u16* KR = (u16*)(p.ws + OFF_KR); u16* VR = (u16*)(p.ws + OFF_VR);
  u16* P2 = (u16*)(p.ws + OFF_P2);
  for (int it = 0;; ++it) {
    int tm, tn;
    if (!next_tile(it, MT, NT, tm, tn)) break;
    f32x4 acc[MI][4];
    gemm_mainloop<MI>(A, Bt, 1024, tm * MI * 32, tn * 128, acc, smem);
    const int r0 = tm * MI * 32 + wr * MI * 16;
    const int c0 = tn * 128 + wc * 64;
    const bool latent = r0 < TLAT;
    if (c0 >= 1792) {
#pragma unroll
      for (int m = 0; m < MI; ++m)
#pragma unroll
        for (int n = 0; n < 4; ++n)
#pragma unroll
          for (int j = 0; j < 4; ++j) {
            int row = r0 + m * 16 + fq * 4 + j;
            P2[(size_t)row * P2C + (c0 - 1792) + n * 16 + fr] = f2bf(acc[m][n][j]);
          }
      continue;
    }
    int kind;
    int ropek;
    int normk;
    float scale = 1.f;
    u16* dst; int hh, nh;
    if (c0 < 256) { kind = 0; ropek = 1; normk = -1; scale = 0.125f * LOG2E; dst = QA; hh = c0 >> 6; nh = 4; }
    else if (c0 < 384) { kind = 1; ropek = 1; normk = -1; dst = KA; hh = (c0 - 256) >> 6; nh = 2; }
    else if (c0 < 512) { kind = 2; ropek = 0; normk = -1; dst = VA; hh = (c0 - 384) >> 6; nh = 2; }
    else if (c0 < 768) { kind = 0; ropek = 1; normk = 0; scale = 0.125f * LOG2E; dst = QB; hh = (c0 - 512) >> 6; nh = 4; }
    else if (c0 < 896) { kind = 1; ropek = 1; normk = 1; dst = KB; hh = (c0 - 768) >> 6; nh = 2; }
    else if (c0 < 1024) { kind = 2; ropek = 0; normk = -1; dst = VB; hh = (c0 - 896) >> 6; nh = 2; }
    else if (c0 < 1280) { kind = 0; ropek = 2; normk = -1; dst = QR; hh = (c0 - 1024) >> 6; nh = 4; }
    else if (c0 < 1536) { kind = 1; ropek = 2; normk = -1; scale = 0.125f; dst = KR; hh = (c0 - 1280) >> 6; nh = 4; }
    else { kind = 2; ropek = 0; normk = -1; dst = VR; hh = (c0 - 1536) >> 6; nh = 4; }
    if (!latent) ropek = 0;
    if (kind == 2) {
#pragma unroll
      for (int m = 0; m < MI; ++m) {
        int b, pos;
        row_bpos(r0 + m * 16 + fq * 4, b, pos);
#pragma unroll
        for (int n = 0; n < 4; ++n) {
          int d = n * 16 + fr;
          bf16x4 o = pack4(acc[m][n][0], acc[m][n][1], acc[m][n][2], acc[m][n][3]);
          *(bf16x4*)(dst + ((size_t)(b * nh + hh) * 64 + d) * STOT + pos) = o;
        }
      }
      continue;
    }
    float gq[4] = {1.f, 1.f, 1.f, 1.f};
    if (normk >= 0) {
#pragma unroll
      for (int n = 0; n < 4; ++n) gq[n] = p.qk_g[((size_t)l * 2 + normk) * 64 + n * 16 + fr];
    }
#pragma unroll
    for (int m = 0; m < MI; ++m)
#pragma unroll
      for (int j = 0; j < 4; ++j) {
        int row = r0 + m * 16 + fq * 4 + j;
        float v0 = acc[m][0][j], v1 = acc[m][1][j], v2 = acc[m][2][j], v3 = acc[m][3][j];
        if (normk >= 0) {
          float ss = v0 * v0 + v1 * v1 + v2 * v2 + v3 * v3;
          ss += __shfl_xor(ss, 1); ss += __shfl_xor(ss, 2); ss += __shfl_xor(ss, 4); ss += __shfl_xor(ss, 8);
          float rstd = rsqrtf(ss * (1.f / 64.f) + RMS_EPS);
          v0 *= rstd * gq[0]; v1 *= rstd * gq[1]; v2 *= rstd * gq[2]; v3 *= rstd * gq[3];
        }
        int b, pos;
        row_bpos(row, b, pos);
        if (ropek == 1) {
          float2 cr = roperow[(pos >> 6) * 16 + fr];
          float2 cc = ropecol[(pos & 63) * 16 + fr];
          float o0 = v0 * cr.x - v1 * cr.y, o1 = v1 * cr.x + v0 * cr.y;
          float o2 = v2 * cc.x - v3 * cc.y, o3 = v3 * cc.x + v2 * cc.y;
          v0 = o0; v1 = o1; v2 = o2; v3 = o3;
        } else if (ropek == 2) {
          float2 ca = ropeseq[pos * 32 + fr];
          float2 cb = ropeseq[pos * 32 + 16 + fr];
          float o0 = v0 * ca.x - v2 * ca.y, o2 = v2 * ca.x + v0 * ca.y;
          float o1 = v1 * cb.x - v3 * cb.y, o3 = v3 * cb.x + v1 * cb.y;
          v0 = o0; v1 = o1; v2 = o2; v3 = o3;
        }
        v0 *= scale; v1 *= scale; v2 *= scale; v3 *= scale;
        u16* dp;
        if (kind == 0) dp = dst + (size_t)row * 256 + hh * 64 + fr;
        else dp = dst + ((size_t)(b * nh + hh) * STOT + pos) * 64 + fr;
        dp[0] = f2bf(v0); dp[16] = f2bf(v1); dp[32] = f2bf(v2); dp[48] = f2bf(v3);
      }
  }
}

__device__ __forceinline__ void attn_item(const u16* __restrict__ Q, const u16* __restrict__ Kb, const u16* __restrict__ Vt,
                          u16* __restrict__ concat, int ccol0, int b, int kvh, int qrow0, int qpos0, int t0, int t1,
                          int c0, int c1, bool masked, const float* sink, unsigned char* smem) {
  const int tid = TIDX(), w = tid >> 6, lane = tid & 63, fr = lane & 15, fq = lane >> 4;
  const int head = kvh * 2 + (w & 1);
  const int qoff = (w >> 1) * 32;
  bf16x8 qf[2][2];
#pragma unroll
  for (int qg = 0; qg < 2; ++qg)
#pragma unroll
    for (int ks = 0; ks < 2; ++ks)
      qf[qg][ks] = *(const bf16x8*)(Q + (size_t)(qrow0 + qoff + qg * 16 + fr) * 256 + head * 64 + ks * 32 + fq * 8);
  f32x4 O[2][4];
  float mrow[2], lrow[2];
#pragma unroll
  for (int qg = 0; qg < 2; ++qg) {
    mrow[qg] = -1e30f; lrow[qg] = 0.f;
#pragma unroll
    for (int dt = 0; dt < 4; ++dt) O[qg][dt] = f32x4{0.f, 0.f, 0.f, 0.f};
  }
  const u16* Kbase = Kb + (size_t)(b * 2 + kvh) * STOT * 64;
  const u16* Vbase = Vt + (size_t)(b * 2 + kvh) * 64 * STOT;
  const int n1 = t1 - t0, total = n1 + (c1 - c0);
  bf16x8 kreg[2], vreg[2];
  auto gload = [&](int i) {
    int tile = i < n1 ? t0 + i : c0 + (i - n1);
#pragma unroll
    for (int ps = 0; ps < 2; ++ps) {
      int idx = tid + ps * 256;
      kreg[ps] = *(const bf16x8*)(Kbase + (size_t)tile * 4096 + idx * 8);
      int d = idx >> 3, ch = idx & 7;
      vreg[ps] = *(const bf16x8*)(Vbase + (size_t)d * STOT + tile * 64 + ch * 8);
    }
  };
  auto lstore = [&](int buf) {
    u16* Ks = (u16*)(smem + buf * 18432);
    u16* Vs = Ks + 64 * 72;
#pragma unroll
    for (int ps = 0; ps < 2; ++ps) {
      int idx = tid + ps * 256;
      int r = idx >> 3, ch = idx & 7;
      *(bf16x8*)(Ks + r * 72 + ch * 8) = kreg[ps];
      *(bf16x8*)(Vs + r * 72 + ch * 8) = vreg[ps];
    }
  };
  __syncthreads();
  gload(0);
  lstore(0);
  __syncthreads();
#pragma unroll 1
  for (int i = 0; i < total; ++i) {
    const int tile = i < n1 ? t0 + i : c0 + (i - n1);
    if (i + 1 < total) gload(i + 1);
    const u16* Ks = (const u16*)(smem + (i & 1) * 18432);
    const u16* Vs = Ks + 64 * 72;
    f32x4 s[2][4];
#pragma unroll
    for (int qg = 0; qg < 2; ++qg)
#pragma unroll
      for (int sub = 0; sub < 4; ++sub) s[qg][sub] = f32x4{0.f, 0.f, 0.f, 0.f};
#pragma unroll
    for (int sub = 0; sub < 4; ++sub)
#pragma unroll
      for (int ks = 0; ks < 2; ++ks) {
        bf16x8 a = *(const bf16x8*)(Ks + (sub * 16 + fr) * 72 + ks * 32 + fq * 8);
#pragma unroll
        for (int qg = 0; qg < 2; ++qg) s[qg][sub] = __builtin_amdgcn_mfma_f32_16x16x32_bf16(a, qf[qg][ks], s[qg][sub], 0, 0, 0);
      }
    __builtin_amdgcn_sched_barrier(0);
    const bool domask = masked && (tile < 128);
    bf16x8 pb[2][2];
#pragma unroll
    for (int qg = 0; qg < 2; ++qg) {
      if (domask) {
        int qpos = qpos0 + qoff + qg * 16 + fr;
#pragma unroll
        for (int sub = 0; sub < 4; ++sub)
#pragma unroll
          for (int j = 0; j < 4; ++j) {
            int kpos = tile * 64 + sub * 16 + fq * 4 + j;
            int dd = kpos - qpos;
            if (dd > 128 || dd < -128) s[qg][sub][j] = -INFINITY;
          }
      }
      float mx = -INFINITY;
#pragma unroll
      for (int sub = 0; sub < 4; ++sub)
#pragma unroll
        for (int j = 0; j < 4; ++j) mx = fmaxf(mx, s[qg][sub][j]);
      mx = fmaxf(mx, __shfl_xor(mx, 16));
      mx = fmaxf(mx, __shfl_xor(mx, 32));
      float mnew = fmaxf(mrow[qg], mx);
      const bool changed = mnew > mrow[qg];
      float alpha = __builtin_amdgcn_exp2f(mrow[qg] - mnew);
      mrow[qg] = mnew;
      float ps = 0.f;
#pragma unroll
      for (int sub = 0; sub < 4; ++sub)
#pragma unroll
        for (int j = 0; j < 4; ++j) {
          float pv = __builtin_amdgcn_exp2f(s[qg][sub][j] - mnew);
          s[qg][sub][j] = pv;
          ps += pv;
        }
      lrow[qg] = lrow[qg] * alpha + ps;
      if (__builtin_amdgcn_ballot_w64(changed) != 0ull) {
#pragma unroll
        for (int dt = 0; dt < 4; ++dt) O[qg][dt] *= alpha;
      }
#pragma unroll
      for (int ks = 0; ks < 2; ++ks)
        pb[qg][ks] = cat8(pack4(s[qg][2 * ks][0], s[qg][2 * ks][1], s[qg][2 * ks][2], s[qg][2 * ks][3]),
                          pack4(s[qg][2 * ks + 1][0], s[qg][2 * ks + 1][1], s[qg][2 * ks + 1][2], s[qg][2 * ks + 1][3]));
      __builtin_amdgcn_sched_barrier(0);
    }
#pragma unroll
    for (int dt = 0; dt < 4; ++dt)
#pragma unroll
      for (int ks = 0; ks < 2; ++ks) {
        const u16* vp = Vs + (dt * 16 + fr) * 72 + ks * 32 + fq * 4;
        bf16x8 va = cat8(*(const bf16x4*)vp, *(const bf16x4*)(vp + 16));
#pragma unroll
        for (int qg = 0; qg < 2; ++qg) O[qg][dt] = __builtin_amdgcn_mfma_f32_16x16x32_bf16(va, pb[qg][ks], O[qg][dt], 0, 0, 0);
      }
    __builtin_amdgcn_sched_barrier(0);
    if (i + 1 < total) lstore((i + 1) & 1);
    __syncthreads();
  }
#pragma unroll
  for (int qg = 0; qg < 2; ++qg) {
    float lt = lrow[qg];
    lt += __shfl_xor(lt, 16);
    lt += __shfl_xor(lt, 32);
    if (sink) lt += __builtin_amdgcn_exp2f(sink[head] * LOG2E - mrow[qg]);
    float inv = 1.f / lt;
    int row = qrow0 + qoff + qg * 16 + fr;
#pragma unroll
    for (int dt = 0; dt < 4; ++dt) {
      bf16x4 o = pack4(O[qg][dt][0] * inv, O[qg][dt][1] * inv, O[qg][dt][2] * inv, O[qg][dt][3] * inv);
      *(bf16x4*)(concat + (size_t)row * D + ccol0 + head * 64 + dt * 16 + fq * 4) = o;
    }
  }
}

__device__ __forceinline__ float ret_lg(int h) {
  return log2f(1.0f - exp2f(-5.0f - (float)h));
}

__device__ __forceinline__ void retU_item(const Params& p, int bh, int c, unsigned char* smem) {
  const int tid = TIDX();
  const int b = bh >> 2, h = bh & 3;
  const u16* KR = (const u16*)(p.ws + OFF_KR) + (size_t)bh * STOT * 64;
  const u16* VR = (const u16*)(p.ws + OFF_VR) + (size_t)bh * 64 * STOT;
  (void)b;
  const int pos0 = c < 64 ? c * 128 : SEQ + (c - 64) * 128;
  u16* Kc = (u16*)smem;
  u16* Vj = Kc + 128 * 64;
  __syncthreads();
#pragma unroll
  for (int ps = 0; ps < 4; ++ps) {
    int idx = tid + ps * 256;
    *(bf16x8*)(Kc + idx * 8) = *(const bf16x8*)(KR + (size_t)pos0 * 64 + idx * 8);
    int d = idx >> 4, ch = idx & 15;
    bf16x8 v = *(const bf16x8*)(VR + (size_t)d * STOT + pos0 + ch * 8);
#pragma unroll
    for (int e = 0; e < 8; ++e) Vj[(ch * 8 + e) * 72 + d] = (u16)v[e];
  }
  __syncthreads();
  const int dk = tid >> 2, dv0 = (tid & 3) * 16;
  const float lg = ret_lg(h);
  float af[16], ab[16];
#pragma unroll
  for (int q = 0; q < 16; ++q) { af[q] = 0.f; ab[q] = 0.f; }
  for (int j = 0; j < 128; ++j) {
    float kf = bf2f(Kc[j * 64 + dk]);
    float kfw = kf * exp2f(lg * (float)(127 - j));
    float kbw = kf * exp2f(lg * (float)j);
    bf16x8 v0 = *(const bf16x8*)(Vj + j * 72 + dv0);
    bf16x8 v1 = *(const bf16x8*)(Vj + j * 72 + dv0 + 8);
#pragma unroll
    for (int q = 0; q < 8; ++q) {
      float a = bf2f((u16)v0[q]), bb = bf2f((u16)v1[q]);
      af[q] += kfw * a; ab[q] += kbw * a;
      af[8 + q] += kfw * bb; ab[8 + q] += kbw * bb;
    }
  }
  float* U = (float*)(p.ws + OFF_U) + ((size_t)bh * 66 + c) * 2 * 4096;
#pragma unroll
  for (int q = 0; q < 16; ++q) {
    U[(dv0 + q) * 64 + dk] = af[q];
    U[4096 + (dv0 + q) * 64 + dk] = ab[q];
  }
}

__device__ __forceinline__ void phase_retU(const Params& p, unsigned char* smem) {
  for (int item = BIDX(); item < 16 * 66; item += gridDim.x) retU_item(p, item / 66, item % 66, smem);
}

__device__ __forceinline__ void attn_worker(const Params& p, int l, unsigned char* smem) {
  const u16* QA = (const u16*)(p.ws + OFF_QA); const u16* QB = (const u16*)(p.ws + OFF_QB);
  const u16* KA = (const u16*)(p.ws + OFF_KA); const u16* VA = (const u16*)(p.ws + OFF_VA);
  const u16* KB = (const u16*)(p.ws + OFF_KB); const u16* VB = (const u16*)(p.ws + OFF_VB);
  u16* concat = (u16*)(p.ws + OFF_H);
  const float* sink = p.attn_sink + l * 4;
  int* qctr = (int*)(p.ws + OFF_QCTR) + l;
  volatile int* slot = (volatile int*)(smem + 65536 - 32);
  for (;;) {
    __syncthreads();
    if (TIDX() == 0) *slot = atomicAdd(qctr, 1);
    __syncthreads();
    const int item = *slot;
    if (item >= 2112) break;
    const bool isB = item < 1024 || (item >= 2048 && item < 2080);
    const bool isctx = item >= 2048;
    int ii = item < 1024 ? item : item < 2048 ? item - 1024 : item < 2080 ? item - 2048 : item - 2080;
    int qt, kvh, b, qrow0, qpos0, t0, t1;
    if (!isctx) {
      qt = ii & 127; kvh = (ii >> 7) & 1; b = ii >> 8;
      qrow0 = b * SEQ + qt * 64; qpos0 = qt * 64;
      if (isB) { t0 = 0; t1 = 128; }
      else { t0 = qt - 2 < 0 ? 0 : qt - 2; t1 = qt + 3 > 128 ? 128 : qt + 3; }
    } else {
      qt = ii & 3; kvh = (ii >> 2) & 1; b = ii >> 3;
      qrow0 = TLAT + b * CTXL + qt * 64; qpos0 = 0; t0 = 0; t1 = 0;
    }
    attn_item(isB ? QB : QA, isB ? KB : KA, isB ? VB : VA, concat, isB ? 256 : 0, b, kvh, qrow0, qpos0, t0, t1, 128, 132,
              (!isB) && (!isctx), isB ? nullptr : sink, smem);
  }
}

__device__ __forceinline__ void phase_retscan(const Params& p) {
  const float* U = (const float*)(p.ws + OFF_U);
  u16* SP = (u16*)(p.ws + OFF_SP);
  for (int gid = BIDX() * 256 + TIDX(); gid < 16 * 2 * 4096; gid += gridDim.x * 256) {
    int e = gid & 4095, dir = (gid >> 12) & 1, bh = gid >> 13;
    float g128 = exp2f(128.f * ret_lg(bh & 3));
    float S = 0.f;
#pragma unroll 1
    for (int n0 = 0; n0 < 66; n0 += 11) {
      float u[11];
      size_t offs[11];
#pragma unroll
      for (int k = 0; k < 11; ++k) {
        int n = n0 + k;
        int c = dir == 0 ? (n < 2 ? 64 + n : n - 2) : 65 - n;
        offs[k] = (((size_t)bh * 66 + c) * 2 + dir) * 4096 + e;
        u[k] = U[offs[k]];
      }
#pragma unroll
      for (int k = 0; k < 11; ++k) {
        SP[offs[k]] = f2bf(S);
        S = g128 * S + u[k];
      }
    }
  }
}

__device__ __forceinline__ void retout_item(const Params& p, int l, int bh, int c, unsigned char* smem) {
  const int tid = TIDX(), w = tid >> 6, lane = tid & 63, fr = lane & 15, fq = lane >> 4;
  const int b = bh >> 2, h = bh & 3;
  const u16* QR = (const u16*)(p.ws + OFF_QR);
  const u16* KR = (const u16*)(p.ws + OFF_KR) + (size_t)bh * STOT * 64;
  const u16* VR = (const u16*)(p.ws + OFF_VR) + (size_t)bh * 64 * STOT;
  const u16* SP = (const u16*)(p.ws + OFF_SP) + ((size_t)bh * 66 + c) * 2 * 4096;
  const u16* P2 = (const u16*)(p.ws + OFF_P2);
  u16* concat = (u16*)(p.ws + OFF_H);
  const int pos0 = c < 64 ? c * 128 : SEQ + (c - 64) * 128;
  const int row0 = bpos_row(b, pos0);
  u16* Kc = (u16*)smem;
  u16* Vs = Kc + 128 * 72;
  __syncthreads();
#pragma unroll
  for (int ps = 0; ps < 4; ++ps) {
    int idx = tid + ps * 256;
    int r = idx >> 3, ch = idx & 7;
    *(bf16x8*)(Kc + r * 72 + ch * 8) = *(const bf16x8*)(KR + (size_t)(pos0 + r) * 64 + ch * 8);
    int d = idx >> 4, c16 = idx & 15;
    *(bf16x8*)(Vs + d * 136 + c16 * 8) = *(const bf16x8*)(VR + (size_t)d * STOT + pos0 + c16 * 8);
  }
  __syncthreads();
  const float lg = ret_lg(h);
#pragma unroll 1
  for (int qg = 0; qg < 2; ++qg) {
    const int i = w * 32 + qg * 16 + fr;
    const int row = row0 + i;
    bf16x8 qf[2];
#pragma unroll
    for (int ks = 0; ks < 2; ++ks) qf[ks] = *(const bf16x8*)(QR + (size_t)row * 256 + h * 64 + ks * 32 + fq * 8);
    f32x4 s[8];
#pragma unroll
    for (int sub = 0; sub < 8; ++sub) {
      s[sub] = f32x4{0.f, 0.f, 0.f, 0.f};
#pragma unroll
      for (int ks = 0; ks < 2; ++ks) {
        bf16x8 a = *(const bf16x8*)(Kc + (sub * 16 + fr) * 72 + ks * 32 + fq * 8);
        s[sub] = __builtin_amdgcn_mfma_f32_16x16x32_bf16(a, qf[ks], s[sub], 0, 0, 0);
      }
    }
    float res[4][4];
#pragma unroll
    for (int dt = 0; dt < 4; ++dt)
#pragma unroll
      for (int j = 0; j < 4; ++j) res[dt][j] = 0.f;
#pragma unroll 1
    for (int dir = 0; dir < 2; ++dir) {
      f32x4 O[4];
      const float qw = dir == 0 ? __builtin_amdgcn_exp2f(lg * (float)(i + 1)) : __builtin_amdgcn_exp2f(lg * (float)(128 - i));
#pragma unroll
      for (int dt = 0; dt < 4; ++dt) {
        O[dt] = f32x4{0.f, 0.f, 0.f, 0.f};
#pragma unroll
        for (int ks = 0; ks < 2; ++ks) {
          bf16x8 a = *(const bf16x8*)(SP + dir * 4096 + (dt * 16 + fr) * 64 + ks * 32 + fq * 8);
          O[dt] = __builtin_amdgcn_mfma_f32_16x16x32_bf16(a, qf[ks], O[dt], 0, 0, 0);
        }
        O[dt] *= qw;
      }
      int fqo = fq;
      asm volatile("" : "+v"(fqo));
#pragma unroll
      for (int ks = 0; ks < 4; ++ks) {
        float pv[8];
#pragma unroll
        for (int e = 0; e < 8; ++e) {
          const int sub = 2 * ks + (e >> 2), j = e & 3;
          const int jk = sub * 16 + fqo * 4 + j;
          const int dd = dir == 0 ? i - jk : jk - i;
          pv[e] = dd >= 0 ? s[sub][j] * __builtin_amdgcn_exp2f(lg * (float)dd) : 0.f;
        }
        bf16x8 pb = cat8(pack4(pv[0], pv[1], pv[2], pv[3]), pack4(pv[4], pv[5], pv[6], pv[7]));
#pragma unroll
        for (int dt = 0; dt < 4; ++dt) {
          const u16* vp = Vs + (dt * 16 + fr) * 136 + ks * 32 + fq * 4;
          bf16x8 va = cat8(*(const bf16x4*)vp, *(const bf16x4*)(vp + 16));
          O[dt] = __builtin_amdgcn_mfma_f32_16x16x32_bf16(va, pb, O[dt], 0, 0, 0);
        }
      }
      float sm = 0.f;
#pragma unroll
      for (int dt = 0; dt < 4; ++dt)
#pragma unroll
        for (int j = 0; j < 4; ++j) sm += O[dt][j];
      sm += __shfl_xor(sm, 16); sm += __shfl_xor(sm, 32);
      const float mu = sm * (1.f / 64.f);
      float vs = 0.f;
#pragma unroll
      for (int dt = 0; dt < 4; ++dt)
#pragma unroll
        for (int j = 0; j < 4; ++j) { float dlt = O[dt][j] - mu; vs += dlt * dlt; }
      vs += __shfl_xor(vs, 16); vs += __shfl_xor(vs, 32);
      const float rstd = rsqrtf(vs * (1.f / 64.f) + GN_EPS);
#pragma unroll
      for (int dt = 0; dt < 4; ++dt) {
        const int d = dt * 16 + fq * 4;
        bf16x4 gt = *(const bf16x4*)(P2 + (size_t)row * P2C + dir * 256 + h * 64 + d);
        float4 rg = *(const float4*)(p.ret_g + (size_t)l * 256 + h * 64 + d);
        res[dt][0] += (O[dt][0] - mu) * rstd * rg.x * siluf_(bf2f((u16)gt[0]));
        res[dt][1] += (O[dt][1] - mu) * rstd * rg.y * siluf_(bf2f((u16)gt[1]));
        res[dt][2] += (O[dt][2] - mu) * rstd * rg.z * siluf_(bf2f((u16)gt[2]));
        res[dt][3] += (O[dt][3] - mu) * rstd * rg.w * siluf_(bf2f((u16)gt[3]));
      }
    }
#pragma unroll
    for (int dt = 0; dt < 4; ++dt)
      *(bf16x4*)(concat + (size_t)row * D + 512 + h * 64 + dt * 16 + fq * 4) = pack4(res[dt][0], res[dt][1], res[dt][2], res[dt][3]);
  }
}

__device__ __forceinline__ void phase_retout(const Params& p, int l, unsigned char* smem) {
  for (int item = BIDX(); item < 16 * 66; item += gridDim.x) retout_item(p, l, item / 66, item % 66, smem);
}

__device__ __forceinline__ void phase_wprep(const Params& p, int l, unsigned char* smem) {
  const int tid = TIDX(), lane = tid & 63, h = tid >> 6;
  const u16* P2 = (const u16*)(p.ws + OFF_P2);
  u16* prep = (u16*)(p.ws + OFF_PREP);
  float* twT = (float*)smem;
  float* amT = twT + 64 * 32;
  for (int item = BIDX(); item < (TALL / 32) * 2; item += gridDim.x) {
    const int dir = item & 1, row0 = (item >> 1) * 32;
    const float* mu = p.mu + ((size_t)l * 2 + dir) * 896;
    __syncthreads();
    {
      const int tok = tid >> 3, e0 = (tid & 7) * 8;
      const int row = row0 + tok;
      int b, pos;
      row_bpos(row, b, pos);
      bool has;
      int nrow;
      if (dir == 0) { has = (pos != 0) && (pos != SEQ); nrow = row - 1; }
      else { has = (pos != SEQ - 1) && (pos != STOT - 1); nrow = row + 1; }
      const u16* cw = P2 + (size_t)row * P2C + 1408 + dir * 64 + e0;
      const u16* ca = P2 + (size_t)row * P2C + 1536 + dir * 64 + e0;
      bf16x8 zw = *(const bf16x8*)cw, za = *(const bf16x8*)ca;
      bf16x8 sw = zw, sa = za;
      if (has) {
        sw = *(const bf16x8*)(P2 + (size_t)nrow * P2C + 1408 + dir * 64 + e0);
        sa = *(const bf16x8*)(P2 + (size_t)nrow * P2C + 1536 + dir * 64 + e0);
      }
#pragma unroll
      for (int e = 0; e < 8; ++e) {
        float z = bf2f((u16)zw[e]), zs = has ? bf2f((u16)sw[e]) : 0.f;
        float m = mu[768 + e0 + e];
        twT[(e0 + e) * 32 + tok] = tanhf_(z + m * (zs - z));
        float z2 = bf2f((u16)za[e]), zs2 = has ? bf2f((u16)sa[e]) : 0.f;
        float m2 = mu[832 + e0 + e];
        amT[(e0 + e) * 32 + tok] = z2 + m2 * (zs2 - z2);
      }
    }
    __syncthreads();
    const int col = tid;
    float accw[32], acca[32];
#pragma unroll
    for (int t = 0; t < 32; ++t) { accw[t] = 0.f; acca[t] = 0.f; }
    const float* w2 = p.w2 + ((size_t)l * 2 + dir) * 64 * 256 + col;
    const float* a2 = p.a2 + ((size_t)l * 2 + dir) * 64 * 256 + col;
    for (int kq = 0; kq < 64; ++kq) {
      float wv = w2[kq * 256], av = a2[kq * 256];
#pragma unroll
      for (int t4 = 0; t4 < 8; ++t4) {
        float4 a = *(const float4*)(twT + kq * 32 + t4 * 4);
        float4 bq = *(const float4*)(amT + kq * 32 + t4 * 4);
        accw[t4 * 4 + 0] += a.x * wv; accw[t4 * 4 + 1] += a.y * wv; accw[t4 * 4 + 2] += a.z * wv; accw[t4 * 4 + 3] += a.w * wv;
        acca[t4 * 4 + 0] += bq.x * av; acca[t4 * 4 + 1] += bq.y * av; acca[t4 * 4 + 2] += bq.z * av; acca[t4 * 4 + 3] += bq.w * av;
      }
    }
    const float w0v = p.w0[((size_t)l * 2 + dir) * 256 + col], a0v = p.a0[((size_t)l * 2 + dir) * 256 + col];
    const float kkv = p.k_k[(size_t)l * 256 + col], kav = p.k_a[(size_t)l * 256 + col];
    const float mur = mu[col], muk = mu[256 + col], muv = mu[512 + col];
#pragma unroll
    for (int t = 0; t < 32; ++t) {
      const int row = row0 + t;
      int b, pos;
      row_bpos(row, b, pos);
      bool has;
      int nrow;
      if (dir == 0) { has = (pos != 0) && (pos != SEQ); nrow = row - 1; }
      else { has = (pos != SEQ - 1) && (pos != STOT - 1); nrow = row + 1; }
      const u16* cp = P2 + (size_t)row * P2C + 512 + col;
      const u16* np = P2 + (size_t)(has ? nrow : row) * P2C + 512 + col;
      float zr = bf2f(cp[0]), zk = bf2f(cp[256]), zv = bf2f(cp[512]);
      float sr = has ? bf2f(np[0]) : 0.f, sk = has ? bf2f(np[256]) : 0.f, sv = has ? bf2f(np[512]) : 0.f;
      float r = zr + mur * (sr - zr), k = zk + muk * (sk - zk), v = zv + muv * (sv - zv);
      float lw2 = -0.6065306597126334f * sigmoidf_(w0v + accw[t]) * LOG2E;
      float av = sigmoidf_(a0v + acca[t]);
      float kkr = k * kkv;
      float ss = wave_sum(kkr * kkr);
      float kk = kkr * rsqrtf(fmaxf(ss, 1e-24f));
      float kt = k * (1.f + (av - 1.f) * kav);
      u16* dp = prep + (((size_t)(b * 4 + h) * 2 + dir) * STOT + pos) * 384 + lane;
      dp[0] = f2bf(lw2); dp[64] = f2bf(kt); dp[128] = f2bf(kk); dp[192] = f2bf(kk * av); dp[256] = f2bf(r); dp[320] = f2bf(v);
    }
  }
}

typedef float f32x2 __attribute__((ext_vector_type(2)));
__device__ __forceinline__ void wscan_item(const Params& p, int item, unsigned char* smem) {
  const int tid = TIDX(), w = tid >> 6, lane = tid & 63;
  const int jl4 = (lane & 15) * 4, rsub = lane >> 4;
  const u16* prep = (const u16*)(p.ws + OFF_PREP);
  u16* P2w = (u16*)(p.ws + OFF_P2);
  float* bufs = (float*)smem;
  {
    const int rq = item & 3, seq = item >> 2;
    const int dir = seq & 1, h = (seq >> 1) & 3, b = seq >> 3;
    const int irow = rq * 16 + w * 4 + rsub;
    const u16* base = prep + (size_t)seq * STOT * 384;
    uint4 lreg[3];
    auto gload = [&](int ch) {
#pragma unroll
      for (int ps = 0; ps < 3; ++ps) {
        int q = tid + ps * 256;
        int sidx = q / 48, within = q % 48;
        int n = ch * 16 + sidx;
        int pos = dir == 0 ? (n < CTXL ? SEQ + n : n - CTXL) : (STOT - 1 - n);
        lreg[ps] = *(const uint4*)(base + (size_t)pos * 384 + within * 8);
      }
    };
    auto lstore = [&](int buf) {
#pragma unroll
      for (int ps = 0; ps < 3; ++ps) {
        int q = tid + ps * 256;
        int sidx = q / 48, within = q % 48;
        float* dp = bufs + buf * 6144 + sidx * 384 + within * 8;
        uint4 u = lreg[ps];
        float4 lo = make_float4(__uint_as_float(u.x << 16), __uint_as_float(u.x & 0xffff0000u), __uint_as_float(u.y << 16), __uint_as_float(u.y & 0xffff0000u));
        float4 hi = make_float4(__uint_as_float(u.z << 16), __uint_as_float(u.z & 0xffff0000u), __uint_as_float(u.w << 16), __uint_as_float(u.w & 0xffff0000u));
        if (within < 8) {
          lo.x = __builtin_amdgcn_exp2f(lo.x); lo.y = __builtin_amdgcn_exp2f(lo.y); lo.z = __builtin_amdgcn_exp2f(lo.z); lo.w = __builtin_amdgcn_exp2f(lo.w);
          hi.x = __builtin_amdgcn_exp2f(hi.x); hi.y = __builtin_amdgcn_exp2f(hi.y); hi.z = __builtin_amdgcn_exp2f(hi.z); hi.w = __builtin_amdgcn_exp2f(hi.w);
        }
        *(float4*)dp = lo;
        *(float4*)(dp + 4) = hi;
      }
    };
    f32x2 S01 = {0.f, 0.f}, S23 = {0.f, 0.f};
    __syncthreads();
    gload(0);
    lstore(0);
    __syncthreads();
    constexpr int NCH = STOT / 16;
    for (int ch = 0; ch < NCH; ++ch) {
      if (ch + 1 < NCH) gload(ch + 1);
      const float* bp = bufs + (ch & 1) * 6144;
      const int n0 = ch * 16;
      const int pos0 = dir == 0 ? (n0 < CTXL ? SEQ + n0 : n0 - CTXL) : (STOT - 1 - n0);
      u16* yp = P2w + (size_t)bpos_row(b, pos0) * P2C + (dir == 0 ? YCOL0 : YCOL1) + h * 64 + irow;
      const int ystride = dir == 0 ? P2C : -P2C;
      float4 Wq[3], Kq[3], Nq[3], Bq[3], Rq[3];
      float Vq[3];
#define SCAN_LD(slot, st)                                        \
      do {                                                         \
        const float* sp_ = bp + (st) * 384;                        \
        Wq[slot] = *(const float4*)(sp_ + jl4);                    \
        Kq[slot] = *(const float4*)(sp_ + 64 + jl4);               \
        Nq[slot] = *(const float4*)(sp_ + 128 + jl4);              \
        Bq[slot] = *(const float4*)(sp_ + 192 + jl4);              \
        Rq[slot] = *(const float4*)(sp_ + 256 + jl4);              \
        Vq[slot] = sp_[320 + irow];                                \
      } while (0)
      SCAN_LD(0, 0);
      SCAN_LD(1, 1);
      SCAN_LD(2, 2);
      float ypart = 0.f;
#pragma unroll
      for (int s = 0; s < 16; ++s) {
        const int sl = s % 3;
        const float4 wv = Wq[sl], kt = Kq[sl], kk = Nq[sl], bb = Bq[sl], rr = Rq[sl];
        const float v = Vq[sl];
        if (s + 3 < 16) SCAN_LD(sl, s + 3);
        const f32x2 vv = {v, v};
        f32x2 A01 = S01 * f32x2{wv.x, wv.y} + vv * f32x2{kt.x, kt.y};
        f32x2 A23 = S23 * f32x2{wv.z, wv.w} + vv * f32x2{kt.z, kt.w};
        f32x2 pp = S01 * f32x2{kk.x, kk.y} + S23 * f32x2{kk.z, kk.w};
        float sa = pp.x + pp.y;
        float yprev = ypart;
        row16_sum2(sa, yprev);
        if (s > 0) { if ((lane & 15) == 0) yp[(s - 1) * ystride] = f2bf(yprev); }
        const f32x2 nsa = {-sa, -sa};
        S01 = nsa * f32x2{bb.x, bb.y} + A01;
        S23 = nsa * f32x2{bb.z, bb.w} + A23;
        f32x2 yy = S01 * f32x2{rr.x, rr.y} + S23 * f32x2{rr.z, rr.w};
        ypart = yy.x + yy.y;
      }
      {
        float ylast = row16_sum(ypart);
        if ((lane & 15) == 0) yp[15 * ystride] = f2bf(ylast);
      }
#undef SCAN_LD
      if (ch + 1 < NCH) lstore((ch + 1) & 1);
      __syncthreads();
    }
  }
}

__device__ __forceinline__ void phase_scan_attn(const Params& p, int l, unsigned char* smem) {
  const int G = gridDim.x, tid = TIDX(), bid = BIDX();
  if (G > 128 && G <= 2048) {
    int* keys = (int*)smem;
    int* red = keys + 2048;
    const int* cutab = (const int*)(p.ws + OFF_CUTAB);
    __syncthreads();
    for (int i = tid; i < G; i += 256) keys[i] = cutab[i];
    if (tid == 0) { red[0] = 0; red[1] = 0; }
    __syncthreads();
    for (int i = 128 + tid; i < G; i += 256) {
      const int ki = keys[i];
      bool m = false;
      for (int j = 0; j < 128; ++j) m = m || (keys[j] == ki);
      if (!m) atomicAdd(&red[0], 1);
      if (m && i == bid) red[1] = 1;
    }
    __syncthreads();
    const int eligible = red[0], mine = red[1];
    __syncthreads();
    if (bid < 128) {
      __builtin_amdgcn_s_setprio(3);
      wscan_item(p, bid, smem);
      __builtin_amdgcn_s_setprio(0);
    } else if (eligible < 64 || !mine) {
      attn_worker(p, l, smem);
    }
  } else {
    for (int item = bid; item < 128; item += G) wscan_item(p, item, smem);
    attn_worker(p, l, smem);
  }
}

__device__ __forceinline__ void phase_wfin(const Params& p, int l, unsigned char* smem) {
  const int tid = TIDX(), lane = tid & 63, h = tid >> 6, col = tid;
  const u16* P2 = (const u16*)(p.ws + OFF_P2);
  const u16* prep = (const u16*)(p.ws + OFF_PREP);
  u16* concat = (u16*)(p.ws + OFF_H);
  float* sgT = (float*)smem;
  const float lng = p.ln_g[(size_t)l * 256 + col], lnb = p.ln_b[(size_t)l * 256 + col];
  const float rho0 = p.rho[((size_t)l * 2 + 0) * 256 + col], rho1 = p.rho[((size_t)l * 2 + 1) * 256 + col];
  const float* g2 = p.g2 + (size_t)l * 128 * 256 + col;
  for (int item = BIDX(); item < TALL / 16; item += gridDim.x) {
    const int row0 = item * 16;
    __syncthreads();
    {
      const int tok = tid >> 4, k0 = (tid & 15) * 8;
      bf16x8 g = *(const bf16x8*)(P2 + (size_t)(row0 + tok) * P2C + 1280 + k0);
#pragma unroll
      for (int e = 0; e < 8; ++e) sgT[(k0 + e) * 16 + tok] = sigmoidf_(bf2f((u16)g[e]));
    }
    __syncthreads();
    float acc[16];
#pragma unroll
    for (int t = 0; t < 16; ++t) acc[t] = 0.f;
    for (int k = 0; k < 128; ++k) {
      float gv = g2[k * 256];
#pragma unroll
      for (int t4 = 0; t4 < 4; ++t4) {
        float4 a = *(const float4*)(sgT + k * 16 + t4 * 4);
        acc[t4 * 4 + 0] += a.x * gv; acc[t4 * 4 + 1] += a.y * gv; acc[t4 * 4 + 2] += a.z * gv; acc[t4 * 4 + 3] += a.w * gv;
      }
    }
#pragma unroll
    for (int t = 0; t < 16; ++t) {
      const int row = row0 + t;
      int b, pos;
      row_bpos(row, b, pos);
      float tot = 0.f;
#pragma unroll
      for (int dir = 0; dir < 2; ++dir) {
        float y = bf2f(P2[(size_t)row * P2C + (dir == 0 ? YCOL0 : YCOL1) + col]);
        float mu = wave_sum(y) * (1.f / 64.f);
        float dl = y - mu;
        float var = wave_sum(dl * dl) * (1.f / 64.f);
        float yn = dl * rsqrtf(var + GN_EPS) * lng + lnb;
        const u16* pp = prep + (((size_t)(b * 4 + h) * 2 + dir) * STOT + pos) * 384 + lane;
        float kt = bf2f(pp[64]), r = bf2f(pp[256]), v = bf2f(pp[320]);
        float bs = wave_sum(r * kt * (dir == 0 ? rho0 : rho1));
        tot += yn + bs * v;
      }
      concat[(size_t)row * D + 768 + col] = f2bf(tot * acc[t]);
    }
  }
}

constexpr int N_PHASES = 1 + 2 * 16 + 1;
__device__ __forceinline__ void run_phase(const Params& p, int ph, unsigned char* smem) {
  if (ph == 0) { phase_init(p, smem); return; }
  if (ph == N_PHASES - 1) { phase_final_norm(p); return; }
  const int l = (ph - 1) / 16, s = (ph - 1) % 16;
  float* xc = (float*)(p.ws + OFF_XC);
  const float* lat_in = (l == 0 && s < 3) ? p.x : p.out;
  const float* cx_in = (l == 0 && s < 3) ? p.ctx : xc;
  const u16* H = (const u16*)(p.ws + OFF_H);
  const u16* ACT = (const u16*)(p.ws + OFF_P2);
  switch (s) {
    case 0: phase_norm(p, l, 0, lat_in, cx_in); break;
    case 1: phase_ffn_in(p, l, 0, smem); break;
    case 2: phase_resid_gemm(p, l, ACT, (const u16*)(p.ws + OFF_WFFO) + (size_t)0 * 1024 * DFF, DFF, 2, 0.5f, lat_in, cx_in, p.out, xc, smem); break;
    case 3: phase_norm(p, l, 1, p.out, xc); break;
    case 4: phase_inproj(p, l, smem); break;
    case 5: phase_retU(p, smem); break;
    case 6: phase_retscan(p); break;
    case 7: phase_retout(p, l, smem); break;
    case 8: phase_wprep(p, l, smem); break;
    case 9: phase_scan_attn(p, l, smem); break;
    case 10: phase_wfin(p, l, smem); break;
    case 11: phase_resid_gemm(p, l, H, (const u16*)(p.ws + OFF_WOUT), 1024, 5, 1.0f, p.out, xc, p.out, xc, smem); break;
    case 12: phase_norm(p, l, 2, p.out, xc); break;
    case 13: phase_ffn_in(p, l, 1, smem); break;
    case 14: phase_resid_gemm(p, l, ACT, (const u16*)(p.ws + OFF_WFFO) + (size_t)1 * 1024 * DFF, DFF, 8, 0.5f, p.out, xc, p.out, xc, smem); break;
    default: if (l == 0) convert_weights(p, 1, smem); break;
  }
}

#if MULTI_LAUNCH
__global__ void __launch_bounds__(256, 2) k_phase(Params p, int ph) {
  __shared__ __attribute__((aligned(16))) unsigned char smem[49152];
  run_phase(p, ph, smem);
}
#else
constexpr int SMEM_BYTES = 65536;
__global__ void __launch_bounds__(256, 2) k_mega(Params p) {
  __shared__ __attribute__((aligned(16))) unsigned char smem[SMEM_BYTES];
  cg::grid_group grid = cg::this_grid();
  volatile LAS unsigned* st = (volatile LAS unsigned*)(smem + SMEM_BYTES - 16);
  if (threadIdx.x == 0) { st[0] = 0u; st[1] = 0u; }
  __syncthreads();
  {
    unsigned* bw = (unsigned*)(p.ws + OFF_BAR);
    for (int i = blockIdx.x * 256 + threadIdx.x; i < XCD_BAR_WORDS; i += gridDim.x * 256) bw[i] = 0u;
  }
  grid.sync();
  XcdBarrier xb = xcd_barrier_post((unsigned*)(p.ws + OFF_BAR), st);
  run_phase(p, 0, smem);
  xcd_barrier(xb);
#pragma unroll 1
  for (int l = 0; l < 2; ++l) {
#pragma unroll 1
    for (int s = 0; s < 16 - l; ++s) {
      run_phase(p, 1 + l * 16 + s, smem);
      xcd_barrier(xb);
#ifdef PROBE_REPEAT
      if ((PROBE_REPEAT >> s) & 1) {
        run_phase(p, 1 + l * 16 + s, smem);
        xcd_barrier(xb);
      }
#endif
    }
  }
  run_phase(p, N_PHASES - 1, smem);
}
#endif

extern "C" void kernel_launch(void* const* d_in, const int* in_sizes, int n_in, void* d_out, int out_size, void* d_ws,
                              size_t ws_size, hipStream_t stream) {
  Params p{};
  const float** pp = (const float**)&p;
  for (int i = 0; i < 26; ++i) pp[i] = (const float*)d_in[i];
  p.out = (float*)d_out;
  p.ws = (unsigned char*)d_ws;
#if MULTI_LAUNCH
  for (int ph = 0; ph < N_PHASES; ++ph) {
    if (ph > 0 && ((ph - 1) % 16) == 15 && ph != N_PHASES - 1) continue;
    k_phase<<<dim3(512), dim3(256), 0, stream>>>(p, ph);
  }
#else
  static int grid_blocks = 0;
  if (!grid_blocks) {
    int dev = 0, cus = 0, per_cu = 0;
    hipGetDevice(&dev);
    hipDeviceGetAttribute(&cus, hipDeviceAttributeMultiprocessorCount, dev);
    hipOccupancyMaxActiveBlocksPerMultiprocessor(&per_cu, k_mega, 256, 0);
    if (per_cu > 2) per_cu = 2;
    grid_blocks = cus * per_cu;
  }
  void* args[] = {&p};
  hipError_t e = hipLaunchCooperativeKernel((void*)k_mega, dim3(grid_blocks), dim3(256), args, 0, stream);
  if (e != hipSuccess) fprintf(stderr, "cooperative launch failed: %s (grid %d)\n", hipGetErrorString(e), grid_blocks);
#endif
}
```

```cpp
#include <hip/hip_runtime.h>
#include <hip/hip_bf16.h>
#include <hip/hip_cooperative_groups.h>
#include <cstdio>
namespace cg = cooperative_groups;

#ifndef MULTI_LAUNCH
#define MULTI_LAUNCH 0
#endif

typedef unsigned short u16;
using bf16x8 = __attribute__((ext_vector_type(8))) short;
using bf16x4 = __attribute__((ext_vector_type(4))) short;
using f32x4 = __attribute__((ext_vector_type(4))) float;

constexpr int D = 1024;
constexpr int TLAT = 32768;
constexpr int TCTX = 1024;
constexpr int TALL = TLAT + TCTX;
constexpr int SEQ = 8192;
constexpr int CTXL = 256;
constexpr int STOT = SEQ + CTXL;
constexpr int DFF = 2816;
constexpr int PC = 3456;
constexpr int P2C = 1664;
constexpr int NMOD = 9 * D;
constexpr float LOG2E = 1.4426950408889634f;
constexpr float RMS_EPS = 1e-6f;
constexpr float GN_EPS = 64e-5f;

constexpr size_t MiB = 1ull << 20;
constexpr size_t OFF_WFFI = 0;
constexpr size_t OFF_WFFO = 22 * MiB;
constexpr size_t OFF_WIN = 33 * MiB;
constexpr size_t OFF_WOUT = OFF_WIN + 27 * MiB / 4;
constexpr size_t OFF_MOD = OFF_WOUT + 2 * MiB;
constexpr size_t OFF_BAR = OFF_MOD + 384 * 1024;
constexpr size_t OFF_QCTR = OFF_MOD + 400 * 1024;
constexpr size_t OFF_CUTAB = OFF_QCTR + 256;
constexpr size_t OFF_ROPE = OFF_MOD + MiB / 2;
constexpr size_t OFF_XC = OFF_ROPE + 5 * MiB / 2;
constexpr size_t OFF_H = OFF_XC + 4 * MiB;
constexpr size_t OFF_P2 = OFF_H + 66 * MiB;
constexpr size_t OFF_BIG = OFF_P2 + 429 * MiB / 4;
constexpr size_t SZ_Q = (size_t)TALL * 256 * 2;
constexpr size_t SZ_KV2 = (size_t)4 * 2 * STOT * 64 * 2;
constexpr size_t SZ_KV4 = (size_t)4 * 4 * STOT * 64 * 2;
constexpr size_t OFF_QA = OFF_BIG;
constexpr size_t OFF_QB = OFF_QA + SZ_Q;
constexpr size_t OFF_KA = OFF_QB + SZ_Q;
constexpr size_t OFF_VA = OFF_KA + SZ_KV2;
constexpr size_t OFF_KB = OFF_VA + SZ_KV2;
constexpr size_t OFF_VB = OFF_KB + SZ_KV2;
constexpr size_t OFF_R0 = OFF_VB + SZ_KV2;
constexpr size_t OFF_QR = OFF_R0;
constexpr size_t OFF_KR = OFF_QR + SZ_Q;
constexpr size_t OFF_VR = OFF_KR + SZ_KV4;
constexpr size_t OFF_U = OFF_VR + SZ_KV4;
constexpr size_t OFF_SP = OFF_U + (size_t)16 * 66 * 2 * 4096 * 4;
constexpr size_t OFF_PREP = OFF_R0;
constexpr size_t WS_END = OFF_PREP + (size_t)32 * STOT * 384 * 2;
constexpr int YCOL0 = 768, YCOL1 = 1408;
static_assert(WS_END <= 512 * MiB, "workspace overflow");
static_assert(OFF_SP + (size_t)16 * 66 * 2 * 4096 * 2 <= 512 * MiB, "workspace overflow");
static_assert(OFF_P2 + (size_t)TALL * DFF * 2 <= 512 * MiB, "act overflow");

struct Params {
  const float *x, *c, *ctx, *c_ctx, *w_mod, *b_mod, *norm_g, *ffn_w_in, *ffn_w_out, *w_in, *w_out, *attn_sink, *qk_g,
      *ret_g, *mu, *w0, *w2, *a0, *a2, *rho, *k_k, *k_a, *g2, *ln_g, *ln_b, *final_g;
  float* out;
  unsigned char* ws;
};

__device__ __forceinline__ int TIDX() { int t = threadIdx.x; asm volatile("" : "+v"(t)); return t & 255; }
__device__ __forceinline__ int BIDX() { int t = blockIdx.x; asm volatile("" : "+s"(t)); return t; }
typedef float f32x2_t __attribute__((ext_vector_type(2)));
typedef __bf16 bf16x2_t __attribute__((ext_vector_type(2)));
__device__ __forceinline__ unsigned pk2bf(float a, float b) {
  f32x2_t v = {a, b};
  return __builtin_bit_cast(unsigned, __builtin_convertvector(v, bf16x2_t));
}
__device__ __forceinline__ u16 f2bf(float f) { return (u16)(pk2bf(f, 0.f) & 0xffffu); }
__device__ __forceinline__ float bf2f(u16 h) { return __uint_as_float(((unsigned)h) << 16); }
__device__ __forceinline__ float sigmoidf_(float x) { return __builtin_amdgcn_rcpf(1.f + __expf(-x)); }
__device__ __forceinline__ float siluf_(float x) { return x * __builtin_amdgcn_rcpf(1.f + __expf(-x)); }
__device__ __forceinline__ float tanhf_(float x) { return 1.f - 2.f * __builtin_amdgcn_rcpf(__expf(2.f * x) + 1.f); }
template <int CTRL>
__device__ __forceinline__ float dpp_f(float x) {
  return __builtin_bit_cast(float, __builtin_amdgcn_update_dpp(0, __builtin_bit_cast(int, x), CTRL, 0xf, 0xf, true));
}
__device__ __forceinline__ float row16_sum(float x) {
  x += dpp_f<0xB1>(x);
  x += dpp_f<0x4E>(x);
  x += dpp_f<0x141>(x);
  x += dpp_f<0x140>(x);
  return x;
}
__device__ __forceinline__ float wave_sum(float x) {
  x = row16_sum(x);
  x += __builtin_bit_cast(float, __builtin_amdgcn_update_dpp(0, __builtin_bit_cast(int, x), 0x142, 0xa, 0xf, false));
  x += __builtin_bit_cast(float, __builtin_amdgcn_update_dpp(0, __builtin_bit_cast(int, x), 0x143, 0xc, 0xf, false));
  return __builtin_bit_cast(float, __builtin_amdgcn_readlane(__builtin_bit_cast(int, x), 63));
}
__device__ __forceinline__ void row16_sum2(float& a, float& b) {
  a += dpp_f<0xB1>(a);  b += dpp_f<0xB1>(b);
  a += dpp_f<0x4E>(a);  b += dpp_f<0x4E>(b);
  a += dpp_f<0x141>(a); b += dpp_f<0x141>(b);
  a += dpp_f<0x140>(a); b += dpp_f<0x140>(b);
}
__device__ __forceinline__ bf16x4 pack4(float a, float b, float c, float d) {
  uint2 u = make_uint2(pk2bf(a, b), pk2bf(c, d));
  return __builtin_bit_cast(bf16x4, u);
}
__device__ __forceinline__ bf16x8 cat8(bf16x4 a, bf16x4 b) {
  bf16x8 r;
  r[0] = a[0]; r[1] = a[1]; r[2] = a[2]; r[3] = a[3]; r[4] = b[0]; r[5] = b[1]; r[6] = b[2]; r[7] = b[3];
  return r;
}
__device__ __forceinline__ const float* rrow(const float* lat, const float* cx, int r) {
  return r < TLAT ? lat + (size_t)r * D : cx + (size_t)(r - TLAT) * D;
}
__device__ __forceinline__ float* wrow(float* lat, float* cx, int r) {
  return r < TLAT ? lat + (size_t)r * D : cx + (size_t)(r - TLAT) * D;
}
__device__ __forceinline__ int mod_index(int r) { return r < TLAT ? (r >> 13) : 4; }
__device__ __forceinline__ void row_bpos(int r, int& b, int& pos) {
  if (r < TLAT) { b = r >> 13; pos = r & 8191; }
  else { int rc = r - TLAT; b = rc >> 8; pos = SEQ + (rc & 255); }
}
__device__ __forceinline__ int bpos_row(int b, int pos) {
  return pos < SEQ ? b * SEQ + pos : TLAT + b * CTXL + (pos - SEQ);
}


#define XB_TMO      128
#define XB_XCNT(j)  (256  + 64 * (j))
#define XB_XSUB(j)  (1280 + 64 * (j))
#define XB_XGEN(j)  (2304 + 64 * (j))
#define XB_TOP      3328
#define XB_TOPGEN   3392
#define XCD_BAR_WORDS 3456
#define XB_SPIN_CAP (1u << 18)
#define LAS __attribute__((address_space(3)))
__device__ __forceinline__ unsigned xb_ld(unsigned* p) { return __hip_atomic_load(p, __ATOMIC_RELAXED, __HIP_MEMORY_SCOPE_AGENT); }
__device__ __forceinline__ unsigned xb_add(unsigned* p, unsigned v) { return __hip_atomic_fetch_add(p, v, __ATOMIC_RELAXED, __HIP_MEMORY_SCOPE_AGENT); }
__device__ __forceinline__ unsigned xb_xcc_id() { return (unsigned)__builtin_amdgcn_s_getreg((3 << 11) | 20) & 0xFu; }
#define XB_SPIN(cond, bar) do { unsigned _sp = 0; while (cond) { __builtin_amdgcn_s_sleep(1); \
    if ((++_sp & 255u) == 0u) { if (xb_ld(&(bar)[XB_TMO])) break; if (_sp > XB_SPIN_CAP) { atomicAdd(&(bar)[XB_TMO], 1u); break; } } } } while (0)
struct XcdBarrier { unsigned* bar; unsigned x; volatile LAS unsigned* st; };
__device__ __forceinline__ XcdBarrier xcd_barrier_post(unsigned* bar, volatile LAS unsigned* st) {
  XcdBarrier b; b.bar = bar; b.x = xb_xcc_id(); b.st = st;
  if (threadIdx.x == 0) (void)xb_add(&bar[XB_XCNT(b.x)], 1u);
  return b;
}
__device__ __forceinline__ void xcd_barrier_complete(unsigned* bar, unsigned x, unsigned& nloc, unsigned& nx) {
  const unsigned G = gridDim.x * gridDim.y * gridDim.z;
  unsigned sum, cnt, mine, sp = 0u;
  for (;;) {
    sum = 0u; cnt = 0u; mine = 0u;
#pragma unroll
    for (unsigned j = 0; j < 16; ++j) { const unsigned c = xb_ld(&bar[XB_XCNT(j)]); sum += c; cnt += (c > 0u) ? 1u : 0u; mine = (j == x) ? c : mine; }
    if (sum == G) break;
    __builtin_amdgcn_s_sleep(1);
    if ((++sp & 255u) == 0u) { if (xb_ld(&bar[XB_TMO])) break; if (sp > XB_SPIN_CAP) { atomicAdd(&bar[XB_TMO], 1u); break; } }
  }
  nloc = mine > 0u ? mine : 1u; nx = cnt > 0u ? cnt : 1u;
}
__device__ __forceinline__ void xcd_barrier(const XcdBarrier& b) {
  asm volatile("s_waitcnt vmcnt(0)" ::: "memory");
  __syncthreads();
  if (threadIdx.x == 0) {
    unsigned* bar = b.bar;
    __builtin_amdgcn_s_waitcnt(0);
    unsigned nloc = b.st[0], nx = b.st[1];
    if (nloc == 0u) { xcd_barrier_complete(bar, b.x, nloc, nx); b.st[0] = nloc; b.st[1] = nx; }
    const unsigned old = xb_add(&bar[XB_XSUB(b.x)], 1u);
    const unsigned gen = old / nloc;
    if (old + 1u == (gen + 1u) * nloc) {
      __builtin_amdgcn_fence(__ATOMIC_RELEASE, "agent");
      asm volatile("s_waitcnt vmcnt(0)" ::: "memory");
      const unsigned og = xb_add(&bar[XB_TOP], 1u);
      const unsigned tg = og / nx;
      if (og + 1u == (tg + 1u) * nx) xb_add(&bar[XB_TOPGEN], 1u);
      else XB_SPIN(xb_ld(&bar[XB_TOPGEN]) == tg, bar);
      __builtin_amdgcn_fence(__ATOMIC_ACQUIRE, "agent");
      xb_add(&bar[XB_XGEN(b.x)], 1u);
      asm volatile("s_waitcnt vmcnt(0)" ::: "memory");
    } else {
      XB_SPIN(xb_ld(&bar[XB_XGEN(b.x)]) == gen, bar);
      __builtin_amdgcn_fence(__ATOMIC_ACQUIRE, "agent");
      asm volatile("s_waitcnt vmcnt(0)" ::: "memory");
    }
  }
  __syncthreads();
}

__device__ __forceinline__ void convert_weights(const Params& p, int layer, unsigned char* smem) {
  const int tid = TIDX();
  const int nb = gridDim.x, bid = BIDX();
  {
    float* tile = (float*)smem;
    constexpr int N_FFI = 2 * 16 * 88, N_FFO = 2 * 44 * 16, N_WIN = 16 * 54, N_WOUT = 16 * 16;
    for (int item = bid; item < N_FFI + N_FFO + N_WIN + N_WOUT; item += nb) {
      const float* src; u16* dst; int K, N, kt, nt; bool perm = false;
      int it = item;
      if (it < N_FFI) {
        int f = it / (16 * 88); it %= (16 * 88);
        K = 1024; N = 5632; kt = it / 88; nt = it % 88; perm = true;
        src = p.ffn_w_in + (size_t)(layer * 2 + f) * 1024 * 5632;
        dst = (u16*)(p.ws + OFF_WFFI) + (size_t)f * 5632 * 1024;
      } else if (it < N_FFI + N_FFO) {
        it -= N_FFI;
        int f = it / (44 * 16); it %= (44 * 16);
        K = 2816; N = 1024; kt = it / 16; nt = it % 16;
        src = p.ffn_w_out + (size_t)(layer * 2 + f) * 2816 * 1024;
        dst = (u16*)(p.ws + OFF_WFFO) + (size_t)f * 1024 * 2816;
      } else if (it < N_FFI + N_FFO + N_WIN) {
        it -= N_FFI + N_FFO;
        K = 1024; N = 3456; kt = it / 54; nt = it % 54;
        src = p.w_in + (size_t)layer * 1024 * 3456;
        dst = (u16*)(p.ws + OFF_WIN);
      } else {
        it -= N_FFI + N_FFO + N_WIN;
        K = 1024; N = 1024; kt = it / 16; nt = it % 16;
        src = p.w_out + (size_t)layer * 1024 * 1024;
        dst = (u16*)(p.ws + OFF_WOUT);
      }
      __syncthreads();
      {
        const int r = tid >> 4, c4 = tid & 15;
        int np = nt * 64 + c4 * 4;
        int scol = np;
        if (perm) {
          int blk = np >> 7, sub = (np & 127) >> 4, i = np & 15;
          scol = ((sub & 1) ? DFF : 0) + blk * 64 + (sub >> 1) * 16 + i;
        }
#pragma unroll
        for (int ps = 0; ps < 4; ++ps) {
          int k = kt * 64 + ps * 16 + r;
          float4 v = *(const float4*)(src + (size_t)k * N + scol);
          float* tp = tile + (ps * 16 + r) * 65 + c4 * 4;
          tp[0] = v.x; tp[1] = v.y; tp[2] = v.z; tp[3] = v.w;
        }
      }
      __syncthreads();
      {
        const int n = tid >> 2, kq = tid & 3;
        bf16x8 o0, o1;
#pragma unroll
        for (int i = 0; i < 8; ++i) {
          o0[i] = (short)f2bf(tile[(kq * 16 + i) * 65 + n]);
          o1[i] = (short)f2bf(tile[(kq * 16 + 8 + i) * 65 + n]);
        }
        u16* dp = dst + (size_t)(nt * 64 + n) * K + kt * 64 + kq * 16;
        *(bf16x8*)dp = o0;
        *(bf16x8*)(dp + 8) = o1;
      }
    }
    __syncthreads();
  }
}

__device__ __forceinline__ void phase_init(const Params& p, unsigned char* smem) {
  const int tid = TIDX();
  const int nb = gridDim.x, bid = BIDX();
  if (bid == 0 && tid < 2) ((int*)(p.ws + OFF_QCTR))[tid] = 0;
  if (tid == 0) {
    const int hw = __builtin_amdgcn_s_getreg((7 << 11) | (8 << 6) | 4);
    const int xcc = __builtin_amdgcn_s_getreg((3 << 11) | 20) & 0xF;
    ((int*)(p.ws + OFF_CUTAB))[bid] = (xcc << 8) | (hw & 0xFF);
  }
  {
    float2* seq = (float2*)(p.ws + OFF_ROPE);
    float2* rowt = seq + 8192 * 32;
    float2* colt = rowt + 128 * 16;
    for (int i = bid * 256 + tid; i < 8192 * 32 + 128 * 16 + 64 * 16; i += nb * 256) {
      float ang;
      float2* dst;
      if (i < 8192 * 32) {
        int t = i >> 5, k = i & 31;
        float inv = 1.0f / powf(10000.0f, (float)(2 * k) / 64.0f);
        ang = (float)t * inv;
        dst = seq + i;
      } else {
        int j = i - 8192 * 32;
        int pidx = (j < 128 * 16) ? (j >> 4) : ((j - 128 * 16) >> 4);
        int k = j & 15;
        float inv = 1.0f / powf(10000.0f, (float)(2 * k) / 32.0f);
        ang = (float)pidx * inv;
        dst = rowt + j;
      }
      *dst = make_float2(cosf(ang), sinf(ang));
    }
    (void)colt;
  }
  {
    float* sc = (float*)smem;
    float* red = sc + 5 * 1024;
    for (int item = bid; item < 288; item += nb) {
      const int l = item / 144, cb = item % 144;
      __syncthreads();
      for (int i = tid; i < 5 * 1024; i += 256) {
        int m = i >> 10, k = i & 1023;
        float v = (m < 4) ? p.c[m * 1024 + k] : p.c_ctx[k];
        sc[i] = siluf_(v);
      }
      __syncthreads();
      const int cq = tid & 15, kg = tid >> 4;
      float acc[5][4];
#pragma unroll
      for (int m = 0; m < 5; ++m)
#pragma unroll
        for (int q = 0; q < 4; ++q) acc[m][q] = 0.f;
      const float* wbase = p.w_mod + (size_t)l * 1024 * NMOD + cb * 64 + cq * 4;
      for (int kk = 0; kk < 64; ++kk) {
        int k = kg * 64 + kk;
        float4 w4 = *(const float4*)(wbase + (size_t)k * NMOD);
#pragma unroll
        for (int m = 0; m < 5; ++m) {
          float s = sc[m * 1024 + k];
          acc[m][0] += s * w4.x; acc[m][1] += s * w4.y; acc[m][2] += s * w4.z; acc[m][3] += s * w4.w;
        }
      }
#pragma unroll
      for (int m = 0; m < 5; ++m)
#pragma unroll
        for (int q = 0; q < 4; ++q) red[(kg * 5 + m) * 64 + cq * 4 + q] = acc[m][q];
      __syncthreads();
      float* modp = (float*)(p.ws + OFF_MOD);
      for (int o = tid; o < 320; o += 256) {
        int m = o >> 6, cc = o & 63;
        float s = 0.f;
        for (int g = 0; g < 16; ++g) s += red[(g * 5 + m) * 64 + cc];
        int col = cb * 64 + cc;
        modp[((size_t)l * 5 + m) * NMOD + col] = s + p.b_mod[(size_t)l * NMOD + col];
      }
    }
    __syncthreads();
  }
  convert_weights(p, 0, smem);
}

__device__ __forceinline__ void phase_norm(const Params& p, int l, int which, const float* lat, const float* cx) {
  const int lane = TIDX() & 63, wid = TIDX() >> 6;
  u16* h = (u16*)(p.ws + OFF_H);
  const float* g = p.norm_g + ((size_t)l * 3 + which) * D;
  const float* modp = (const float*)(p.ws + OFF_MOD) + (size_t)l * 5 * NMOD;
  for (int r = BIDX() * 4 + wid; r < TALL; r += gridDim.x * 4) {
    const float* xr = rrow(lat, cx, r);
    const float* mp = modp + (size_t)mod_index(r) * NMOD + which * 3 * D;
    float4 v[4];
    float ss = 0.f;
#pragma unroll
    for (int i = 0; i < 4; ++i) {
      v[i] = *(const float4*)(xr + i * 256 + lane * 4);
      ss += v[i].x * v[i].x + v[i].y * v[i].y + v[i].z * v[i].z + v[i].w * v[i].w;
    }
    ss = wave_sum(ss);
    float rstd = rsqrtf(ss * (1.f / 1024.f) + RMS_EPS);
#pragma unroll
    for (int i = 0; i < 4; ++i) {
      int col = i * 256 + lane * 4;
      float4 gg = *(const float4*)(g + col);
      float4 sh = *(const float4*)(mp + col);
      float4 scl = *(const float4*)(mp + D + col);
      bf16x4 o = pack4(v[i].x * rstd * gg.x * (1.f + scl.x) + sh.x, v[i].y * rstd * gg.y * (1.f + scl.y) + sh.y,
                       v[i].z * rstd * gg.z * (1.f + scl.z) + sh.z, v[i].w * rstd * gg.w * (1.f + scl.w) + sh.w);
      *(bf16x4*)(h + (size_t)r * D + col) = o;
    }
  }
}

__device__ __forceinline__ void phase_final_norm(const Params& p) {
  const int lane = TIDX() & 63, wid = TIDX() >> 6;
  for (int r = BIDX() * 4 + wid; r < TLAT; r += gridDim.x * 4) {
    float* xr = p.out + (size_t)r * D;
    float4 v[4];
    float ss = 0.f;
#pragma unroll
    for (int i = 0; i < 4; ++i) {
      v[i] = *(const float4*)(xr + i * 256 + lane * 4);
      ss += v[i].x * v[i].x + v[i].y * v[i].y + v[i].z * v[i].z + v[i].w * v[i].w;
    }
    ss = wave_sum(ss);
    float rstd = rsqrtf(ss * (1.f / 1024.f) + RMS_EPS);
#pragma unroll
    for (int i = 0; i < 4; ++i) {
      int col = i * 256 + lane * 4;
      float4 gg = *(const float4*)(p.final_g + col);
      float4 o = make_float4(v[i].x * rstd * gg.x, v[i].y * rstd * gg.y, v[i].z * rstd * gg.z, v[i].w * rstd * gg.w);
      *(float4*)(xr + col) = o;
    }
  }
}

template <int MI>
__device__ __forceinline__ void gemm_mainloop(const u16* __restrict__ A, const u16* __restrict__ Bt, int K, int brow,
                                              int bcol, f32x4 (&acc)[MI][4], unsigned char* smem) {
  const int tid = TIDX(), wid = tid >> 6, lane = tid & 63, wr = wid >> 1, wc = wid & 1, fr = lane & 15, fq = lane >> 4;
  constexpr int BM = MI * 32;
  constexpr int ACH = BM * 4 / 256;
  constexpr int STAGE = BM * 64 + 8192;
#pragma unroll
  for (int m = 0; m < MI; ++m)
#pragma unroll
    for (int n = 0; n < 4; ++n) acc[m][n] = f32x4{0.f, 0.f, 0.f, 0.f};
  const int nk = K / 32;
  const int prow = tid >> 2, pq = ((tid & 3) ^ ((0x78 >> (((tid >> 4) & 3) * 2)) & 3)) * 8;
  const u16* ga = A + (size_t)(brow + prow) * K + pq;
  const u16* gb = Bt + (size_t)(bcol + prow) * K + pq;
  auto stage = [&](int t, int buf) {
    unsigned char* base = smem + buf * STAGE;
#pragma unroll
    for (int i = 0; i < ACH; ++i)
      __builtin_amdgcn_global_load_lds((const unsigned*)(ga + (size_t)i * 64 * K + t * 32),
                                       (__attribute__((address_space(3))) unsigned*)(base + (tid + i * 256) * 16), 16, 0, 0);
#pragma unroll
    for (int i = 0; i < 2; ++i)
      __builtin_amdgcn_global_load_lds((const unsigned*)(gb + (size_t)i * 64 * K + t * 32),
                                       (__attribute__((address_space(3))) unsigned*)(base + BM * 64 + (tid + i * 256) * 16), 16, 0, 0);
  };
  const int swz = (fq ^ ((0x78 >> (((fr >> 2) & 3) * 2)) & 3)) * 16;
  __syncthreads();
  stage(0, 0);
  for (int t = 0; t < nk; ++t) {
    __syncthreads();
    if (t + 1 < nk) stage(t + 1, (t + 1) & 1);
    const unsigned char* base = smem + (t & 1) * STAGE;
    bf16x8 af[MI], bfr[4];
#pragma unroll
    for (int m = 0; m < MI; ++m) af[m] = *(const bf16x8*)(base + (wr * MI * 16 + m * 16 + fr) * 64 + swz);
#pragma unroll
    for (int n = 0; n < 4; ++n) bfr[n] = *(const bf16x8*)(base + BM * 64 + (wc * 64 + n * 16 + fr) * 64 + swz);
#pragma unroll
    for (int m = 0; m < MI; ++m)
#pragma unroll
      for (int n = 0; n < 4; ++n) acc[m][n] = __builtin_amdgcn_mfma_f32_16x16x32_bf16(af[m], bfr[n], acc[m][n], 0, 0, 0);
  }
}

__device__ __forceinline__ bool next_tile(int it, int MT, int NT, int& tm, int& tn) {
  const int G = gridDim.x, b = BIDX();
  const int total = MT * NT;
  int id;
  if ((G & 7) == 0) {
    const int per = G >> 3;
    id = it * G + (b & 7) * per + (b >> 3);
  } else {
    id = b + it * G;
  }
  if (id >= total) return false;
  constexpr int GM = 8;
  const int gsz = GM * NT;
  const int g = id / gsz, rem = id - g * gsz;
  const int rows = (MT - g * GM) < GM ? (MT - g * GM) : GM;
  tn = rem / rows;
  tm = g * GM + (rem - tn * rows);
  return true;
}

__device__ __forceinline__ void phase_ffn_in(const Params& p, int l, int f, unsigned char* smem) {
  const u16* A = (const u16*)(p.ws + OFF_H);
  const u16* Bt = (const u16*)(p.ws + OFF_WFFI) + (size_t)f * 5632 * 1024;
  u16* act = (u16*)(p.ws + OFF_P2);
  const int tid = TIDX(), wid = tid >> 6, lane = tid & 63, wr = wid >> 1, wc = wid & 1, fr = lane & 15, fq = lane >> 4;
  constexpr int MI = 8, NT = 44, MT = TALL / (MI * 32);
  for (int it = 0;; ++it) {
    int tm, tn;
    if (!next_tile(it, MT, NT, tm, tn)) break;
    f32x4 acc[MI][4];
    gemm_mainloop<MI>(A, Bt, 1024, tm * MI * 32, tn * 128, acc, smem);
#pragma unroll
    for (int m = 0; m < MI; ++m)
#pragma unroll
      for (int q = 0; q < 2; ++q)
#pragma unroll
        for (int j = 0; j < 4; ++j) {
          int row = tm * MI * 32 + wr * MI * 16 + m * 16 + fq * 4 + j;
          int col = tn * 64 + wc * 32 + q * 16 + fr;
          float u1 = acc[m][2 * q][j], u2 = acc[m][2 * q + 1][j];
          act[(size_t)row * DFF + col] = f2bf(siluf_(u1) * u2);
        }
  }
}

__device__ __forceinline__ void phase_resid_gemm(const Params& p, int l, const u16* A, const u16* Bt, int K, int gate, float gscale,
                                 const float* lat_in, const float* cx_in, float* lat_out, float* cx_out,
                                 unsigned char* smem) {
  const int tid = TIDX(), wid = tid >> 6, lane = tid & 63, wr = wid >> 1, wc = wid & 1, fr = lane & 15, fq = lane >> 4;
  constexpr int MI = 6, NT = 8, MT = TALL / (MI * 32);
  const float* modp = (const float*)(p.ws + OFF_MOD) + (size_t)l * 5 * NMOD + gate * D;
  for (int it = 0;; ++it) {
    int tm, tn;
    if (!next_tile(it, MT, NT, tm, tn)) break;
    f32x4 acc[MI][4];
    gemm_mainloop<MI>(A, Bt, K, tm * MI * 32, tn * 128, acc, smem);
#pragma unroll
    for (int m = 0; m < MI; ++m)
#pragma unroll
      for (int j = 0; j < 4; ++j) {
        int row = tm * MI * 32 + wr * MI * 16 + m * 16 + fq * 4 + j;
        const float* mp = modp + (size_t)mod_index(row) * NMOD;
        const float* xi = rrow(lat_in, cx_in, row);
        float* xo = wrow(lat_out, cx_out, row);
#pragma unroll
        for (int n = 0; n < 4; ++n) {
          int col = tn * 128 + wc * 64 + n * 16 + fr;
          xo[col] = xi[col] + gscale * mp[col] * acc[m][n][j];
        }
      }
  }
}

__device__ __forceinline__ void phase_inproj(const Params& p, int l, unsigned char* smem) {
  const u16* A = (const u16*)(p.ws + OFF_H);
  const u16* Bt = (const u16*)(p.ws + OFF_WIN);
  const int tid = TIDX(), wid = tid >> 6, lane = tid & 63, wr = wid >> 1, wc = wid & 1, fr = lane & 15, fq = lane >> 4;
  constexpr int MI = 8, NT = 27, MT = TALL / (MI * 32);
  const float2* ropeseq = (const float2*)(p.ws + OFF_ROPE);
  const float2* roperow = ropeseq + 8192 * 32;
  const float2* ropecol = roperow + 128 * 16;
  u16* QA = (u16*)(p.ws + OFF_QA); u16* QB = (u16*)(p.ws + OFF_QB); u16* QR = (u16*)(p.ws + OFF_QR);
  u16* KA = (u16*)(p.ws + OFF_KA); u16* VA = (u16*)(p.ws + OFF_VA);
  u16* KB = (u16*)(p.ws + OFF_KB); u16* VB = (u16*)(p.ws + OFF_VB);
  u16* KR = (u16*)(p.ws + OFF_KR); u16* VR = (u16*)(p.ws + OFF_VR);
  u16* P2 = (u16*)(p.ws + OFF_P2);
  for (int it = 0;; ++it) {
    int tm, tn;
    if (!next_tile(it, MT, NT, tm, tn)) break;
    f32x4 acc[MI][4];
    gemm_mainloop<MI>(A, Bt, 1024, tm * MI * 32, tn * 128, acc, smem);
    const int r0 = tm * MI * 32 + wr * MI * 16;
    const int c0 = tn * 128 + wc * 64;
    const bool latent = r0 < TLAT;
    if (c0 >= 1792) {
#pragma unroll
      for (int m = 0; m < MI; ++m)
#pragma unroll
        for (int n = 0; n < 4; ++n)
#pragma unroll
          for (int j = 0; j < 4; ++j) {
            int row = r0 + m * 16 + fq * 4 + j;
            P2[(size_t)row * P2C + (c0 - 1792) + n * 16 + fr] = f2bf(acc[m][n][j]);
          }
      continue;
    }
    int kind;
    int ropek;
    int normk;
    float scale = 1.f;
    u16* dst; int hh, nh;
    if (c0 < 256) { kind = 0; ropek = 1; normk = -1; scale = 0.125f * LOG2E; dst = QA; hh = c0 >> 6; nh = 4; }
    else if (c0 < 384) { kind = 1; ropek = 1; normk = -1; dst = KA; hh = (c0 - 256) >> 6; nh = 2; }
    else if (c0 < 512) { kind = 2; ropek = 0; normk = -1; dst = VA; hh = (c0 - 384) >> 6; nh = 2; }
    else if (c0 < 768) { kind = 0; ropek = 1; normk = 0; scale = 0.125f * LOG2E; dst = QB; hh = (c0 - 512) >> 6; nh = 4; }
    else if (c0 < 896) { kind = 1; ropek = 1; normk = 1; dst = KB; hh = (c0 - 768) >> 6; nh = 2; }
    else if (c0 < 1024) { kind = 2; ropek = 0; normk = -1; dst = VB; hh = (c0 - 896) >> 6; nh = 2; }
    else if (c0 < 1280) { kind = 0; ropek = 2; normk = -1; dst = QR; hh = (c0 - 1024) >> 6; nh = 4; }
    else if (c0 < 1536) { kind = 1; ropek = 2; normk = -1; scale = 0.125f; dst = KR; hh = (c0 - 1280) >> 6; nh = 4; }
    else { kind = 2; ropek = 0; normk = -1; dst = VR; hh = (c0 - 1536) >> 6; nh = 4; }
    if (!latent) ropek = 0;
    if (kind == 2) {
#pragma unroll
      for (int m = 0; m < MI; ++m) {
        int b, pos;
        row_bpos(r0 + m * 16 + fq * 4, b, pos);
#pragma unroll
        for (int n = 0; n < 4; ++n) {
          int d = n * 16 + fr;
          bf16x4 o = pack4(acc[m][n][0], acc[m][n][1], acc[m][n][2], acc[m][n][3]);
          *(bf16x4*)(dst + ((size_t)(b * nh + hh) * 64 + d) * STOT + pos) = o;
        }
      }
      continue;
    }
    float gq[4] = {1.f, 1.f, 1.f, 1.f};
    if (normk >= 0) {
#pragma unroll
      for (int n = 0; n < 4; ++n) gq[n] = p.qk_g[((size_t)l * 2 + normk) * 64 + n * 16 + fr];
    }
#pragma unroll
    for (int m = 0; m < MI; ++m)
#pragma unroll
      for (int j = 0; j < 4; ++j) {
        int row = r0 + m * 16 + fq * 4 + j;
        float v0 = acc[m][0][j], v1 = acc[m][1][j], v2 = acc[m][2][j], v3 = acc[m][3][j];
        if (normk >= 0) {
          float ss = v0 * v0 + v1 * v1 + v2 * v2 + v3 * v3;
          ss += __shfl_xor(ss, 1); ss += __shfl_xor(ss, 2); ss += __shfl_xor(ss, 4); ss += __shfl_xor(ss, 8);
          float rstd = rsqrtf(ss * (1.f / 64.f) + RMS_EPS);
          v0 *= rstd * gq[0]; v1 *= rstd * gq[1]; v2 *= rstd * gq[2]; v3 *= rstd * gq[3];
        }
        int b, pos;
        row_bpos(row, b, pos);
        if (ropek == 1) {
          float2 cr = roperow[(pos >> 6) * 16 + fr];
          float2 cc = ropecol[(pos & 63) * 16 + fr];
          float o0 = v0 * cr.x - v1 * cr.y, o1 = v1 * cr.x + v0 * cr.y;
          float o2 = v2 * cc.x - v3 * cc.y, o3 = v3 * cc.x + v2 * cc.y;
          v0 = o0; v1 = o1; v2 = o2; v3 = o3;
        } else if (ropek == 2) {
          float2 ca = ropeseq[pos * 32 + fr];
          float2 cb = ropeseq[pos * 32 + 16 + fr];
          float o0 = v0 * ca.x - v2 * ca.y, o2 = v2 * ca.x + v0 * ca.y;
          float o1 = v1 * cb.x - v3 * cb.y, o3 = v3 * cb.x + v1 * cb.y;
          v0 = o0; v1 = o1; v2 = o2; v3 = o3;
        }
        v0 *= scale; v1 *= scale; v2 *= scale; v3 *= scale;
        u16* dp;
        if (kind == 0) dp = dst + (size_t)row * 256 + hh * 64 + fr;
        else dp = dst + ((size_t)(b * nh + hh) * STOT + pos) * 64 + fr;
        dp[0] = f2bf(v0); dp[16] = f2bf(v1); dp[32] = f2bf(v2); dp[48] = f2bf(v3);
      }
  }
}

__device__ __forceinline__ void attn_item(const u16* __restrict__ Q, const u16* __restrict__ Kb, const u16* __restrict__ Vt,
                          u16* __restrict__ concat, int ccol0, int b, int kvh, int qrow0, int qpos0, int t0, int t1,
                          int c0, int c1, bool masked, const float* sink, unsigned char* smem) {
  const int tid = TIDX(), w = tid >> 6, lane = tid & 63, fr = lane & 15, fq = lane >> 4;
  const int head = kvh * 2 + (w & 1);
  const int qoff = (w >> 1) * 32;
  bf16x8 qf[2][2];
#pragma unroll
  for (int qg = 0; qg < 2; ++qg)
#pragma unroll
    for (int ks = 0; ks < 2; ++ks)
      qf[qg][ks] = *(const bf16x8*)(Q + (size_t)(qrow0 + qoff + qg * 16 + fr) * 256 + head * 64 + ks * 32 + fq * 8);
  f32x4 O[2][4];
  float mrow[2], lrow[2];
#pragma unroll
  for (int qg = 0; qg < 2; ++qg) {
    mrow[qg] = -1e30f; lrow[qg] = 0.f;
#pragma unroll
    for (int dt = 0; dt < 4; ++dt) O[qg][dt] = f32x4{0.f, 0.f, 0.f, 0.f};
  }
  const u16* Kbase = Kb + (size_t)(b * 2 + kvh) * STOT * 64;
  const u16* Vbase = Vt + (size_t)(b * 2 + kvh) * 64 * STOT;
  const int n1 = t1 - t0, total = n1 + (c1 - c0);
  bf16x8 kreg[2], vreg[2];
  auto gload = [&](int i) {
    int tile = i < n1 ? t0 + i : c0 + (i - n1);
#pragma unroll
    for (int ps = 0; ps < 2; ++ps) {
      int idx = tid + ps * 256;
      kreg[ps] = *(const bf16x8*)(Kbase + (size_t)tile * 4096 + idx * 8);
      int d = idx >> 3, ch = idx & 7;
      vreg[ps] = *(const bf16x8*)(Vbase + (size_t)d * STOT + tile * 64 + ch * 8);
    }
  };
  auto lstore = [&](int buf) {
    u16* Ks = (u16*)(smem + buf * 18432);
    u16* Vs = Ks + 64 * 72;
#pragma unroll
    for (int ps = 0; ps < 2; ++ps) {
      int idx = tid + ps * 256;
      int r = idx >> 3, ch = idx & 7;
      *(bf16x8*)(Ks + r * 72 + ch * 8) = kreg[ps];
      *(bf16x8*)(Vs + r * 72 + ch * 8) = vreg[ps];
    }
  };
  __syncthreads();
  gload(0);
  lstore(0);
  __syncthreads();
#pragma unroll 1
  for (int i = 0; i < total; ++i) {
    const int tile = i < n1 ? t0 + i : c0 + (i - n1);
    if (i + 1 < total) gload(i + 1);
    const u16* Ks = (const u16*)(smem + (i & 1) * 18432);
    const u16* Vs = Ks + 64 * 72;
    f32x4 s[2][4];
#pragma unroll
    for (int qg = 0; qg < 2; ++qg)
#pragma unroll
      for (int sub = 0; sub < 4; ++sub) s[qg][sub] = f32x4{0.f, 0.f, 0.f, 0.f};
#pragma unroll
    for (int sub = 0; sub < 4; ++sub)
#pragma unroll
      for (int ks = 0; ks < 2; ++ks) {
        bf16x8 a = *(const bf16x8*)(Ks + (sub * 16 + fr) * 72 + ks * 32 + fq * 8);
#pragma unroll
        for (int qg = 0; qg < 2; ++qg) s[qg][sub] = __builtin_amdgcn_mfma_f32_16x16x32_bf16(a, qf[qg][ks], s[qg][sub], 0, 0, 0);
      }
    __builtin_amdgcn_sched_barrier(0);
    const bool domask = masked && (tile < 128);
    bf16x8 pb[2][2];
#pragma unroll
    for (int qg = 0; qg < 2; ++qg) {
      if (domask) {
        int qpos = qpos0 + qoff + qg * 16 + fr;
#pragma unroll
        for (int sub = 0; sub < 4; ++sub)
#pragma unroll
          for (int j = 0; j < 4; ++j) {
            int kpos = tile * 64 + sub * 16 + fq * 4 + j;
            int dd = kpos - qpos;
            if (dd > 128 || dd < -128) s[qg][sub][j] = -INFINITY;
          }
      }
      float mx = -INFINITY;
#pragma unroll
      for (int sub = 0; sub < 4; ++sub)
#pragma unroll
        for (int j = 0; j < 4; ++j) mx = fmaxf(mx, s[qg][sub][j]);
      mx = fmaxf(mx, __shfl_xor(mx, 16));
      mx = fmaxf(mx, __shfl_xor(mx, 32));
      float mnew = fmaxf(mrow[qg], mx);
      const bool changed = mnew > mrow[qg];
      float alpha = __builtin_amdgcn_exp2f(mrow[qg] - mnew);
      mrow[qg] = mnew;
      float ps = 0.f;
#pragma unroll
      for (int sub = 0; sub < 4; ++sub)
#pragma unroll
        for (int j = 0; j < 4; ++j) {
          float pv = __builtin_amdgcn_exp2f(s[qg][sub][j] - mnew);
          s[qg][sub][j] = pv;
          ps += pv;
        }
      lrow[qg] = lrow[qg] * alpha + ps;
      if (__builtin_amdgcn_ballot_w64(changed) != 0ull) {
#pragma unroll
        for (int dt = 0; dt < 4; ++dt) O[qg][dt] *= alpha;
      }
#pragma unroll
      for (int ks = 0; ks < 2; ++ks)
        pb[qg][ks] = cat8(pack4(s[qg][2 * ks][0], s[qg][2 * ks][1], s[qg][2 * ks][2], s[qg][2 * ks][3]),
                          pack4(s[qg][2 * ks + 1][0], s[qg][2 * ks + 1][1], s[qg][2 * ks + 1][2], s[qg][2 * ks + 1][3]));
      __builtin_amdgcn_sched_barrier(0);
    }
#pragma unroll
    for (int dt = 0; dt < 4; ++dt)
#pragma unroll
      for (int ks = 0; ks < 2; ++ks) {
        const u16* vp = Vs + (dt * 16 + fr) * 72 + ks * 32 + fq * 4;
        bf16x8 va = cat8(*(const bf16x4*)vp, *(const bf16x4*)(vp + 16));
#pragma unroll
        for (int qg = 0; qg < 2; ++qg) O[qg][dt] = __builtin_amdgcn_mfma_f32_16x16x32_bf16(va, pb[qg][ks], O[qg][dt], 0, 0, 0);
      }
    __builtin_amdgcn_sched_barrier(0);
    if (i + 1 < total) lstore((i + 1) & 1);
    __syncthreads();
  }
#pragma unroll
  for (int qg = 0; qg < 2; ++qg) {
    float lt = lrow[qg];
    lt += __shfl_xor(lt, 16);
    lt += __shfl_xor(lt, 32);
    if (sink) lt += __builtin_amdgcn_exp2f(sink[head] * LOG2E - mrow[qg]);
    float inv = 1.f / lt;
    int row = qrow0 + qoff + qg * 16 + fr;
#pragma unroll
    for (int dt = 0; dt < 4; ++dt) {
      bf16x4 o = pack4(O[qg][dt][0] * inv, O[qg][dt][1] * inv, O[qg][dt][2] * inv, O[qg][dt][3] * inv);
      *(bf16x4*)(concat + (size_t)row * D + ccol0 + head * 64 + dt * 16 + fq * 4) = o;
    }
  }
}

__device__ __forceinline__ float ret_lg(int h) {
  return log2f(1.0f - exp2f(-5.0f - (float)h));
}

__device__ __forceinline__ void retU_item(const Params& p, int bh, int c, unsigned char* smem) {
  const int tid = TIDX();
  const int b = bh >> 2, h = bh & 3;
  const u16* KR = (const u16*)(p.ws + OFF_KR) + (size_t)bh * STOT * 64;
  const u16* VR = (const u16*)(p.ws + OFF_VR) + (size_t)bh * 64 * STOT;
  (void)b;
  const int pos0 = c < 64 ? c * 128 : SEQ + (c - 64) * 128;
  u16* Kc = (u16*)smem;
  u16* Vj = Kc + 128 * 64;
  __syncthreads();
#pragma unroll
  for (int ps = 0; ps < 4; ++ps) {
    int idx = tid + ps * 256;
    *(bf16x8*)(Kc + idx * 8) = *(const bf16x8*)(KR + (size_t)pos0 * 64 + idx * 8);
    int d = idx >> 4, ch = idx & 15;
    bf16x8 v = *(const bf16x8*)(VR + (size_t)d * STOT + pos0 + ch * 8);
#pragma unroll
    for (int e = 0; e < 8; ++e) Vj[(ch * 8 + e) * 72 + d] = (u16)v[e];
  }
  __syncthreads();
  const int dk = tid >> 2, dv0 = (tid & 3) * 16;
  const float lg = ret_lg(h);
  float af[16], ab[16];
#pragma unroll
  for (int q = 0; q < 16; ++q) { af[q] = 0.f; ab[q] = 0.f; }
  for (int j = 0; j < 128; ++j) {
    float kf = bf2f(Kc[j * 64 + dk]);
    float kfw = kf * exp2f(lg * (float)(127 - j));
    float kbw = kf * exp2f(lg * (float)j);
    bf16x8 v0 = *(const bf16x8*)(Vj + j * 72 + dv0);
    bf16x8 v1 = *(const bf16x8*)(Vj + j * 72 + dv0 + 8);
#pragma unroll
    for (int q = 0; q < 8; ++q) {
      float a = bf2f((u16)v0[q]), bb = bf2f((u16)v1[q]);
      af[q] += kfw * a; ab[q] += kbw * a;
      af[8 + q] += kfw * bb; ab[8 + q] += kbw * bb;
    }
  }
  float* U = (float*)(p.ws + OFF_U) + ((size_t)bh * 66 + c) * 2 * 4096;
#pragma unroll
  for (int q = 0; q < 16; ++q) {
    U[(dv0 + q) * 64 + dk] = af[q];
    U[4096 + (dv0 + q) * 64 + dk] = ab[q];
  }
}

__device__ __forceinline__ void phase_retU(const Params& p, unsigned char* smem) {
  for (int item = BIDX(); item < 16 * 66; item += gridDim.x) retU_item(p, item / 66, item % 66, smem);
}

__device__ __forceinline__ void attn_worker(const Params& p, int l, unsigned char* smem) {
  const u16* QA = (const u16*)(p.ws + OFF_QA); const u16* QB = (const u16*)(p.ws + OFF_QB);
  const u16* KA = (const u16*)(p.ws + OFF_KA); const u16* VA = (const u16*)(p.ws + OFF_VA);
  const u16* KB = (const u16*)(p.ws + OFF_KB); const u16* VB = (const u16*)(p.ws + OFF_VB);
  u16* concat = (u16*)(p.ws + OFF_H);
  const float* sink = p.attn_sink + l * 4;
  int* qctr = (int*)(p.ws + OFF_QCTR) + l;
  volatile int* slot = (volatile int*)(smem + 65536 - 32);
  for (;;) {
    __syncthreads();
    if (TIDX() == 0) *slot = atomicAdd(qctr, 1);
    __syncthreads();
    const int item = *slot;
    if (item >= 2112) break;
    const bool isB = item < 1024 || (item >= 2048 && item < 2080);
    const bool isctx = item >= 2048;
    int ii = item < 1024 ? item : item < 2048 ? item - 1024 : item < 2080 ? item - 2048 : item - 2080;
    int qt, kvh, b, qrow0, qpos0, t0, t1;
    if (!isctx) {
      qt = ii & 127; kvh = (ii >> 7) & 1; b = ii >> 8;
      qrow0 = b * SEQ + qt * 64; qpos0 = qt * 64;
      if (isB) { t0 = 0; t1 = 128; }
      else { t0 = qt - 2 < 0 ? 0 : qt - 2; t1 = qt + 3 > 128 ? 128 : qt + 3; }
    } else {
      qt = ii & 3; kvh = (ii >> 2) & 1; b = ii >> 3;
      qrow0 = TLAT + b * CTXL + qt * 64; qpos0 = 0; t0 = 0; t1 = 0;
    }
    attn_item(isB ? QB : QA, isB ? KB : KA, isB ? VB : VA, concat, isB ? 256 : 0, b, kvh, qrow0, qpos0, t0, t1, 128, 132,
              (!isB) && (!isctx), isB ? nullptr : sink, smem);
  }
}

__device__ __forceinline__ void phase_retscan(const Params& p) {
  const float* U = (const float*)(p.ws + OFF_U);
  u16* SP = (u16*)(p.ws + OFF_SP);
  for (int gid = BIDX() * 256 + TIDX(); gid < 16 * 2 * 4096; gid += gridDim.x * 256) {
    int e = gid & 4095, dir = (gid >> 12) & 1, bh = gid >> 13;
    float g128 = exp2f(128.f * ret_lg(bh & 3));
    float S = 0.f;
#pragma unroll 1
    for (int n0 = 0; n0 < 66; n0 += 11) {
      float u[11];
      size_t offs[11];
#pragma unroll
      for (int k = 0; k < 11; ++k) {
        int n = n0 + k;
        int c = dir == 0 ? (n < 2 ? 64 + n : n - 2) : 65 - n;
        offs[k] = (((size_t)bh * 66 + c) * 2 + dir) * 4096 + e;
        u[k] = U[offs[k]];
      }
#pragma unroll
      for (int k = 0; k < 11; ++k) {
        SP[offs[k]] = f2bf(S);
        S = g128 * S + u[k];
      }
    }
  }
}

__device__ __forceinline__ void retout_item(const Params& p, int l, int bh, int c, unsigned char* smem) {
  const int tid = TIDX(), w = tid >> 6, lane = tid & 63, fr = lane & 15, fq = lane >> 4;
  const int b = bh >> 2, h = bh & 3;
  const u16* QR = (const u16*)(p.ws + OFF_QR);
  const u16* KR = (const u16*)(p.ws + OFF_KR) + (size_t)bh * STOT * 64;
  const u16* VR = (const u16*)(p.ws + OFF_VR) + (size_t)bh * 64 * STOT;
  const u16* SP = (const u16*)(p.ws + OFF_SP) + ((size_t)bh * 66 + c) * 2 * 4096;
  const u16* P2 = (const u16*)(p.ws + OFF_P2);
  u16* concat = (u16*)(p.ws + OFF_H);
  const int pos0 = c < 64 ? c * 128 : SEQ + (c - 64) * 128;
  const int row0 = bpos_row(b, pos0);
  u16* Kc = (u16*)smem;
  u16* Vs = Kc + 128 * 72;
  __syncthreads();
#pragma unroll
  for (int ps = 0; ps < 4; ++ps) {
    int idx = tid + ps * 256;
    int r = idx >> 3, ch = idx & 7;
    *(bf16x8*)(Kc + r * 72 + ch * 8) = *(const bf16x8*)(KR + (size_t)(pos0 + r) * 64 + ch * 8);
    int d = idx >> 4, c16 = idx & 15;
    *(bf16x8*)(Vs + d * 136 + c16 * 8) = *(const bf16x8*)(VR + (size_t)d * STOT + pos0 + c16 * 8);
  }
  __syncthreads();
  const float lg = ret_lg(h);
#pragma unroll 1
  for (int qg = 0; qg < 2; ++qg) {
    const int i = w * 32 + qg * 16 + fr;
    const int row = row0 + i;
    bf16x8 qf[2];
#pragma unroll
    for (int ks = 0; ks < 2; ++ks) qf[ks] = *(const bf16x8*)(QR + (size_t)row * 256 + h * 64 + ks * 32 + fq * 8);
    f32x4 s[8];
#pragma unroll
    for (int sub = 0; sub < 8; ++sub) {
      s[sub] = f32x4{0.f, 0.f, 0.f, 0.f};
#pragma unroll
      for (int ks = 0; ks < 2; ++ks) {
        bf16x8 a = *(const bf16x8*)(Kc + (sub * 16 + fr) * 72 + ks * 32 + fq * 8);
        s[sub] = __builtin_amdgcn_mfma_f32_16x16x32_bf16(a, qf[ks], s[sub], 0, 0, 0);
      }
    }
    float res[4][4];
#pragma unroll
    for (int dt = 0; dt < 4; ++dt)
#pragma unroll
      for (int j = 0; j < 4; ++j) res[dt][j] = 0.f;
#pragma unroll 1
    for (int dir = 0; dir < 2; ++dir) {
      f32x4 O[4];
      const float qw = dir == 0 ? __builtin_amdgcn_exp2f(lg * (float)(i + 1)) : __builtin_amdgcn_exp2f(lg * (float)(128 - i));
#pragma unroll
      for (int dt = 0; dt < 4; ++dt) {
        O[dt] = f32x4{0.f, 0.f, 0.f, 0.f};
#pragma unroll
        for (int ks = 0; ks < 2; ++ks) {
          bf16x8 a = *(const bf16x8*)(SP + dir * 4096 + (dt * 16 + fr) * 64 + ks * 32 + fq * 8);
          O[dt] = __builtin_amdgcn_mfma_f32_16x16x32_bf16(a, qf[ks], O[dt], 0, 0, 0);
        }
        O[dt] *= qw;
      }
      int fqo = fq;
      asm volatile("" : "+v"(fqo));
#pragma unroll
      for (int ks = 0; ks < 4; ++ks) {
        float pv[8];
#pragma unroll
        for (int e = 0; e < 8; ++e) {
          const int sub = 2 * ks + (e >> 2), j = e & 3;
          const int jk = sub * 16 + fqo * 4 + j;
          const int dd = dir == 0 ? i - jk : jk - i;
          pv[e] = dd >= 0 ? s[sub][j] * __builtin_amdgcn_exp2f(lg * (float)dd) : 0.f;
        }
        bf16x8 pb = cat8(pack4(pv[0], pv[1], pv[2], pv[3]), pack4(pv[4], pv[5], pv[6], pv[7]));
#pragma unroll
        for (int dt = 0; dt < 4; ++dt) {
          const u16* vp = Vs + (dt * 16 + fr) * 136 + ks * 32 + fq * 4;
          bf16x8 va = cat8(*(const bf16x4*)vp, *(const bf16x4*)(vp + 16));
          O[dt] = __builtin_amdgcn_mfma_f32_16x16x32_bf16(va, pb, O[dt], 0, 0, 0);
        }
      }
      float sm = 0.f;
#pragma unroll
      for (int dt = 0; dt < 4; ++dt)
#pragma unroll
        for (int j = 0; j < 4; ++j) sm += O[dt][j];
      sm += __shfl_xor(sm, 16); sm += __shfl_xor(sm, 32);
      const float mu = sm * (1.f / 64.f);
      float vs = 0.f;
#pragma unroll
      for (int dt = 0; dt < 4; ++dt)
#pragma unroll
        for (int j = 0; j < 4; ++j) { float dlt = O[dt][j] - mu; vs += dlt * dlt; }
      vs += __shfl_xor(vs, 16); vs += __shfl_xor(vs, 32);
      const float rstd = rsqrtf(vs * (1.f / 64.f) + GN_EPS);
#pragma unroll
      for (int dt = 0; dt < 4; ++dt) {
        const int d = dt * 16 + fq * 4;
        bf16x4 gt = *(const bf16x4*)(P2 + (size_t)row * P2C + dir * 256 + h * 64 + d);
        float4 rg = *(const float4*)(p.ret_g + (size_t)l * 256 + h * 64 + d);
        res[dt][0] += (O[dt][0] - mu) * rstd * rg.x * siluf_(bf2f((u16)gt[0]));
        res[dt][1] += (O[dt][1] - mu) * rstd * rg.y * siluf_(bf2f((u16)gt[1]));
        res[dt][2] += (O[dt][2] - mu) * rstd * rg.z * siluf_(bf2f((u16)gt[2]));
        res[dt][3] += (O[dt][3] - mu) * rstd * rg.w * siluf_(bf2f((u16)gt[3]));
      }
    }
#pragma unroll
    for (int dt = 0; dt < 4; ++dt)
      *(bf16x4*)(concat + (size_t)row * D + 512 + h * 64 + dt * 16 + fq * 4) = pack4(res[dt][0], res[dt][1], res[dt][2], res[dt][3]);
  }
}

__device__ __forceinline__ void phase_retout(const Params& p, int l, unsigned char* smem) {
  for (int item = BIDX(); item < 16 * 66; item += gridDim.x) retout_item(p, l, item / 66, item % 66, smem);
}

__device__ __forceinline__ void phase_wprep(const Params& p, int l, unsigned char* smem) {
  const int tid = TIDX(), lane = tid & 63, h = tid >> 6;
  const u16* P2 = (const u16*)(p.ws + OFF_P2);
  u16* prep = (u16*)(p.ws + OFF_PREP);
  float* twT = (float*)smem;
  float* amT = twT + 64 * 32;
  for (int item = BIDX(); item < (TALL / 32) * 2; item += gridDim.x) {
    const int dir = item & 1, row0 = (item >> 1) * 32;
    const float* mu = p.mu + ((size_t)l * 2 + dir) * 896;
    __syncthreads();
    {
      const int tok = tid >> 3, e0 = (tid & 7) * 8;
      const int row = row0 + tok;
      int b, pos;
      row_bpos(row, b, pos);
      bool has;
      int nrow;
      if (dir == 0) { has = (pos != 0) && (pos != SEQ); nrow = row - 1; }
      else { has = (pos != SEQ - 1) && (pos != STOT - 1); nrow = row + 1; }
      const u16* cw = P2 + (size_t)row * P2C + 1408 + dir * 64 + e0;
      const u16* ca = P2 + (size_t)row * P2C + 1536 + dir * 64 + e0;
      bf16x8 zw = *(const bf16x8*)cw, za = *(const bf16x8*)ca;
      bf16x8 sw = zw, sa = za;
      if (has) {
        sw = *(const bf16x8*)(P2 + (size_t)nrow * P2C + 1408 + dir * 64 + e0);
        sa = *(const bf16x8*)(P2 + (size_t)nrow * P2C + 1536 + dir * 64 + e0);
      }
#pragma unroll
      for (int e = 0; e < 8; ++e) {
        float z = bf2f((u16)zw[e]), zs = has ? bf2f((u16)sw[e]) : 0.f;
        float m = mu[768 + e0 + e];
        twT[(e0 + e) * 32 + tok] = tanhf_(z + m * (zs - z));
        float z2 = bf2f((u16)za[e]), zs2 = has ? bf2f((u16)sa[e]) : 0.f;
        float m2 = mu[832 + e0 + e];
        amT[(e0 + e) * 32 + tok] = z2 + m2 * (zs2 - z2);
      }
    }
    __syncthreads();
    const int col = tid;
    float accw[32], acca[32];
#pragma unroll
    for (int t = 0; t < 32; ++t) { accw[t] = 0.f; acca[t] = 0.f; }
    const float* w2 = p.w2 + ((size_t)l * 2 + dir) * 64 * 256 + col;
    const float* a2 = p.a2 + ((size_t)l * 2 + dir) * 64 * 256 + col;
    for (int kq = 0; kq < 64; ++kq) {
      float wv = w2[kq * 256], av = a2[kq * 256];
#pragma unroll
      for (int t4 = 0; t4 < 8; ++t4) {
        float4 a = *(const float4*)(twT + kq * 32 + t4 * 4);
        float4 bq = *(const float4*)(amT + kq * 32 + t4 * 4);
        accw[t4 * 4 + 0] += a.x * wv; accw[t4 * 4 + 1] += a.y * wv; accw[t4 * 4 + 2] += a.z * wv; accw[t4 * 4 + 3] += a.w * wv;
        acca[t4 * 4 + 0] += bq.x * av; acca[t4 * 4 + 1] += bq.y * av; acca[t4 * 4 + 2] += bq.z * av; acca[t4 * 4 + 3] += bq.w * av;
      }
    }
    const float w0v = p.w0[((size_t)l * 2 + dir) * 256 + col], a0v = p.a0[((size_t)l * 2 + dir) * 256 + col];
    const float kkv = p.k_k[(size_t)l * 256 + col], kav = p.k_a[(size_t)l * 256 + col];
    const float mur = mu[col], muk = mu[256 + col], muv = mu[512 + col];
#pragma unroll
    for (int t = 0; t < 32; ++t) {
      const int row = row0 + t;
      int b, pos;
      row_bpos(row, b, pos);
      bool has;
      int nrow;
      if (dir == 0) { has = (pos != 0) && (pos != SEQ); nrow = row - 1; }
      else { has = (pos != SEQ - 1) && (pos != STOT - 1); nrow = row + 1; }
      const u16* cp = P2 + (size_t)row * P2C + 512 + col;
      const u16* np = P2 + (size_t)(has ? nrow : row) * P2C + 512 + col;
      float zr = bf2f(cp[0]), zk = bf2f(cp[256]), zv = bf2f(cp[512]);
      float sr = has ? bf2f(np[0]) : 0.f, sk = has ? bf2f(np[256]) : 0.f, sv = has ? bf2f(np[512]) : 0.f;
      float r = zr + mur * (sr - zr), k = zk + muk * (sk - zk), v = zv + muv * (sv - zv);
      float lw2 = -0.6065306597126334f * sigmoidf_(w0v + accw[t]) * LOG2E;
      float av = sigmoidf_(a0v + acca[t]);
      float kkr = k * kkv;
      float ss = wave_sum(kkr * kkr);
      float kk = kkr * rsqrtf(fmaxf(ss, 1e-24f));
      float kt = k * (1.f + (av - 1.f) * kav);
      u16* dp = prep + (((size_t)(b * 4 + h) * 2 + dir) * STOT + pos) * 384 + lane;
      dp[0] = f2bf(lw2); dp[64] = f2bf(kt); dp[128] = f2bf(kk); dp[192] = f2bf(kk * av); dp[256] = f2bf(r); dp[320] = f2bf(v);
    }
  }
}

typedef float f32x2 __attribute__((ext_vector_type(2)));
__device__ __forceinline__ void wscan_item(const Params& p, int item, unsigned char* smem) {
  const int tid = TIDX(), w = tid >> 6, lane = tid & 63;
  const int jl4 = (lane & 15) * 4, rsub = lane >> 4;
  const u16* prep = (const u16*)(p.ws + OFF_PREP);
  u16* P2w = (u16*)(p.ws + OFF_P2);
  float* bufs = (float*)smem;
  {
    const int rq = item & 3, seq = item >> 2;
    const int dir = seq & 1, h = (seq >> 1) & 3, b = seq >> 3;
    const int irow = rq * 16 + w * 4 + rsub;
    const u16* base = prep + (size_t)seq * STOT * 384;
    uint4 lreg[3];
    auto gload = [&](int ch) {
#pragma unroll
      for (int ps = 0; ps < 3; ++ps) {
        int q = tid + ps * 256;
        int sidx = q / 48, within = q % 48;
        int n = ch * 16 + sidx;
        int pos = dir == 0 ? (n < CTXL ? SEQ + n : n - CTXL) : (STOT - 1 - n);
        lreg[ps] = *(const uint4*)(base + (size_t)pos * 384 + within * 8);
      }
    };
    auto lstore = [&](int buf) {
#pragma unroll
      for (int ps = 0; ps < 3; ++ps) {
        int q = tid + ps * 256;
        int sidx = q / 48, within = q % 48;
        float* dp = bufs + buf * 6144 + sidx * 384 + within * 8;
        uint4 u = lreg[ps];
        float4 lo = make_float4(__uint_as_float(u.x << 16), __uint_as_float(u.x & 0xffff0000u), __uint_as_float(u.y << 16), __uint_as_float(u.y & 0xffff0000u));
        float4 hi = make_float4(__uint_as_float(u.z << 16), __uint_as_float(u.z & 0xffff0000u), __uint_as_float(u.w << 16), __uint_as_float(u.w & 0xffff0000u));
        if (within < 8) {
          lo.x = __builtin_amdgcn_exp2f(lo.x); lo.y = __builtin_amdgcn_exp2f(lo.y); lo.z = __builtin_amdgcn_exp2f(lo.z); lo.w = __builtin_amdgcn_exp2f(lo.w);
          hi.x = __builtin_amdgcn_exp2f(hi.x); hi.y = __builtin_amdgcn_exp2f(hi.y); hi.z = __builtin_amdgcn_exp2f(hi.z); hi.w = __builtin_amdgcn_exp2f(hi.w);
        }
        *(float4*)dp = lo;
        *(float4*)(dp + 4) = hi;
      }
    };
    f32x2 S01 = {0.f, 0.f}, S23 = {0.f, 0.f};
    __syncthreads();
    gload(0);
    lstore(0);
    __syncthreads();
    constexpr int NCH = STOT / 16;
    for (int ch = 0; ch < NCH; ++ch) {
      if (ch + 1 < NCH) gload(ch + 1);
      const float* bp = bufs + (ch & 1) * 6144;
      const int n0 = ch * 16;
      const int pos0 = dir == 0 ? (n0 < CTXL ? SEQ + n0 : n0 - CTXL) : (STOT - 1 - n0);
      u16* yp = P2w + (size_t)bpos_row(b, pos0) * P2C + (dir == 0 ? YCOL0 : YCOL1) + h * 64 + irow;
      const int ystride = dir == 0 ? P2C : -P2C;
      float4 Wq[3], Kq[3], Nq[3], Bq[3], Rq[3];
      float Vq[3];
#define SCAN_LD(slot, st)                                        \
      do {                                                         \
        const float* sp_ = bp + (st) * 384;                        \
        Wq[slot] = *(const float4*)(sp_ + jl4);                    \
        Kq[slot] = *(const float4*)(sp_ + 64 + jl4);               \
        Nq[slot] = *(const float4*)(sp_ + 128 + jl4);              \
        Bq[slot] = *(const float4*)(sp_ + 192 + jl4);              \
        Rq[slot] = *(const float4*)(sp_ + 256 + jl4);              \
        Vq[slot] = sp_[320 + irow];                                \
      } while (0)
      SCAN_LD(0, 0);
      SCAN_LD(1, 1);
      SCAN_LD(2, 2);
      float ypart = 0.f;
#pragma unroll
      for (int s = 0; s < 16; ++s) {
        const int sl = s % 3;
        const float4 wv = Wq[sl], kt = Kq[sl], kk = Nq[sl], bb = Bq[sl], rr = Rq[sl];
        const float v = Vq[sl];
        if (s + 3 < 16) SCAN_LD(sl, s + 3);
        const f32x2 vv = {v, v};
        f32x2 A01 = S01 * f32x2{wv.x, wv.y} + vv * f32x2{kt.x, kt.y};
        f32x2 A23 = S23 * f32x2{wv.z, wv.w} + vv * f32x2{kt.z, kt.w};
        f32x2 pp = S01 * f32x2{kk.x, kk.y} + S23 * f32x2{kk.z, kk.w};
        float sa = pp.x + pp.y;
        float yprev = ypart;
        row16_sum2(sa, yprev);
        if (s > 0) { if ((lane & 15) == 0) yp[(s - 1) * ystride] = f2bf(yprev); }
        const f32x2 nsa = {-sa, -sa};
        S01 = nsa * f32x2{bb.x, bb.y} + A01;
        S23 = nsa * f32x2{bb.z, bb.w} + A23;
        f32x2 yy = S01 * f32x2{rr.x, rr.y} + S23 * f32x2{rr.z, rr.w};
        ypart = yy.x + yy.y;
      }
      {
        float ylast = row16_sum(ypart);
        if ((lane & 15) == 0) yp[15 * ystride] = f2bf(ylast);
      }
#undef SCAN_LD
      if (ch + 1 < NCH) lstore((ch + 1) & 1);
      __syncthreads();
    }
  }
}

__device__ __forceinline__ void phase_scan_attn(const Params& p, int l, unsigned char* smem) {
  const int G = gridDim.x, tid = TIDX(), bid = BIDX();
  if (G > 128 && G <= 2048) {
    int* keys = (int*)smem;
    int* red = keys + 2048;
    const int* cutab = (const int*)(p.ws + OFF_CUTAB);
    __syncthreads();
    for (int i = tid; i < G; i += 256) keys[i] = cutab[i];
    if (tid == 0) { red[0] = 0; red[1] = 0; }
    __syncthreads();
    for (int i = 128 + tid; i < G; i += 256) {
      const int ki = keys[i];
      bool m = false;
      for (int j = 0; j < 128; ++j) m = m || (keys[j] == ki);
      if (!m) atomicAdd(&red[0], 1);
      if (m && i == bid) red[1] = 1;
    }
    __syncthreads();
    const int eligible = red[0], mine = red[1];
    __syncthreads();
    if (bid < 128) {
      __builtin_amdgcn_s_setprio(3);
      wscan_item(p, bid, smem);
      __builtin_amdgcn_s_setprio(0);
    } else if (eligible < 64 || !mine) {
      attn_worker(p, l, smem);
    }
  } else {
    for (int item = bid; item < 128; item += G) wscan_item(p, item, smem);
    attn_worker(p, l, smem);
  }
}

__device__ __forceinline__ float half8_sum(float x) {
  x += dpp_f<0xB1>(x);
  x += dpp_f<0x4E>(x);
  x += dpp_f<0x141>(x);
  return x;
}
__device__ __forceinline__ void phase_wfin(const Params& p, int l, unsigned char* smem) {
  const int tid = TIDX(), col = tid;
  const u16* P2 = (const u16*)(p.ws + OFF_P2);
  const u16* prep = (const u16*)(p.ws + OFF_PREP);
  u16* concat = (u16*)(p.ws + OFF_H);
  float* sgT = (float*)smem;
  float* gateL = sgT + 128 * 16;
  const float* g2 = p.g2 + (size_t)l * 128 * 256 + col;
  const int j = tid & 31, tsub = tid >> 5, head = j >> 3, c8 = (j & 7) * 8, ch0 = head * 64 + c8;
  float lng[8], lnb[8], rho[2][8];
#pragma unroll
  for (int e = 0; e < 8; ++e) {
    lng[e] = p.ln_g[(size_t)l * 256 + ch0 + e];
    lnb[e] = p.ln_b[(size_t)l * 256 + ch0 + e];
    rho[0][e] = p.rho[((size_t)l * 2 + 0) * 256 + ch0 + e];
    rho[1][e] = p.rho[((size_t)l * 2 + 1) * 256 + ch0 + e];
  }
  for (int item = BIDX(); item < TALL / 16; item += gridDim.x) {
    const int row0 = item * 16;
    __syncthreads();
    {
      const int tok = tid >> 4, k0 = (tid & 15) * 8;
      bf16x8 g = *(const bf16x8*)(P2 + (size_t)(row0 + tok) * P2C + 1280 + k0);
#pragma unroll
      for (int e = 0; e < 8; ++e) sgT[(k0 + e) * 16 + tok] = sigmoidf_(bf2f((u16)g[e]));
    }
    __syncthreads();
    float acc[16];
#pragma unroll
    for (int t = 0; t < 16; ++t) acc[t] = 0.f;
    for (int k = 0; k < 128; ++k) {
      float gv = g2[k * 256];
#pragma unroll
      for (int t4 = 0; t4 < 4; ++t4) {
        float4 a = *(const float4*)(sgT + k * 16 + t4 * 4);
        acc[t4 * 4 + 0] += a.x * gv; acc[t4 * 4 + 1] += a.y * gv; acc[t4 * 4 + 2] += a.z * gv; acc[t4 * 4 + 3] += a.w * gv;
      }
    }
#pragma unroll
    for (int t = 0; t < 16; ++t) gateL[t * 256 + col] = acc[t];
    __syncthreads();
#pragma unroll
    for (int pass = 0; pass < 2; ++pass) {
      const int tok = pass * 8 + tsub, row = row0 + tok;
      int b, pos;
      row_bpos(row, b, pos);
      float tot[8];
#pragma unroll
      for (int e = 0; e < 8; ++e) tot[e] = 0.f;
#pragma unroll
      for (int dir = 0; dir < 2; ++dir) {
        const bf16x8 y8 = *(const bf16x8*)(P2 + (size_t)row * P2C + (dir == 0 ? YCOL0 : YCOL1) + ch0);
        const u16* pp = prep + (((size_t)(b * 4 + head) * 2 + dir) * STOT + pos) * 384 + c8;
        const bf16x8 kt8 = *(const bf16x8*)(pp + 64), r8 = *(const bf16x8*)(pp + 256), v8 = *(const bf16x8*)(pp + 320);
        float y[8], s1 = 0.f, s3 = 0.f;
#pragma unroll
        for (int e = 0; e < 8; ++e) {
          y[e] = bf2f((u16)y8[e]);
          s1 += y[e];
          s3 += bf2f((u16)r8[e]) * bf2f((u16)kt8[e]) * rho[dir][e];
        }
        s1 = half8_sum(s1);
        s3 = half8_sum(s3);
        const float mu = s1 * (1.f / 64.f);
        float s2 = 0.f;
#pragma unroll
        for (int e = 0; e < 8; ++e) { y[e] -= mu; s2 += y[e] * y[e]; }
        s2 = half8_sum(s2);
        const float rstd = rsqrtf(s2 * (1.f / 64.f) + GN_EPS);
#pragma unroll
        for (int e = 0; e < 8; ++e) tot[e] += y[e] * rstd * lng[e] + lnb[e] + s3 * bf2f((u16)v8[e]);
      }
      const float4 g0 = *(const float4*)(gateL + tok * 256 + ch0), g1 = *(const float4*)(gateL + tok * 256 + ch0 + 4);
      bf16x8 o = cat8(pack4(tot[0] * g0.x, tot[1] * g0.y, tot[2] * g0.z, tot[3] * g0.w),
                      pack4(tot[4] * g1.x, tot[5] * g1.y, tot[6] * g1.z, tot[7] * g1.w));
      *(bf16x8*)(concat + (size_t)row * D + 768 + ch0) = o;
    }
  }
}

constexpr int N_PHASES = 1 + 2 * 16 + 1;
__device__ __forceinline__ void run_phase(const Params& p, int ph, unsigned char* smem) {
  if (ph == 0) { phase_init(p, smem); return; }
  if (ph == N_PHASES - 1) { phase_final_norm(p); return; }
  const int l = (ph - 1) / 16, s = (ph - 1) % 16;
  float* xc = (float*)(p.ws + OFF_XC);
  const float* lat_in = (l == 0 && s < 3) ? p.x : p.out;
  const float* cx_in = (l == 0 && s < 3) ? p.ctx : xc;
  const u16* H = (const u16*)(p.ws + OFF_H);
  const u16* ACT = (const u16*)(p.ws + OFF_P2);
  switch (s) {
    case 0: phase_norm(p, l, 0, lat_in, cx_in); break;
    case 1: phase_ffn_in(p, l, 0, smem); break;
    case 2: phase_resid_gemm(p, l, ACT, (const u16*)(p.ws + OFF_WFFO) + (size_t)0 * 1024 * DFF, DFF, 2, 0.5f, lat_in, cx_in, p.out, xc, smem); break;
    case 3: phase_norm(p, l, 1, p.out, xc); break;
    case 4: phase_inproj(p, l, smem); break;
    case 5: phase_retU(p, smem); break;
    case 6: phase_retscan(p); break;
    case 7: phase_retout(p, l, smem); break;
    case 8: phase_wprep(p, l, smem); break;
    case 9: phase_scan_attn(p, l, smem); break;
    case 10: phase_wfin(p, l, smem); break;
    case 11: phase_resid_gemm(p, l, H, (const u16*)(p.ws + OFF_WOUT), 1024, 5, 1.0f, p.out, xc, p.out, xc, smem); break;
    case 12: phase_norm(p, l, 2, p.out, xc); break;
    case 13: phase_ffn_in(p, l, 1, smem); break;
    case 14: phase_resid_gemm(p, l, ACT, (const u16*)(p.ws + OFF_WFFO) + (size_t)1 * 1024 * DFF, DFF, 8, 0.5f, p.out, xc, p.out, xc, smem); break;
    default: if (l == 0) convert_weights(p, 1, smem); break;
  }
}

#if MULTI_LAUNCH
__global__ void __launch_bounds__(256, 2) k_phase(Params p, int ph) {
  __shared__ __attribute__((aligned(16))) unsigned char smem[49152];
  run_phase(p, ph, smem);
}
#else
constexpr int SMEM_BYTES = 65536;
__global__ void __launch_bounds__(256, 2) k_mega(Params p) {
  __shared__ __attribute__((aligned(16))) unsigned char smem[SMEM_BYTES];
  cg::grid_group grid = cg::this_grid();
  volatile LAS unsigned* st = (volatile LAS unsigned*)(smem + SMEM_BYTES - 16);
  if (threadIdx.x == 0) { st[0] = 0u; st[1] = 0u; }
  __syncthreads();
  {
    unsigned* bw = (unsigned*)(p.ws + OFF_BAR);
    for (int i = blockIdx.x * 256 + threadIdx.x; i < XCD_BAR_WORDS; i += gridDim.x * 256) bw[i] = 0u;
  }
  grid.sync();
  XcdBarrier xb = xcd_barrier_post((unsigned*)(p.ws + OFF_BAR), st);
  run_phase(p, 0, smem);
  xcd_barrier(xb);
#pragma unroll 1
  for (int l = 0; l < 2; ++l) {
#pragma unroll 1
    for (int s = 0; s < 16 - l; ++s) {
      run_phase(p, 1 + l * 16 + s, smem);
      xcd_barrier(xb);
#ifdef PROBE_REPEAT
      if ((PROBE_REPEAT >> s) & 1) {
        run_phase(p, 1 + l * 16 + s, smem);
        xcd_barrier(xb);
      }
#endif
    }
  }
  run_phase(p, N_PHASES - 1, smem);
}
#endif

extern "C" void kernel_launch(void* const* d_in, const int* in_sizes, int n_in, void* d_out, int out_size, void* d_ws,
                              size_t ws_size, hipStream_t stream) {
  Params p{};
  const float** pp = (const float**)&p;
  for (int i = 0; i < 26; ++i) pp[i] = (const float*)d_in[i];
  p.out = (float*)d_out;
  p.ws = (unsigned char*)d_ws;
#if MULTI_LAUNCH
  for (int ph = 0; ph < N_PHASES; ++ph) {
    if (ph > 0 && ((ph - 1) % 16) == 15 && ph != N_PHASES - 1) continue;
    k_phase<<<dim3(512), dim3(256), 0, stream>>>(p, ph);
  }
#else
  static int grid_blocks = 0;
  if (!grid_blocks) {
    int dev = 0, cus = 0, per_cu = 0;
    hipGetDevice(&dev);
    hipDeviceGetAttribute(&cus, hipDeviceAttributeMultiprocessorCount, dev);
    hipOccupancyMaxActiveBlocksPerMultiprocessor(&per_cu, k_mega, 256, 0);
    if (per_cu > 2) per_cu = 2;
    grid_blocks = cus * per_cu;
  }
  void* args[] = {&p};
  hipError_t e = hipLaunchCooperativeKernel((void*)k_mega, dim3(grid_blocks), dim3(256), args, 0, stream);
  if (e != hipSuccess) fprintf(stderr, "cooperative launch failed: %s (grid %d)\n", hipGetErrorString(e), grid_blocks);
#endif
}
```

```cpp
#include <hip/hip_runtime.h>
#include <hip/hip_bf16.h>
#include <hip/hip_cooperative_groups.h>
#include <cstdio>
namespace cg = cooperative_groups;

#ifndef MULTI_LAUNCH
#define MULTI_LAUNCH 0
#endif

typedef unsigned short u16;
using bf16x8 = __attribute__((ext_vector_type(8))) short;
using bf16x4 = __attribute__((ext_vector_type(4))) short;
using f32x4 = __attribute__((ext_vector_type(4))) float;

constexpr int D = 1024;
constexpr int TLAT = 32768;
constexpr int TCTX = 1024;
constexpr int TALL = TLAT + TCTX;
constexpr int SEQ = 8192;
constexpr int CTXL = 256;
constexpr int STOT = SEQ + CTXL;
constexpr int DFF = 2816;
constexpr int PC = 3456;
constexpr int P2C = 1664;
constexpr int NMOD = 9 * D;
constexpr float LOG2E = 1.4426950408889634f;
constexpr float RMS_EPS = 1e-6f;
constexpr float GN_EPS = 64e-5f;

constexpr size_t MiB = 1ull << 20;
constexpr size_t OFF_WFFI = 0;
constexpr size_t OFF_WFFO = 22 * MiB;
constexpr size_t OFF_WIN = 33 * MiB;
constexpr size_t OFF_WOUT = OFF_WIN + 27 * MiB / 4;
constexpr size_t OFF_MOD = OFF_WOUT + 2 * MiB;
constexpr size_t OFF_BAR = OFF_MOD + 384 * 1024;
constexpr size_t OFF_QCTR = OFF_MOD + 400 * 1024;
constexpr size_t OFF_CUTAB = OFF_QCTR + 256;
constexpr size_t OFF_ROPE = OFF_MOD + MiB / 2;
constexpr size_t OFF_XC = OFF_ROPE + 5 * MiB / 2;
constexpr size_t OFF_H = OFF_XC + 4 * MiB;
constexpr size_t OFF_P2 = OFF_H + 66 * MiB;
constexpr size_t OFF_BIG = OFF_P2 + 429 * MiB / 4;
constexpr size_t SZ_Q = (size_t)TALL * 256 * 2;
constexpr size_t SZ_KV2 = (size_t)4 * 2 * STOT * 64 * 2;
constexpr size_t SZ_KV4 = (size_t)4 * 4 * STOT * 64 * 2;
constexpr size_t OFF_QA = OFF_BIG;
constexpr size_t OFF_QB = OFF_QA + SZ_Q;
constexpr size_t OFF_KA = OFF_QB + SZ_Q;
constexpr size_t OFF_VA = OFF_KA + SZ_KV2;
constexpr size_t OFF_KB = OFF_VA + SZ_KV2;
constexpr size_t OFF_VB = OFF_KB + SZ_KV2;
constexpr size_t OFF_R0 = OFF_VB + SZ_KV2;
constexpr size_t OFF_QR = OFF_R0;
constexpr size_t OFF_KR = OFF_QR + SZ_Q;
constexpr size_t OFF_VR = OFF_KR + SZ_KV4;
constexpr size_t OFF_U = OFF_VR + SZ_KV4;
constexpr size_t OFF_SP = OFF_U + (size_t)16 * 66 * 2 * 4096 * 4;
constexpr size_t OFF_PREP = OFF_R0;
constexpr size_t WS_END = OFF_PREP + (size_t)32 * STOT * 384 * 2;
constexpr int YCOL0 = 768, YCOL1 = 1408;
static_assert(WS_END <= 512 * MiB, "workspace overflow");
static_assert(OFF_SP + (size_t)16 * 66 * 2 * 4096 * 2 <= 512 * MiB, "workspace overflow");
static_assert(OFF_P2 + (size_t)TALL * DFF * 2 <= 512 * MiB, "act overflow");

struct Params {
  const float *x, *c, *ctx, *c_ctx, *w_mod, *b_mod, *norm_g, *ffn_w_in, *ffn_w_out, *w_in, *w_out, *attn_sink, *qk_g,
      *ret_g, *mu, *w0, *w2, *a0, *a2, *rho, *k_k, *k_a, *g2, *ln_g, *ln_b, *final_g;
  float* out;
  unsigned char* ws;
};

__device__ __forceinline__ int TIDX() { int t = threadIdx.x; asm volatile("" : "+v"(t)); return t & 255; }
__device__ __forceinline__ int BIDX() { int t = blockIdx.x; asm volatile("" : "+s"(t)); return t; }
typedef float f32x2_t __attribute__((ext_vector_type(2)));
typedef __bf16 bf16x2_t __attribute__((ext_vector_type(2)));
__device__ __forceinline__ unsigned pk2bf(float a, float b) {
  f32x2_t v = {a, b};
  return __builtin_bit_cast(unsigned, __builtin_convertvector(v, bf16x2_t));
}
__device__ __forceinline__ u16 f2bf(float f) { return (u16)(pk2bf(f, 0.f) & 0xffffu); }
__device__ __forceinline__ float bf2f(u16 h) { return __uint_as_float(((unsigned)h) << 16); }
__device__ __forceinline__ float sigmoidf_(float x) { return __builtin_amdgcn_rcpf(1.f + __expf(-x)); }
__device__ __forceinline__ float siluf_(float x) { return x * __builtin_amdgcn_rcpf(1.f + __expf(-x)); }
__device__ __forceinline__ float tanhf_(float x) { return 1.f - 2.f * __builtin_amdgcn_rcpf(__expf(2.f * x) + 1.f); }
template <int CTRL>
__device__ __forceinline__ float dpp_f(float x) {
  return __builtin_bit_cast(float, __builtin_amdgcn_update_dpp(0, __builtin_bit_cast(int, x), CTRL, 0xf, 0xf, true));
}
__device__ __forceinline__ float row16_sum(float x) {
  x += dpp_f<0xB1>(x);
  x += dpp_f<0x4E>(x);
  x += dpp_f<0x141>(x);
  x += dpp_f<0x140>(x);
  return x;
}
__device__ __forceinline__ float wave_sum(float x) {
  x = row16_sum(x);
  x += __builtin_bit_cast(float, __builtin_amdgcn_update_dpp(0, __builtin_bit_cast(int, x), 0x142, 0xa, 0xf, false));
  x += __builtin_bit_cast(float, __builtin_amdgcn_update_dpp(0, __builtin_bit_cast(int, x), 0x143, 0xc, 0xf, false));
  return __builtin_bit_cast(float, __builtin_amdgcn_readlane(__builtin_bit_cast(int, x), 63));
}
__device__ __forceinline__ float half8_sum(float x) {
  x += dpp_f<0xB1>(x);
  x += dpp_f<0x4E>(x);
  x += dpp_f<0x141>(x);
  return x;
}
__device__ __forceinline__ void row16_sum2(float& a, float& b) {
  a += dpp_f<0xB1>(a);  b += dpp_f<0xB1>(b);
  a += dpp_f<0x4E>(a);  b += dpp_f<0x4E>(b);
  a += dpp_f<0x141>(a); b += dpp_f<0x141>(b);
  a += dpp_f<0x140>(a); b += dpp_f<0x140>(b);
}
__device__ __forceinline__ bf16x4 pack4(float a, float b, float c, float d) {
  uint2 u = make_uint2(pk2bf(a, b), pk2bf(c, d));
  return __builtin_bit_cast(bf16x4, u);
}
__device__ __forceinline__ bf16x8 cat8(bf16x4 a, bf16x4 b) {
  bf16x8 r;
  r[0] = a[0]; r[1] = a[1]; r[2] = a[2]; r[3] = a[3]; r[4] = b[0]; r[5] = b[1]; r[6] = b[2]; r[7] = b[3];
  return r;
}
__device__ __forceinline__ const float* rrow(const float* lat, const float* cx, int r) {
  return r < TLAT ? lat + (size_t)r * D : cx + (size_t)(r - TLAT) * D;
}
__device__ __forceinline__ float* wrow(float* lat, float* cx, int r) {
  return r < TLAT ? lat + (size_t)r * D : cx + (size_t)(r - TLAT) * D;
}
__device__ __forceinline__ int mod_index(int r) { return r < TLAT ? (r >> 13) : 4; }
__device__ __forceinline__ void row_bpos(int r, int& b, int& pos) {
  if (r < TLAT) { b = r >> 13; pos = r & 8191; }
  else { int rc = r - TLAT; b = rc >> 8; pos = SEQ + (rc & 255); }
}
__device__ __forceinline__ int bpos_row(int b, int pos) {
  return pos < SEQ ? b * SEQ + pos : TLAT + b * CTXL + (pos - SEQ);
}


#define XB_TMO      128
#define XB_XCNT(j)  (256  + 64 * (j))
#define XB_XSUB(j)  (1280 + 64 * (j))
#define XB_XGEN(j)  (2304 + 64 * (j))
#define XB_TOP      3328
#define XB_TOPGEN   3392
#define XCD_BAR_WORDS 3456
#define XB_SPIN_CAP (1u << 18)
#define LAS __attribute__((address_space(3)))
__device__ __forceinline__ unsigned xb_ld(unsigned* p) { return __hip_atomic_load(p, __ATOMIC_RELAXED, __HIP_MEMORY_SCOPE_AGENT); }
__device__ __forceinline__ unsigned xb_add(unsigned* p, unsigned v) { return __hip_atomic_fetch_add(p, v, __ATOMIC_RELAXED, __HIP_MEMORY_SCOPE_AGENT); }
__device__ __forceinline__ unsigned xb_xcc_id() { return (unsigned)__builtin_amdgcn_s_getreg((3 << 11) | 20) & 0xFu; }
#define XB_SPIN(cond, bar) do { unsigned _sp = 0; while (cond) { __builtin_amdgcn_s_sleep(1); \
    if ((++_sp & 255u) == 0u) { if (xb_ld(&(bar)[XB_TMO])) break; if (_sp > XB_SPIN_CAP) { atomicAdd(&(bar)[XB_TMO], 1u); break; } } } } while (0)
struct XcdBarrier { unsigned* bar; unsigned x; volatile LAS unsigned* st; };
__device__ __forceinline__ XcdBarrier xcd_barrier_post(unsigned* bar, volatile LAS unsigned* st) {
  XcdBarrier b; b.bar = bar; b.x = xb_xcc_id(); b.st = st;
  if (threadIdx.x == 0) (void)xb_add(&bar[XB_XCNT(b.x)], 1u);
  return b;
}
__device__ __forceinline__ void xcd_barrier_complete(unsigned* bar, unsigned x, unsigned& nloc, unsigned& nx) {
  const unsigned G = gridDim.x * gridDim.y * gridDim.z;
  unsigned sum, cnt, mine, sp = 0u;
  for (;;) {
    sum = 0u; cnt = 0u; mine = 0u;
#pragma unroll
    for (unsigned j = 0; j < 16; ++j) { const unsigned c = xb_ld(&bar[XB_XCNT(j)]); sum += c; cnt += (c > 0u) ? 1u : 0u; mine = (j == x) ? c : mine; }
    if (sum == G) break;
    __builtin_amdgcn_s_sleep(1);
    if ((++sp & 255u) == 0u) { if (xb_ld(&bar[XB_TMO])) break; if (sp > XB_SPIN_CAP) { atomicAdd(&bar[XB_TMO], 1u); break; } }
  }
  nloc = mine > 0u ? mine : 1u; nx = cnt > 0u ? cnt : 1u;
}
__device__ __forceinline__ void xcd_barrier(const XcdBarrier& b) {
  asm volatile("s_waitcnt vmcnt(0)" ::: "memory");
  __syncthreads();
  if (threadIdx.x == 0) {
    unsigned* bar = b.bar;
    __builtin_amdgcn_s_waitcnt(0);
    unsigned nloc = b.st[0], nx = b.st[1];
    if (nloc == 0u) { xcd_barrier_complete(bar, b.x, nloc, nx); b.st[0] = nloc; b.st[1] = nx; }
    const unsigned old = xb_add(&bar[XB_XSUB(b.x)], 1u);
    const unsigned gen = old / nloc;
    if (old + 1u == (gen + 1u) * nloc) {
      __builtin_amdgcn_fence(__ATOMIC_RELEASE, "agent");
      asm volatile("s_waitcnt vmcnt(0)" ::: "memory");
      const unsigned og = xb_add(&bar[XB_TOP], 1u);
      const unsigned tg = og / nx;
      if (og + 1u == (tg + 1u) * nx) xb_add(&bar[XB_TOPGEN], 1u);
      else XB_SPIN(xb_ld(&bar[XB_TOPGEN]) == tg, bar);
      __builtin_amdgcn_fence(__ATOMIC_ACQUIRE, "agent");
      xb_add(&bar[XB_XGEN(b.x)], 1u);
      asm volatile("s_waitcnt vmcnt(0)" ::: "memory");
    } else {
      XB_SPIN(xb_ld(&bar[XB_XGEN(b.x)]) == gen, bar);
      __builtin_amdgcn_fence(__ATOMIC_ACQUIRE, "agent");
      asm volatile("s_waitcnt vmcnt(0)" ::: "memory");
    }
  }
  __syncthreads();
}

__device__ __forceinline__ void convert_weights(const Params& p, int layer, unsigned char* smem) {
  const int tid = TIDX();
  const int nb = gridDim.x, bid = BIDX();
  {
    float* tile = (float*)smem;
    constexpr int N_FFI = 2 * 16 * 88, N_FFO = 2 * 44 * 16, N_WIN = 16 * 54, N_WOUT = 16 * 16;
    for (int item = bid; item < N_FFI + N_FFO + N_WIN + N_WOUT; item += nb) {
      const float* src; u16* dst; int K, N, kt, nt; bool perm = false;
      int it = item;
      if (it < N_FFI) {
        int f = it / (16 * 88); it %= (16 * 88);
        K = 1024; N = 5632; kt = it / 88; nt = it % 88; perm = true;
        src = p.ffn_w_in + (size_t)(layer * 2 + f) * 1024 * 5632;
        dst = (u16*)(p.ws + OFF_WFFI) + (size_t)f * 5632 * 1024;
      } else if (it < N_FFI + N_FFO) {
        it -= N_FFI;
        int f = it / (44 * 16); it %= (44 * 16);
        K = 2816; N = 1024; kt = it / 16; nt = it % 16;
        src = p.ffn_w_out + (size_t)(layer * 2 + f) * 2816 * 1024;
        dst = (u16*)(p.ws + OFF_WFFO) + (size_t)f * 1024 * 2816;
      } else if (it < N_FFI + N_FFO + N_WIN) {
        it -= N_FFI + N_FFO;
        K = 1024; N = 3456; kt = it / 54; nt = it % 54;
        src = p.w_in + (size_t)layer * 1024 * 3456;
        dst = (u16*)(p.ws + OFF_WIN);
      } else {
        it -= N_FFI + N_FFO + N_WIN;
        K = 1024; N = 1024; kt = it / 16; nt = it % 16;
        src = p.w_out + (size_t)layer * 1024 * 1024;
        dst = (u16*)(p.ws + OFF_WOUT);
      }
      __syncthreads();
      {
        const int r = tid >> 4, c4 = tid & 15;
        int np = nt * 64 + c4 * 4;
        int scol = np;
        if (perm) {
          int blk = np >> 7, sub = (np & 127) >> 4, i = np & 15;
          scol = ((sub & 1) ? DFF : 0) + blk * 64 + (sub >> 1) * 16 + i;
        }
#pragma unroll
        for (int ps = 0; ps < 4; ++ps) {
          int k = kt * 64 + ps * 16 + r;
          float4 v = *(const float4*)(src + (size_t)k * N + scol);
          float* tp = tile + (ps * 16 + r) * 65 + c4 * 4;
          tp[0] = v.x; tp[1] = v.y; tp[2] = v.z; tp[3] = v.w;
        }
      }
      __syncthreads();
      {
        const int n = tid >> 2, kq = tid & 3;
        bf16x8 o0, o1;
#pragma unroll
        for (int i = 0; i < 8; ++i) {
          o0[i] = (short)f2bf(tile[(kq * 16 + i) * 65 + n]);
          o1[i] = (short)f2bf(tile[(kq * 16 + 8 + i) * 65 + n]);
        }
        u16* dp = dst + (size_t)(nt * 64 + n) * K + kt * 64 + kq * 16;
        *(bf16x8*)dp = o0;
        *(bf16x8*)(dp + 8) = o1;
      }
    }
    __syncthreads();
  }
}

__device__ __forceinline__ void phase_init(const Params& p, unsigned char* smem) {
  const int tid = TIDX();
  const int nb = gridDim.x, bid = BIDX();
  if (bid == 0 && tid < 2) ((int*)(p.ws + OFF_QCTR))[tid] = 0;
  if (tid == 0) {
    const int hw = __builtin_amdgcn_s_getreg((7 << 11) | (8 << 6) | 4);
    const int xcc = __builtin_amdgcn_s_getreg((3 << 11) | 20) & 0xF;
    ((int*)(p.ws + OFF_CUTAB))[bid] = (xcc << 8) | (hw & 0xFF);
  }
  {
    float2* seq = (float2*)(p.ws + OFF_ROPE);
    float2* rowt = seq + 8192 * 32;
    float2* colt = rowt + 128 * 16;
    for (int i = bid * 256 + tid; i < 8192 * 32 + 128 * 16 + 64 * 16; i += nb * 256) {
      float ang;
      float2* dst;
      if (i < 8192 * 32) {
        int t = i >> 5, k = i & 31;
        float inv = 1.0f / powf(10000.0f, (float)(2 * k) / 64.0f);
        ang = (float)t * inv;
        dst = seq + i;
      } else {
        int j = i - 8192 * 32;
        int pidx = (j < 128 * 16) ? (j >> 4) : ((j - 128 * 16) >> 4);
        int k = j & 15;
        float inv = 1.0f / powf(10000.0f, (float)(2 * k) / 32.0f);
        ang = (float)pidx * inv;
        dst = rowt + j;
      }
      *dst = make_float2(cosf(ang), sinf(ang));
    }
    (void)colt;
  }
  {
    float* sc = (float*)smem;
    float* red = sc + 5 * 1024;
    for (int item = bid; item < 288; item += nb) {
      const int l = item / 144, cb = item % 144;
      __syncthreads();
      for (int i = tid; i < 5 * 1024; i += 256) {
        int m = i >> 10, k = i & 1023;
        float v = (m < 4) ? p.c[m * 1024 + k] : p.c_ctx[k];
        sc[i] = siluf_(v);
      }
      __syncthreads();
      const int cq = tid & 15, kg = tid >> 4;
      float acc[5][4];
#pragma unroll
      for (int m = 0; m < 5; ++m)
#pragma unroll
        for (int q = 0; q < 4; ++q) acc[m][q] = 0.f;
      const float* wbase = p.w_mod + (size_t)l * 1024 * NMOD + cb * 64 + cq * 4;
      for (int kk = 0; kk < 64; ++kk) {
        int k = kg * 64 + kk;
        float4 w4 = *(const float4*)(wbase + (size_t)k * NMOD);
#pragma unroll
        for (int m = 0; m < 5; ++m) {
          float s = sc[m * 1024 + k];
          acc[m][0] += s * w4.x; acc[m][1] += s * w4.y; acc[m][2] += s * w4.z; acc[m][3] += s * w4.w;
        }
      }
#pragma unroll
      for (int m = 0; m < 5; ++m)
#pragma unroll
        for (int q = 0; q < 4; ++q) red[(kg * 5 + m) * 64 + cq * 4 + q] = acc[m][q];
      __syncthreads();
      float* modp = (float*)(p.ws + OFF_MOD);
      for (int o = tid; o < 320; o += 256) {
        int m = o >> 6, cc = o & 63;
        float s = 0.f;
        for (int g = 0; g < 16; ++g) s += red[(g * 5 + m) * 64 + cc];
        int col = cb * 64 + cc;
        modp[((size_t)l * 5 + m) * NMOD + col] = s + p.b_mod[(size_t)l * NMOD + col];
      }
    }
    __syncthreads();
  }
  convert_weights(p, 0, smem);
}

__device__ __forceinline__ void phase_norm(const Params& p, int l, int which, const float* lat, const float* cx) {
  const int lane = TIDX() & 63, wid = TIDX() >> 6;
  u16* h = (u16*)(p.ws + OFF_H);
  const float* g = p.norm_g + ((size_t)l * 3 + which) * D;
  const float* modp = (const float*)(p.ws + OFF_MOD) + (size_t)l * 5 * NMOD;
  for (int r = BIDX() * 4 + wid; r < TALL; r += gridDim.x * 4) {
    const float* xr = rrow(lat, cx, r);
    const float* mp = modp + (size_t)mod_index(r) * NMOD + which * 3 * D;
    float4 v[4];
    float ss = 0.f;
#pragma unroll
    for (int i = 0; i < 4; ++i) {
      v[i] = *(const float4*)(xr + i * 256 + lane * 4);
      ss += v[i].x * v[i].x + v[i].y * v[i].y + v[i].z * v[i].z + v[i].w * v[i].w;
    }
    ss = wave_sum(ss);
    float rstd = rsqrtf(ss * (1.f / 1024.f) + RMS_EPS);
#pragma unroll
    for (int i = 0; i < 4; ++i) {
      int col = i * 256 + lane * 4;
      float4 gg = *(const float4*)(g + col);
      float4 sh = *(const float4*)(mp + col);
      float4 scl = *(const float4*)(mp + D + col);
      bf16x4 o = pack4(v[i].x * rstd * gg.x * (1.f + scl.x) + sh.x, v[i].y * rstd * gg.y * (1.f + scl.y) + sh.y,
                       v[i].z * rstd * gg.z * (1.f + scl.z) + sh.z, v[i].w * rstd * gg.w * (1.f + scl.w) + sh.w);
      *(bf16x4*)(h + (size_t)r * D + col) = o;
    }
  }
}

__device__ __forceinline__ void phase_final_norm(const Params& p) {
  const int lane = TIDX() & 63, wid = TIDX() >> 6;
  for (int r = BIDX() * 4 + wid; r < TLAT; r += gridDim.x * 4) {
    float* xr = p.out + (size_t)r * D;
    float4 v[4];
    float ss = 0.f;
#pragma unroll
    for (int i = 0; i < 4; ++i) {
      v[i] = *(const float4*)(xr + i * 256 + lane * 4);
      ss += v[i].x * v[i].x + v[i].y * v[i].y + v[i].z * v[i].z + v[i].w * v[i].w;
    }
    ss = wave_sum(ss);
    float rstd = rsqrtf(ss * (1.f / 1024.f) + RMS_EPS);
#pragma unroll
    for (int i = 0; i < 4; ++i) {
      int col = i * 256 + lane * 4;
      float4 gg = *(const float4*)(p.final_g + col);
      float4 o = make_float4(v[i].x * rstd * gg.x, v[i].y * rstd * gg.y, v[i].z * rstd * gg.z, v[i].w * rstd * gg.w);
      *(float4*)(xr + col) = o;
    }
  }
}

template <int MI>
__device__ __forceinline__ void gemm_mainloop(const u16* __restrict__ A, const u16* __restrict__ Bt, int K, int brow,
                                              int bcol, f32x4 (&acc)[MI][4], unsigned char* smem) {
  const int tid = TIDX(), wid = tid >> 6, lane = tid & 63, wr = wid >> 1, wc = wid & 1, fr = lane & 15, fq = lane >> 4;
  constexpr int BM = MI * 32;
  constexpr int ACH = BM * 4 / 256;
  constexpr int STAGE = BM * 64 + 8192;
#pragma unroll
  for (int m = 0; m < MI; ++m)
#pragma unroll
    for (int n = 0; n < 4; ++n) acc[m][n] = f32x4{0.f, 0.f, 0.f, 0.f};
  const int nk = K / 32;
  const int prow = tid >> 2, pq = ((tid & 3) ^ ((0x78 >> (((tid >> 4) & 3) * 2)) & 3)) * 8;
  const u16* ga = A + (size_t)(brow + prow) * K + pq;
  const u16* gb = Bt + (size_t)(bcol + prow) * K + pq;
  auto stage = [&](int t, int buf) {
    unsigned char* base = smem + buf * STAGE;
#pragma unroll
    for (int i = 0; i < ACH; ++i)
      __builtin_amdgcn_global_load_lds((const unsigned*)(ga + (size_t)i * 64 * K + t * 32),
                                       (__attribute__((address_space(3))) unsigned*)(base + (tid + i * 256) * 16), 16, 0, 0);
#pragma unroll
    for (int i = 0; i < 2; ++i)
      __builtin_amdgcn_global_load_lds((const unsigned*)(gb + (size_t)i * 64 * K + t * 32),
                                       (__attribute__((address_space(3))) unsigned*)(base + BM * 64 + (tid + i * 256) * 16), 16, 0, 0);
  };
  const int swz = (fq ^ ((0x78 >> (((fr >> 2) & 3) * 2)) & 3)) * 16;
  __syncthreads();
  stage(0, 0);
  for (int t = 0; t < nk; ++t) {
    __syncthreads();
    if (t + 1 < nk) stage(t + 1, (t + 1) & 1);
    const unsigned char* base = smem + (t & 1) * STAGE;
    bf16x8 af[MI], bfr[4];
#pragma unroll
    for (int m = 0; m < MI; ++m) af[m] = *(const bf16x8*)(base + (wr * MI * 16 + m * 16 + fr) * 64 + swz);
#pragma unroll
    for (int n = 0; n < 4; ++n) bfr[n] = *(const bf16x8*)(base + BM * 64 + (wc * 64 + n * 16 + fr) * 64 + swz);
#pragma unroll
    for (int m = 0; m < MI; ++m)
#pragma unroll
      for (int n = 0; n < 4; ++n) acc[m][n] = __builtin_amdgcn_mfma_f32_16x16x32_bf16(af[m], bfr[n], acc[m][n], 0, 0, 0);
  }
}

__device__ __forceinline__ bool next_tile(int it, int MT, int NT, int& tm, int& tn) {
  const int G = gridDim.x, b = BIDX();
  const int total = MT * NT;
  int id;
  if ((G & 7) == 0) {
    const int per = G >> 3;
    id = it * G + (b & 7) * per + (b >> 3);
  } else {
    id = b + it * G;
  }
  if (id >= total) return false;
  constexpr int GM = 8;
  const int gsz = GM * NT;
  const int g = id / gsz, rem = id - g * gsz;
  const int rows = (MT - g * GM) < GM ? (MT - g * GM) : GM;
  tn = rem / rows;
  tm = g * GM + (rem - tn * rows);
  return true;
}

__device__ __forceinline__ void phase_ffn_in(const Params& p, int l, int f, unsigned char* smem) {
  const u16* A = (const u16*)(p.ws + OFF_H);
  const u16* Bt = (const u16*)(p.ws + OFF_WFFI) + (size_t)f * 5632 * 1024;
  u16* act = (u16*)(p.ws + OFF_P2);
  const int tid = TIDX(), wid = tid >> 6, lane = tid & 63, wr = wid >> 1, wc = wid & 1, fr = lane & 15, fq = lane >> 4;
  constexpr int MI = 8, NT = 44, MT = TALL / (MI * 32);
  for (int it = 0;; ++it) {
    int tm, tn;
    if (!next_tile(it, MT, NT, tm, tn)) break;
    f32x4 acc[MI][4];
    gemm_mainloop<MI>(A, Bt, 1024, tm * MI * 32, tn * 128, acc, smem);
#pragma unroll
    for (int m = 0; m < MI; ++m)
#pragma unroll
      for (int q = 0; q < 2; ++q)
#pragma unroll
        for (int j = 0; j < 4; ++j) {
          int row = tm * MI * 32 + wr * MI * 16 + m * 16 + fq * 4 + j;
          int col = tn * 64 + wc * 32 + q * 16 + fr;
          float u1 = acc[m][2 * q][j], u2 = acc[m][2 * q + 1][j];
          act[(size_t)row * DFF + col] = f2bf(siluf_(u1) * u2);
        }
  }
}

__device__ __forceinline__ void phase_resid_gemm(const Params& p, int l, const u16* A, const u16* Bt, int K, int gate, float gscale,
                                 const float* lat_in, const float* cx_in, float* lat_out, float* cx_out,
                                 unsigned char* smem) {
  const int tid = TIDX(), wid = tid >> 6, lane = tid & 63, wr = wid >> 1, wc = wid & 1, fr = lane & 15, fq = lane >> 4;
  constexpr int MI = 6, NT = 8, MT = TALL / (MI * 32);
  const float* modp = (const float*)(p.ws + OFF_MOD) + (size_t)l * 5 * NMOD + gate * D;
  for (int it = 0;; ++it) {
    int tm, tn;
    if (!next_tile(it, MT, NT, tm, tn)) break;
    f32x4 acc[MI][4];
    gemm_mainloop<MI>(A, Bt, K, tm * MI * 32, tn * 128, acc, smem);
#pragma unroll
    for (int m = 0; m < MI; ++m)
#pragma unroll
      for (int j = 0; j < 4; ++j) {
        int row = tm * MI * 32 + wr * MI * 16 + m * 16 + fq * 4 + j;
        const float* mp = modp + (size_t)mod_index(row) * NMOD;
        const float* xi = rrow(lat_in, cx_in, row);
        float* xo = wrow(lat_out, cx_out, row);
#pragma unroll
        for (int n = 0; n < 4; ++n) {
          int col = tn * 128 + wc * 64 + n * 16 + fr;
          xo[col] = xi[col] + gscale * mp[col] * acc[m][n][j];
        }
      }
  }
}

__device__ __forceinline__ void phase_inproj(const Params& p, int l, unsigned char* smem) {
  const u16* A = (const u16*)(p.ws + OFF_H);
  const u16* Bt = (const u16*)(p.ws + OFF_WIN);
  const int tid = TIDX(), wid = tid >> 6, lane = tid & 63, wr = wid >> 1, wc = wid & 1, fr = lane & 15, fq = lane >> 4;
  constexpr int MI = 8, NT = 27, MT = TALL / (MI * 32);
  const float2* ropeseq = (const float2*)(p.ws + OFF_ROPE);
  const float2* roperow = ropeseq + 8192 * 32;
  const float2* ropecol = roperow + 128 * 16;
  u16* QA = (u16*)(p.ws + OFF_QA); u16* QB = (u16*)(p.ws + OFF_QB); u16* QR = (u16*)(p.ws + OFF_QR);
  u16* KA = (u16*)(p.ws + OFF_KA); u16* VA = (u16*)(p.ws + OFF_VA);
  u16* KB = (u16*)(p.ws + OFF_KB); u16* VB = (u16*)(p.ws + OFF_VB);
  u16* KR = (u16*)(p.ws + OFF_KR); u16* VR = (u16*)(p.ws + OFF_VR);
  u16* P2 = (u16*)(p.ws + OFF_P2);
  for (int it = 0;; ++it) {
    int tm, tn;
    if (!next_tile(it, MT, NT, tm, tn)) break;
    f32x4 acc[MI][4];
    gemm_mainloop<MI>(A, Bt, 1024, tm * MI * 32, tn * 128, acc, smem);
    const int r0 = tm * MI * 32 + wr * MI * 16;
    const int c0 = tn * 128 + wc * 64;
    const bool latent = r0 < TLAT;
    if (c0 >= 1792) {
#pragma unroll
      for (int m = 0; m < MI; ++m)
#pragma unroll
        for (int n = 0; n < 4; ++n)
#pragma unroll
          for (int j = 0; j < 4; ++j) {
            int row = r0 + m * 16 + fq * 4 + j;
            P2[(size_t)row * P2C + (c0 - 1792) + n * 16 + fr] = f2bf(acc[m][n][j]);
          }
      continue;
    }
    int kind;
    int ropek;
    int normk;
    float scale = 1.f;
    u16* dst; int hh, nh;
    if (c0 < 256) { kind = 0; ropek = 1; normk = -1; scale = 0.125f * LOG2E; dst = QA; hh = c0 >> 6; nh = 4; }
    else if (c0 < 384) { kind = 1; ropek = 1; normk = -1; dst = KA; hh = (c0 - 256) >> 6; nh = 2; }
    else if (c0 < 512) { kind = 2; ropek = 0; normk = -1; dst = VA; hh = (c0 - 384) >> 6; nh = 2; }
    else if (c0 < 768) { kind = 0; ropek = 1; normk = 0; scale = 0.125f * LOG2E; dst = QB; hh = (c0 - 512) >> 6; nh = 4; }
    else if (c0 < 896) { kind = 1; ropek = 1; normk = 1; dst = KB; hh = (c0 - 768) >> 6; nh = 2; }
    else if (c0 < 1024) { kind = 2; ropek = 0; normk = -1; dst = VB; hh = (c0 - 896) >> 6; nh = 2; }
    else if (c0 < 1280) { kind = 0; ropek = 2; normk = -1; dst = QR; hh = (c0 - 1024) >> 6; nh = 4; }
    else if (c0 < 1536) { kind = 1; ropek = 2; normk = -1; scale = 0.125f; dst = KR; hh = (c0 - 1280) >> 6; nh = 4; }
    else { kind = 2; ropek = 0; normk = -1; dst = VR; hh = (c0 - 1536) >> 6; nh = 4; }
    if (!latent) ropek = 0;
    if (kind == 2) {
#pragma unroll
      for (int m = 0; m < MI; ++m) {
        int b, pos;
        row_bpos(r0 + m * 16 + fq * 4, b, pos);
#pragma unroll
        for (int n = 0; n < 4; ++n) {
          int d = n * 16 + fr;
          bf16x4 o = pack4(acc[m][n][0], acc[m][n][1], acc[m][n][2], acc[m][n][3]);
          *(bf16x4*)(dst + ((size_t)(b * nh + hh) * 64 + d) * STOT + pos) = o;
        }
      }
      continue;
    }
    float gq[4] = {1.f, 1.f, 1.f, 1.f};
    if (normk >= 0) {
#pragma unroll
      for (int n = 0; n < 4; ++n) gq[n] = p.qk_g[((size_t)l * 2 + normk) * 64 + n * 16 + fr];
    }
#pragma unroll
    for (int m = 0; m < MI; ++m)
#pragma unroll
      for (int j = 0; j < 4; ++j) {
        int row = r0 + m * 16 + fq * 4 + j;
        float v0 = acc[m][0][j], v1 = acc[m][1][j], v2 = acc[m][2][j], v3 = acc[m][3][j];
        if (normk >= 0) {
          float ss = v0 * v0 + v1 * v1 + v2 * v2 + v3 * v3;
          ss += __shfl_xor(ss, 1); ss += __shfl_xor(ss, 2); ss += __shfl_xor(ss, 4); ss += __shfl_xor(ss, 8);
          float rstd = rsqrtf(ss * (1.f / 64.f) + RMS_EPS);
          v0 *= rstd * gq[0]; v1 *= rstd * gq[1]; v2 *= rstd * gq[2]; v3 *= rstd * gq[3];
        }
        int b, pos;
        row_bpos(row, b, pos);
        if (ropek == 1) {
          float2 cr = roperow[(pos >> 6) * 16 + fr];
          float2 cc = ropecol[(pos & 63) * 16 + fr];
          float o0 = v0 * cr.x - v1 * cr.y, o1 = v1 * cr.x + v0 * cr.y;
          float o2 = v2 * cc.x - v3 * cc.y, o3 = v3 * cc.x + v2 * cc.y;
          v0 = o0; v1 = o1; v2 = o2; v3 = o3;
        } else if (ropek == 2) {
          float2 ca = ropeseq[pos * 32 + fr];
          float2 cb = ropeseq[pos * 32 + 16 + fr];
          float o0 = v0 * ca.x - v2 * ca.y, o2 = v2 * ca.x + v0 * ca.y;
          float o1 = v1 * cb.x - v3 * cb.y, o3 = v3 * cb.x + v1 * cb.y;
          v0 = o0; v1 = o1; v2 = o2; v3 = o3;
        }
        v0 *= scale; v1 *= scale; v2 *= scale; v3 *= scale;
        u16* dp;
        if (kind == 0) dp = dst + (size_t)row * 256 + hh * 64 + fr;
        else dp = dst + ((size_t)(b * nh + hh) * STOT + pos) * 64 + fr;
        dp[0] = f2bf(v0); dp[16] = f2bf(v1); dp[32] = f2bf(v2); dp[48] = f2bf(v3);
      }
  }
}

__device__ __forceinline__ void attn_item(const u16* __restrict__ Q, const u16* __restrict__ Kb, const u16* __restrict__ Vt,
                          u16* __restrict__ concat, int ccol0, int b, int kvh, int qrow0, int qpos0, int t0, int t1,
                          int c0, int c1, bool masked, const float* sink, unsigned char* smem) {
  const int tid = TIDX(), w = tid >> 6, lane = tid & 63, fr = lane & 15, fq = lane >> 4;
  const int head = kvh * 2 + (w & 1);
  const int qoff = (w >> 1) * 32;
  bf16x8 qf[2][2];
#pragma unroll
  for (int qg = 0; qg < 2; ++qg)
#pragma unroll
    for (int ks = 0; ks < 2; ++ks)
      qf[qg][ks] = *(const bf16x8*)(Q + (size_t)(qrow0 + qoff + qg * 16 + fr) * 256 + head * 64 + ks * 32 + fq * 8);
  f32x4 O[2][4];
  float mrow[2], lrow[2];
#pragma unroll
  for (int qg = 0; qg < 2; ++qg) {
    mrow[qg] = -1e30f; lrow[qg] = 0.f;
#pragma unroll
    for (int dt = 0; dt < 4; ++dt) O[qg][dt] = f32x4{0.f, 0.f, 0.f, 0.f};
  }
  const u16* Kbase = Kb + (size_t)(b * 2 + kvh) * STOT * 64;
  const u16* Vbase = Vt + (size_t)(b * 2 + kvh) * 64 * STOT;
  const int n1 = t1 - t0, total = n1 + (c1 - c0);
  bf16x8 kreg[2], vreg[2];
  auto gload = [&](int i) {
    int tile = i < n1 ? t0 + i : c0 + (i - n1);
#pragma unroll
    for (int ps = 0; ps < 2; ++ps) {
      int idx = tid + ps * 256;
      kreg[ps] = *(const bf16x8*)(Kbase + (size_t)tile * 4096 + idx * 8);
      int d = idx >> 3, ch = idx & 7;
      vreg[ps] = *(const bf16x8*)(Vbase + (size_t)d * STOT + tile * 64 + ch * 8);
    }
  };
  auto lstore = [&](int buf) {
    u16* Ks = (u16*)(smem + buf * 18432);
    u16* Vs = Ks + 64 * 72;
#pragma unroll
    for (int ps = 0; ps < 2; ++ps) {
      int idx = tid + ps * 256;
      int r = idx >> 3, ch = idx & 7;
      *(bf16x8*)(Ks + r * 72 + ch * 8) = kreg[ps];
      *(bf16x8*)(Vs + r * 72 + ch * 8) = vreg[ps];
    }
  };
  __syncthreads();
  gload(0);
  lstore(0);
  __syncthreads();
#pragma unroll 1
  for (int i = 0; i < total; ++i) {
    const int tile = i < n1 ? t0 + i : c0 + (i - n1);
    if (i + 1 < total) gload(i + 1);
    const u16* Ks = (const u16*)(smem + (i & 1) * 18432);
    const u16* Vs = Ks + 64 * 72;
    f32x4 s[2][4];
#pragma unroll
    for (int qg = 0; qg < 2; ++qg)
#pragma unroll
      for (int sub = 0; sub < 4; ++sub) s[qg][sub] = f32x4{0.f, 0.f, 0.f, 0.f};
#pragma unroll
    for (int sub = 0; sub < 4; ++sub)
#pragma unroll
      for (int ks = 0; ks < 2; ++ks) {
        bf16x8 a = *(const bf16x8*)(Ks + (sub * 16 + fr) * 72 + ks * 32 + fq * 8);
#pragma unroll
        for (int qg = 0; qg < 2; ++qg) s[qg][sub] = __builtin_amdgcn_mfma_f32_16x16x32_bf16(a, qf[qg][ks], s[qg][sub], 0, 0, 0);
      }
    __builtin_amdgcn_sched_barrier(0);
    const bool domask = masked && (tile < 128);
    bf16x8 pb[2][2];
#pragma unroll
    for (int qg = 0; qg < 2; ++qg) {
      if (domask) {
        int qpos = qpos0 + qoff + qg * 16 + fr;
#pragma unroll
        for (int sub = 0; sub < 4; ++sub)
#pragma unroll
          for (int j = 0; j < 4; ++j) {
            int kpos = tile * 64 + sub * 16 + fq * 4 + j;
            int dd = kpos - qpos;
            if (dd > 128 || dd < -128) s[qg][sub][j] = -INFINITY;
          }
      }
      float mx = -INFINITY;
#pragma unroll
      for (int sub = 0; sub < 4; ++sub)
#pragma unroll
        for (int j = 0; j < 4; ++j) mx = fmaxf(mx, s[qg][sub][j]);
      mx = fmaxf(mx, __shfl_xor(mx, 16));
      mx = fmaxf(mx, __shfl_xor(mx, 32));
      float mnew = fmaxf(mrow[qg], mx);
      const bool changed = mnew > mrow[qg];
      float alpha = __builtin_amdgcn_exp2f(mrow[qg] - mnew);
      mrow[qg] = mnew;
      float ps = 0.f;
#pragma unroll
      for (int sub = 0; sub < 4; ++sub)
#pragma unroll
        for (int j = 0; j < 4; ++j) {
          float pv = __builtin_amdgcn_exp2f(s[qg][sub][j] - mnew);
          s[qg][sub][j] = pv;
          ps += pv;
        }
      lrow[qg] = lrow[qg] * alpha + ps;
      if (__builtin_amdgcn_ballot_w64(changed) != 0ull) {
#pragma unroll
        for (int dt = 0; dt < 4; ++dt) O[qg][dt] *= alpha;
      }
#pragma unroll
      for (int ks = 0; ks < 2; ++ks)
        pb[qg][ks] = cat8(pack4(s[qg][2 * ks][0], s[qg][2 * ks][1], s[qg][2 * ks][2], s[qg][2 * ks][3]),
                          pack4(s[qg][2 * ks + 1][0], s[qg][2 * ks + 1][1], s[qg][2 * ks + 1][2], s[qg][2 * ks + 1][3]));
      __builtin_amdgcn_sched_barrier(0);
    }
#pragma unroll
    for (int dt = 0; dt < 4; ++dt)
#pragma unroll
      for (int ks = 0; ks < 2; ++ks) {
        const u16* vp = Vs + (dt * 16 + fr) * 72 + ks * 32 + fq * 4;
        bf16x8 va = cat8(*(const bf16x4*)vp, *(const bf16x4*)(vp + 16));
#pragma unroll
        for (int qg = 0; qg < 2; ++qg) O[qg][dt] = __builtin_amdgcn_mfma_f32_16x16x32_bf16(va, pb[qg][ks], O[qg][dt], 0, 0, 0);
      }
    __builtin_amdgcn_sched_barrier(0);
    if (i + 1 < total) lstore((i + 1) & 1);
    __syncthreads();
  }
#pragma unroll
  for (int qg = 0; qg < 2; ++qg) {
    float lt = lrow[qg];
    lt += __shfl_xor(lt, 16);
    lt += __shfl_xor(lt, 32);
    if (sink) lt += __builtin_amdgcn_exp2f(sink[head] * LOG2E - mrow[qg]);
    float inv = 1.f / lt;
    int row = qrow0 + qoff + qg * 16 + fr;
#pragma unroll
    for (int dt = 0; dt < 4; ++dt) {
      bf16x4 o = pack4(O[qg][dt][0] * inv, O[qg][dt][1] * inv, O[qg][dt][2] * inv, O[qg][dt][3] * inv);
      *(bf16x4*)(concat + (size_t)row * D + ccol0 + head * 64 + dt * 16 + fq * 4) = o;
    }
  }
}

__device__ __forceinline__ float ret_lg(int h) {
  return log2f(1.0f - exp2f(-5.0f - (float)h));
}

__device__ __forceinline__ void retU_item(const Params& p, int bh, int c, unsigned char* smem) {
  const int tid = TIDX();
  const int b = bh >> 2, h = bh & 3;
  const u16* KR = (const u16*)(p.ws + OFF_KR) + (size_t)bh * STOT * 64;
  const u16* VR = (const u16*)(p.ws + OFF_VR) + (size_t)bh * 64 * STOT;
  (void)b;
  const int pos0 = c < 64 ? c * 128 : SEQ + (c - 64) * 128;
  u16* Kc = (u16*)smem;
  u16* Vj = Kc + 128 * 64;
  __syncthreads();
#pragma unroll
  for (int ps = 0; ps < 4; ++ps) {
    int idx = tid + ps * 256;
    *(bf16x8*)(Kc + idx * 8) = *(const bf16x8*)(KR + (size_t)pos0 * 64 + idx * 8);
    int d = idx >> 4, ch = idx & 15;
    bf16x8 v = *(const bf16x8*)(VR + (size_t)d * STOT + pos0 + ch * 8);
#pragma unroll
    for (int e = 0; e < 8; ++e) Vj[(ch * 8 + e) * 72 + d] = (u16)v[e];
  }
  __syncthreads();
  const int dk = tid >> 2, dv0 = (tid & 3) * 16;
  const float lg = ret_lg(h);
  float af[16], ab[16];
#pragma unroll
  for (int q = 0; q < 16; ++q) { af[q] = 0.f; ab[q] = 0.f; }
  for (int j = 0; j < 128; ++j) {
    float kf = bf2f(Kc[j * 64 + dk]);
    float kfw = kf * exp2f(lg * (float)(127 - j));
    float kbw = kf * exp2f(lg * (float)j);
    bf16x8 v0 = *(const bf16x8*)(Vj + j * 72 + dv0);
    bf16x8 v1 = *(const bf16x8*)(Vj + j * 72 + dv0 + 8);
#pragma unroll
    for (int q = 0; q < 8; ++q) {
      float a = bf2f((u16)v0[q]), bb = bf2f((u16)v1[q]);
      af[q] += kfw * a; ab[q] += kbw * a;
      af[8 + q] += kfw * bb; ab[8 + q] += kbw * bb;
    }
  }
  float* U = (float*)(p.ws + OFF_U) + ((size_t)bh * 66 + c) * 2 * 4096;
#pragma unroll
  for (int q = 0; q < 16; ++q) {
    U[(dv0 + q) * 64 + dk] = af[q];
    U[4096 + (dv0 + q) * 64 + dk] = ab[q];
  }
}

__device__ __forceinline__ void phase_retU(const Params& p, unsigned char* smem) {
  for (int item = BIDX(); item < 16 * 66; item += gridDim.x) retU_item(p, item / 66, item % 66, smem);
}

__device__ __forceinline__ void attn_worker(const Params& p, int l, unsigned char* smem) {
  const u16* QA = (const u16*)(p.ws + OFF_QA); const u16* QB = (const u16*)(p.ws + OFF_QB);
  const u16* KA = (const u16*)(p.ws + OFF_KA); const u16* VA = (const u16*)(p.ws + OFF_VA);
  const u16* KB = (const u16*)(p.ws + OFF_KB); const u16* VB = (const u16*)(p.ws + OFF_VB);
  u16* concat = (u16*)(p.ws + OFF_H);
  const float* sink = p.attn_sink + l * 4;
  int* qctr = (int*)(p.ws + OFF_QCTR) + l;
  volatile int* slot = (volatile int*)(smem + 65536 - 32);
  for (;;) {
    __syncthreads();
    if (TIDX() == 0) *slot = atomicAdd(qctr, 1);
    __syncthreads();
    const int item = *slot;
    if (item >= 2112) break;
    const bool isB = item < 1024 || (item >= 2048 && item < 2080);
    const bool isctx = item >= 2048;
    int ii = item < 1024 ? item : item < 2048 ? item - 1024 : item < 2080 ? item - 2048 : item - 2080;
    int qt, kvh, b, qrow0, qpos0, t0, t1;
    if (!isctx) {
      qt = ii & 127; kvh = (ii >> 7) & 1; b = ii >> 8;
      qrow0 = b * SEQ + qt * 64; qpos0 = qt * 64;
      if (isB) { t0 = 0; t1 = 128; }
      else { t0 = qt - 2 < 0 ? 0 : qt - 2; t1 = qt + 3 > 128 ? 128 : qt + 3; }
    } else {
      qt = ii & 3; kvh = (ii >> 2) & 1; b = ii >> 3;
      qrow0 = TLAT + b * CTXL + qt * 64; qpos0 = 0; t0 = 0; t1 = 0;
    }
    attn_item(isB ? QB : QA, isB ? KB : KA, isB ? VB : VA, concat, isB ? 256 : 0, b, kvh, qrow0, qpos0, t0, t1, 128, 132,
              (!isB) && (!isctx), isB ? nullptr : sink, smem);
  }
}

__device__ __forceinline__ void phase_retscan(const Params& p) {
  const float* U = (const float*)(p.ws + OFF_U);
  u16* SP = (u16*)(p.ws + OFF_SP);
  for (int gid = BIDX() * 256 + TIDX(); gid < 16 * 2 * 4096; gid += gridDim.x * 256) {
    int e = gid & 4095, dir = (gid >> 12) & 1, bh = gid >> 13;
    float g128 = exp2f(128.f * ret_lg(bh & 3));
    float S = 0.f;
#pragma unroll 1
    for (int n0 = 0; n0 < 66; n0 += 11) {
      float u[11];
      size_t offs[11];
#pragma unroll
      for (int k = 0; k < 11; ++k) {
        int n = n0 + k;
        int c = dir == 0 ? (n < 2 ? 64 + n : n - 2) : 65 - n;
        offs[k] = (((size_t)bh * 66 + c) * 2 + dir) * 4096 + e;
        u[k] = U[offs[k]];
      }
#pragma unroll
      for (int k = 0; k < 11; ++k) {
        SP[offs[k]] = f2bf(S);
        S = g128 * S + u[k];
      }
    }
  }
}

__device__ __forceinline__ void retout_item(const Params& p, int l, int bh, int c, unsigned char* smem) {
  const int tid = TIDX(), w = tid >> 6, lane = tid & 63, fr = lane & 15, fq = lane >> 4;
  const int b = bh >> 2, h = bh & 3;
  const u16* QR = (const u16*)(p.ws + OFF_QR);
  const u16* KR = (const u16*)(p.ws + OFF_KR) + (size_t)bh * STOT * 64;
  const u16* VR = (const u16*)(p.ws + OFF_VR) + (size_t)bh * 64 * STOT;
  const u16* SP = (const u16*)(p.ws + OFF_SP) + ((size_t)bh * 66 + c) * 2 * 4096;
  const u16* P2 = (const u16*)(p.ws + OFF_P2);
  u16* concat = (u16*)(p.ws + OFF_H);
  const int pos0 = c < 64 ? c * 128 : SEQ + (c - 64) * 128;
  const int row0 = bpos_row(b, pos0);
  u16* Kc = (u16*)smem;
  u16* Vs = Kc + 128 * 72;
  __syncthreads();
#pragma unroll
  for (int ps = 0; ps < 4; ++ps) {
    int idx = tid + ps * 256;
    int r = idx >> 3, ch = idx & 7;
    *(bf16x8*)(Kc + r * 72 + ch * 8) = *(const bf16x8*)(KR + (size_t)(pos0 + r) * 64 + ch * 8);
    int d = idx >> 4, c16 = idx & 15;
    *(bf16x8*)(Vs + d * 136 + c16 * 8) = *(const bf16x8*)(VR + (size_t)d * STOT + pos0 + c16 * 8);
  }
  __syncthreads();
  const float lg = ret_lg(h);
#pragma unroll 1
  for (int qg = 0; qg < 2; ++qg) {
    const int i = w * 32 + qg * 16 + fr;
    const int row = row0 + i;
    bf16x8 qf[2];
#pragma unroll
    for (int ks = 0; ks < 2; ++ks) qf[ks] = *(const bf16x8*)(QR + (size_t)row * 256 + h * 64 + ks * 32 + fq * 8);
    f32x4 s[8];
#pragma unroll
    for (int sub = 0; sub < 8; ++sub) {
      s[sub] = f32x4{0.f, 0.f, 0.f, 0.f};
#pragma unroll
      for (int ks = 0; ks < 2; ++ks) {
        bf16x8 a = *(const bf16x8*)(Kc + (sub * 16 + fr) * 72 + ks * 32 + fq * 8);
        s[sub] = __builtin_amdgcn_mfma_f32_16x16x32_bf16(a, qf[ks], s[sub], 0, 0, 0);
      }
    }
    float res[4][4];
#pragma unroll
    for (int dt = 0; dt < 4; ++dt)
#pragma unroll
      for (int j = 0; j < 4; ++j) res[dt][j] = 0.f;
#pragma unroll 1
    for (int dir = 0; dir < 2; ++dir) {
      f32x4 O[4];
      const float qw = dir == 0 ? __builtin_amdgcn_exp2f(lg * (float)(i + 1)) : __builtin_amdgcn_exp2f(lg * (float)(128 - i));
#pragma unroll
      for (int dt = 0; dt < 4; ++dt) {
        O[dt] = f32x4{0.f, 0.f, 0.f, 0.f};
#pragma unroll
        for (int ks = 0; ks < 2; ++ks) {
          bf16x8 a = *(const bf16x8*)(SP + dir * 4096 + (dt * 16 + fr) * 64 + ks * 32 + fq * 8);
          O[dt] = __builtin_amdgcn_mfma_f32_16x16x32_bf16(a, qf[ks], O[dt], 0, 0, 0);
        }
        O[dt] *= qw;
      }
      int fqo = fq;
      asm volatile("" : "+v"(fqo));
#pragma unroll
      for (int ks = 0; ks < 4; ++ks) {
        float pv[8];
#pragma unroll
        for (int e = 0; e < 8; ++e) {
          const int sub = 2 * ks + (e >> 2), j = e & 3;
          const int jk = sub * 16 + fqo * 4 + j;
          const int dd = dir == 0 ? i - jk : jk - i;
          pv[e] = dd >= 0 ? s[sub][j] * __builtin_amdgcn_exp2f(lg * (float)dd) : 0.f;
        }
        bf16x8 pb = cat8(pack4(pv[0], pv[1], pv[2], pv[3]), pack4(pv[4], pv[5], pv[6], pv[7]));
#pragma unroll
        for (int dt = 0; dt < 4; ++dt) {
          const u16* vp = Vs + (dt * 16 + fr) * 136 + ks * 32 + fq * 4;
          bf16x8 va = cat8(*(const bf16x4*)vp, *(const bf16x4*)(vp + 16));
          O[dt] = __builtin_amdgcn_mfma_f32_16x16x32_bf16(va, pb, O[dt], 0, 0, 0);
        }
      }
      float sm = 0.f;
#pragma unroll
      for (int dt = 0; dt < 4; ++dt)
#pragma unroll
        for (int j = 0; j < 4; ++j) sm += O[dt][j];
      sm += __shfl_xor(sm, 16); sm += __shfl_xor(sm, 32);
      const float mu = sm * (1.f / 64.f);
      float vs = 0.f;
#pragma unroll
      for (int dt = 0; dt < 4; ++dt)
#pragma unroll
        for (int j = 0; j < 4; ++j) { float dlt = O[dt][j] - mu; vs += dlt * dlt; }
      vs += __shfl_xor(vs, 16); vs += __shfl_xor(vs, 32);
      const float rstd = rsqrtf(vs * (1.f / 64.f) + GN_EPS);
#pragma unroll
      for (int dt = 0; dt < 4; ++dt) {
        const int d = dt * 16 + fq * 4;
        bf16x4 gt = *(const bf16x4*)(P2 + (size_t)row * P2C + dir * 256 + h * 64 + d);
        float4 rg = *(const float4*)(p.ret_g + (size_t)l * 256 + h * 64 + d);
        res[dt][0] += (O[dt][0] - mu) * rstd * rg.x * siluf_(bf2f((u16)gt[0]));
        res[dt][1] += (O[dt][1] - mu) * rstd * rg.y * siluf_(bf2f((u16)gt[1]));
        res[dt][2] += (O[dt][2] - mu) * rstd * rg.z * siluf_(bf2f((u16)gt[2]));
        res[dt][3] += (O[dt][3] - mu) * rstd * rg.w * siluf_(bf2f((u16)gt[3]));
      }
    }
#pragma unroll
    for (int dt = 0; dt < 4; ++dt)
      *(bf16x4*)(concat + (size_t)row * D + 512 + h * 64 + dt * 16 + fq * 4) = pack4(res[dt][0], res[dt][1], res[dt][2], res[dt][3]);
  }
}

__device__ __forceinline__ void phase_retout(const Params& p, int l, unsigned char* smem) {
  for (int item = BIDX(); item < 16 * 66; item += gridDim.x) retout_item(p, l, item / 66, item % 66, smem);
}

__device__ __forceinline__ void phase_wprep(const Params& p, int l, unsigned char* smem) {
  const int tid = TIDX(), col = tid;
  const u16* P2 = (const u16*)(p.ws + OFF_P2);
  u16* prep = (u16*)(p.ws + OFF_PREP);
  float* twT = (float*)smem;
  float* amT = twT + 64 * 16;
  float* outW = amT + 64 * 16;
  float* outA = outW + 16 * 256;
  const int j = tid & 31, tsub = tid >> 5, head = j >> 3, c8 = (j & 7) * 8, ch0 = head * 64 + c8;
  float kkv[8], kav[8];
#pragma unroll
  for (int e = 0; e < 8; ++e) { kkv[e] = p.k_k[(size_t)l * 256 + ch0 + e]; kav[e] = p.k_a[(size_t)l * 256 + ch0 + e]; }
  for (int item = BIDX(); item < (TALL / 16) * 2; item += gridDim.x) {
    const int dir = item & 1, row0 = (item >> 1) * 16;
    const float* mu = p.mu + ((size_t)l * 2 + dir) * 896;
    __syncthreads();
    {
      const int tok = tid >> 4, e0 = (tid & 15) * 4;
      const int row = row0 + tok;
      int b, pos;
      row_bpos(row, b, pos);
      bool has;
      int nrow;
      if (dir == 0) { has = (pos != 0) && (pos != SEQ); nrow = row - 1; }
      else { has = (pos != SEQ - 1) && (pos != STOT - 1); nrow = row + 1; }
      const int srow = has ? nrow : row;
      bf16x4 zw = *(const bf16x4*)(P2 + (size_t)row * P2C + 1408 + dir * 64 + e0);
      bf16x4 za = *(const bf16x4*)(P2 + (size_t)row * P2C + 1536 + dir * 64 + e0);
      bf16x4 sw = *(const bf16x4*)(P2 + (size_t)srow * P2C + 1408 + dir * 64 + e0);
      bf16x4 sa = *(const bf16x4*)(P2 + (size_t)srow * P2C + 1536 + dir * 64 + e0);
#pragma unroll
      for (int e = 0; e < 4; ++e) {
        float z = bf2f((u16)zw[e]), zs = has ? bf2f((u16)sw[e]) : 0.f;
        twT[(e0 + e) * 16 + tok] = tanhf_(z + mu[768 + e0 + e] * (zs - z));
        float z2 = bf2f((u16)za[e]), zs2 = has ? bf2f((u16)sa[e]) : 0.f;
        amT[(e0 + e) * 16 + tok] = z2 + mu[832 + e0 + e] * (zs2 - z2);
      }
    }
    __syncthreads();
    {
      float accw[16], acca[16];
#pragma unroll
      for (int t = 0; t < 16; ++t) { accw[t] = 0.f; acca[t] = 0.f; }
      const float* w2 = p.w2 + ((size_t)l * 2 + dir) * 64 * 256 + col;
      const float* a2 = p.a2 + ((size_t)l * 2 + dir) * 64 * 256 + col;
      for (int kq = 0; kq < 64; ++kq) {
        float wv = w2[kq * 256], av = a2[kq * 256];
#pragma unroll
        for (int t4 = 0; t4 < 4; ++t4) {
          float4 a = *(const float4*)(twT + kq * 16 + t4 * 4);
          float4 bq = *(const float4*)(amT + kq * 16 + t4 * 4);
          accw[t4 * 4 + 0] += a.x * wv; accw[t4 * 4 + 1] += a.y * wv; accw[t4 * 4 + 2] += a.z * wv; accw[t4 * 4 + 3] += a.w * wv;
          acca[t4 * 4 + 0] += bq.x * av; acca[t4 * 4 + 1] += bq.y * av; acca[t4 * 4 + 2] += bq.z * av; acca[t4 * 4 + 3] += bq.w * av;
        }
      }
      const float w0v = p.w0[((size_t)l * 2 + dir) * 256 + col], a0v = p.a0[((size_t)l * 2 + dir) * 256 + col];
#pragma unroll
      for (int t = 0; t < 16; ++t) {
        outW[t * 256 + col] = -0.6065306597126334f * sigmoidf_(w0v + accw[t]) * LOG2E;
        outA[t * 256 + col] = sigmoidf_(a0v + acca[t]);
      }
    }
    __syncthreads();
    {
      float mur[8], muk[8], muv[8];
#pragma unroll
      for (int e = 0; e < 8; ++e) { mur[e] = mu[ch0 + e]; muk[e] = mu[256 + ch0 + e]; muv[e] = mu[512 + ch0 + e]; }
#pragma unroll
      for (int pass = 0; pass < 2; ++pass) {
        const int tok = pass * 8 + tsub, row = row0 + tok;
        int b, pos;
        row_bpos(row, b, pos);
        bool has;
        int nrow;
        if (dir == 0) { has = (pos != 0) && (pos != SEQ); nrow = row - 1; }
        else { has = (pos != SEQ - 1) && (pos != STOT - 1); nrow = row + 1; }
        const u16* cp = P2 + (size_t)row * P2C + 512 + ch0;
        const u16* np = P2 + (size_t)(has ? nrow : row) * P2C + 512 + ch0;
        const bf16x8 zr8 = *(const bf16x8*)cp, zk8 = *(const bf16x8*)(cp + 256), zv8 = *(const bf16x8*)(cp + 512);
        const bf16x8 sr8 = *(const bf16x8*)np, sk8 = *(const bf16x8*)(np + 256), sv8 = *(const bf16x8*)(np + 512);
        const float4 lw0 = *(const float4*)(outW + tok * 256 + ch0), lw1 = *(const float4*)(outW + tok * 256 + ch0 + 4);
        const float4 av0 = *(const float4*)(outA + tok * 256 + ch0), av1 = *(const float4*)(outA + tok * 256 + ch0 + 4);
        const float lw[8] = {lw0.x, lw0.y, lw0.z, lw0.w, lw1.x, lw1.y, lw1.z, lw1.w};
        const float av[8] = {av0.x, av0.y, av0.z, av0.w, av1.x, av1.y, av1.z, av1.w};
        float r[8], k[8], v[8], kkr[8], ss = 0.f;
#pragma unroll
        for (int e = 0; e < 8; ++e) {
          float zr = bf2f((u16)zr8[e]), zk = bf2f((u16)zk8[e]), zv = bf2f((u16)zv8[e]);
          float sr = has ? bf2f((u16)sr8[e]) : 0.f, sk = has ? bf2f((u16)sk8[e]) : 0.f, sv = has ? bf2f((u16)sv8[e]) : 0.f;
          r[e] = zr + mur[e] * (sr - zr); k[e] = zk + muk[e] * (sk - zk); v[e] = zv + muv[e] * (sv - zv);
          kkr[e] = k[e] * kkv[e];
          ss += kkr[e] * kkr[e];
        }
        ss = half8_sum(ss);
        const float rs = rsqrtf(fmaxf(ss, 1e-24f));
        float kt[8], kk[8], bb[8];
#pragma unroll
        for (int e = 0; e < 8; ++e) {
          kk[e] = kkr[e] * rs;
          kt[e] = k[e] * (1.f + (av[e] - 1.f) * kav[e]);
          bb[e] = kk[e] * av[e];
        }
        u16* dp = prep + (((size_t)(b * 4 + head) * 2 + dir) * STOT + pos) * 384 + c8;
        *(bf16x8*)(dp) = cat8(pack4(lw[0], lw[1], lw[2], lw[3]), pack4(lw[4], lw[5], lw[6], lw[7]));
        *(bf16x8*)(dp + 64) = cat8(pack4(kt[0], kt[1], kt[2], kt[3]), pack4(kt[4], kt[5], kt[6], kt[7]));
        *(bf16x8*)(dp + 128) = cat8(pack4(kk[0], kk[1], kk[2], kk[3]), pack4(kk[4], kk[5], kk[6], kk[7]));
        *(bf16x8*)(dp + 192) = cat8(pack4(bb[0], bb[1], bb[2], bb[3]), pack4(bb[4], bb[5], bb[6], bb[7]));
        *(bf16x8*)(dp + 256) = cat8(pack4(r[0], r[1], r[2], r[3]), pack4(r[4], r[5], r[6], r[7]));
        *(bf16x8*)(dp + 320) = cat8(pack4(v[0], v[1], v[2], v[3]), pack4(v[4], v[5], v[6], v[7]));
      }
    }
  }
}

typedef float f32x2 __attribute__((ext_vector_type(2)));
__device__ __forceinline__ void wscan_item(const Params& p, int item, unsigned char* smem) {
  const int tid = TIDX(), w = tid >> 6, lane = tid & 63;
  const int jl4 = (lane & 15) * 4, rsub = lane >> 4;
  const u16* prep = (const u16*)(p.ws + OFF_PREP);
  u16* P2w = (u16*)(p.ws + OFF_P2);
  float* bufs = (float*)smem;
  {
    const int rq = item & 3, seq = item >> 2;
    const int dir = seq & 1, h = (seq >> 1) & 3, b = seq >> 3;
    const int irow = rq * 16 + w * 4 + rsub;
    const u16* base = prep + (size_t)seq * STOT * 384;
    uint4 lreg[3];
    auto gload = [&](int ch) {
#pragma unroll
      for (int ps = 0; ps < 3; ++ps) {
        int q = tid + ps * 256;
        int sidx = q / 48, within = q % 48;
        int n = ch * 16 + sidx;
        int pos = dir == 0 ? (n < CTXL ? SEQ + n : n - CTXL) : (STOT - 1 - n);
        lreg[ps] = *(const uint4*)(base + (size_t)pos * 384 + within * 8);
      }
    };
    auto lstore = [&](int buf) {
#pragma unroll
      for (int ps = 0; ps < 3; ++ps) {
        int q = tid + ps * 256;
        int sidx = q / 48, within = q % 48;
        float* dp = bufs + buf * 6144 + sidx * 384 + within * 8;
        uint4 u = lreg[ps];
        float4 lo = make_float4(__uint_as_float(u.x << 16), __uint_as_float(u.x & 0xffff0000u), __uint_as_float(u.y << 16), __uint_as_float(u.y & 0xffff0000u));
        float4 hi = make_float4(__uint_as_float(u.z << 16), __uint_as_float(u.z & 0xffff0000u), __uint_as_float(u.w << 16), __uint_as_float(u.w & 0xffff0000u));
        if (within < 8) {
          lo.x = __builtin_amdgcn_exp2f(lo.x); lo.y = __builtin_amdgcn_exp2f(lo.y); lo.z = __builtin_amdgcn_exp2f(lo.z); lo.w = __builtin_amdgcn_exp2f(lo.w);
          hi.x = __builtin_amdgcn_exp2f(hi.x); hi.y = __builtin_amdgcn_exp2f(hi.y); hi.z = __builtin_amdgcn_exp2f(hi.z); hi.w = __builtin_amdgcn_exp2f(hi.w);
        }
        *(float4*)dp = lo;
        *(float4*)(dp + 4) = hi;
      }
    };
    f32x2 S01 = {0.f, 0.f}, S23 = {0.f, 0.f};
    __syncthreads();
    gload(0);
    lstore(0);
    __syncthreads();
    constexpr int NCH = STOT / 16;
    for (int ch = 0; ch < NCH; ++ch) {
      if (ch + 1 < NCH) gload(ch + 1);
      const float* bp = bufs + (ch & 1) * 6144;
      const int n0 = ch * 16;
      const int pos0 = dir == 0 ? (n0 < CTXL ? SEQ + n0 : n0 - CTXL) : (STOT - 1 - n0);
      u16* yp = P2w + (size_t)bpos_row(b, pos0) * P2C + (dir == 0 ? YCOL0 : YCOL1) + h * 64 + irow;
      const int ystride = dir == 0 ? P2C : -P2C;
      float4 Wq[3], Kq[3], Nq[3], Bq[3], Rq[3];
      float Vq[3];
#define SCAN_LD(slot, st)                                        \
      do {                                                         \
        const float* sp_ = bp + (st) * 384;                        \
        Wq[slot] = *(const float4*)(sp_ + jl4);                    \
        Kq[slot] = *(const float4*)(sp_ + 64 + jl4);               \
        Nq[slot] = *(const float4*)(sp_ + 128 + jl4);              \
        Bq[slot] = *(const float4*)(sp_ + 192 + jl4);              \
        Rq[slot] = *(const float4*)(sp_ + 256 + jl4);              \
        Vq[slot] = sp_[320 + irow];                                \
      } while (0)
      SCAN_LD(0, 0);
      SCAN_LD(1, 1);
      SCAN_LD(2, 2);
      float ypart = 0.f;
#pragma unroll
      for (int s = 0; s < 16; ++s) {
        const int sl = s % 3;
        const float4 wv = Wq[sl], kt = Kq[sl], kk = Nq[sl], bb = Bq[sl], rr = Rq[sl];
        const float v = Vq[sl];
        if (s + 3 < 16) SCAN_LD(sl, s + 3);
        const f32x2 vv = {v, v};
        f32x2 A01 = S01 * f32x2{wv.x, wv.y} + vv * f32x2{kt.x, kt.y};
        f32x2 A23 = S23 * f32x2{wv.z, wv.w} + vv * f32x2{kt.z, kt.w};
        f32x2 pp = S01 * f32x2{kk.x, kk.y} + S23 * f32x2{kk.z, kk.w};
        float sa = pp.x + pp.y;
        float yprev = ypart;
        row16_sum2(sa, yprev);
        if (s > 0) { if ((lane & 15) == 0) yp[(s - 1) * ystride] = f2bf(yprev); }
        const f32x2 nsa = {-sa, -sa};
        S01 = nsa * f32x2{bb.x, bb.y} + A01;
        S23 = nsa * f32x2{bb.z, bb.w} + A23;
        f32x2 yy = S01 * f32x2{rr.x, rr.y} + S23 * f32x2{rr.z, rr.w};
        ypart = yy.x + yy.y;
      }
      {
        float ylast = row16_sum(ypart);
        if ((lane & 15) == 0) yp[15 * ystride] = f2bf(ylast);
      }
#undef SCAN_LD
      if (ch + 1 < NCH) lstore((ch + 1) & 1);
      __syncthreads();
    }
  }
}

__device__ __forceinline__ void phase_scan_attn(const Params& p, int l, unsigned char* smem) {
  const int G = gridDim.x, tid = TIDX(), bid = BIDX();
  if (G > 128 && G <= 2048) {
    int* keys = (int*)smem;
    int* red = keys + 2048;
    const int* cutab = (const int*)(p.ws + OFF_CUTAB);
    __syncthreads();
    for (int i = tid; i < G; i += 256) keys[i] = cutab[i];
    if (tid == 0) { red[0] = 0; red[1] = 0; }
    __syncthreads();
    for (int i = 128 + tid; i < G; i += 256) {
      const int ki = keys[i];
      bool m = false;
      for (int j = 0; j < 128; ++j) m = m || (keys[j] == ki);
      if (!m) atomicAdd(&red[0], 1);
      if (m && i == bid) red[1] = 1;
    }
    __syncthreads();
    const int eligible = red[0], mine = red[1];
    __syncthreads();
    if (bid < 128) {
      __builtin_amdgcn_s_setprio(3);
      wscan_item(p, bid, smem);
      __builtin_amdgcn_s_setprio(0);
    } else if (eligible < 64 || !mine) {
      attn_worker(p, l, smem);
    }
  } else {
    for (int item = bid; item < 128; item += G) wscan_item(p, item, smem);
    attn_worker(p, l, smem);
  }
}

__device__ __forceinline__ void phase_wfin(const Params& p, int l, unsigned char* smem) {
  const int tid = TIDX(), col = tid;
  const u16* P2 = (const u16*)(p.ws + OFF_P2);
  const u16* prep = (const u16*)(p.ws + OFF_PREP);
  u16* concat = (u16*)(p.ws + OFF_H);
  float* sgT = (float*)smem;
  float* gateL = sgT + 128 * 16;
  const float* g2 = p.g2 + (size_t)l * 128 * 256 + col;
  const int j = tid & 31, tsub = tid >> 5, head = j >> 3, c8 = (j & 7) * 8, ch0 = head * 64 + c8;
  float lng[8], lnb[8], rho[2][8];
#pragma unroll
  for (int e = 0; e < 8; ++e) {
    lng[e] = p.ln_g[(size_t)l * 256 + ch0 + e];
    lnb[e] = p.ln_b[(size_t)l * 256 + ch0 + e];
    rho[0][e] = p.rho[((size_t)l * 2 + 0) * 256 + ch0 + e];
    rho[1][e] = p.rho[((size_t)l * 2 + 1) * 256 + ch0 + e];
  }
  for (int item = BIDX(); item < TALL / 16; item += gridDim.x) {
    const int row0 = item * 16;
    __syncthreads();
    {
      const int tok = tid >> 4, k0 = (tid & 15) * 8;
      bf16x8 g = *(const bf16x8*)(P2 + (size_t)(row0 + tok) * P2C + 1280 + k0);
#pragma unroll
      for (int e = 0; e < 8; ++e) sgT[(k0 + e) * 16 + tok] = sigmoidf_(bf2f((u16)g[e]));
    }
    __syncthreads();
    float acc[16];
#pragma unroll
    for (int t = 0; t < 16; ++t) acc[t] = 0.f;
    for (int k = 0; k < 128; ++k) {
      float gv = g2[k * 256];
#pragma unroll
      for (int t4 = 0; t4 < 4; ++t4) {
        float4 a = *(const float4*)(sgT + k * 16 + t4 * 4);
        acc[t4 * 4 + 0] += a.x * gv; acc[t4 * 4 + 1] += a.y * gv; acc[t4 * 4 + 2] += a.z * gv; acc[t4 * 4 + 3] += a.w * gv;
      }
    }
#pragma unroll
    for (int t = 0; t < 16; ++t) gateL[t * 256 + col] = acc[t];
    __syncthreads();
#pragma unroll
    for (int pass = 0; pass < 2; ++pass) {
      const int tok = pass * 8 + tsub, row = row0 + tok;
      int b, pos;
      row_bpos(row, b, pos);
      float tot[8];
#pragma unroll
      for (int e = 0; e < 8; ++e) tot[e] = 0.f;
#pragma unroll
      for (int dir = 0; dir < 2; ++dir) {
        const bf16x8 y8 = *(const bf16x8*)(P2 + (size_t)row * P2C + (dir == 0 ? YCOL0 : YCOL1) + ch0);
        const u16* pp = prep + (((size_t)(b * 4 + head) * 2 + dir) * STOT + pos) * 384 + c8;
        const bf16x8 kt8 = *(const bf16x8*)(pp + 64), r8 = *(const bf16x8*)(pp + 256), v8 = *(const bf16x8*)(pp + 320);
        float y[8], s1 = 0.f, s3 = 0.f;
#pragma unroll
        for (int e = 0; e < 8; ++e) {
          y[e] = bf2f((u16)y8[e]);
          s1 += y[e];
          s3 += bf2f((u16)r8[e]) * bf2f((u16)kt8[e]) * rho[dir][e];
        }
        s1 = half8_sum(s1);
        s3 = half8_sum(s3);
        const float mu = s1 * (1.f / 64.f);
        float s2 = 0.f;
#pragma unroll
        for (int e = 0; e < 8; ++e) { y[e] -= mu; s2 += y[e] * y[e]; }
        s2 = half8_sum(s2);
        const float rstd = rsqrtf(s2 * (1.f / 64.f) + GN_EPS);
#pragma unroll
        for (int e = 0; e < 8; ++e) tot[e] += y[e] * rstd * lng[e] + lnb[e] + s3 * bf2f((u16)v8[e]);
      }
      const float4 g0 = *(const float4*)(gateL + tok * 256 + ch0), g1 = *(const float4*)(gateL + tok * 256 + ch0 + 4);
      bf16x8 o = cat8(pack4(tot[0] * g0.x, tot[1] * g0.y, tot[2] * g0.z, tot[3] * g0.w),
                      pack4(tot[4] * g1.x, tot[5] * g1.y, tot[6] * g1.z, tot[7] * g1.w));
      *(bf16x8*)(concat + (size_t)row * D + 768 + ch0) = o;
    }
  }
}

constexpr int N_PHASES = 1 + 2 * 16 + 1;
__device__ __forceinline__ void run_phase(const Params& p, int ph, unsigned char* smem) {
  if (ph == 0) { phase_init(p, smem); return; }
  if (ph == N_PHASES - 1) { phase_final_norm(p); return; }
  const int l = (ph - 1) / 16, s = (ph - 1) % 16;
  float* xc = (float*)(p.ws + OFF_XC);
  const float* lat_in = (l == 0 && s < 3) ? p.x : p.out;
  const float* cx_in = (l == 0 && s < 3) ? p.ctx : xc;
  const u16* H = (const u16*)(p.ws + OFF_H);
  const u16* ACT = (const u16*)(p.ws + OFF_P2);
  switch (s) {
    case 0: phase_norm(p, l, 0, lat_in, cx_in); break;
    case 1: phase_ffn_in(p, l, 0, smem); break;
    case 2: phase_resid_gemm(p, l, ACT, (const u16*)(p.ws + OFF_WFFO) + (size_t)0 * 1024 * DFF, DFF, 2, 0.5f, lat_in, cx_in, p.out, xc, smem); break;
    case 3: phase_norm(p, l, 1, p.out, xc); break;
    case 4: phase_inproj(p, l, smem); break;
    case 5: phase_retU(p, smem); break;
    case 6: phase_retscan(p); break;
    case 7: phase_retout(p, l, smem); break;
    case 8: phase_wprep(p, l, smem); break;
    case 9: phase_scan_attn(p, l, smem); break;
    case 10: phase_wfin(p, l, smem); break;
    case 11: phase_resid_gemm(p, l, H, (const u16*)(p.ws + OFF_WOUT), 1024, 5, 1.0f, p.out, xc, p.out, xc, smem); break;
    case 12: phase_norm(p, l, 2, p.out, xc); break;
    case 13: phase_ffn_in(p, l, 1, smem); break;
    case 14: phase_resid_gemm(p, l, ACT, (const u16*)(p.ws + OFF_WFFO) + (size_t)1 * 1024 * DFF, DFF, 8, 0.5f, p.out, xc, p.out, xc, smem); break;
    default: if (l == 0) convert_weights(p, 1, smem); break;
  }
}

#if MULTI_LAUNCH
__global__ void __launch_bounds__(256, 2) k_phase(Params p, int ph) {
  __shared__ __attribute__((aligned(16))) unsigned char smem[49152];
  run_phase(p, ph, smem);
}
#else
constexpr int SMEM_BYTES = 65536;
__global__ void __launch_bounds__(256, 2) k_mega(Params p) {
  __shared__ __attribute__((aligned(16))) unsigned char smem[SMEM_BYTES];
  cg::grid_group grid = cg::this_grid();
  volatile LAS unsigned* st = (volatile LAS unsigned*)(smem + SMEM_BYTES - 16);
  if (threadIdx.x == 0) { st[0] = 0u; st[1] = 0u; }
  __syncthreads();
  {
    unsigned* bw = (unsigned*)(p.ws + OFF_BAR);
    for (int i = blockIdx.x * 256 + threadIdx.x; i < XCD_BAR_WORDS; i += gridDim.x * 256) bw[i] = 0u;
  }
  grid.sync();
  XcdBarrier xb = xcd_barrier_post((unsigned*)(p.ws + OFF_BAR), st);
  run_phase(p, 0, smem);
  xcd_barrier(xb);
#pragma unroll 1
  for (int l = 0; l < 2; ++l) {
#pragma unroll 1
    for (int s = 0; s < 16 - l; ++s) {
      run_phase(p, 1 + l * 16 + s, smem);
      xcd_barrier(xb);
#ifdef PROBE_REPEAT
      if ((PROBE_REPEAT >> s) & 1) {
        run_phase(p, 1 + l * 16 + s, smem);
        xcd_barrier(xb);
      }
#endif
    }
  }
  run_phase(p, N_PHASES - 1, smem);
}
#endif

extern "C" void kernel_launch(void* const* d_in, const int* in_sizes, int n_in, void* d_out, int out_size, void* d_ws,
                              size_t ws_size, hipStream_t stream) {
  Params p{};
  const float** pp = (const float**)&p;
  for (int i = 0; i < 26; ++i) pp[i] = (const float*)d_in[i];
  p.out = (float*)d_out;
  p.ws = (unsigned char*)d_ws;
#if MULTI_LAUNCH
  for (int ph = 0; ph < N_PHASES; ++ph) {
    if (ph > 0 && ((ph - 1) % 16) == 15 && ph != N_PHASES - 1) continue;
    k_phase<<<dim3(512), dim3(256), 0, stream>>>(p, ph);
  }
#else
  static int grid_blocks = 0;
  if (!grid_blocks) {
    int dev = 0, cus = 0, per_cu = 0;
    hipGetDevice(&dev);
    hipDeviceGetAttribute(&cus, hipDeviceAttributeMultiprocessorCount, dev);
    hipOccupancyMaxActiveBlocksPerMultiprocessor(&per_cu, k_mega, 256, 0);
    if (per_cu > 2) per_cu = 2;
    grid_blocks = cus * per_cu;
  }
  void* args[] = {&p};
  hipError_t e = hipLaunchCooperativeKernel((void*)k_mega, dim3(grid_blocks), dim3(256), args, 0, stream);
  if (e != hipSuccess) fprintf(stderr, "cooperative launch failed: %s (grid %d)\n", hipGetErrorString(e), grid_blocks);
#endif
}
```

```cpp
#include <hip/hip_runtime.h>
#include <hip/hip_bf16.h>
#include <hip/hip_cooperative_groups.h>
#include <cstdio>
namespace cg = cooperative_groups;

#ifndef MULTI_LAUNCH
#define MULTI_LAUNCH 0
#endif

typedef unsigned short u16;
using bf16x8 = __attribute__((ext_vector_type(8))) short;
using bf16x4 = __attribute__((ext_vector_type(4))) short;
using f32x4 = __attribute__((ext_vector_type(4))) float;

constexpr int D = 1024;
constexpr int TLAT = 32768;
constexpr int TCTX = 1024;
constexpr int TALL = TLAT + TCTX;
constexpr int SEQ = 8192;
constexpr int CTXL = 256;
constexpr int STOT = SEQ + CTXL;
constexpr int DFF = 2816;
constexpr int PC = 3456;
constexpr int P2C = 1664;
constexpr int NMOD = 9 * D;
constexpr float LOG2E = 1.4426950408889634f;
constexpr float RMS_EPS = 1e-6f;
constexpr float GN_EPS = 64e-5f;

constexpr size_t MiB = 1ull << 20;
constexpr size_t OFF_WFFI = 0;
constexpr size_t OFF_WFFO = 22 * MiB;
constexpr size_t OFF_WIN = 33 * MiB;
constexpr size_t OFF_WOUT = OFF_WIN + 27 * MiB / 4;
constexpr size_t OFF_MOD = OFF_WOUT + 2 * MiB;
constexpr size_t OFF_BAR = OFF_MOD + 384 * 1024;
constexpr size_t OFF_QCTR = OFF_MOD + 400 * 1024;
constexpr size_t OFF_CUTAB = OFF_QCTR + 256;
constexpr size_t OFF_ROPE = OFF_MOD + MiB / 2;
constexpr size_t OFF_XC = OFF_ROPE + 5 * MiB / 2;
constexpr size_t OFF_H = OFF_XC + 4 * MiB;
constexpr size_t OFF_P2 = OFF_H + 66 * MiB;
constexpr size_t OFF_BIG = OFF_P2 + 429 * MiB / 4;
constexpr size_t SZ_Q = (size_t)TALL * 256 * 2;
constexpr size_t SZ_KV2 = (size_t)4 * 2 * STOT * 64 * 2;
constexpr size_t SZ_KV4 = (size_t)4 * 4 * STOT * 64 * 2;
constexpr size_t OFF_QA = OFF_BIG;
constexpr size_t OFF_QB = OFF_QA + SZ_Q;
constexpr size_t OFF_KA = OFF_QB + SZ_Q;
constexpr size_t OFF_VA = OFF_KA + SZ_KV2;
constexpr size_t OFF_KB = OFF_VA + SZ_KV2;
constexpr size_t OFF_VB = OFF_KB + SZ_KV2;
constexpr size_t OFF_R0 = OFF_VB + SZ_KV2;
constexpr size_t OFF_QR = OFF_R0;
constexpr size_t OFF_KR = OFF_QR + SZ_Q;
constexpr size_t OFF_VR = OFF_KR + SZ_KV4;
constexpr size_t OFF_U = OFF_VR + SZ_KV4;
constexpr size_t OFF_SP = OFF_U + (size_t)16 * 66 * 2 * 4096 * 4;
constexpr size_t OFF_PREP = OFF_R0;
constexpr size_t WS_END = OFF_PREP + (size_t)32 * STOT * 384 * 2;
constexpr int YCOL0 = 768, YCOL1 = 1408;
static_assert(WS_END <= 512 * MiB, "workspace overflow");
static_assert(OFF_SP + (size_t)16 * 66 * 2 * 4096 * 2 <= 512 * MiB, "workspace overflow");
static_assert(OFF_P2 + (size_t)TALL * DFF * 2 <= 512 * MiB, "act overflow");

struct Params {
  const float *x, *c, *ctx, *c_ctx, *w_mod, *b_mod, *norm_g, *ffn_w_in, *ffn_w_out, *w_in, *w_out, *attn_sink, *qk_g,
      *ret_g, *mu, *w0, *w2, *a0, *a2, *rho, *k_k, *k_a, *g2, *ln_g, *ln_b, *final_g;
  float* out;
  unsigned char* ws;
};

__device__ __forceinline__ int TIDX() { int t = threadIdx.x; asm volatile("" : "+v"(t)); return t & 255; }
__device__ __forceinline__ int BIDX() { int t = blockIdx.x; asm volatile("" : "+s"(t)); return t; }
typedef float f32x2_t __attribute__((ext_vector_type(2)));
typedef __bf16 bf16x2_t __attribute__((ext_vector_type(2)));
__device__ __forceinline__ unsigned pk2bf(float a, float b) {
  f32x2_t v = {a, b};
  return __builtin_bit_cast(unsigned, __builtin_convertvector(v, bf16x2_t));
}
__device__ __forceinline__ u16 f2bf(float f) { return (u16)(pk2bf(f, 0.f) & 0xffffu); }
__device__ __forceinline__ float bf2f(u16 h) { return __uint_as_float(((unsigned)h) << 16); }
__device__ __forceinline__ float sigmoidf_(float x) { return __builtin_amdgcn_rcpf(1.f + __expf(-x)); }
__device__ __forceinline__ float siluf_(float x) { return x * __builtin_amdgcn_rcpf(1.f + __expf(-x)); }
__device__ __forceinline__ float tanhf_(float x) { return 1.f - 2.f * __builtin_amdgcn_rcpf(__expf(2.f * x) + 1.f); }
template <int CTRL>
__device__ __forceinline__ float dpp_f(float x) {
  return __builtin_bit_cast(float, __builtin_amdgcn_update_dpp(0, __builtin_bit_cast(int, x), CTRL, 0xf, 0xf, true));
}
__device__ __forceinline__ float row16_sum(float x) {
  x += dpp_f<0xB1>(x);
  x += dpp_f<0x4E>(x);
  x += dpp_f<0x141>(x);
  x += dpp_f<0x140>(x);
  return x;
}
__device__ __forceinline__ float wave_sum(float x) {
  x = row16_sum(x);
  x += __builtin_bit_cast(float, __builtin_amdgcn_update_dpp(0, __builtin_bit_cast(int, x), 0x142, 0xa, 0xf, false));
  x += __builtin_bit_cast(float, __builtin_amdgcn_update_dpp(0, __builtin_bit_cast(int, x), 0x143, 0xc, 0xf, false));
  return __builtin_bit_cast(float, __builtin_amdgcn_readlane(__builtin_bit_cast(int, x), 63));
}
__device__ __forceinline__ float half8_sum(float x) {
  x += dpp_f<0xB1>(x);
  x += dpp_f<0x4E>(x);
  x += dpp_f<0x141>(x);
  return x;
}
__device__ __forceinline__ void row16_sum2(float& a, float& b) {
  a += dpp_f<0xB1>(a);  b += dpp_f<0xB1>(b);
  a += dpp_f<0x4E>(a);  b += dpp_f<0x4E>(b);
  a += dpp_f<0x141>(a); b += dpp_f<0x141>(b);
  a += dpp_f<0x140>(a); b += dpp_f<0x140>(b);
}
__device__ __forceinline__ bf16x4 pack4(float a, float b, float c, float d) {
  uint2 u = make_uint2(pk2bf(a, b), pk2bf(c, d));
  return __builtin_bit_cast(bf16x4, u);
}
__device__ __forceinline__ bf16x8 cat8(bf16x4 a, bf16x4 b) {
  bf16x8 r;
  r[0] = a[0]; r[1] = a[1]; r[2] = a[2]; r[3] = a[3]; r[4] = b[0]; r[5] = b[1]; r[6] = b[2]; r[7] = b[3];
  return r;
}
__device__ __forceinline__ const float* rrow(const float* lat, const float* cx, int r) {
  return r < TLAT ? lat + (size_t)r * D : cx + (size_t)(r - TLAT) * D;
}
__device__ __forceinline__ float* wrow(float* lat, float* cx, int r) {
  return r < TLAT ? lat + (size_t)r * D : cx + (size_t)(r - TLAT) * D;
}
__device__ __forceinline__ int mod_index(int r) { return r < TLAT ? (r >> 13) : 4; }
__device__ __forceinline__ void row_bpos(int r, int& b, int& pos) {
  if (r < TLAT) { b = r >> 13; pos = r & 8191; }
  else { int rc = r - TLAT; b = rc >> 8; pos = SEQ + (rc & 255); }
}
__device__ __forceinline__ int bpos_row(int b, int pos) {
  return pos < SEQ ? b * SEQ + pos : TLAT + b * CTXL + (pos - SEQ);
}


#define XB_TMO      128
#define XB_XCNT(j)  (256  + 64 * (j))
#define XB_XSUB(j)  (1280 + 64 * (j))
#define XB_XGEN(j)  (2304 + 64 * (j))
#define XB_TOP      3328
#define XB_TOPGEN   3392
#define XCD_BAR_WORDS 3456
#define XB_SPIN_CAP (1u << 18)
#define LAS __attribute__((address_space(3)))
__device__ __forceinline__ unsigned xb_ld(unsigned* p) { return __hip_atomic_load(p, __ATOMIC_RELAXED, __HIP_MEMORY_SCOPE_AGENT); }
__device__ __forceinline__ unsigned xb_add(unsigned* p, unsigned v) { return __hip_atomic_fetch_add(p, v, __ATOMIC_RELAXED, __HIP_MEMORY_SCOPE_AGENT); }
__device__ __forceinline__ unsigned xb_xcc_id() { return (unsigned)__builtin_amdgcn_s_getreg((3 << 11) | 20) & 0xFu; }
#define XB_SPIN(cond, bar) do { unsigned _sp = 0; while (cond) { __builtin_amdgcn_s_sleep(1); \
    if ((++_sp & 255u) == 0u) { if (xb_ld(&(bar)[XB_TMO])) break; if (_sp > XB_SPIN_CAP) { atomicAdd(&(bar)[XB_TMO], 1u); break; } } } } while (0)
struct XcdBarrier { unsigned* bar; unsigned x; volatile LAS unsigned* st; };
__device__ __forceinline__ XcdBarrier xcd_barrier_post(unsigned* bar, volatile LAS unsigned* st) {
  XcdBarrier b; b.bar = bar; b.x = xb_xcc_id(); b.st = st;
  if (threadIdx.x == 0) (void)xb_add(&bar[XB_XCNT(b.x)], 1u);
  return b;
}
__device__ __forceinline__ void xcd_barrier_complete(unsigned* bar, unsigned x, unsigned& nloc, unsigned& nx) {
  const unsigned G = gridDim.x * gridDim.y * gridDim.z;
  unsigned sum, cnt, mine, sp = 0u;
  for (;;) {
    sum = 0u; cnt = 0u; mine = 0u;
#pragma unroll
    for (unsigned j = 0; j < 16; ++j) { const unsigned c = xb_ld(&bar[XB_XCNT(j)]); sum += c; cnt += (c > 0u) ? 1u : 0u; mine = (j == x) ? c : mine; }
    if (sum == G) break;
    __builtin_amdgcn_s_sleep(1);
    if ((++sp & 255u) == 0u) { if (xb_ld(&bar[XB_TMO])) break; if (sp > XB_SPIN_CAP) { atomicAdd(&bar[XB_TMO], 1u); break; } }
  }
  nloc = mine > 0u ? mine : 1u; nx = cnt > 0u ? cnt : 1u;
}
__device__ __forceinline__ void xcd_barrier(const XcdBarrier& b) {
  asm volatile("s_waitcnt vmcnt(0)" ::: "memory");
  __syncthreads();
  if (threadIdx.x == 0) {
    unsigned* bar = b.bar;
    __builtin_amdgcn_s_waitcnt(0);
    unsigned nloc = b.st[0], nx = b.st[1];
    if (nloc == 0u) { xcd_barrier_complete(bar, b.x, nloc, nx); b.st[0] = nloc; b.st[1] = nx; }
    const unsigned old = xb_add(&bar[XB_XSUB(b.x)], 1u);
    const unsigned gen = old / nloc;
    if (old + 1u == (gen + 1u) * nloc) {
      __builtin_amdgcn_fence(__ATOMIC_RELEASE, "agent");
      asm volatile("s_waitcnt vmcnt(0)" ::: "memory");
      const unsigned og = xb_add(&bar[XB_TOP], 1u);
      const unsigned tg = og / nx;
      if (og + 1u == (tg + 1u) * nx) xb_add(&bar[XB_TOPGEN], 1u);
      else XB_SPIN(xb_ld(&bar[XB_TOPGEN]) == tg, bar);
      __builtin_amdgcn_fence(__ATOMIC_ACQUIRE, "agent");
      xb_add(&bar[XB_XGEN(b.x)], 1u);
      asm volatile("s_waitcnt vmcnt(0)" ::: "memory");
    } else {
      XB_SPIN(xb_ld(&bar[XB_XGEN(b.x)]) == gen, bar);
      __builtin_amdgcn_fence(__ATOMIC_ACQUIRE, "agent");
      asm volatile("s_waitcnt vmcnt(0)" ::: "memory");
    }
  }
  __syncthreads();
}

__device__ __forceinline__ void convert_weights(const Params& p, int layer, unsigned char* smem) {
  const int tid = TIDX();
  const int nb = gridDim.x, bid = BIDX();
  {
    float* tile = (float*)smem;
    constexpr int N_FFI = 2 * 16 * 88, N_FFO = 2 * 44 * 16, N_WIN = 16 * 54, N_WOUT = 16 * 16;
    for (int item = bid; item < N_FFI + N_FFO + N_WIN + N_WOUT; item += nb) {
      const float* src; u16* dst; int K, N, kt, nt; bool perm = false;
      int it = item;
      if (it < N_FFI) {
        int f = it / (16 * 88); it %= (16 * 88);
        K = 1024; N = 5632; kt = it / 88; nt = it % 88; perm = true;
        src = p.ffn_w_in + (size_t)(layer * 2 + f) * 1024 * 5632;
        dst = (u16*)(p.ws + OFF_WFFI) + (size_t)f * 5632 * 1024;
      } else if (it < N_FFI + N_FFO) {
        it -= N_FFI;
        int f = it / (44 * 16); it %= (44 * 16);
        K = 2816; N = 1024; kt = it / 16; nt = it % 16;
        src = p.ffn_w_out + (size_t)(layer * 2 + f) * 2816 * 1024;
        dst = (u16*)(p.ws + OFF_WFFO) + (size_t)f * 1024 * 2816;
      } else if (it < N_FFI + N_FFO + N_WIN) {
        it -= N_FFI + N_FFO;
        K = 1024; N = 3456; kt = it / 54; nt = it % 54;
        src = p.w_in + (size_t)layer * 1024 * 3456;
        dst = (u16*)(p.ws + OFF_WIN);
      } else {
        it -= N_FFI + N_FFO + N_WIN;
        K = 1024; N = 1024; kt = it / 16; nt = it % 16;
        src = p.w_out + (size_t)layer * 1024 * 1024;
        dst = (u16*)(p.ws + OFF_WOUT);
      }
      __syncthreads();
      {
        const int r = tid >> 4, c4 = tid & 15;
        int np = nt * 64 + c4 * 4;
        int scol = np;
        if (perm) {
          int blk = np >> 7, sub = (np & 127) >> 4, i = np & 15;
          scol = ((sub & 1) ? DFF : 0) + blk * 64 + (sub >> 1) * 16 + i;
        }
#pragma unroll
        for (int ps = 0; ps < 4; ++ps) {
          int k = kt * 64 + ps * 16 + r;
          float4 v = *(const float4*)(src + (size_t)k * N + scol);
          float* tp = tile + (ps * 16 + r) * 65 + c4 * 4;
          tp[0] = v.x; tp[1] = v.y; tp[2] = v.z; tp[3] = v.w;
        }
      }
      __syncthreads();
      {
        const int n = tid >> 2, kq = tid & 3;
        bf16x8 o0, o1;
#pragma unroll
        for (int i = 0; i < 8; ++i) {
          o0[i] = (short)f2bf(tile[(kq * 16 + i) * 65 + n]);
          o1[i] = (short)f2bf(tile[(kq * 16 + 8 + i) * 65 + n]);
        }
        u16* dp = dst + (size_t)(nt * 64 + n) * K + kt * 64 + kq * 16;
        *(bf16x8*)dp = o0;
        *(bf16x8*)(dp + 8) = o1;
      }
    }
    __syncthreads();
  }
}

__device__ __forceinline__ void phase_init(const Params& p, unsigned char* smem) {
  const int tid = TIDX();
  const int nb = gridDim.x, bid = BIDX();
  if (bid == 0 && tid < 2) ((int*)(p.ws + OFF_QCTR))[tid] = 0;
  if (tid == 0) {
    const int hw = __builtin_amdgcn_s_getreg((7 << 11) | (8 << 6) | 4);
    const int xcc = __builtin_amdgcn_s_getreg((3 << 11) | 20) & 0xF;
    ((int*)(p.ws + OFF_CUTAB))[bid] = (xcc << 8) | (hw & 0xFF);
  }
  {
    float2* seq = (float2*)(p.ws + OFF_ROPE);
    float2* rowt = seq + 8192 * 32;
    float2* colt = rowt + 128 * 16;
    for (int i = bid * 256 + tid; i < 8192 * 32 + 128 * 16 + 64 * 16; i += nb * 256) {
      float ang;
      float2* dst;
      if (i < 8192 * 32) {
        int t = i >> 5, k = i & 31;
        float inv = 1.0f / powf(10000.0f, (float)(2 * k) / 64.0f);
        ang = (float)t * inv;
        dst = seq + i;
      } else {
        int j = i - 8192 * 32;
        int pidx = (j < 128 * 16) ? (j >> 4) : ((j - 128 * 16) >> 4);
        int k = j & 15;
        float inv = 1.0f / powf(10000.0f, (float)(2 * k) / 32.0f);
        ang = (float)pidx * inv;
        dst = rowt + j;
      }
      *dst = make_float2(cosf(ang), sinf(ang));
    }
    (void)colt;
  }
  {
    float* sc = (float*)smem;
    float* red = sc + 5 * 1024;
    for (int item = bid; item < 288; item += nb) {
      const int l = item / 144, cb = item % 144;
      __syncthreads();
      for (int i = tid; i < 5 * 1024; i += 256) {
        int m = i >> 10, k = i & 1023;
        float v = (m < 4) ? p.c[m * 1024 + k] : p.c_ctx[k];
        sc[i] = siluf_(v);
      }
      __syncthreads();
      const int cq = tid & 15, kg = tid >> 4;
      float acc[5][4];
#pragma unroll
      for (int m = 0; m < 5; ++m)
#pragma unroll
        for (int q = 0; q < 4; ++q) acc[m][q] = 0.f;
      const float* wbase = p.w_mod + (size_t)l * 1024 * NMOD + cb * 64 + cq * 4;
      for (int kk = 0; kk < 64; ++kk) {
        int k = kg * 64 + kk;
        float4 w4 = *(const float4*)(wbase + (size_t)k * NMOD);
#pragma unroll
        for (int m = 0; m < 5; ++m) {
          float s = sc[m * 1024 + k];
          acc[m][0] += s * w4.x; acc[m][1] += s * w4.y; acc[m][2] += s * w4.z; acc[m][3] += s * w4.w;
        }
      }
#pragma unroll
      for (int m = 0; m < 5; ++m)
#pragma unroll
        for (int q = 0; q < 4; ++q) red[(kg * 5 + m) * 64 + cq * 4 + q] = acc[m][q];
      __syncthreads();
      float* modp = (float*)(p.ws + OFF_MOD);
      for (int o = tid; o < 320; o += 256) {
        int m = o >> 6, cc = o & 63;
        float s = 0.f;
        for (int g = 0; g < 16; ++g) s += red[(g * 5 + m) * 64 + cc];
        int col = cb * 64 + cc;
        modp[((size_t)l * 5 + m) * NMOD + col] = s + p.b_mod[(size_t)l * NMOD + col];
      }
    }
    __syncthreads();
  }
  convert_weights(p, 0, smem);
}

__device__ __forceinline__ void phase_norm(const Params& p, int l, int which, const float* lat, const float* cx) {
  const int lane = TIDX() & 63, wid = TIDX() >> 6;
  u16* h = (u16*)(p.ws + OFF_H);
  const float* g = p.norm_g + ((size_t)l * 3 + which) * D;
  const float* modp = (const float*)(p.ws + OFF_MOD) + (size_t)l * 5 * NMOD;
  for (int r = BIDX() * 4 + wid; r < TALL; r += gridDim.x * 4) {
    const float* xr = rrow(lat, cx, r);
    const float* mp = modp + (size_t)mod_index(r) * NMOD + which * 3 * D;
    float4 v[4];
    float ss = 0.f;
#pragma unroll
    for (int i = 0; i < 4; ++i) {
      v[i] = *(const float4*)(xr + i * 256 + lane * 4);
      ss += v[i].x * v[i].x + v[i].y * v[i].y + v[i].z * v[i].z + v[i].w * v[i].w;
    }
    ss = wave_sum(ss);
    float rstd = rsqrtf(ss * (1.f / 1024.f) + RMS_EPS);
#pragma unroll
    for (int i = 0; i < 4; ++i) {
      int col = i * 256 + lane * 4;
      float4 gg = *(const float4*)(g + col);
      float4 sh = *(const float4*)(mp + col);
      float4 scl = *(const float4*)(mp + D + col);
      bf16x4 o = pack4(v[i].x * rstd * gg.x * (1.f + scl.x) + sh.x, v[i].y * rstd * gg.y * (1.f + scl.y) + sh.y,
                       v[i].z * rstd * gg.z * (1.f + scl.z) + sh.z, v[i].w * rstd * gg.w * (1.f + scl.w) + sh.w);
      *(bf16x4*)(h + (size_t)r * D + col) = o;
    }
  }
}

__device__ __forceinline__ void phase_final_norm(const Params& p) {
  const int lane = TIDX() & 63, wid = TIDX() >> 6;
  for (int r = BIDX() * 4 + wid; r < TLAT; r += gridDim.x * 4) {
    float* xr = p.out + (size_t)r * D;
    float4 v[4];
    float ss = 0.f;
#pragma unroll
    for (int i = 0; i < 4; ++i) {
      v[i] = *(const float4*)(xr + i * 256 + lane * 4);
      ss += v[i].x * v[i].x + v[i].y * v[i].y + v[i].z * v[i].z + v[i].w * v[i].w;
    }
    ss = wave_sum(ss);
    float rstd = rsqrtf(ss * (1.f / 1024.f) + RMS_EPS);
#pragma unroll
    for (int i = 0; i < 4; ++i) {
      int col = i * 256 + lane * 4;
      float4 gg = *(const float4*)(p.final_g + col);
      float4 o = make_float4(v[i].x * rstd * gg.x, v[i].y * rstd * gg.y, v[i].z * rstd * gg.z, v[i].w * rstd * gg.w);
      *(float4*)(xr + col) = o;
    }
  }
}

template <int MI>
__device__ __forceinline__ void gemm_mainloop(const u16* __restrict__ A, const u16* __restrict__ Bt, int K, int brow,
                                              int bcol, f32x4 (&acc)[MI][4], unsigned char* smem) {
  const int tid = TIDX(), wid = tid >> 6, lane = tid & 63, wr = wid >> 1, wc = wid & 1, fr = lane & 15, fq = lane >> 4;
  constexpr int BM = MI * 32;
  constexpr int ACH = BM * 4 / 256;
  constexpr int STAGE = BM * 64 + 8192;
#pragma unroll
  for (int m = 0; m < MI; ++m)
#pragma unroll
    for (int n = 0; n < 4; ++n) acc[m][n] = f32x4{0.f, 0.f, 0.f, 0.f};
  const int nk = K / 32;
  const int prow = tid >> 2, pq = ((tid & 3) ^ ((0x78 >> (((tid >> 4) & 3) * 2)) & 3)) * 8;
  const u16* ga = A + (size_t)(brow + prow) * K + pq;
  const u16* gb = Bt + (size_t)(bcol + prow) * K + pq;
  auto stage = [&](int t, int buf) {
    unsigned char* base = smem + buf * STAGE;
#pragma unroll
    for (int i = 0; i < ACH; ++i)
      __builtin_amdgcn_global_load_lds((const unsigned*)(ga + (size_t)i * 64 * K + t * 32),
                                       (__attribute__((address_space(3))) unsigned*)(base + (tid + i * 256) * 16), 16, 0, 0);
#pragma unroll
    for (int i = 0; i < 2; ++i)
      __builtin_amdgcn_global_load_lds((const unsigned*)(gb + (size_t)i * 64 * K + t * 32),
                                       (__attribute__((address_space(3))) unsigned*)(base + BM * 64 + (tid + i * 256) * 16), 16, 0, 0);
  };
  const int swz = (fq ^ ((0x78 >> (((fr >> 2) & 3) * 2)) & 3)) * 16;
  __syncthreads();
  stage(0, 0);
  for (int t = 0; t < nk; ++t) {
    __syncthreads();
    if (t + 1 < nk) stage(t + 1, (t + 1) & 1);
    const unsigned char* base = smem + (t & 1) * STAGE;
    bf16x8 af[MI], bfr[4];
#pragma unroll
    for (int m = 0; m < MI; ++m) af[m] = *(const bf16x8*)(base + (wr * MI * 16 + m * 16 + fr) * 64 + swz);
#pragma unroll
    for (int n = 0; n < 4; ++n) bfr[n] = *(const bf16x8*)(base + BM * 64 + (wc * 64 + n * 16 + fr) * 64 + swz);
#pragma unroll
    for (int m = 0; m < MI; ++m)
#pragma unroll
      for (int n = 0; n < 4; ++n) acc[m][n] = __builtin_amdgcn_mfma_f32_16x16x32_bf16(af[m], bfr[n], acc[m][n], 0, 0, 0);
  }
}

__device__ __forceinline__ bool next_tile(int it, int MT, int NT, int& tm, int& tn) {
  const int G = gridDim.x, b = BIDX();
  const int total = MT * NT;
  int id;
  if ((G & 7) == 0) {
    const int per = G >> 3;
    id = it * G + (b & 7) * per + (b >> 3);
  } else {
    id = b + it * G;
  }
  if (id >= total) return false;
  constexpr int GM = 8;
  const int gsz = GM * NT;
  const int g = id / gsz, rem = id - g * gsz;
  const int rows = (MT - g * GM) < GM ? (MT - g * GM) : GM;
  tn = rem / rows;
  tm = g * GM + (rem - tn * rows);
  return true;
}

__device__ __forceinline__ void phase_ffn_in(const Params& p, int l, int f, unsigned char* smem) {
  const u16* A = (const u16*)(p.ws + OFF_H);
  const u16* Bt = (const u16*)(p.ws + OFF_WFFI) + (size_t)f * 5632 * 1024;
  u16* act = (u16*)(p.ws + OFF_P2);
  const int tid = TIDX(), wid = tid >> 6, lane = tid & 63, wr = wid >> 1, wc = wid & 1, fr = lane & 15, fq = lane >> 4;
  constexpr int MI = 8, NT = 44, MT = TALL / (MI * 32);
  for (int it = 0;; ++it) {
    int tm, tn;
    if (!next_tile(it, MT, NT, tm, tn)) break;
    f32x4 acc[MI][4];
    gemm_mainloop<MI>(A, Bt, 1024, tm * MI * 32, tn * 128, acc, smem);
#pragma unroll
    for (int m = 0; m < MI; ++m)
#pragma unroll
      for (int q = 0; q < 2; ++q)
#pragma unroll
        for (int j = 0; j < 4; ++j) {
          int row = tm * MI * 32 + wr * MI * 16 + m * 16 + fq * 4 + j;
          int col = tn * 64 + wc * 32 + q * 16 + fr;
          float u1 = acc[m][2 * q][j], u2 = acc[m][2 * q + 1][j];
          act[(size_t)row * DFF + col] = f2bf(siluf_(u1) * u2);
        }
  }
}

__device__ __forceinline__ void phase_resid_gemm(const Params& p, int l, const u16* A, const u16* Bt, int K, int gate, float gscale,
                                 const float* lat_in, const float* cx_in, float* lat_out, float* cx_out,
                                 unsigned char* smem) {
  const int tid = TIDX(), wid = tid >> 6, lane = tid & 63, wr = wid >> 1, wc = wid & 1, fr = lane & 15, fq = lane >> 4;
  constexpr int MI = 6, NT = 8, MT = TALL / (MI * 32);
  const float* modp = (const float*)(p.ws + OFF_MOD) + (size_t)l * 5 * NMOD + gate * D;
  for (int it = 0;; ++it) {
    int tm, tn;
    if (!next_tile(it, MT, NT, tm, tn)) break;
    f32x4 acc[MI][4];
    gemm_mainloop<MI>(A, Bt, K, tm * MI * 32, tn * 128, acc, smem);
#pragma unroll
    for (int m = 0; m < MI; ++m)
#pragma unroll
      for (int j = 0; j < 4; ++j) {
        int row = tm * MI * 32 + wr * MI * 16 + m * 16 + fq * 4 + j;
        const float* mp = modp + (size_t)mod_index(row) * NMOD;
        const float* xi = rrow(lat_in, cx_in, row);
        float* xo = wrow(lat_out, cx_out, row);
#pragma unroll
        for (int n = 0; n < 4; ++n) {
          int col = tn * 128 + wc * 64 + n * 16 + fr;
          xo[col] = xi[col] + gscale * mp[col] * acc[m][n][j];
        }
      }
  }
}

__device__ __forceinline__ void phase_inproj(const Params& p, int l, unsigned char* smem) {
  const u16* A = (const u16*)(p.ws + OFF_H);
  const u16* Bt = (const u16*)(p.ws + OFF_WIN);
  const int tid = TIDX(), wid = tid >> 6, lane = tid & 63, wr = wid >> 1, wc = wid & 1, fr = lane & 15, fq = lane >> 4;
  constexpr int MI = 8, NT = 27, MT = TALL / (MI * 32);
  const float2* ropeseq = (const float2*)(p.ws + OFF_ROPE);
  const float2* roperow = ropeseq + 8192 * 32;
  const float2* ropecol = roperow + 128 * 16;
  u16* QA = (u16*)(p.ws + OFF_QA); u16* QB = (u16*)(p.ws + OFF_QB); u16* QR = (u16*)(p.ws + OFF_QR);
  u16* KA = (u16*)(p.ws + OFF_KA); u16* VA = (u16*)(p.ws + OFF_VA);
  u16* KB = (u16*)(p.ws + OFF_KB); u16* VB = (u16*)(p.ws + OFF_VB);
  u16* KR = (u16*)(p.ws + OFF_KR); u16* VR = (u16*)(p.ws + OFF_VR);
  u16* P2 = (u16*)(p.ws + OFF_P2);
  for (int it = 0;; ++it) {
    int tm, tn;
    if (!next_tile(it, MT, NT, tm, tn)) break;
    f32x4 acc[MI][4];
    gemm_mainloop<MI>(A, Bt, 1024, tm * MI * 32, tn * 128, acc, smem);
    const int r0 = tm * MI * 32 + wr * MI * 16;
    const int c0 = tn * 128 + wc * 64;
    const bool latent = r0 < TLAT;
    if (c0 >= 1792) {
#pragma unroll
      for (int m = 0; m < MI; ++m)
#pragma unroll
        for (int n = 0; n < 4; ++n)
#pragma unroll
          for (int j = 0; j < 4; ++j) {
            int row = r0 + m * 16 + fq * 4 + j;
            P2[(size_t)row * P2C + (c0 - 1792) + n * 16 + fr] = f2bf(acc[m][n][j]);
          }
      continue;
    }
    int kind;
    int ropek;
    int normk;
    float scale = 1.f;
    u16* dst; int hh, nh;
    if (c0 < 256) { kind = 0; ropek = 1; normk = -1; scale = 0.125f * LOG2E; dst = QA; hh = c0 >> 6; nh = 4; }
    else if (c0 < 384) { kind = 1; ropek = 1; normk = -1; dst = KA; hh = (c0 - 256) >> 6; nh = 2; }
    else if (c0 < 512) { kind = 2; ropek = 0; normk = -1; dst = VA; hh = (c0 - 384) >> 6; nh = 2; }
    else if (c0 < 768) { kind = 0; ropek = 1; normk = 0; scale = 0.125f * LOG2E; dst = QB; hh = (c0 - 512) >> 6; nh = 4; }
    else if (c0 < 896) { kind = 1; ropek = 1; normk = 1; dst = KB; hh = (c0 - 768) >> 6; nh = 2; }
    else if (c0 < 1024) { kind = 2; ropek = 0; normk = -1; dst = VB; hh = (c0 - 896) >> 6; nh = 2; }
    else if (c0 < 1280) { kind = 0; ropek = 2; normk = -1; dst = QR; hh = (c0 - 1024) >> 6; nh = 4; }
    else if (c0 < 1536) { kind = 1; ropek = 2; normk = -1; scale = 0.125f; dst = KR; hh = (c0 - 1280) >> 6; nh = 4; }
    else { kind = 2; ropek = 0; normk = -1; dst = VR; hh = (c0 - 1536) >> 6; nh = 4; }
    if (!latent) ropek = 0;
    if (kind == 2) {
#pragma unroll
      for (int m = 0; m < MI; ++m) {
        int b, pos;
        row_bpos(r0 + m * 16 + fq * 4, b, pos);
#pragma unroll
        for (int n = 0; n < 4; ++n) {
          int d = n * 16 + fr;
          bf16x4 o = pack4(acc[m][n][0], acc[m][n][1], acc[m][n][2], acc[m][n][3]);
          *(bf16x4*)(dst + ((size_t)(b * nh + hh) * 64 + d) * STOT + pos) = o;
        }
      }
      continue;
    }
    float gq[4] = {1.f, 1.f, 1.f, 1.f};
    if (normk >= 0) {
#pragma unroll
      for (int n = 0; n < 4; ++n) gq[n] = p.qk_g[((size_t)l * 2 + normk) * 64 + n * 16 + fr];
    }
#pragma unroll
    for (int m = 0; m < MI; ++m)
#pragma unroll
      for (int j = 0; j < 4; ++j) {
        int row = r0 + m * 16 + fq * 4 + j;
        float v0 = acc[m][0][j], v1 = acc[m][1][j], v2 = acc[m][2][j], v3 = acc[m][3][j];
        if (normk >= 0) {
          float ss = v0 * v0 + v1 * v1 + v2 * v2 + v3 * v3;
          ss += __shfl_xor(ss, 1); ss += __shfl_xor(ss, 2); ss += __shfl_xor(ss, 4); ss += __shfl_xor(ss, 8);
          float rstd = rsqrtf(ss * (1.f / 64.f) + RMS_EPS);
          v0 *= rstd * gq[0]; v1 *= rstd * gq[1]; v2 *= rstd * gq[2]; v3 *= rstd * gq[3];
        }
        int b, pos;
        row_bpos(row, b, pos);
        if (ropek == 1) {
          float2 cr = roperow[(pos >> 6) * 16 + fr];
          float2 cc = ropecol[(pos & 63) * 16 + fr];
          float o0 = v0 * cr.x - v1 * cr.y, o1 = v1 * cr.x + v0 * cr.y;
          float o2 = v2 * cc.x - v3 * cc.y, o3 = v3 * cc.x + v2 * cc.y;
          v0 = o0; v1 = o1; v2 = o2; v3 = o3;
        } else if (ropek == 2) {
          float2 ca = ropeseq[pos * 32 + fr];
          float2 cb = ropeseq[pos * 32 + 16 + fr];
          float o0 = v0 * ca.x - v2 * ca.y, o2 = v2 * ca.x + v0 * ca.y;
          float o1 = v1 * cb.x - v3 * cb.y, o3 = v3 * cb.x + v1 * cb.y;
          v0 = o0; v1 = o1; v2 = o2; v3 = o3;
        }
        v0 *= scale; v1 *= scale; v2 *= scale; v3 *= scale;
        u16* dp;
        if (kind == 0) dp = dst + (size_t)row * 256 + hh * 64 + fr;
        else dp = dst + ((size_t)(b * nh + hh) * STOT + pos) * 64 + fr;
        dp[0] = f2bf(v0); dp[16] = f2bf(v1); dp[32] = f2bf(v2); dp[48] = f2bf(v3);
      }
  }
}

__device__ __forceinline__ void attn_item(const u16* __restrict__ Q, const u16* __restrict__ Kb, const u16* __restrict__ Vt,
                          u16* __restrict__ concat, int ccol0, int b, int kvh, int qrow0, int qpos0, int t0, int t1,
                          int c0, int c1, bool masked, const float* sink, unsigned char* smem) {
  const int tid = TIDX(), w = tid >> 6, lane = tid & 63, fr = lane & 15, fq = lane >> 4;
  const int head = kvh * 2 + (w & 1);
  const int qoff = (w >> 1) * 32;
  bf16x8 qf[2][2];
#pragma unroll
  for (int qg = 0; qg < 2; ++qg)
#pragma unroll
    for (int ks = 0; ks < 2; ++ks)
      qf[qg][ks] = *(const bf16x8*)(Q + (size_t)(qrow0 + qoff + qg * 16 + fr) * 256 + head * 64 + ks * 32 + fq * 8);
  f32x4 O[2][4];
  float mrow[2], lrow[2];
#pragma unroll
  for (int qg = 0; qg < 2; ++qg) {
    mrow[qg] = -1e30f; lrow[qg] = 0.f;
#pragma unroll
    for (int dt = 0; dt < 4; ++dt) O[qg][dt] = f32x4{0.f, 0.f, 0.f, 0.f};
  }
  const u16* Kbase = Kb + (size_t)(b * 2 + kvh) * STOT * 64;
  const u16* Vbase = Vt + (size_t)(b * 2 + kvh) * 64 * STOT;
  const int n1 = t1 - t0, total = n1 + (c1 - c0);
  bf16x8 kreg[2], vreg[2];
  auto gload = [&](int i) {
    int tile = i < n1 ? t0 + i : c0 + (i - n1);
#pragma unroll
    for (int ps = 0; ps < 2; ++ps) {
      int idx = tid + ps * 256;
      kreg[ps] = *(const bf16x8*)(Kbase + (size_t)tile * 4096 + idx * 8);
      int d = idx >> 3, ch = idx & 7;
      vreg[ps] = *(const bf16x8*)(Vbase + (size_t)d * STOT + tile * 64 + ch * 8);
    }
  };
  auto lstore = [&](int buf) {
    u16* Ks = (u16*)(smem + buf * 18432);
    u16* Vs = Ks + 64 * 72;
#pragma unroll
    for (int ps = 0; ps < 2; ++ps) {
      int idx = tid + ps * 256;
      int r = idx >> 3, ch = idx & 7;
      *(bf16x8*)(Ks + r * 72 + ch * 8) = kreg[ps];
      *(bf16x8*)(Vs + r * 72 + ch * 8) = vreg[ps];
    }
  };
  __syncthreads();
  gload(0);
  lstore(0);
  __syncthreads();
#pragma unroll 1
  for (int i = 0; i < total; ++i) {
    const int tile = i < n1 ? t0 + i : c0 + (i - n1);
    if (i + 1 < total) gload(i + 1);
    const u16* Ks = (const u16*)(smem + (i & 1) * 18432);
    const u16* Vs = Ks + 64 * 72;
    f32x4 s[2][4];
#pragma unroll
    for (int qg = 0; qg < 2; ++qg)
#pragma unroll
      for (int sub = 0; sub < 4; ++sub) s[qg][sub] = f32x4{0.f, 0.f, 0.f, 0.f};
#pragma unroll
    for (int sub = 0; sub < 4; ++sub)
#pragma unroll
      for (int ks = 0; ks < 2; ++ks) {
        bf16x8 a = *(const bf16x8*)(Ks + (sub * 16 + fr) * 72 + ks * 32 + fq * 8);
#pragma unroll
        for (int qg = 0; qg < 2; ++qg) s[qg][sub] = __builtin_amdgcn_mfma_f32_16x16x32_bf16(a, qf[qg][ks], s[qg][sub], 0, 0, 0);
      }
    __builtin_amdgcn_sched_barrier(0);
    const bool domask = masked && (tile < 128);
    bf16x8 pb[2][2];
#pragma unroll
    for (int qg = 0; qg < 2; ++qg) {
      if (domask) {
        int qpos = qpos0 + qoff + qg * 16 + fr;
#pragma unroll
        for (int sub = 0; sub < 4; ++sub)
#pragma unroll
          for (int j = 0; j < 4; ++j) {
            int kpos = tile * 64 + sub * 16 + fq * 4 + j;
            int dd = kpos - qpos;
            if (dd > 128 || dd < -128) s[qg][sub][j] = -INFINITY;
          }
      }
      float mx = -INFINITY;
#pragma unroll
      for (int sub = 0; sub < 4; ++sub)
#pragma unroll
        for (int j = 0; j < 4; ++j) mx = fmaxf(mx, s[qg][sub][j]);
      mx = fmaxf(mx, __shfl_xor(mx, 16));
      mx = fmaxf(mx, __shfl_xor(mx, 32));
      float mnew = fmaxf(mrow[qg], mx);
      const bool changed = mnew > mrow[qg];
      float alpha = __builtin_amdgcn_exp2f(mrow[qg] - mnew);
      mrow[qg] = mnew;
      float ps = 0.f;
#pragma unroll
      for (int sub = 0; sub < 4; ++sub)
#pragma unroll
        for (int j = 0; j < 4; ++j) {
          float pv = __builtin_amdgcn_exp2f(s[qg][sub][j] - mnew);
          s[qg][sub][j] = pv;
          ps += pv;
        }
      lrow[qg] = lrow[qg] * alpha + ps;
      if (__builtin_amdgcn_ballot_w64(changed) != 0ull) {
#pragma unroll
        for (int dt = 0; dt < 4; ++dt) O[qg][dt] *= alpha;
      }
#pragma unroll
      for (int ks = 0; ks < 2; ++ks)
        pb[qg][ks] = cat8(pack4(s[qg][2 * ks][0], s[qg][2 * ks][1], s[qg][2 * ks][2], s[qg][2 * ks][3]),
                          pack4(s[qg][2 * ks + 1][0], s[qg][2 * ks + 1][1], s[qg][2 * ks + 1][2], s[qg][2 * ks + 1][3]));
      __builtin_amdgcn_sched_barrier(0);
    }
#pragma unroll
    for (int dt = 0; dt < 4; ++dt)
#pragma unroll
      for (int ks = 0; ks < 2; ++ks) {
        const u16* vp = Vs + (dt * 16 + fr) * 72 + ks * 32 + fq * 4;
        bf16x8 va = cat8(*(const bf16x4*)vp, *(const bf16x4*)(vp + 16));
#pragma unroll
        for (int qg = 0; qg < 2; ++qg) O[qg][dt] = __builtin_amdgcn_mfma_f32_16x16x32_bf16(va, pb[qg][ks], O[qg][dt], 0, 0, 0);
      }
    __builtin_amdgcn_sched_barrier(0);
    if (i + 1 < total) lstore((i + 1) & 1);
    __syncthreads();
  }
#pragma unroll
  for (int qg = 0; qg < 2; ++qg) {
    float lt = lrow[qg];
    lt += __shfl_xor(lt, 16);
    lt += __shfl_xor(lt, 32);
    if (sink) lt += __builtin_amdgcn_exp2f(sink[head] * LOG2E - mrow[qg]);
    float inv = 1.f / lt;
    int row = qrow0 + qoff + qg * 16 + fr;
#pragma unroll
    for (int dt = 0; dt < 4; ++dt) {
      bf16x4 o = pack4(O[qg][dt][0] * inv, O[qg][dt][1] * inv, O[qg][dt][2] * inv, O[qg][dt][3] * inv);
      *(bf16x4*)(concat + (size_t)row * D + ccol0 + head * 64 + dt * 16 + fq * 4) = o;
    }
  }
}

__device__ __forceinline__ float ret_lg(int h) {
  return log2f(1.0f - exp2f(-5.0f - (float)h));
}

__device__ __forceinline__ void retU_item(const Params& p, int bh, int c, unsigned char* smem) {
  const int tid = TIDX();
  const int b = bh >> 2, h = bh & 3;
  const u16* KR = (const u16*)(p.ws + OFF_KR) + (size_t)bh * STOT * 64;
  const u16* VR = (const u16*)(p.ws + OFF_VR) + (size_t)bh * 64 * STOT;
  (void)b;
  const int pos0 = c < 64 ? c * 128 : SEQ + (c - 64) * 128;
  u16* Kc = (u16*)smem;
  u16* Vj = Kc + 128 * 64;
  __syncthreads();
#pragma unroll
  for (int ps = 0; ps < 4; ++ps) {
    int idx = tid + ps * 256;
    *(bf16x8*)(Kc + idx * 8) = *(const bf16x8*)(KR + (size_t)pos0 * 64 + idx * 8);
    int d = idx >> 4, ch = idx & 15;
    bf16x8 v = *(const bf16x8*)(VR + (size_t)d * STOT + pos0 + ch * 8);
#pragma unroll
    for (int e = 0; e < 8; ++e) Vj[(ch * 8 + e) * 72 + d] = (u16)v[e];
  }
  __syncthreads();
  const int dk = tid >> 2, dv0 = (tid & 3) * 16;
  const float lg = ret_lg(h);
  float af[16], ab[16];
#pragma unroll
  for (int q = 0; q < 16; ++q) { af[q] = 0.f; ab[q] = 0.f; }
  for (int j = 0; j < 128; ++j) {
    float kf = bf2f(Kc[j * 64 + dk]);
    float kfw = kf * exp2f(lg * (float)(127 - j));
    float kbw = kf * exp2f(lg * (float)j);
    bf16x8 v0 = *(const bf16x8*)(Vj + j * 72 + dv0);
    bf16x8 v1 = *(const bf16x8*)(Vj + j * 72 + dv0 + 8);
#pragma unroll
    for (int q = 0; q < 8; ++q) {
      float a = bf2f((u16)v0[q]), bb = bf2f((u16)v1[q]);
      af[q] += kfw * a; ab[q] += kbw * a;
      af[8 + q] += kfw * bb; ab[8 + q] += kbw * bb;
    }
  }
  float* U = (float*)(p.ws + OFF_U) + ((size_t)bh * 66 + c) * 2 * 4096;
#pragma unroll
  for (int q = 0; q < 16; ++q) {
    U[(dv0 + q) * 64 + dk] = af[q];
    U[4096 + (dv0 + q) * 64 + dk] = ab[q];
  }
}

__device__ __forceinline__ void phase_retU(const Params& p, unsigned char* smem) {
  for (int item = BIDX(); item < 16 * 66; item += gridDim.x) retU_item(p, item / 66, item % 66, smem);
}

__device__ __forceinline__ void attn_worker(const Params& p, int l, unsigned char* smem) {
  const u16* QA = (const u16*)(p.ws + OFF_QA); const u16* QB = (const u16*)(p.ws + OFF_QB);
  const u16* KA = (const u16*)(p.ws + OFF_KA); const u16* VA = (const u16*)(p.ws + OFF_VA);
  const u16* KB = (const u16*)(p.ws + OFF_KB); const u16* VB = (const u16*)(p.ws + OFF_VB);
  u16* concat = (u16*)(p.ws + OFF_H);
  const float* sink = p.attn_sink + l * 4;
  int* qctr = (int*)(p.ws + OFF_QCTR) + l;
  volatile int* slot = (volatile int*)(smem + 65536 - 32);
  for (;;) {
    __syncthreads();
    if (TIDX() == 0) *slot = atomicAdd(qctr, 1);
    __syncthreads();
    const int item = *slot;
    if (item >= 2112) break;
    const bool isB = item < 1024 || (item >= 2048 && item < 2080);
    const bool isctx = item >= 2048;
    int ii = item < 1024 ? item : item < 2048 ? item - 1024 : item < 2080 ? item - 2048 : item - 2080;
    int qt, kvh, b, qrow0, qpos0, t0, t1;
    if (!isctx) {
      qt = ii & 127; kvh = (ii >> 7) & 1; b = ii >> 8;
      qrow0 = b * SEQ + qt * 64; qpos0 = qt * 64;
      if (isB) { t0 = 0; t1 = 128; }
      else { t0 = qt - 2 < 0 ? 0 : qt - 2; t1 = qt + 3 > 128 ? 128 : qt + 3; }
    } else {
      qt = ii & 3; kvh = (ii >> 2) & 1; b = ii >> 3;
      qrow0 = TLAT + b * CTXL + qt * 64; qpos0 = 0; t0 = 0; t1 = 0;
    }
    attn_item(isB ? QB : QA, isB ? KB : KA, isB ? VB : VA, concat, isB ? 256 : 0, b, kvh, qrow0, qpos0, t0, t1, 128, 132,
              (!isB) && (!isctx), isB ? nullptr : sink, smem);
  }
}

__device__ __forceinline__ void phase_retscan(const Params& p) {
  const float* U = (const float*)(p.ws + OFF_U);
  u16* SP = (u16*)(p.ws + OFF_SP);
  for (int gid = BIDX() * 256 + TIDX(); gid < 16 * 2 * 4096; gid += gridDim.x * 256) {
    int e = gid & 4095, dir = (gid >> 12) & 1, bh = gid >> 13;
    float g128 = exp2f(128.f * ret_lg(bh & 3));
    float S = 0.f;
#pragma unroll 1
    for (int n0 = 0; n0 < 66; n0 += 11) {
      float u[11];
      size_t offs[11];
#pragma unroll
      for (int k = 0; k < 11; ++k) {
        int n = n0 + k;
        int c = dir == 0 ? (n < 2 ? 64 + n : n - 2) : 65 - n;
        offs[k] = (((size_t)bh * 66 + c) * 2 + dir) * 4096 + e;
        u[k] = U[offs[k]];
      }
#pragma unroll
      for (int k = 0; k < 11; ++k) {
        SP[offs[k]] = f2bf(S);
        S = g128 * S + u[k];
      }
    }
  }
}

__device__ __forceinline__ void retout_item(const Params& p, int l, int bh, int c, unsigned char* smem) {
  const int tid = TIDX(), w = tid >> 6, lane = tid & 63, fr = lane & 15, fq = lane >> 4;
  const int b = bh >> 2, h = bh & 3;
  const u16* QR = (const u16*)(p.ws + OFF_QR);
  const u16* KR = (const u16*)(p.ws + OFF_KR) + (size_t)bh * STOT * 64;
  const u16* VR = (const u16*)(p.ws + OFF_VR) + (size_t)bh * 64 * STOT;
  const u16* SP = (const u16*)(p.ws + OFF_SP) + ((size_t)bh * 66 + c) * 2 * 4096;
  const u16* P2 = (const u16*)(p.ws + OFF_P2);
  u16* concat = (u16*)(p.ws + OFF_H);
  const int pos0 = c < 64 ? c * 128 : SEQ + (c - 64) * 128;
  const int row0 = bpos_row(b, pos0);
  u16* Kc = (u16*)smem;
  u16* Vs = Kc + 128 * 72;
  __syncthreads();
#pragma unroll
  for (int ps = 0; ps < 4; ++ps) {
    int idx = tid + ps * 256;
    int r = idx >> 3, ch = idx & 7;
    *(bf16x8*)(Kc + r * 72 + ch * 8) = *(const bf16x8*)(KR + (size_t)(pos0 + r) * 64 + ch * 8);
    int d = idx >> 4, c16 = idx & 15;
    *(bf16x8*)(Vs + d * 136 + c16 * 8) = *(const bf16x8*)(VR + (size_t)d * STOT + pos0 + c16 * 8);
  }
  __syncthreads();
  const float lg = ret_lg(h);
#pragma unroll 1
  for (int qg = 0; qg < 2; ++qg) {
    const int i = w * 32 + qg * 16 + fr;
    const int row = row0 + i;
    bf16x8 qf[2];
#pragma unroll
    for (int ks = 0; ks < 2; ++ks) qf[ks] = *(const bf16x8*)(QR + (size_t)row * 256 + h * 64 + ks * 32 + fq * 8);
    f32x4 s[8];
#pragma unroll
    for (int sub = 0; sub < 8; ++sub) {
      s[sub] = f32x4{0.f, 0.f, 0.f, 0.f};
#pragma unroll
      for (int ks = 0; ks < 2; ++ks) {
        bf16x8 a = *(const bf16x8*)(Kc + (sub * 16 + fr) * 72 + ks * 32 + fq * 8);
        s[sub] = __builtin_amdgcn_mfma_f32_16x16x32_bf16(a, qf[ks], s[sub], 0, 0, 0);
      }
    }
    float res[4][4];
#pragma unroll
    for (int dt = 0; dt < 4; ++dt)
#pragma unroll
      for (int j = 0; j < 4; ++j) res[dt][j] = 0.f;
#pragma unroll 1
    for (int dir = 0; dir < 2; ++dir) {
      f32x4 O[4];
      const float qw = dir == 0 ? __builtin_amdgcn_exp2f(lg * (float)(i + 1)) : __builtin_amdgcn_exp2f(lg * (float)(128 - i));
#pragma unroll
      for (int dt = 0; dt < 4; ++dt) {
        O[dt] = f32x4{0.f, 0.f, 0.f, 0.f};
#pragma unroll
        for (int ks = 0; ks < 2; ++ks) {
          bf16x8 a = *(const bf16x8*)(SP + dir * 4096 + (dt * 16 + fr) * 64 + ks * 32 + fq * 8);
          O[dt] = __builtin_amdgcn_mfma_f32_16x16x32_bf16(a, qf[ks], O[dt], 0, 0, 0);
        }
        O[dt] *= qw;
      }
      int fqo = fq;
      asm volatile("" : "+v"(fqo));
#pragma unroll
      for (int ks = 0; ks < 4; ++ks) {
        float pv[8];
#pragma unroll
        for (int e = 0; e < 8; ++e) {
          const int sub = 2 * ks + (e >> 2), j = e & 3;
          const int jk = sub * 16 + fqo * 4 + j;
          const int dd = dir == 0 ? i - jk : jk - i;
          pv[e] = dd >= 0 ? s[sub][j] * __builtin_amdgcn_exp2f(lg * (float)dd) : 0.f;
        }
        bf16x8 pb = cat8(pack4(pv[0], pv[1], pv[2], pv[3]), pack4(pv[4], pv[5], pv[6], pv[7]));
#pragma unroll
        for (int dt = 0; dt < 4; ++dt) {
          const u16* vp = Vs + (dt * 16 + fr) * 136 + ks * 32 + fq * 4;
          bf16x8 va = cat8(*(const bf16x4*)vp, *(const bf16x4*)(vp + 16));
          O[dt] = __builtin_amdgcn_mfma_f32_16x16x32_bf16(va, pb, O[dt], 0, 0, 0);
        }
      }
      float sm = 0.f;
#pragma unroll
      for (int dt = 0; dt < 4; ++dt)
#pragma unroll
        for (int j = 0; j < 4; ++j) sm += O[dt][j];
      sm += __shfl_xor(sm, 16); sm += __shfl_xor(sm, 32);
      const float mu = sm * (1.f / 64.f);
      float vs = 0.f;
#pragma unroll
      for (int dt = 0; dt < 4; ++dt)
#pragma unroll
        for (int j = 0; j < 4; ++j) { float dlt = O[dt][j] - mu; vs += dlt * dlt; }
      vs += __shfl_xor(vs, 16); vs += __shfl_xor(vs, 32);
      const float rstd = rsqrtf(vs * (1.f / 64.f) + GN_EPS);
#pragma unroll
      for (int dt = 0; dt < 4; ++dt) {
        const int d = dt * 16 + fq * 4;
        bf16x4 gt = *(const bf16x4*)(P2 + (size_t)row * P2C + dir * 256 + h * 64 + d);
        float4 rg = *(const float4*)(p.ret_g + (size_t)l * 256 + h * 64 + d);
        res[dt][0] += (O[dt][0] - mu) * rstd * rg.x * siluf_(bf2f((u16)gt[0]));
        res[dt][1] += (O[dt][1] - mu) * rstd * rg.y * siluf_(bf2f((u16)gt[1]));
        res[dt][2] += (O[dt][2] - mu) * rstd * rg.z * siluf_(bf2f((u16)gt[2]));
        res[dt][3] += (O[dt][3] - mu) * rstd * rg.w * siluf_(bf2f((u16)gt[3]));
      }
    }
#pragma unroll
    for (int dt = 0; dt < 4; ++dt)
      *(bf16x4*)(concat + (size_t)row * D + 512 + h * 64 + dt * 16 + fq * 4) = pack4(res[dt][0], res[dt][1], res[dt][2], res[dt][3]);
  }
}

__device__ __forceinline__ void phase_retout(const Params& p, int l, unsigned char* smem) {
  for (int item = BIDX(); item < 16 * 66; item += gridDim.x) retout_item(p, l, item / 66, item % 66, smem);
}

__device__ __forceinline__ void phase_wprep(const Params& p, int l, unsigned char* smem) {
  const int tid = TIDX(), col = tid;
  const u16* P2 = (const u16*)(p.ws + OFF_P2);
  u16* prep = (u16*)(p.ws + OFF_PREP);
  float* twT = (float*)smem;
  float* amT = twT + 64 * 16;
  float* outW = amT + 64 * 16;
  float* outA = outW + 16 * 256;
  const int j = tid & 31, tsub = tid >> 5, head = j >> 3, c8 = (j & 7) * 8, ch0 = head * 64 + c8;
  float kkv[8], kav[8];
#pragma unroll
  for (int e = 0; e < 8; ++e) { kkv[e] = p.k_k[(size_t)l * 256 + ch0 + e]; kav[e] = p.k_a[(size_t)l * 256 + ch0 + e]; }
  for (int item = BIDX(); item < (TALL / 16) * 2; item += gridDim.x) {
    const int dir = item & 1, row0 = (item >> 1) * 16;
    const float* mu = p.mu + ((size_t)l * 2 + dir) * 896;
    __syncthreads();
    {
      const int tok = tid >> 4, e0 = (tid & 15) * 4;
      const int row = row0 + tok;
      int b, pos;
      row_bpos(row, b, pos);
      bool has;
      int nrow;
      if (dir == 0) { has = (pos != 0) && (pos != SEQ); nrow = row - 1; }
      else { has = (pos != SEQ - 1) && (pos != STOT - 1); nrow = row + 1; }
      const int srow = has ? nrow : row;
      bf16x4 zw = *(const bf16x4*)(P2 + (size_t)row * P2C + 1408 + dir * 64 + e0);
      bf16x4 za = *(const bf16x4*)(P2 + (size_t)row * P2C + 1536 + dir * 64 + e0);
      bf16x4 sw = *(const bf16x4*)(P2 + (size_t)srow * P2C + 1408 + dir * 64 + e0);
      bf16x4 sa = *(const bf16x4*)(P2 + (size_t)srow * P2C + 1536 + dir * 64 + e0);
#pragma unroll
      for (int e = 0; e < 4; ++e) {
        float z = bf2f((u16)zw[e]), zs = has ? bf2f((u16)sw[e]) : 0.f;
        twT[(e0 + e) * 16 + tok] = tanhf_(z + mu[768 + e0 + e] * (zs - z));
        float z2 = bf2f((u16)za[e]), zs2 = has ? bf2f((u16)sa[e]) : 0.f;
        amT[(e0 + e) * 16 + tok] = z2 + mu[832 + e0 + e] * (zs2 - z2);
      }
    }
    __syncthreads();
    {
      float accw[16], acca[16];
#pragma unroll
      for (int t = 0; t < 16; ++t) { accw[t] = 0.f; acca[t] = 0.f; }
      const float* w2 = p.w2 + ((size_t)l * 2 + dir) * 64 * 256 + col;
      const float* a2 = p.a2 + ((size_t)l * 2 + dir) * 64 * 256 + col;
#pragma unroll 1
      for (int k0 = 0; k0 < 64; k0 += 4) {
        float wv8[4], av8[4];
#pragma unroll
        for (int u = 0; u < 4; ++u) { wv8[u] = w2[(k0 + u) * 256]; av8[u] = a2[(k0 + u) * 256]; }
#pragma unroll
        for (int u = 0; u < 4; ++u) {
          const int kq = k0 + u;
          const float wv = wv8[u], av = av8[u];
#pragma unroll
          for (int t4 = 0; t4 < 4; ++t4) {
            float4 a = *(const float4*)(twT + kq * 16 + t4 * 4);
            float4 bq = *(const float4*)(amT + kq * 16 + t4 * 4);
            accw[t4 * 4 + 0] += a.x * wv; accw[t4 * 4 + 1] += a.y * wv; accw[t4 * 4 + 2] += a.z * wv; accw[t4 * 4 + 3] += a.w * wv;
            acca[t4 * 4 + 0] += bq.x * av; acca[t4 * 4 + 1] += bq.y * av; acca[t4 * 4 + 2] += bq.z * av; acca[t4 * 4 + 3] += bq.w * av;
          }
        }
      }
      const float w0v = p.w0[((size_t)l * 2 + dir) * 256 + col], a0v = p.a0[((size_t)l * 2 + dir) * 256 + col];
#pragma unroll
      for (int t = 0; t < 16; ++t) {
        outW[t * 256 + col] = -0.6065306597126334f * sigmoidf_(w0v + accw[t]) * LOG2E;
        outA[t * 256 + col] = sigmoidf_(a0v + acca[t]);
      }
    }
    __syncthreads();
    {
      float mur[8], muk[8], muv[8];
#pragma unroll
      for (int e = 0; e < 8; ++e) { mur[e] = mu[ch0 + e]; muk[e] = mu[256 + ch0 + e]; muv[e] = mu[512 + ch0 + e]; }
#pragma unroll
      for (int pass = 0; pass < 2; ++pass) {
        const int tok = pass * 8 + tsub, row = row0 + tok;
        int b, pos;
        row_bpos(row, b, pos);
        bool has;
        int nrow;
        if (dir == 0) { has = (pos != 0) && (pos != SEQ); nrow = row - 1; }
        else { has = (pos != SEQ - 1) && (pos != STOT - 1); nrow = row + 1; }
        const u16* cp = P2 + (size_t)row * P2C + 512 + ch0;
        const u16* np = P2 + (size_t)(has ? nrow : row) * P2C + 512 + ch0;
        const bf16x8 zr8 = *(const bf16x8*)cp, zk8 = *(const bf16x8*)(cp + 256), zv8 = *(const bf16x8*)(cp + 512);
        const bf16x8 sr8 = *(const bf16x8*)np, sk8 = *(const bf16x8*)(np + 256), sv8 = *(const bf16x8*)(np + 512);
        const float4 lw0 = *(const float4*)(outW + tok * 256 + ch0), lw1 = *(const float4*)(outW + tok * 256 + ch0 + 4);
        const float4 av0 = *(const float4*)(outA + tok * 256 + ch0), av1 = *(const float4*)(outA + tok * 256 + ch0 + 4);
        const float lw[8] = {lw0.x, lw0.y, lw0.z, lw0.w, lw1.x, lw1.y, lw1.z, lw1.w};
        const float av[8] = {av0.x, av0.y, av0.z, av0.w, av1.x, av1.y, av1.z, av1.w};
        float r[8], k[8], v[8], kkr[8], ss = 0.f;
#pragma unroll
        for (int e = 0; e < 8; ++e) {
          float zr = bf2f((u16)zr8[e]), zk = bf2f((u16)zk8[e]), zv = bf2f((u16)zv8[e]);
          float sr = has ? bf2f((u16)sr8[e]) : 0.f, sk = has ? bf2f((u16)sk8[e]) : 0.f, sv = has ? bf2f((u16)sv8[e]) : 0.f;
          r[e] = zr + mur[e] * (sr - zr); k[e] = zk + muk[e] * (sk - zk); v[e] = zv + muv[e] * (sv - zv);
          kkr[e] = k[e] * kkv[e];
          ss += kkr[e] * kkr[e];
        }
        ss = half8_sum(ss);
        const float rs = rsqrtf(fmaxf(ss, 1e-24f));
        float kt[8], kk[8], bb[8];
#pragma unroll
        for (int e = 0; e < 8; ++e) {
          kk[e] = kkr[e] * rs;
          kt[e] = k[e] * (1.f + (av[e] - 1.f) * kav[e]);
          bb[e] = kk[e] * av[e];
        }
        u16* dp = prep + (((size_t)(b * 4 + head) * 2 + dir) * STOT + pos) * 384 + c8;
        *(bf16x8*)(dp) = cat8(pack4(lw[0], lw[1], lw[2], lw[3]), pack4(lw[4], lw[5], lw[6], lw[7]));
        *(bf16x8*)(dp + 64) = cat8(pack4(kt[0], kt[1], kt[2], kt[3]), pack4(kt[4], kt[5], kt[6], kt[7]));
        *(bf16x8*)(dp + 128) = cat8(pack4(kk[0], kk[1], kk[2], kk[3]), pack4(kk[4], kk[5], kk[6], kk[7]));
        *(bf16x8*)(dp + 192) = cat8(pack4(bb[0], bb[1], bb[2], bb[3]), pack4(bb[4], bb[5], bb[6], bb[7]));
        *(bf16x8*)(dp + 256) = cat8(pack4(r[0], r[1], r[2], r[3]), pack4(r[4], r[5], r[6], r[7]));
        *(bf16x8*)(dp + 320) = cat8(pack4(v[0], v[1], v[2], v[3]), pack4(v[4], v[5], v[6], v[7]));
      }
    }
  }
}

typedef float f32x2 __attribute__((ext_vector_type(2)));
__device__ __forceinline__ void wscan_item(const Params& p, int item, unsigned char* smem) {
  const int tid = TIDX(), w = tid >> 6, lane = tid & 63;
  const int jl4 = (lane & 15) * 4, rsub = lane >> 4;
  const u16* prep = (const u16*)(p.ws + OFF_PREP);
  u16* P2w = (u16*)(p.ws + OFF_P2);
  float* bufs = (float*)smem;
  {
    const int rq = item & 3, seq = item >> 2;
    const int dir = seq & 1, h = (seq >> 1) & 3, b = seq >> 3;
    const int irow = rq * 16 + w * 4 + rsub;
    const u16* base = prep + (size_t)seq * STOT * 384;
    uint4 lreg[3];
    auto gload = [&](int ch) {
#pragma unroll
      for (int ps = 0; ps < 3; ++ps) {
        int q = tid + ps * 256;
        int sidx = q / 48, within = q % 48;
        int n = ch * 16 + sidx;
        int pos = dir == 0 ? (n < CTXL ? SEQ + n : n - CTXL) : (STOT - 1 - n);
        lreg[ps] = *(const uint4*)(base + (size_t)pos * 384 + within * 8);
      }
    };
    auto lstore = [&](int buf) {
#pragma unroll
      for (int ps = 0; ps < 3; ++ps) {
        int q = tid + ps * 256;
        int sidx = q / 48, within = q % 48;
        float* dp = bufs + buf * 6144 + sidx * 384 + within * 8;
        uint4 u = lreg[ps];
        float4 lo = make_float4(__uint_as_float(u.x << 16), __uint_as_float(u.x & 0xffff0000u), __uint_as_float(u.y << 16), __uint_as_float(u.y & 0xffff0000u));
        float4 hi = make_float4(__uint_as_float(u.z << 16), __uint_as_float(u.z & 0xffff0000u), __uint_as_float(u.w << 16), __uint_as_float(u.w & 0xffff0000u));
        if (within < 8) {
          lo.x = __builtin_amdgcn_exp2f(lo.x); lo.y = __builtin_amdgcn_exp2f(lo.y); lo.z = __builtin_amdgcn_exp2f(lo.z); lo.w = __builtin_amdgcn_exp2f(lo.w);
          hi.x = __builtin_amdgcn_exp2f(hi.x); hi.y = __builtin_amdgcn_exp2f(hi.y); hi.z = __builtin_amdgcn_exp2f(hi.z); hi.w = __builtin_amdgcn_exp2f(hi.w);
        }
        *(float4*)dp = lo;
        *(float4*)(dp + 4) = hi;
      }
    };
    f32x2 S01 = {0.f, 0.f}, S23 = {0.f, 0.f};
    __syncthreads();
    gload(0);
    lstore(0);
    __syncthreads();
    constexpr int NCH = STOT / 16;
    for (int ch = 0; ch < NCH; ++ch) {
      if (ch + 1 < NCH) gload(ch + 1);
      const float* bp = bufs + (ch & 1) * 6144;
      const int n0 = ch * 16;
      const int pos0 = dir == 0 ? (n0 < CTXL ? SEQ + n0 : n0 - CTXL) : (STOT - 1 - n0);
      u16* yp = P2w + (size_t)bpos_row(b, pos0) * P2C + (dir == 0 ? YCOL0 : YCOL1) + h * 64 + irow;
      const int ystride = dir == 0 ? P2C : -P2C;
      float4 Wq[3], Kq[3], Nq[3], Bq[3], Rq[3];
      float Vq[3];
#define SCAN_LD(slot, st)                                        \
      do {                                                         \
        const float* sp_ = bp + (st) * 384;                        \
        Wq[slot] = *(const float4*)(sp_ + jl4);                    \
        Kq[slot] = *(const float4*)(sp_ + 64 + jl4);               \
        Nq[slot] = *(const float4*)(sp_ + 128 + jl4);              \
        Bq[slot] = *(const float4*)(sp_ + 192 + jl4);              \
        Rq[slot] = *(const float4*)(sp_ + 256 + jl4);              \
        Vq[slot] = sp_[320 + irow];                                \
      } while (0)
      SCAN_LD(0, 0);
      SCAN_LD(1, 1);
      SCAN_LD(2, 2);
      float ypart = 0.f;
#pragma unroll
      for (int s = 0; s < 16; ++s) {
        const int sl = s % 3;
        const float4 wv = Wq[sl], kt = Kq[sl], kk = Nq[sl], bb = Bq[sl], rr = Rq[sl];
        const float v = Vq[sl];
        if (s + 3 < 16) SCAN_LD(sl, s + 3);
        const f32x2 vv = {v, v};
        f32x2 A01 = S01 * f32x2{wv.x, wv.y} + vv * f32x2{kt.x, kt.y};
        f32x2 A23 = S23 * f32x2{wv.z, wv.w} + vv * f32x2{kt.z, kt.w};
        f32x2 pp = S01 * f32x2{kk.x, kk.y} + S23 * f32x2{kk.z, kk.w};
        float sa = pp.x + pp.y;
        float yprev = ypart;
        row16_sum2(sa, yprev);
        if (s > 0) { if ((lane & 15) == 0) yp[(s - 1) * ystride] = f2bf(yprev); }
        const f32x2 nsa = {-sa, -sa};
        S01 = nsa * f32x2{bb.x, bb.y} + A01;
        S23 = nsa * f32x2{bb.z, bb.w} + A23;
        f32x2 yy = S01 * f32x2{rr.x, rr.y} + S23 * f32x2{rr.z, rr.w};
        ypart = yy.x + yy.y;
      }
      {
        float ylast = row16_sum(ypart);
        if ((lane & 15) == 0) yp[15 * ystride] = f2bf(ylast);
      }
#undef SCAN_LD
      if (ch + 1 < NCH) lstore((ch + 1) & 1);
      __syncthreads();
    }
  }
}

__device__ __forceinline__ void phase_scan_attn(const Params& p, int l, unsigned char* smem) {
  const int G = gridDim.x, tid = TIDX(), bid = BIDX();
  if (G > 128 && G <= 2048) {
    int* keys = (int*)smem;
    int* red = keys + 2048;
    const int* cutab = (const int*)(p.ws + OFF_CUTAB);
    __syncthreads();
    for (int i = tid; i < G; i += 256) keys[i] = cutab[i];
    if (tid == 0) { red[0] = 0; red[1] = 0; }
    __syncthreads();
    for (int i = 128 + tid; i < G; i += 256) {
      const int ki = keys[i];
      bool m = false;
      for (int j = 0; j < 128; ++j) m = m || (keys[j] == ki);
      if (!m) atomicAdd(&red[0], 1);
      if (m && i == bid) red[1] = 1;
    }
    __syncthreads();
    const int eligible = red[0], mine = red[1];
    __syncthreads();
    if (bid < 128) {
      __builtin_amdgcn_s_setprio(3);
      wscan_item(p, bid, smem);
      __builtin_amdgcn_s_setprio(0);
    } else if (eligible < 64 || !mine) {
      attn_worker(p, l, smem);
    }
  } else {
    for (int item = bid; item < 128; item += G) wscan_item(p, item, smem);
    attn_worker(p, l, smem);
  }
}

__device__ __forceinline__ void phase_wfin(const Params& p, int l, unsigned char* smem) {
  const int tid = TIDX(), col = tid;
  const u16* P2 = (const u16*)(p.ws + OFF_P2);
  const u16* prep = (const u16*)(p.ws + OFF_PREP);
  u16* concat = (u16*)(p.ws + OFF_H);
  float* sgT = (float*)smem;
  float* gateL = sgT + 128 * 16;
  const float* g2 = p.g2 + (size_t)l * 128 * 256 + col;
  const int j = tid & 31, tsub = tid >> 5, head = j >> 3, c8 = (j & 7) * 8, ch0 = head * 64 + c8;
  float lng[8], lnb[8], rho[2][8];
#pragma unroll
  for (int e = 0; e < 8; ++e) {
    lng[e] = p.ln_g[(size_t)l * 256 + ch0 + e];
    lnb[e] = p.ln_b[(size_t)l * 256 + ch0 + e];
    rho[0][e] = p.rho[((size_t)l * 2 + 0) * 256 + ch0 + e];
    rho[1][e] = p.rho[((size_t)l * 2 + 1) * 256 + ch0 + e];
  }
  for (int item = BIDX(); item < TALL / 16; item += gridDim.x) {
    const int row0 = item * 16;
    __syncthreads();
    {
      const int tok = tid >> 4, k0 = (tid & 15) * 8;
      bf16x8 g = *(const bf16x8*)(P2 + (size_t)(row0 + tok) * P2C + 1280 + k0);
#pragma unroll
      for (int e = 0; e < 8; ++e) sgT[(k0 + e) * 16 + tok] = sigmoidf_(bf2f((u16)g[e]));
    }
    __syncthreads();
    float acc[16];
#pragma unroll
    for (int t = 0; t < 16; ++t) acc[t] = 0.f;
#pragma unroll 1
    for (int k0 = 0; k0 < 128; k0 += 4) {
      float gv8[4];
#pragma unroll
      for (int u = 0; u < 4; ++u) gv8[u] = g2[(k0 + u) * 256];
#pragma unroll
      for (int u = 0; u < 4; ++u) {
        const int k = k0 + u;
        const float gv = gv8[u];
#pragma unroll
        for (int t4 = 0; t4 < 4; ++t4) {
          float4 a = *(const float4*)(sgT + k * 16 + t4 * 4);
          acc[t4 * 4 + 0] += a.x * gv; acc[t4 * 4 + 1] += a.y * gv; acc[t4 * 4 + 2] += a.z * gv; acc[t4 * 4 + 3] += a.w * gv;
        }
      }
    }
#pragma unroll
    for (int t = 0; t < 16; ++t) gateL[t * 256 + col] = acc[t];
    __syncthreads();
#pragma unroll
    for (int pass = 0; pass < 2; ++pass) {
      const int tok = pass * 8 + tsub, row = row0 + tok;
      int b, pos;
      row_bpos(row, b, pos);
      float tot[8];
#pragma unroll
      for (int e = 0; e < 8; ++e) tot[e] = 0.f;
#pragma unroll
      for (int dir = 0; dir < 2; ++dir) {
        const bf16x8 y8 = *(const bf16x8*)(P2 + (size_t)row * P2C + (dir == 0 ? YCOL0 : YCOL1) + ch0);
        const u16* pp = prep + (((size_t)(b * 4 + head) * 2 + dir) * STOT + pos) * 384 + c8;
        const bf16x8 kt8 = *(const bf16x8*)(pp + 64), r8 = *(const bf16x8*)(pp + 256), v8 = *(const bf16x8*)(pp + 320);
        float y[8], s1 = 0.f, s3 = 0.f;
#pragma unroll
        for (int e = 0; e < 8; ++e) {
          y[e] = bf2f((u16)y8[e]);
          s1 += y[e];
          s3 += bf2f((u16)r8[e]) * bf2f((u16)kt8[e]) * rho[dir][e];
        }
        s1 = half8_sum(s1);
        s3 = half8_sum(s3);
        const float mu = s1 * (1.f / 64.f);
        float s2 = 0.f;
#pragma unroll
        for (int e = 0; e < 8; ++e) { y[e] -= mu; s2 += y[e] * y[e]; }
        s2 = half8_sum(s2);
        const float rstd = rsqrtf(s2 * (1.f / 64.f) + GN_EPS);
#pragma unroll
        for (int e = 0; e < 8; ++e) tot[e] += y[e] * rstd * lng[e] + lnb[e] + s3 * bf2f((u16)v8[e]);
      }
      const float4 g0 = *(const float4*)(gateL + tok * 256 + ch0), g1 = *(const float4*)(gateL + tok * 256 + ch0 + 4);
      bf16x8 o = cat8(pack4(tot[0] * g0.x, tot[1] * g0.y, tot[2] * g0.z, tot[3] * g0.w),
                      pack4(tot[4] * g1.x, tot[5] * g1.y, tot[6] * g1.z, tot[7] * g1.w));
      *(bf16x8*)(concat + (size_t)row * D + 768 + ch0) = o;
    }
  }
}

constexpr int N_PHASES = 1 + 2 * 16 + 1;
__device__ __forceinline__ void run_phase(const Params& p_in, int ph, unsigned char* smem) {
  Params p = p_in;
  {
    unsigned long long w = (unsigned long long)p.ws;
    asm volatile("" : "+s"(w));
    p.ws = (unsigned char*)w;
  }
  if (ph == 0) { phase_init(p, smem); return; }
  if (ph == N_PHASES - 1) { phase_final_norm(p); return; }
  const int l = (ph - 1) / 16, s = (ph - 1) % 16;
  float* xc = (float*)(p.ws + OFF_XC);
  const float* lat_in = (l == 0 && s < 3) ? p.x : p.out;
  const float* cx_in = (l == 0 && s < 3) ? p.ctx : xc;
  const u16* H = (const u16*)(p.ws + OFF_H);
  const u16* ACT = (const u16*)(p.ws + OFF_P2);
  switch (s) {
    case 0: phase_norm(p, l, 0, lat_in, cx_in); break;
    case 1: phase_ffn_in(p, l, 0, smem); break;
    case 2: phase_resid_gemm(p, l, ACT, (const u16*)(p.ws + OFF_WFFO) + (size_t)0 * 1024 * DFF, DFF, 2, 0.5f, lat_in, cx_in, p.out, xc, smem); break;
    case 3: phase_norm(p, l, 1, p.out, xc); break;
    case 4: phase_inproj(p, l, smem); break;
    case 5: phase_retU(p, smem); break;
    case 6: phase_retscan(p); break;
    case 7: phase_retout(p, l, smem); break;
    case 8: phase_wprep(p, l, smem); break;
    case 9: phase_scan_attn(p, l, smem); break;
    case 10: phase_wfin(p, l, smem); break;
    case 11: phase_resid_gemm(p, l, H, (const u16*)(p.ws + OFF_WOUT), 1024, 5, 1.0f, p.out, xc, p.out, xc, smem); break;
    case 12: phase_norm(p, l, 2, p.out, xc); break;
    case 13: phase_ffn_in(p, l, 1, smem); break;
    case 14: phase_resid_gemm(p, l, ACT, (const u16*)(p.ws + OFF_WFFO) + (size_t)1 * 1024 * DFF, DFF, 8, 0.5f, p.out, xc, p.out, xc, smem); break;
    default: if (l == 0) convert_weights(p, 1, smem); break;
  }
}

#if MULTI_LAUNCH
__global__ void __launch_bounds__(256, 2) k_phase(Params p, int ph) {
  __shared__ __attribute__((aligned(16))) unsigned char smem[49152];
  run_phase(p, ph, smem);
}
#else
constexpr int SMEM_BYTES = 65536;
__global__ void __launch_bounds__(256, 2) k_mega(Params p) {
  __shared__ __attribute__((aligned(16))) unsigned char smem[SMEM_BYTES];
  cg::grid_group grid = cg::this_grid();
  volatile LAS unsigned* st = (volatile LAS unsigned*)(smem + SMEM_BYTES - 16);
  if (threadIdx.x == 0) { st[0] = 0u; st[1] = 0u; }
  __syncthreads();
  {
    unsigned* bw = (unsigned*)(p.ws + OFF_BAR);
    for (int i = blockIdx.x * 256 + threadIdx.x; i < XCD_BAR_WORDS; i += gridDim.x * 256) bw[i] = 0u;
  }
  grid.sync();
  XcdBarrier xb = xcd_barrier_post((unsigned*)(p.ws + OFF_BAR), st);
  run_phase(p, 0, smem);
  xcd_barrier(xb);
#pragma unroll 1
  for (int l = 0; l < 2; ++l) {
#pragma unroll 1
    for (int s = 0; s < 16 - l; ++s) {
      run_phase(p, 1 + l * 16 + s, smem);
      xcd_barrier(xb);
#ifdef PROBE_REPEAT
      if ((PROBE_REPEAT >> s) & 1) {
        run_phase(p, 1 + l * 16 + s, smem);
        xcd_barrier(xb);
      }
#endif
    }
  }
  run_phase(p, N_PHASES - 1, smem);
}
#endif

extern "C" void kernel_launch(void* const* d_in, const int* in_sizes, int n_in, void* d_out, int out_size, void* d_ws,
                              size_t ws_size, hipStream_t stream) {
  Params p{};
  const float** pp = (const float**)&p;
  for (int i = 0; i < 26; ++i) pp[i] = (const float*)d_in[i];
  p.out = (float*)d_out;
  p.ws = (unsigned char*)d_ws;
#if MULTI_LAUNCH
  for (int ph = 0; ph < N_PHASES; ++ph) {
    if (ph > 0 && ((ph - 1) % 16) == 15 && ph != N_PHASES - 1) continue;
    k_phase<<<dim3(512), dim3(256), 0, stream>>>(p, ph);
  }
#else
  static int grid_blocks = 0;
  if (!grid_blocks) {
    int dev = 0, cus = 0, per_cu = 0;
    hipGetDevice(&dev);
    hipDeviceGetAttribute(&cus, hipDeviceAttributeMultiprocessorCount, dev);
    hipOccupancyMaxActiveBlocksPerMultiprocessor(&per_cu, k_mega, 256, 0);
    if (per_cu > 2) per_cu = 2;
    grid_blocks = cus * per_cu;
  }
  void* args[] = {&p};
  hipError_t e = hipLaunchCooperativeKernel((void*)k_mega, dim3(grid_blocks), dim3(256), args, 0, stream);
  if (e != hipSuccess) fprintf(stderr, "cooperative launch failed: %s (grid %d)\n", hipGetErrorString(e), grid_blocks);
#endif
}
```

```cpp
#include <hip/hip_runtime.h>
#include <hip/hip_bf16.h>
#include <hip/hip_cooperative_groups.h>
#include <cstdio>
namespace cg = cooperative_groups;

#ifndef MULTI_LAUNCH
#define MULTI_LAUNCH 0
#endif

typedef unsigned short u16;
using bf16x8 = __attribute__((ext_vector_type(8))) short;
using bf16x4 = __attribute__((ext_vector_type(4))) short;
using f32x4 = __attribute__((ext_vector_type(4))) float;

constexpr int D = 1024;
constexpr int TLAT = 32768;
constexpr int TCTX = 1024;
constexpr int TALL = TLAT + TCTX;
constexpr int SEQ = 8192;
constexpr int CTXL = 256;
constexpr int STOT = SEQ + CTXL;
constexpr int DFF = 2816;
constexpr int PC = 3456;
constexpr int P2C = 1664;
constexpr int NMOD = 9 * D;
constexpr float LOG2E = 1.4426950408889634f;
constexpr float RMS_EPS = 1e-6f;
constexpr float GN_EPS = 64e-5f;

constexpr size_t MiB = 1ull << 20;
constexpr size_t OFF_WFFI = 0;
constexpr size_t OFF_WFFO = 22 * MiB;
constexpr size_t OFF_WIN = 33 * MiB;
constexpr size_t OFF_WOUT = OFF_WIN + 27 * MiB / 4;
constexpr size_t OFF_MOD = OFF_WOUT + 2 * MiB;
constexpr size_t OFF_BAR = OFF_MOD + 384 * 1024;
constexpr size_t OFF_QCTR = OFF_MOD + 400 * 1024;
constexpr size_t OFF_CUTAB = OFF_QCTR + 256;
constexpr size_t OFF_ROPE = OFF_MOD + MiB / 2;
constexpr size_t OFF_XC = OFF_ROPE + 5 * MiB / 2;
constexpr size_t OFF_H = OFF_XC + 4 * MiB;
constexpr size_t OFF_P2 = OFF_H + 66 * MiB;
constexpr size_t OFF_BIG = OFF_P2 + 429 * MiB / 4;
constexpr size_t SZ_Q = (size_t)TALL * 256 * 2;
constexpr size_t SZ_KV2 = (size_t)4 * 2 * STOT * 64 * 2;
constexpr size_t SZ_KV4 = (size_t)4 * 4 * STOT * 64 * 2;
constexpr size_t OFF_QA = OFF_BIG;
constexpr size_t OFF_QB = OFF_QA + SZ_Q;
constexpr size_t OFF_KA = OFF_QB + SZ_Q;
constexpr size_t OFF_VA = OFF_KA + SZ_KV2;
constexpr size_t OFF_KB = OFF_VA + SZ_KV2;
constexpr size_t OFF_VB = OFF_KB + SZ_KV2;
constexpr size_t OFF_R0 = OFF_VB + SZ_KV2;
constexpr size_t OFF_QR = OFF_R0;
constexpr size_t OFF_KR = OFF_QR + SZ_Q;
constexpr size_t OFF_VR = OFF_KR + SZ_KV4;
constexpr size_t OFF_U = OFF_VR + SZ_KV4;
constexpr size_t OFF_SP = OFF_U + (size_t)16 * 66 * 2 * 4096 * 4;
constexpr size_t OFF_PREP = OFF_R0;
constexpr size_t WS_END = OFF_PREP + (size_t)32 * STOT * 384 * 2;
constexpr int YCOL0 = 768, YCOL1 = 1408;
static_assert(WS_END <= 512 * MiB, "workspace overflow");
static_assert(OFF_SP + (size_t)16 * 66 * 2 * 4096 * 2 <= 512 * MiB, "workspace overflow");
static_assert(OFF_P2 + (size_t)TALL * DFF * 2 <= 512 * MiB, "act overflow");

struct Params {
  const float *x, *c, *ctx, *c_ctx, *w_mod, *b_mod, *norm_g, *ffn_w_in, *ffn_w_out, *w_in, *w_out, *attn_sink, *qk_g,
      *ret_g, *mu, *w0, *w2, *a0, *a2, *rho, *k_k, *k_a, *g2, *ln_g, *ln_b, *final_g;
  float* out;
  unsigned char* ws;
};

__device__ __forceinline__ int TIDX() { int t = threadIdx.x; asm volatile("" : "+v"(t)); return t & 255; }
__device__ __forceinline__ int BIDX() { int t = blockIdx.x; asm volatile("" : "+s"(t)); return t; }
typedef float f32x2_t __attribute__((ext_vector_type(2)));
typedef __bf16 bf16x2_t __attribute__((ext_vector_type(2)));
__device__ __forceinline__ unsigned pk2bf(float a, float b) {
  f32x2_t v = {a, b};
  return __builtin_bit_cast(unsigned, __builtin_convertvector(v, bf16x2_t));
}
__device__ __forceinline__ u16 f2bf(float f) { return (u16)(pk2bf(f, 0.f) & 0xffffu); }
__device__ __forceinline__ float bf2f(u16 h) { return __uint_as_float(((unsigned)h) << 16); }
__device__ __forceinline__ float sigmoidf_(float x) { return __builtin_amdgcn_rcpf(1.f + __expf(-x)); }
__device__ __forceinline__ float siluf_(float x) { return x * __builtin_amdgcn_rcpf(1.f + __expf(-x)); }
__device__ __forceinline__ float tanhf_(float x) { return 1.f - 2.f * __builtin_amdgcn_rcpf(__expf(2.f * x) + 1.f); }
template <int CTRL>
__device__ __forceinline__ float dpp_f(float x) {
  return __builtin_bit_cast(float, __builtin_amdgcn_update_dpp(0, __builtin_bit_cast(int, x), CTRL, 0xf, 0xf, true));
}
__device__ __forceinline__ float row16_sum(float x) {
  x += dpp_f<0xB1>(x);
  x += dpp_f<0x4E>(x);
  x += dpp_f<0x141>(x);
  x += dpp_f<0x140>(x);
  return x;
}
__device__ __forceinline__ float wave_sum(float x) {
  x = row16_sum(x);
  x += __builtin_bit_cast(float, __builtin_amdgcn_update_dpp(0, __builtin_bit_cast(int, x), 0x142, 0xa, 0xf, false));
  x += __builtin_bit_cast(float, __builtin_amdgcn_update_dpp(0, __builtin_bit_cast(int, x), 0x143, 0xc, 0xf, false));
  return __builtin_bit_cast(float, __builtin_amdgcn_readlane(__builtin_bit_cast(int, x), 63));
}
__device__ __forceinline__ float half8_sum(float x) {
  x += dpp_f<0xB1>(x);
  x += dpp_f<0x4E>(x);
  x += dpp_f<0x141>(x);
  return x;
}
__device__ __forceinline__ void row16_sum2(float& a, float& b) {
  a += dpp_f<0xB1>(a);  b += dpp_f<0xB1>(b);
  a += dpp_f<0x4E>(a);  b += dpp_f<0x4E>(b);
  a += dpp_f<0x141>(a); b += dpp_f<0x141>(b);
  a += dpp_f<0x140>(a); b += dpp_f<0x140>(b);
}
__device__ __forceinline__ bf16x4 pack4(float a, float b, float c, float d) {
  uint2 u = make_uint2(pk2bf(a, b), pk2bf(c, d));
  return __builtin_bit_cast(bf16x4, u);
}
__device__ __forceinline__ bf16x8 cat8(bf16x4 a, bf16x4 b) {
  bf16x8 r;
  r[0] = a[0]; r[1] = a[1]; r[2] = a[2]; r[3] = a[3]; r[4] = b[0]; r[5] = b[1]; r[6] = b[2]; r[7] = b[3];
  return r;
}
__device__ __forceinline__ const float* rrow(const float* lat, const float* cx, int r) {
  return r < TLAT ? lat + (size_t)r * D : cx + (size_t)(r - TLAT) * D;
}
__device__ __forceinline__ float* wrow(float* lat, float* cx, int r) {
  return r < TLAT ? lat + (size_t)r * D : cx + (size_t)(r - TLAT) * D;
}
__device__ __forceinline__ int mod_index(int r) { return r < TLAT ? (r >> 13) : 4; }
__device__ __forceinline__ void row_bpos(int r, int& b, int& pos) {
  if (r < TLAT) { b = r >> 13; pos = r & 8191; }
  else { int rc = r - TLAT; b = rc >> 8; pos = SEQ + (rc & 255); }
}
__device__ __forceinline__ int bpos_row(int b, int pos) {
  return pos < SEQ ? b * SEQ + pos : TLAT + b * CTXL + (pos - SEQ);
}


#define XB_TMO      128
#define XB_XCNT(j)  (256  + 64 * (j))
#define XB_XSUB(j)  (1280 + 64 * (j))
#define XB_XGEN(j)  (2304 + 64 * (j))
#define XB_TOP      3328
#define XB_TOPGEN   3392
#define XCD_BAR_WORDS 3456
#define XB_SPIN_CAP (1u << 18)
#define LAS __attribute__((address_space(3)))
__device__ __forceinline__ unsigned xb_ld(unsigned* p) { return __hip_atomic_load(p, __ATOMIC_RELAXED, __HIP_MEMORY_SCOPE_AGENT); }
__device__ __forceinline__ unsigned xb_add(unsigned* p, unsigned v) { return __hip_atomic_fetch_add(p, v, __ATOMIC_RELAXED, __HIP_MEMORY_SCOPE_AGENT); }
__device__ __forceinline__ unsigned xb_xcc_id() { return (unsigned)__builtin_amdgcn_s_getreg((3 << 11) | 20) & 0xFu; }
#define XB_SPIN(cond, bar) do { unsigned _sp = 0; while (cond) { __builtin_amdgcn_s_sleep(1); \
    if ((++_sp & 255u) == 0u) { if (xb_ld(&(bar)[XB_TMO])) break; if (_sp > XB_SPIN_CAP) { atomicAdd(&(bar)[XB_TMO], 1u); break; } } } } while (0)
struct XcdBarrier { unsigned* bar; unsigned x; volatile LAS unsigned* st; };
__device__ __forceinline__ XcdBarrier xcd_barrier_post(unsigned* bar, volatile LAS unsigned* st) {
  XcdBarrier b; b.bar = bar; b.x = xb_xcc_id(); b.st = st;
  if (threadIdx.x == 0) (void)xb_add(&bar[XB_XCNT(b.x)], 1u);
  return b;
}
__device__ __forceinline__ void xcd_barrier_complete(unsigned* bar, unsigned x, unsigned& nloc, unsigned& nx) {
  const unsigned G = gridDim.x * gridDim.y * gridDim.z;
  unsigned sum, cnt, mine, sp = 0u;
  for (;;) {
    sum = 0u; cnt = 0u; mine = 0u;
#pragma unroll
    for (unsigned j = 0; j < 16; ++j) { const unsigned c = xb_ld(&bar[XB_XCNT(j)]); sum += c; cnt += (c > 0u) ? 1u : 0u; mine = (j == x) ? c : mine; }
    if (sum == G) break;
    __builtin_amdgcn_s_sleep(1);
    if ((++sp & 255u) == 0u) { if (xb_ld(&bar[XB_TMO])) break; if (sp > XB_SPIN_CAP) { atomicAdd(&bar[XB_TMO], 1u); break; } }
  }
  nloc = mine > 0u ? mine : 1u; nx = cnt > 0u ? cnt : 1u;
}
__device__ __forceinline__ void xcd_barrier(const XcdBarrier& b) {
  asm volatile("s_waitcnt vmcnt(0)" ::: "memory");
  __syncthreads();
  if (threadIdx.x == 0) {
    unsigned* bar = b.bar;
    __builtin_amdgcn_s_waitcnt(0);
    unsigned nloc = b.st[0], nx = b.st[1];
    if (nloc == 0u) { xcd_barrier_complete(bar, b.x, nloc, nx); b.st[0] = nloc; b.st[1] = nx; }
    const unsigned old = xb_add(&bar[XB_XSUB(b.x)], 1u);
    const unsigned gen = old / nloc;
    if (old + 1u == (gen + 1u) * nloc) {
      __builtin_amdgcn_fence(__ATOMIC_RELEASE, "agent");
      asm volatile("s_waitcnt vmcnt(0)" ::: "memory");
      const unsigned og = xb_add(&bar[XB_TOP], 1u);
      const unsigned tg = og / nx;
      if (og + 1u == (tg + 1u) * nx) xb_add(&bar[XB_TOPGEN], 1u);
      else XB_SPIN(xb_ld(&bar[XB_TOPGEN]) == tg, bar);
      __builtin_amdgcn_fence(__ATOMIC_ACQUIRE, "agent");
      xb_add(&bar[XB_XGEN(b.x)], 1u);
      asm volatile("s_waitcnt vmcnt(0)" ::: "memory");
    } else {
      XB_SPIN(xb_ld(&bar[XB_XGEN(b.x)]) == gen, bar);
      __builtin_amdgcn_fence(__ATOMIC_ACQUIRE, "agent");
      asm volatile("s_waitcnt vmcnt(0)" ::: "memory");
    }
  }
  __syncthreads();
}

__device__ __forceinline__ void convert_weights(const Params& p, int layer, unsigned char* smem) {
  const int tid = TIDX();
  const int nb = gridDim.x, bid = BIDX();
  {
    float* tile = (float*)smem;
    constexpr int N_FFI = 2 * 16 * 88, N_FFO = 2 * 44 * 16, N_WIN = 16 * 54, N_WOUT = 16 * 16;
    for (int item = bid; item < N_FFI + N_FFO + N_WIN + N_WOUT; item += nb) {
      const float* src; u16* dst; int K, N, kt, nt; bool perm = false;
      int it = item;
      if (it < N_FFI) {
        int f = it / (16 * 88); it %= (16 * 88);
        K = 1024; N = 5632; kt = it / 88; nt = it % 88; perm = true;
        src = p.ffn_w_in + (size_t)(layer * 2 + f) * 1024 * 5632;
        dst = (u16*)(p.ws + OFF_WFFI) + (size_t)f * 5632 * 1024;
      } else if (it < N_FFI + N_FFO) {
        it -= N_FFI;
        int f = it / (44 * 16); it %= (44 * 16);
        K = 2816; N = 1024; kt = it / 16; nt = it % 16;
        src = p.ffn_w_out + (size_t)(layer * 2 + f) * 2816 * 1024;
        dst = (u16*)(p.ws + OFF_WFFO) + (size_t)f * 1024 * 2816;
      } else if (it < N_FFI + N_FFO + N_WIN) {
        it -= N_FFI + N_FFO;
        K = 1024; N = 3456; kt = it / 54; nt = it % 54;
        src = p.w_in + (size_t)layer * 1024 * 3456;
        dst = (u16*)(p.ws + OFF_WIN);
      } else {
        it -= N_FFI + N_FFO + N_WIN;
        K = 1024; N = 1024; kt = it / 16; nt = it % 16;
        src = p.w_out + (size_t)layer * 1024 * 1024;
        dst = (u16*)(p.ws + OFF_WOUT);
      }
      __syncthreads();
      {
        const int r = tid >> 4, c4 = tid & 15;
        int np = nt * 64 + c4 * 4;
        int scol = np;
        if (perm) {
          int blk = np >> 7, sub = (np & 127) >> 4, i = np & 15;
          scol = ((sub & 1) ? DFF : 0) + blk * 64 + (sub >> 1) * 16 + i;
        }
#pragma unroll
        for (int ps = 0; ps < 4; ++ps) {
          int k = kt * 64 + ps * 16 + r;
          float4 v = *(const float4*)(src + (size_t)k * N + scol);
          float* tp = tile + (ps * 16 + r) * 65 + c4 * 4;
          tp[0] = v.x; tp[1] = v.y; tp[2] = v.z; tp[3] = v.w;
        }
      }
      __syncthreads();
      {
        const int n = tid >> 2, kq = tid & 3;
        bf16x8 o0, o1;
#pragma unroll
        for (int i = 0; i < 8; ++i) {
          o0[i] = (short)f2bf(tile[(kq * 16 + i) * 65 + n]);
          o1[i] = (short)f2bf(tile[(kq * 16 + 8 + i) * 65 + n]);
        }
        u16* dp = dst + (size_t)(nt * 64 + n) * K + kt * 64 + kq * 16;
        *(bf16x8*)dp = o0;
        *(bf16x8*)(dp + 8) = o1;
      }
    }
    __syncthreads();
  }
}

__device__ __forceinline__ void phase_init(const Params& p, unsigned char* smem) {
  const int tid = TIDX();
  const int nb = gridDim.x, bid = BIDX();
  if (bid == 0 && tid < 2) ((int*)(p.ws + OFF_QCTR))[tid] = 0;
  if (tid == 0) {
    const int hw = __builtin_amdgcn_s_getreg((7 << 11) | (8 << 6) | 4);
    const int xcc = __builtin_amdgcn_s_getreg((3 << 11) | 20) & 0xF;
    ((int*)(p.ws + OFF_CUTAB))[bid] = (xcc << 8) | (hw & 0xFF);
  }
  {
    float2* seq = (float2*)(p.ws + OFF_ROPE);
    float2* rowt = seq + 8192 * 32;
    float2* colt = rowt + 128 * 16;
    for (int i = bid * 256 + tid; i < 8192 * 32 + 128 * 16 + 64 * 16; i += nb * 256) {
      float ang;
      float2* dst;
      if (i < 8192 * 32) {
        int t = i >> 5, k = i & 31;
        float inv = 1.0f / powf(10000.0f, (float)(2 * k) / 64.0f);
        ang = (float)t * inv;
        dst = seq + i;
      } else {
        int j = i - 8192 * 32;
        int pidx = (j < 128 * 16) ? (j >> 4) : ((j - 128 * 16) >> 4);
        int k = j & 15;
        float inv = 1.0f / powf(10000.0f, (float)(2 * k) / 32.0f);
        ang = (float)pidx * inv;
        dst = rowt + j;
      }
      *dst = make_float2(cosf(ang), sinf(ang));
    }
    (void)colt;
  }
  {
    float* sc = (float*)smem;
    float* red = sc + 5 * 1024;
    for (int item = bid; item < 288; item += nb) {
      const int l = item / 144, cb = item % 144;
      __syncthreads();
      for (int i = tid; i < 5 * 1024; i += 256) {
        int m = i >> 10, k = i & 1023;
        float v = (m < 4) ? p.c[m * 1024 + k] : p.c_ctx[k];
        sc[i] = siluf_(v);
      }
      __syncthreads();
      const int cq = tid & 15, kg = tid >> 4;
      float acc[5][4];
#pragma unroll
      for (int m = 0; m < 5; ++m)
#pragma unroll
        for (int q = 0; q < 4; ++q) acc[m][q] = 0.f;
      const float* wbase = p.w_mod + (size_t)l * 1024 * NMOD + cb * 64 + cq * 4;
      for (int kk = 0; kk < 64; ++kk) {
        int k = kg * 64 + kk;
        float4 w4 = *(const float4*)(wbase + (size_t)k * NMOD);
#pragma unroll
        for (int m = 0; m < 5; ++m) {
          float s = sc[m * 1024 + k];
          acc[m][0] += s * w4.x; acc[m][1] += s * w4.y; acc[m][2] += s * w4.z; acc[m][3] += s * w4.w;
        }
      }
#pragma unroll
      for (int m = 0; m < 5; ++m)
#pragma unroll
        for (int q = 0; q < 4; ++q) red[(kg * 5 + m) * 64 + cq * 4 + q] = acc[m][q];
      __syncthreads();
      float* modp = (float*)(p.ws + OFF_MOD);
      for (int o = tid; o < 320; o += 256) {
        int m = o >> 6, cc = o & 63;
        float s = 0.f;
        for (int g = 0; g < 16; ++g) s += red[(g * 5 + m) * 64 + cc];
        int col = cb * 64 + cc;
        modp[((size_t)l * 5 + m) * NMOD + col] = s + p.b_mod[(size_t)l * NMOD + col];
      }
    }
    __syncthreads();
  }
  convert_weights(p, 0, smem);
}

__device__ __forceinline__ void phase_norm(const Params& p, int l, int which, const float* lat, const float* cx) {
  const int lane = TIDX() & 63, wid = TIDX() >> 6;
  u16* h = (u16*)(p.ws + OFF_H);
  const float* g = p.norm_g + ((size_t)l * 3 + which) * D;
  const float* modp = (const float*)(p.ws + OFF_MOD) + (size_t)l * 5 * NMOD;
  for (int r = BIDX() * 4 + wid; r < TALL; r += gridDim.x * 4) {
    const float* xr = rrow(lat, cx, r);
    const float* mp = modp + (size_t)mod_index(r) * NMOD + which * 3 * D;
    float4 v[4];
    float ss = 0.f;
#pragma unroll
    for (int i = 0; i < 4; ++i) {
      v[i] = *(const float4*)(xr + i * 256 + lane * 4);
      ss += v[i].x * v[i].x + v[i].y * v[i].y + v[i].z * v[i].z + v[i].w * v[i].w;
    }
    ss = wave_sum(ss);
    float rstd = rsqrtf(ss * (1.f / 1024.f) + RMS_EPS);
#pragma unroll
    for (int i = 0; i < 4; ++i) {
      int col = i * 256 + lane * 4;
      float4 gg = *(const float4*)(g + col);
      float4 sh = *(const float4*)(mp + col);
      float4 scl = *(const float4*)(mp + D + col);
      bf16x4 o = pack4(v[i].x * rstd * gg.x * (1.f + scl.x) + sh.x, v[i].y * rstd * gg.y * (1.f + scl.y) + sh.y,
                       v[i].z * rstd * gg.z * (1.f + scl.z) + sh.z, v[i].w * rstd * gg.w * (1.f + scl.w) + sh.w);
      *(bf16x4*)(h + (size_t)r * D + col) = o;
    }
  }
}

__device__ __forceinline__ void phase_final_norm(const Params& p) {
  const int lane = TIDX() & 63, wid = TIDX() >> 6;
  for (int r = BIDX() * 4 + wid; r < TLAT; r += gridDim.x * 4) {
    float* xr = p.out + (size_t)r * D;
    float4 v[4];
    float ss = 0.f;
#pragma unroll
    for (int i = 0; i < 4; ++i) {
      v[i] = *(const float4*)(xr + i * 256 + lane * 4);
      ss += v[i].x * v[i].x + v[i].y * v[i].y + v[i].z * v[i].z + v[i].w * v[i].w;
    }
    ss = wave_sum(ss);
    float rstd = rsqrtf(ss * (1.f / 1024.f) + RMS_EPS);
#pragma unroll
    for (int i = 0; i < 4; ++i) {
      int col = i * 256 + lane * 4;
      float4 gg = *(const float4*)(p.final_g + col);
      float4 o = make_float4(v[i].x * rstd * gg.x, v[i].y * rstd * gg.y, v[i].z * rstd * gg.z, v[i].w * rstd * gg.w);
      *(float4*)(xr + col) = o;
    }
  }
}

template <int MI>
__device__ __forceinline__ void gemm_mainloop(const u16* __restrict__ A, const u16* __restrict__ Bt, int K, int brow,
                                              int bcol, f32x4 (&acc)[MI][4], unsigned char* smem) {
  const int tid = TIDX(), wid = tid >> 6, lane = tid & 63, wr = wid >> 1, wc = wid & 1, fr = lane & 15, fq = lane >> 4;
  constexpr int BM = MI * 32;
  constexpr int ACH = BM * 4 / 256;
  constexpr int STAGE = BM * 64 + 8192;
#pragma unroll
  for (int m = 0; m < MI; ++m)
#pragma unroll
    for (int n = 0; n < 4; ++n) acc[m][n] = f32x4{0.f, 0.f, 0.f, 0.f};
  const int nk = K / 32;
  const int prow = tid >> 2, pq = ((tid & 3) ^ ((0x78 >> (((tid >> 4) & 3) * 2)) & 3)) * 8;
  const u16* ga = A + (size_t)(brow + prow) * K + pq;
  const u16* gb = Bt + (size_t)(bcol + prow) * K + pq;
  auto stage = [&](int t, int buf) {
    unsigned char* base = smem + buf * STAGE;
#pragma unroll
    for (int i = 0; i < ACH; ++i)
      __builtin_amdgcn_global_load_lds((const unsigned*)(ga + (size_t)i * 64 * K + t * 32),
                                       (__attribute__((address_space(3))) unsigned*)(base + (tid + i * 256) * 16), 16, 0, 0);
#pragma unroll
    for (int i = 0; i < 2; ++i)
      __builtin_amdgcn_global_load_lds((const unsigned*)(gb + (size_t)i * 64 * K + t * 32),
                                       (__attribute__((address_space(3))) unsigned*)(base + BM * 64 + (tid + i * 256) * 16), 16, 0, 0);
  };
  const int swz = (fq ^ ((0x78 >> (((fr >> 2) & 3) * 2)) & 3)) * 16;
  __syncthreads();
  stage(0, 0);
  for (int t = 0; t < nk; ++t) {
    __syncthreads();
    if (t + 1 < nk) stage(t + 1, (t + 1) & 1);
    const unsigned char* base = smem + (t & 1) * STAGE;
    bf16x8 af[MI], bfr[4];
#pragma unroll
    for (int m = 0; m < MI; ++m) af[m] = *(const bf16x8*)(base + (wr * MI * 16 + m * 16 + fr) * 64 + swz);
#pragma unroll
    for (int n = 0; n < 4; ++n) bfr[n] = *(const bf16x8*)(base + BM * 64 + (wc * 64 + n * 16 + fr) * 64 + swz);
#pragma unroll
    for (int m = 0; m < MI; ++m)
#pragma unroll
      for (int n = 0; n < 4; ++n) acc[m][n] = __builtin_amdgcn_mfma_f32_16x16x32_bf16(af[m], bfr[n], acc[m][n], 0, 0, 0);
  }
}

__device__ __forceinline__ bool next_tile(int it, int MT, int NT, int& tm, int& tn) {
  const int G = gridDim.x, b = BIDX();
  const int total = MT * NT;
  int id;
  if ((G & 7) == 0) {
    const int per = G >> 3;
    id = it * G + (b & 7) * per + (b >> 3);
  } else {
    id = b + it * G;
  }
  if (id >= total) return false;
  constexpr int GM = 8;
  const int gsz = GM * NT;
  const int g = id / gsz, rem = id - g * gsz;
  const int rows = (MT - g * GM) < GM ? (MT - g * GM) : GM;
  tn = rem / rows;
  tm = g * GM + (rem - tn * rows);
  return true;
}

__device__ __forceinline__ void phase_ffn_in(const Params& p, int l, int f, unsigned char* smem) {
  const u16* A = (const u16*)(p.ws + OFF_H);
  const u16* Bt = (const u16*)(p.ws + OFF_WFFI) + (size_t)f * 5632 * 1024;
  u16* act = (u16*)(p.ws + OFF_P2);
  const int tid = TIDX(), wid = tid >> 6, lane = tid & 63, wr = wid >> 1, wc = wid & 1, fr = lane & 15, fq = lane >> 4;
  constexpr int MI = 8, NT = 44, MT = TALL / (MI * 32);
  for (int it = 0;; ++it) {
    int tm, tn;
    if (!next_tile(it, MT, NT, tm, tn)) break;
    f32x4 acc[MI][4];
    gemm_mainloop<MI>(A, Bt, 1024, tm * MI * 32, tn * 128, acc, smem);
#pragma unroll
    for (int m = 0; m < MI; ++m)
#pragma unroll
      for (int q = 0; q < 2; ++q)
#pragma unroll
        for (int j = 0; j < 4; ++j) {
          int row = tm * MI * 32 + wr * MI * 16 + m * 16 + fq * 4 + j;
          int col = tn * 64 + wc * 32 + q * 16 + fr;
          float u1 = acc[m][2 * q][j], u2 = acc[m][2 * q + 1][j];
          act[(size_t)row * DFF + col] = f2bf(siluf_(u1) * u2);
        }
  }
}

__device__ __forceinline__ void phase_resid_gemm(const Params& p, int l, const u16* A, const u16* Bt, int K, int gate, float gscale,
                                 const float* lat_in, const float* cx_in, float* lat_out, float* cx_out,
                                 unsigned char* smem) {
  const int tid = TIDX(), wid = tid >> 6, lane = tid & 63, wr = wid >> 1, wc = wid & 1, fr = lane & 15, fq = lane >> 4;
  constexpr int MI = 6, NT = 8, MT = TALL / (MI * 32);
  const float* modp = (const float*)(p.ws + OFF_MOD) + (size_t)l * 5 * NMOD + gate * D;
  for (int it = 0;; ++it) {
    int tm, tn;
    if (!next_tile(it, MT, NT, tm, tn)) break;
    f32x4 acc[MI][4];
    gemm_mainloop<MI>(A, Bt, K, tm * MI * 32, tn * 128, acc, smem);
#pragma unroll
    for (int m = 0; m < MI; ++m)
#pragma unroll
      for (int j = 0; j < 4; ++j) {
        int row = tm * MI * 32 + wr * MI * 16 + m * 16 + fq * 4 + j;
        const float* mp = modp + (size_t)mod_index(row) * NMOD;
        const float* xi = rrow(lat_in, cx_in, row);
        float* xo = wrow(lat_out, cx_out, row);
#pragma unroll
        for (int n = 0; n < 4; ++n) {
          int col = tn * 128 + wc * 64 + n * 16 + fr;
          xo[col] = xi[col] + gscale * mp[col] * acc[m][n][j];
        }
      }
  }
}

__device__ __forceinline__ void phase_inproj(const Params& p, int l, unsigned char* smem) {
  const u16* A = (const u16*)(p.ws + OFF_H);
  const u16* Bt = (const u16*)(p.ws + OFF_WIN);
  const int tid = TIDX(), wid = tid >> 6, lane = tid & 63, wr = wid >> 1, wc = wid & 1, fr = lane & 15, fq = lane >> 4;
  constexpr int MI = 8, NT = 27, MT = TALL / (MI * 32);
  const float2* ropeseq = (const float2*)(p.ws + OFF_ROPE);
  const float2* roperow = ropeseq + 8192 * 32;
  const float2* ropecol = roperow + 128 * 16;
  u16* QA = (u16*)(p.ws + OFF_QA); u16* QB = (u16*)(p.ws + OFF_QB); u16* QR = (u16*)(p.ws + OFF_QR);
  u16* KA = (u16*)(p.ws + OFF_KA); u16* VA = (u16*)(p.ws + OFF_VA);
  u16* KB = (u16*)(p.ws + OFF_KB); u16* VB = (u16*)(p.ws + OFF_VB);
  u16* KR = (u16*)(p.ws + OFF_KR); u16* VR = (u16*)(p.ws + OFF_VR);
  u16* P2 = (u16*)(p.ws + OFF_P2);
  for (int it = 0;; ++it) {
    int tm, tn;
    if (!next_tile(it, MT, NT, tm, tn)) break;
    f32x4 acc[MI][4];
    gemm_mainloop<MI>(A, Bt, 1024, tm * MI * 32, tn * 128, acc, smem);
    const int r0 = tm * MI * 32 + wr * MI * 16;
    const int c0 = tn * 128 + wc * 64;
    const bool latent = r0 < TLAT;
    if (c0 >= 1792) {
#pragma unroll
      for (int m = 0; m < MI; ++m)
#pragma unroll
        for (int n = 0; n < 4; ++n)
#pragma unroll
          for (int j = 0; j < 4; ++j) {
            int row = r0 + m * 16 + fq * 4 + j;
            P2[(size_t)row * P2C + (c0 - 1792) + n * 16 + fr] = f2bf(acc[m][n][j]);
          }
      continue;
    }
    int kind;
    int ropek;
    int normk;
    float scale = 1.f;
    u16* dst; int hh, nh;
    if (c0 < 256) { kind = 0; ropek = 1; normk = -1; scale = 0.125f * LOG2E; dst = QA; hh = c0 >> 6; nh = 4; }
    else if (c0 < 384) { kind = 1; ropek = 1; normk = -1; dst = KA; hh = (c0 - 256) >> 6; nh = 2; }
    else if (c0 < 512) { kind = 2; ropek = 0; normk = -1; dst = VA; hh = (c0 - 384) >> 6; nh = 2; }
    else if (c0 < 768) { kind = 0; ropek = 1; normk = 0; scale = 0.125f * LOG2E; dst = QB; hh = (c0 - 512) >> 6; nh = 4; }
    else if (c0 < 896) { kind = 1; ropek = 1; normk = 1; dst = KB; hh = (c0 - 768) >> 6; nh = 2; }
    else if (c0 < 1024) { kind = 2; ropek = 0; normk = -1; dst = VB; hh = (c0 - 896) >> 6; nh = 2; }
    else if (c0 < 1280) { kind = 0; ropek = 2; normk = -1; dst = QR; hh = (c0 - 1024) >> 6; nh = 4; }
    else if (c0 < 1536) { kind = 1; ropek = 2; normk = -1; scale = 0.125f; dst = KR; hh = (c0 - 1280) >> 6; nh = 4; }
    else { kind = 2; ropek = 0; normk = -1; dst = VR; hh = (c0 - 1536) >> 6; nh = 4; }
    if (!latent) ropek = 0;
    if (kind == 2) {
#pragma unroll
      for (int m = 0; m < MI; ++m) {
        int b, pos;
        row_bpos(r0 + m * 16 + fq * 4, b, pos);
#pragma unroll
        for (int n = 0; n < 4; ++n) {
          int d = n * 16 + fr;
          bf16x4 o = pack4(acc[m][n][0], acc[m][n][1], acc[m][n][2], acc[m][n][3]);
          *(bf16x4*)(dst + ((size_t)(b * nh + hh) * 64 + d) * STOT + pos) = o;
        }
      }
      continue;
    }
    float gq[4] = {1.f, 1.f, 1.f, 1.f};
    if (normk >= 0) {
#pragma unroll
      for (int n = 0; n < 4; ++n) gq[n] = p.qk_g[((size_t)l * 2 + normk) * 64 + n * 16 + fr];
    }
#pragma unroll
    for (int m = 0; m < MI; ++m)
#pragma unroll
      for (int j = 0; j < 4; ++j) {
        int row = r0 + m * 16 + fq * 4 + j;
        float v0 = acc[m][0][j], v1 = acc[m][1][j], v2 = acc[m][2][j], v3 = acc[m][3][j];
        if (normk >= 0) {
          float ss = v0 * v0 + v1 * v1 + v2 * v2 + v3 * v3;
          ss += __shfl_xor(ss, 1); ss += __shfl_xor(ss, 2); ss += __shfl_xor(ss, 4); ss += __shfl_xor(ss, 8);
          float rstd = rsqrtf(ss * (1.f / 64.f) + RMS_EPS);
          v0 *= rstd * gq[0]; v1 *= rstd * gq[1]; v2 *= rstd * gq[2]; v3 *= rstd * gq[3];
        }
        int b, pos;
        row_bpos(row, b, pos);
        if (ropek == 1) {
          float2 cr = roperow[(pos >> 6) * 16 + fr];
          float2 cc = ropecol[(pos & 63) * 16 + fr];
          float o0 = v0 * cr.x - v1 * cr.y, o1 = v1 * cr.x + v0 * cr.y;
          float o2 = v2 * cc.x - v3 * cc.y, o3 = v3 * cc.x + v2 * cc.y;
          v0 = o0; v1 = o1; v2 = o2; v3 = o3;
        } else if (ropek == 2) {
          float2 ca = ropeseq[pos * 32 + fr];
          float2 cb = ropeseq[pos * 32 + 16 + fr];
          float o0 = v0 * ca.x - v2 * ca.y, o2 = v2 * ca.x + v0 * ca.y;
          float o1 = v1 * cb.x - v3 * cb.y, o3 = v3 * cb.x + v1 * cb.y;
          v0 = o0; v1 = o1; v2 = o2; v3 = o3;
        }
        v0 *= scale; v1 *= scale; v2 *= scale; v3 *= scale;
        u16* dp;
        if (kind == 0) dp = dst + (size_t)row * 256 + hh * 64 + fr;
        else dp = dst + ((size_t)(b * nh + hh) * STOT + pos) * 64 + fr;
        dp[0] = f2bf(v0); dp[16] = f2bf(v1); dp[32] = f2bf(v2); dp[48] = f2bf(v3);
      }
  }
}

__device__ __forceinline__ void attn_item(const u16* __restrict__ Q, const u16* __restrict__ Kb, const u16* __restrict__ Vt,
                          u16* __restrict__ concat, int ccol0, int b, int kvh, int qrow0, int qpos0, int t0, int t1,
                          int c0, int c1, bool masked, const float* sink, unsigned char* smem) {
  const int tid = TIDX(), w = tid >> 6, lane = tid & 63, fr = lane & 15, fq = lane >> 4;
  const int head = kvh * 2 + (w & 1);
  const int qoff = (w >> 1) * 32;
  bf16x8 qf[2][2];
#pragma unroll
  for (int qg = 0; qg < 2; ++qg)
#pragma unroll
    for (int ks = 0; ks < 2; ++ks)
      qf[qg][ks] = *(const bf16x8*)(Q + (size_t)(qrow0 + qoff + qg * 16 + fr) * 256 + head * 64 + ks * 32 + fq * 8);
  f32x4 O[2][4];
  float mrow[2], lrow[2];
#pragma unroll
  for (int qg = 0; qg < 2; ++qg) {
    mrow[qg] = -1e30f; lrow[qg] = 0.f;
#pragma unroll
    for (int dt = 0; dt < 4; ++dt) O[qg][dt] = f32x4{0.f, 0.f, 0.f, 0.f};
  }
  const u16* Kbase = Kb + (size_t)(b * 2 + kvh) * STOT * 64;
  const u16* Vbase = Vt + (size_t)(b * 2 + kvh) * 64 * STOT;
  const int n1 = t1 - t0, total = n1 + (c1 - c0);
  bf16x8 kreg[2], vreg[2];
  auto gload = [&](int i) {
    int tile = i < n1 ? t0 + i : c0 + (i - n1);
#pragma unroll
    for (int ps = 0; ps < 2; ++ps) {
      int idx = tid + ps * 256;
      kreg[ps] = *(const bf16x8*)(Kbase + (size_t)tile * 4096 + idx * 8);
      int d = idx >> 3, ch = idx & 7;
      vreg[ps] = *(const bf16x8*)(Vbase + (size_t)d * STOT + tile * 64 + ch * 8);
    }
  };
  auto lstore = [&](int buf) {
    u16* Ks = (u16*)(smem + buf * 18432);
    u16* Vs = Ks + 64 * 72;
#pragma unroll
    for (int ps = 0; ps < 2; ++ps) {
      int idx = tid + ps * 256;
      int r = idx >> 3, ch = idx & 7;
      *(bf16x8*)(Ks + r * 72 + ch * 8) = kreg[ps];
      *(bf16x8*)(Vs + r * 72 + ch * 8) = vreg[ps];
    }
  };
  __syncthreads();
  gload(0);
  lstore(0);
  __syncthreads();
#pragma unroll 1
  for (int i = 0; i < total; ++i) {
    const int tile = i < n1 ? t0 + i : c0 + (i - n1);
    if (i + 1 < total) gload(i + 1);
    const u16* Ks = (const u16*)(smem + (i & 1) * 18432);
    const u16* Vs = Ks + 64 * 72;
    f32x4 s[2][4];
#pragma unroll
    for (int qg = 0; qg < 2; ++qg)
#pragma unroll
      for (int sub = 0; sub < 4; ++sub) s[qg][sub] = f32x4{0.f, 0.f, 0.f, 0.f};
#pragma unroll
    for (int sub = 0; sub < 4; ++sub)
#pragma unroll
      for (int ks = 0; ks < 2; ++ks) {
        bf16x8 a = *(const bf16x8*)(Ks + (sub * 16 + fr) * 72 + ks * 32 + fq * 8);
#pragma unroll
        for (int qg = 0; qg < 2; ++qg) s[qg][sub] = __builtin_amdgcn_mfma_f32_16x16x32_bf16(a, qf[qg][ks], s[qg][sub], 0, 0, 0);
      }
    __builtin_amdgcn_sched_barrier(0);
    const bool domask = masked && (tile < 128);
    bf16x8 pb[2][2];
#pragma unroll
    for (int qg = 0; qg < 2; ++qg) {
      if (domask) {
        int qpos = qpos0 + qoff + qg * 16 + fr;
#pragma unroll
        for (int sub = 0; sub < 4; ++sub)
#pragma unroll
          for (int j = 0; j < 4; ++j) {
            int kpos = tile * 64 + sub * 16 + fq * 4 + j;
            int dd = kpos - qpos;
            if (dd > 128 || dd < -128) s[qg][sub][j] = -INFINITY;
          }
      }
      float mx = -INFINITY;
#pragma unroll
      for (int sub = 0; sub < 4; ++sub)
#pragma unroll
        for (int j = 0; j < 4; ++j) mx = fmaxf(mx, s[qg][sub][j]);
      mx = fmaxf(mx, __shfl_xor(mx, 16));
      mx = fmaxf(mx, __shfl_xor(mx, 32));
      float mnew = fmaxf(mrow[qg], mx);
      const bool changed = mnew > mrow[qg];
      float alpha = __builtin_amdgcn_exp2f(mrow[qg] - mnew);
      mrow[qg] = mnew;
      float ps = 0.f;
#pragma unroll
      for (int sub = 0; sub < 4; ++sub)
#pragma unroll
        for (int j = 0; j < 4; ++j) {
          float pv = __builtin_amdgcn_exp2f(s[qg][sub][j] - mnew);
          s[qg][sub][j] = pv;
          ps += pv;
        }
      lrow[qg] = lrow[qg] * alpha + ps;
      if (__builtin_amdgcn_ballot_w64(changed) != 0ull) {
#pragma unroll
        for (int dt = 0; dt < 4; ++dt) O[qg][dt] *= alpha;
      }
#pragma unroll
      for (int ks = 0; ks < 2; ++ks)
        pb[qg][ks] = cat8(pack4(s[qg][2 * ks][0], s[qg][2 * ks][1], s[qg][2 * ks][2], s[qg][2 * ks][3]),
                          pack4(s[qg][2 * ks + 1][0], s[qg][2 * ks + 1][1], s[qg][2 * ks + 1][2], s[qg][2 * ks + 1][3]));
      __builtin_amdgcn_sched_barrier(0);
    }
#pragma unroll
    for (int dt = 0; dt < 4; ++dt)
#pragma unroll
      for (int ks = 0; ks < 2; ++ks) {
        const u16* vp = Vs + (dt * 16 + fr) * 72 + ks * 32 + fq * 4;
        bf16x8 va = cat8(*(const bf16x4*)vp, *(const bf16x4*)(vp + 16));
#pragma unroll
        for (int qg = 0; qg < 2; ++qg) O[qg][dt] = __builtin_amdgcn_mfma_f32_16x16x32_bf16(va, pb[qg][ks], O[qg][dt], 0, 0, 0);
      }
    __builtin_amdgcn_sched_barrier(0);
    if (i + 1 < total) lstore((i + 1) & 1);
    __syncthreads();
  }
#pragma unroll
  for (int qg = 0; qg < 2; ++qg) {
    float lt = lrow[qg];
    lt += __shfl_xor(lt, 16);
    lt += __shfl_xor(lt, 32);
    if (sink) lt += __builtin_amdgcn_exp2f(sink[head] * LOG2E - mrow[qg]);
    float inv = 1.f / lt;
    int row = qrow0 + qoff + qg * 16 + fr;
#pragma unroll
    for (int dt = 0; dt < 4; ++dt) {
      bf16x4 o = pack4(O[qg][dt][0] * inv, O[qg][dt][1] * inv, O[qg][dt][2] * inv, O[qg][dt][3] * inv);
      *(bf16x4*)(concat + (size_t)row * D + ccol0 + head * 64 + dt * 16 + fq * 4) = o;
    }
  }
}

__device__ __forceinline__ float ret_lg(int h) {
  return log2f(1.0f - exp2f(-5.0f - (float)h));
}

__device__ __forceinline__ void retU_item(const Params& p, int bh, int c, unsigned char* smem) {
  const int tid = TIDX();
  const int b = bh >> 2, h = bh & 3;
  const u16* KR = (const u16*)(p.ws + OFF_KR) + (size_t)bh * STOT * 64;
  const u16* VR = (const u16*)(p.ws + OFF_VR) + (size_t)bh * 64 * STOT;
  (void)b;
  const int pos0 = c < 64 ? c * 128 : SEQ + (c - 64) * 128;
  u16* Kc = (u16*)smem;
  u16* Vj = Kc + 128 * 64;
  __syncthreads();
#pragma unroll
  for (int ps = 0; ps < 4; ++ps) {
    int idx = tid + ps * 256;
    *(bf16x8*)(Kc + idx * 8) = *(const bf16x8*)(KR + (size_t)pos0 * 64 + idx * 8);
    int d = idx >> 4, ch = idx & 15;
    bf16x8 v = *(const bf16x8*)(VR + (size_t)d * STOT + pos0 + ch * 8);
#pragma unroll
    for (int e = 0; e < 8; ++e) Vj[(ch * 8 + e) * 72 + d] = (u16)v[e];
  }
  __syncthreads();
  const int dk = tid >> 2, dv0 = (tid & 3) * 16;
  const float lg = ret_lg(h);
  float af[16], ab[16];
#pragma unroll
  for (int q = 0; q < 16; ++q) { af[q] = 0.f; ab[q] = 0.f; }
  for (int j = 0; j < 128; ++j) {
    float kf = bf2f(Kc[j * 64 + dk]);
    float kfw = kf * exp2f(lg * (float)(127 - j));
    float kbw = kf * exp2f(lg * (float)j);
    bf16x8 v0 = *(const bf16x8*)(Vj + j * 72 + dv0);
    bf16x8 v1 = *(const bf16x8*)(Vj + j * 72 + dv0 + 8);
#pragma unroll
    for (int q = 0; q < 8; ++q) {
      float a = bf2f((u16)v0[q]), bb = bf2f((u16)v1[q]);
      af[q] += kfw * a; ab[q] += kbw * a;
      af[8 + q] += kfw * bb; ab[8 + q] += kbw * bb;
    }
  }
  float* U = (float*)(p.ws + OFF_U) + ((size_t)bh * 66 + c) * 2 * 4096;
#pragma unroll
  for (int q = 0; q < 16; ++q) {
    U[(dv0 + q) * 64 + dk] = af[q];
    U[4096 + (dv0 + q) * 64 + dk] = ab[q];
  }
}

__device__ __forceinline__ void phase_retU(const Params& p, unsigned char* smem) {
  for (int item = BIDX(); item < 16 * 66; item += gridDim.x) retU_item(p, item / 66, item % 66, smem);
}

__device__ __forceinline__ void attn_worker(const Params& p, int l, unsigned char* smem) {
  const u16* QA = (const u16*)(p.ws + OFF_QA); const u16* QB = (const u16*)(p.ws + OFF_QB);
  const u16* KA = (const u16*)(p.ws + OFF_KA); const u16* VA = (const u16*)(p.ws + OFF_VA);
  const u16* KB = (const u16*)(p.ws + OFF_KB); const u16* VB = (const u16*)(p.ws + OFF_VB);
  u16* concat = (u16*)(p.ws + OFF_H);
  const float* sink = p.attn_sink + l * 4;
  int* qctr = (int*)(p.ws + OFF_QCTR) + l;
  volatile int* slot = (volatile int*)(smem + 65536 - 32);
  for (;;) {
    __syncthreads();
    if (TIDX() == 0) *slot = atomicAdd(qctr, 1);
    __syncthreads();
    const int item = *slot;
    if (item >= 2112) break;
    const bool isB = item < 1024 || (item >= 2048 && item < 2080);
    const bool isctx = item >= 2048;
    int ii = item < 1024 ? item : item < 2048 ? item - 1024 : item < 2080 ? item - 2048 : item - 2080;
    int qt, kvh, b, qrow0, qpos0, t0, t1;
    if (!isctx) {
      qt = ii & 127; kvh = (ii >> 7) & 1; b = ii >> 8;
      qrow0 = b * SEQ + qt * 64; qpos0 = qt * 64;
      if (isB) { t0 = 0; t1 = 128; }
      else { t0 = qt - 2 < 0 ? 0 : qt - 2; t1 = qt + 3 > 128 ? 128 : qt + 3; }
    } else {
      qt = ii & 3; kvh = (ii >> 2) & 1; b = ii >> 3;
      qrow0 = TLAT + b * CTXL + qt * 64; qpos0 = 0; t0 = 0; t1 = 0;
    }
    attn_item(isB ? QB : QA, isB ? KB : KA, isB ? VB : VA, concat, isB ? 256 : 0, b, kvh, qrow0, qpos0, t0, t1, 128, 132,
              (!isB) && (!isctx), isB ? nullptr : sink, smem);
  }
}

__device__ __forceinline__ void phase_retscan(const Params& p) {
  const float* U = (const float*)(p.ws + OFF_U);
  u16* SP = (u16*)(p.ws + OFF_SP);
  for (int gid = BIDX() * 256 + TIDX(); gid < 16 * 2 * 4096; gid += gridDim.x * 256) {
    int e = gid & 4095, dir = (gid >> 12) & 1, bh = gid >> 13;
    float g128 = exp2f(128.f * ret_lg(bh & 3));
    float S = 0.f;
#pragma unroll 1
    for (int n0 = 0; n0 < 66; n0 += 11) {
      float u[11];
      size_t offs[11];
#pragma unroll
      for (int k = 0; k < 11; ++k) {
        int n = n0 + k;
        int c = dir == 0 ? (n < 2 ? 64 + n : n - 2) : 65 - n;
        offs[k] = (((size_t)bh * 66 + c) * 2 + dir) * 4096 + e;
        u[k] = U[offs[k]];
      }
#pragma unroll
      for (int k = 0; k < 11; ++k) {
        SP[offs[k]] = f2bf(S);
        S = g128 * S + u[k];
      }
    }
  }
}

__device__ __forceinline__ void retout_item(const Params& p, int l, int bh, int c, unsigned char* smem) {
  const int tid = TIDX(), w = tid >> 6, lane = tid & 63, fr = lane & 15, fq = lane >> 4;
  const int b = bh >> 2, h = bh & 3;
  const u16* QR = (const u16*)(p.ws + OFF_QR);
  const u16* KR = (const u16*)(p.ws + OFF_KR) + (size_t)bh * STOT * 64;
  const u16* VR = (const u16*)(p.ws + OFF_VR) + (size_t)bh * 64 * STOT;
  const u16* SP = (const u16*)(p.ws + OFF_SP) + ((size_t)bh * 66 + c) * 2 * 4096;
  const u16* P2 = (const u16*)(p.ws + OFF_P2);
  u16* concat = (u16*)(p.ws + OFF_H);
  const int pos0 = c < 64 ? c * 128 : SEQ + (c - 64) * 128;
  const int row0 = bpos_row(b, pos0);
  u16* Kc = (u16*)smem;
  u16* Vs = Kc + 128 * 72;
  __syncthreads();
#pragma unroll
  for (int ps = 0; ps < 4; ++ps) {
    int idx = tid + ps * 256;
    int r = idx >> 3, ch = idx & 7;
    *(bf16x8*)(Kc + r * 72 + ch * 8) = *(const bf16x8*)(KR + (size_t)(pos0 + r) * 64 + ch * 8);
    int d = idx >> 4, c16 = idx & 15;
    *(bf16x8*)(Vs + d * 136 + c16 * 8) = *(const bf16x8*)(VR + (size_t)d * STOT + pos0 + c16 * 8);
  }
  __syncthreads();
  const float lg = ret_lg(h);
#pragma unroll 1
  for (int qg = 0; qg < 2; ++qg) {
    const int i = w * 32 + qg * 16 + fr;
    const int row = row0 + i;
    bf16x8 qf[2];
#pragma unroll
    for (int ks = 0; ks < 2; ++ks) qf[ks] = *(const bf16x8*)(QR + (size_t)row * 256 + h * 64 + ks * 32 + fq * 8);
    f32x4 s[8];
#pragma unroll
    for (int sub = 0; sub < 8; ++sub) {
      s[sub] = f32x4{0.f, 0.f, 0.f, 0.f};
#pragma unroll
      for (int ks = 0; ks < 2; ++ks) {
        bf16x8 a = *(const bf16x8*)(Kc + (sub * 16 + fr) * 72 + ks * 32 + fq * 8);
        s[sub] = __builtin_amdgcn_mfma_f32_16x16x32_bf16(a, qf[ks], s[sub], 0, 0, 0);
      }
    }
    float res[4][4];
#pragma unroll
    for (int dt = 0; dt < 4; ++dt)
#pragma unroll
      for (int j = 0; j < 4; ++j) res[dt][j] = 0.f;
#pragma unroll 1
    for (int dir = 0; dir < 2; ++dir) {
      f32x4 O[4];
      const float qw = dir == 0 ? __builtin_amdgcn_exp2f(lg * (float)(i + 1)) : __builtin_amdgcn_exp2f(lg * (float)(128 - i));
#pragma unroll
      for (int dt = 0; dt < 4; ++dt) {
        O[dt] = f32x4{0.f, 0.f, 0.f, 0.f};
#pragma unroll
        for (int ks = 0; ks < 2; ++ks) {
          bf16x8 a = *(const bf16x8*)(SP + dir * 4096 + (dt * 16 + fr) * 64 + ks * 32 + fq * 8);
          O[dt] = __builtin_amdgcn_mfma_f32_16x16x32_bf16(a, qf[ks], O[dt], 0, 0, 0);
        }
        O[dt] *= qw;
      }
      int fqo = fq;
      asm volatile("" : "+v"(fqo));
#pragma unroll
      for (int ks = 0; ks < 4; ++ks) {
        float pv[8];
#pragma unroll
        for (int e = 0; e < 8; ++e) {
          const int sub = 2 * ks + (e >> 2), j = e & 3;
          const int jk = sub * 16 + fqo * 4 + j;
          const int dd = dir == 0 ? i - jk : jk - i;
          pv[e] = dd >= 0 ? s[sub][j] * __builtin_amdgcn_exp2f(lg * (float)dd) : 0.f;
        }
        bf16x8 pb = cat8(pack4(pv[0], pv[1], pv[2], pv[3]), pack4(pv[4], pv[5], pv[6], pv[7]));
#pragma unroll
        for (int dt = 0; dt < 4; ++dt) {
          const u16* vp = Vs + (dt * 16 + fr) * 136 + ks * 32 + fq * 4;
          bf16x8 va = cat8(*(const bf16x4*)vp, *(const bf16x4*)(vp + 16));
          O[dt] = __builtin_amdgcn_mfma_f32_16x16x32_bf16(va, pb, O[dt], 0, 0, 0);
        }
      }
      float sm = 0.f;
#pragma unroll
      for (int dt = 0; dt < 4; ++dt)
#pragma unroll
        for (int j = 0; j < 4; ++j) sm += O[dt][j];
      sm += __shfl_xor(sm, 16); sm += __shfl_xor(sm, 32);
      const float mu = sm * (1.f / 64.f);
      float vs = 0.f;
#pragma unroll
      for (int dt = 0; dt < 4; ++dt)
#pragma unroll
        for (int j = 0; j < 4; ++j) { float dlt = O[dt][j] - mu; vs += dlt * dlt; }
      vs += __shfl_xor(vs, 16); vs += __shfl_xor(vs, 32);
      const float rstd = rsqrtf(vs * (1.f / 64.f) + GN_EPS);
#pragma unroll
      for (int dt = 0; dt < 4; ++dt) {
        const int d = dt * 16 + fq * 4;
        bf16x4 gt = *(const bf16x4*)(P2 + (size_t)row * P2C + dir * 256 + h * 64 + d);
        float4 rg = *(const float4*)(p.ret_g + (size_t)l * 256 + h * 64 + d);
        res[dt][0] += (O[dt][0] - mu) * rstd * rg.x * siluf_(bf2f((u16)gt[0]));
        res[dt][1] += (O[dt][1] - mu) * rstd * rg.y * siluf_(bf2f((u16)gt[1]));
        res[dt][2] += (O[dt][2] - mu) * rstd * rg.z * siluf_(bf2f((u16)gt[2]));
        res[dt][3] += (O[dt][3] - mu) * rstd * rg.w * siluf_(bf2f((u16)gt[3]));
      }
    }
#pragma unroll
    for (int dt = 0; dt < 4; ++dt)
      *(bf16x4*)(concat + (size_t)row * D + 512 + h * 64 + dt * 16 + fq * 4) = pack4(res[dt][0], res[dt][1], res[dt][2], res[dt][3]);
  }
}

__device__ __forceinline__ void phase_retout(const Params& p, int l, unsigned char* smem) {
  for (int item = BIDX(); item < 16 * 66; item += gridDim.x) retout_item(p, l, item / 66, item % 66, smem);
}

__device__ __forceinline__ void phase_wprep(const Params& p, int l, unsigned char* smem) {
  const int tid = TIDX(), col = tid;
  const u16* P2 = (const u16*)(p.ws + OFF_P2);
  u16* prep = (u16*)(p.ws + OFF_PREP);
  float* twT = (float*)smem;
  float* amT = twT + 64 * 16;
  float* outW = amT + 64 * 16;
  float* outA = outW + 16 * 256;
  const int j = tid & 31, tsub = tid >> 5, head = j >> 3, c8 = (j & 7) * 8, ch0 = head * 64 + c8;
  float kkv[8], kav[8];
#pragma unroll
  for (int e = 0; e < 8; ++e) { kkv[e] = p.k_k[(size_t)l * 256 + ch0 + e]; kav[e] = p.k_a[(size_t)l * 256 + ch0 + e]; }
  for (int item = BIDX(); item < (TALL / 16) * 2; item += gridDim.x) {
    const int dir = item & 1, row0 = (item >> 1) * 16;
    const float* mu = p.mu + ((size_t)l * 2 + dir) * 896;
    __syncthreads();
    {
      const int tok = tid >> 4, e0 = (tid & 15) * 4;
      const int row = row0 + tok;
      int b, pos;
      row_bpos(row, b, pos);
      bool has;
      int nrow;
      if (dir == 0) { has = (pos != 0) && (pos != SEQ); nrow = row - 1; }
      else { has = (pos != SEQ - 1) && (pos != STOT - 1); nrow = row + 1; }
      const int srow = has ? nrow : row;
      bf16x4 zw = *(const bf16x4*)(P2 + (size_t)row * P2C + 1408 + dir * 64 + e0);
      bf16x4 za = *(const bf16x4*)(P2 + (size_t)row * P2C + 1536 + dir * 64 + e0);
      bf16x4 sw = *(const bf16x4*)(P2 + (size_t)srow * P2C + 1408 + dir * 64 + e0);
      bf16x4 sa = *(const bf16x4*)(P2 + (size_t)srow * P2C + 1536 + dir * 64 + e0);
#pragma unroll
      for (int e = 0; e < 4; ++e) {
        float z = bf2f((u16)zw[e]), zs = has ? bf2f((u16)sw[e]) : 0.f;
        twT[(e0 + e) * 16 + tok] = tanhf_(z + mu[768 + e0 + e] * (zs - z));
        float z2 = bf2f((u16)za[e]), zs2 = has ? bf2f((u16)sa[e]) : 0.f;
        amT[(e0 + e) * 16 + tok] = z2 + mu[832 + e0 + e] * (zs2 - z2);
      }
    }
    __syncthreads();
    {
      float accw[16], acca[16];
#pragma unroll
      for (int t = 0; t < 16; ++t) { accw[t] = 0.f; acca[t] = 0.f; }
      const float* w2 = p.w2 + ((size_t)l * 2 + dir) * 64 * 256 + col;
      const float* a2 = p.a2 + ((size_t)l * 2 + dir) * 64 * 256 + col;
#pragma unroll 1
      for (int k0 = 0; k0 < 64; k0 += 4) {
        float wv8[4], av8[4];
#pragma unroll
        for (int u = 0; u < 4; ++u) { wv8[u] = w2[(k0 + u) * 256]; av8[u] = a2[(k0 + u) * 256]; }
#pragma unroll
        for (int u = 0; u < 4; ++u) {
          const int kq = k0 + u;
          const float wv = wv8[u], av = av8[u];
#pragma unroll
          for (int t4 = 0; t4 < 4; ++t4) {
            float4 a = *(const float4*)(twT + kq * 16 + t4 * 4);
            float4 bq = *(const float4*)(amT + kq * 16 + t4 * 4);
            accw[t4 * 4 + 0] += a.x * wv; accw[t4 * 4 + 1] += a.y * wv; accw[t4 * 4 + 2] += a.z * wv; accw[t4 * 4 + 3] += a.w * wv;
            acca[t4 * 4 + 0] += bq.x * av; acca[t4 * 4 + 1] += bq.y * av; acca[t4 * 4 + 2] += bq.z * av; acca[t4 * 4 + 3] += bq.w * av;
          }
        }
      }
      const float w0v = p.w0[((size_t)l * 2 + dir) * 256 + col], a0v = p.a0[((size_t)l * 2 + dir) * 256 + col];
#pragma unroll
      for (int t = 0; t < 16; ++t) {
        outW[t * 256 + col] = -0.6065306597126334f * sigmoidf_(w0v + accw[t]) * LOG2E;
        outA[t * 256 + col] = sigmoidf_(a0v + acca[t]);
      }
    }
    __syncthreads();
    {
      float mur[8], muk[8], muv[8];
#pragma unroll
      for (int e = 0; e < 8; ++e) { mur[e] = mu[ch0 + e]; muk[e] = mu[256 + ch0 + e]; muv[e] = mu[512 + ch0 + e]; }
#pragma unroll
      for (int pass = 0; pass < 2; ++pass) {
        const int tok = pass * 8 + tsub, row = row0 + tok;
        int b, pos;
        row_bpos(row, b, pos);
        bool has;
        int nrow;
        if (dir == 0) { has = (pos != 0) && (pos != SEQ); nrow = row - 1; }
        else { has = (pos != SEQ - 1) && (pos != STOT - 1); nrow = row + 1; }
        const u16* cp = P2 + (size_t)row * P2C + 512 + ch0;
        const u16* np = P2 + (size_t)(has ? nrow : row) * P2C + 512 + ch0;
        const bf16x8 zr8 = *(const bf16x8*)cp, zk8 = *(const bf16x8*)(cp + 256), zv8 = *(const bf16x8*)(cp + 512);
        const bf16x8 sr8 = *(const bf16x8*)np, sk8 = *(const bf16x8*)(np + 256), sv8 = *(const bf16x8*)(np + 512);
        const float4 lw0 = *(const float4*)(outW + tok * 256 + ch0), lw1 = *(const float4*)(outW + tok * 256 + ch0 + 4);
        const float4 av0 = *(const float4*)(outA + tok * 256 + ch0), av1 = *(const float4*)(outA + tok * 256 + ch0 + 4);
        const float lw[8] = {lw0.x, lw0.y, lw0.z, lw0.w, lw1.x, lw1.y, lw1.z, lw1.w};
        const float av[8] = {av0.x, av0.y, av0.z, av0.w, av1.x, av1.y, av1.z, av1.w};
        float r[8], k[8], v[8], kkr[8], ss = 0.f;
#pragma unroll
        for (int e = 0; e < 8; ++e) {
          float zr = bf2f((u16)zr8[e]), zk = bf2f((u16)zk8[e]), zv = bf2f((u16)zv8[e]);
          float sr = has ? bf2f((u16)sr8[e]) : 0.f, sk = has ? bf2f((u16)sk8[e]) : 0.f, sv = has ? bf2f((u16)sv8[e]) : 0.f;
          r[e] = zr + mur[e] * (sr - zr); k[e] = zk + muk[e] * (sk - zk); v[e] = zv + muv[e] * (sv - zv);
          kkr[e] = k[e] * kkv[e];
          ss += kkr[e] * kkr[e];
        }
        ss = half8_sum(ss);
        const float rs = rsqrtf(fmaxf(ss, 1e-24f));
        float kt[8], kk[8], bb[8];
#pragma unroll
        for (int e = 0; e < 8; ++e) {
          kk[e] = kkr[e] * rs;
          kt[e] = k[e] * (1.f + (av[e] - 1.f) * kav[e]);
          bb[e] = kk[e] * av[e];
        }
        u16* dp = prep + (((size_t)(b * 4 + head) * 2 + dir) * STOT + pos) * 384 + c8;
        *(bf16x8*)(dp) = cat8(pack4(lw[0], lw[1], lw[2], lw[3]), pack4(lw[4], lw[5], lw[6], lw[7]));
        *(bf16x8*)(dp + 64) = cat8(pack4(kt[0], kt[1], kt[2], kt[3]), pack4(kt[4], kt[5], kt[6], kt[7]));
        *(bf16x8*)(dp + 128) = cat8(pack4(kk[0], kk[1], kk[2], kk[3]), pack4(kk[4], kk[5], kk[6], kk[7]));
        *(bf16x8*)(dp + 192) = cat8(pack4(bb[0], bb[1], bb[2], bb[3]), pack4(bb[4], bb[5], bb[6], bb[7]));
        *(bf16x8*)(dp + 256) = cat8(pack4(r[0], r[1], r[2], r[3]), pack4(r[4], r[5], r[6], r[7]));
        *(bf16x8*)(dp + 320) = cat8(pack4(v[0], v[1], v[2], v[3]), pack4(v[4], v[5], v[6], v[7]));
      }
    }
  }
}

typedef float f32x2 __attribute__((ext_vector_type(2)));
__device__ __forceinline__ void wscan_item(const Params& p, int item, unsigned char* smem) {
  const int tid = TIDX(), w = tid >> 6, lane = tid & 63;
  const int jl4 = (lane & 15) * 4, rsub = lane >> 4;
  const u16* prep = (const u16*)(p.ws + OFF_PREP);
  u16* P2w = (u16*)(p.ws + OFF_P2);
  float* bufs = (float*)smem;
  {
    const int rq = item & 3, seq = item >> 2;
    const int dir = seq & 1, h = (seq >> 1) & 3, b = seq >> 3;
    const int irow = rq * 16 + w * 4 + rsub;
    const u16* base = prep + (size_t)seq * STOT * 384;
    uint4 lreg[3];
    auto gload = [&](int ch) {
#pragma unroll
      for (int ps = 0; ps < 3; ++ps) {
        int q = tid + ps * 256;
        int sidx = q / 48, within = q % 48;
        int n = ch * 16 + sidx;
        int pos = dir == 0 ? (n < CTXL ? SEQ + n : n - CTXL) : (STOT - 1 - n);
        lreg[ps] = *(const uint4*)(base + (size_t)pos * 384 + within * 8);
      }
    };
    auto lstore = [&](int buf) {
#pragma unroll
      for (int ps = 0; ps < 3; ++ps) {
        int q = tid + ps * 256;
        int sidx = q / 48, within = q % 48;
        float* dp = bufs + buf * 6144 + sidx * 384 + within * 8;
        uint4 u = lreg[ps];
        float4 lo = make_float4(__uint_as_float(u.x << 16), __uint_as_float(u.x & 0xffff0000u), __uint_as_float(u.y << 16), __uint_as_float(u.y & 0xffff0000u));
        float4 hi = make_float4(__uint_as_float(u.z << 16), __uint_as_float(u.z & 0xffff0000u), __uint_as_float(u.w << 16), __uint_as_float(u.w & 0xffff0000u));
        if (within < 8) {
          lo.x = __builtin_amdgcn_exp2f(lo.x); lo.y = __builtin_amdgcn_exp2f(lo.y); lo.z = __builtin_amdgcn_exp2f(lo.z); lo.w = __builtin_amdgcn_exp2f(lo.w);
          hi.x = __builtin_amdgcn_exp2f(hi.x); hi.y = __builtin_amdgcn_exp2f(hi.y); hi.z = __builtin_amdgcn_exp2f(hi.z); hi.w = __builtin_amdgcn_exp2f(hi.w);
        }
        *(float4*)dp = lo;
        *(float4*)(dp + 4) = hi;
      }
    };
    f32x2 S01 = {0.f, 0.f}, S23 = {0.f, 0.f};
    __syncthreads();
    gload(0);
    lstore(0);
    __syncthreads();
    constexpr int NCH = STOT / 16;
    for (int ch = 0; ch < NCH; ++ch) {
      if (ch + 1 < NCH) gload(ch + 1);
      const float* bp = bufs + (ch & 1) * 6144;
      const int n0 = ch * 16;
      const int pos0 = dir == 0 ? (n0 < CTXL ? SEQ + n0 : n0 - CTXL) : (STOT - 1 - n0);
      u16* yp = P2w + (size_t)bpos_row(b, pos0) * P2C + (dir == 0 ? YCOL0 : YCOL1) + h * 64 + irow;
      const int ystride = dir == 0 ? P2C : -P2C;
      float4 Wq[3], Kq[3], Nq[3], Bq[3], Rq[3];
      float Vq[3];
#define SCAN_LD(slot, st)                                        \
      do {                                                         \
        const float* sp_ = bp + (st) * 384;                        \
        Wq[slot] = *(const float4*)(sp_ + jl4);                    \
        Kq[slot] = *(const float4*)(sp_ + 64 + jl4);               \
        Nq[slot] = *(const float4*)(sp_ + 128 + jl4);              \
        Bq[slot] = *(const float4*)(sp_ + 192 + jl4);              \
        Rq[slot] = *(const float4*)(sp_ + 256 + jl4);              \
        Vq[slot] = sp_[320 + irow];                                \
      } while (0)
      SCAN_LD(0, 0);
      SCAN_LD(1, 1);
      SCAN_LD(2, 2);
      float ypart = 0.f;
#pragma unroll
      for (int s = 0; s < 16; ++s) {
        const int sl = s % 3;
        const float4 wv = Wq[sl], kt = Kq[sl], kk = Nq[sl], bb = Bq[sl], rr = Rq[sl];
        const float v = Vq[sl];
        if (s + 3 < 16) SCAN_LD(sl, s + 3);
        const f32x2 vv = {v, v};
        f32x2 A01 = S01 * f32x2{wv.x, wv.y} + vv * f32x2{kt.x, kt.y};
        f32x2 A23 = S23 * f32x2{wv.z, wv.w} + vv * f32x2{kt.z, kt.w};
        f32x2 pp = S01 * f32x2{kk.x, kk.y} + S23 * f32x2{kk.z, kk.w};
        float sa = pp.x + pp.y;
        float yprev = ypart;
        row16_sum2(sa, yprev);
        if (s > 0) { if ((lane & 15) == 0) yp[(s - 1) * ystride] = f2bf(yprev); }
        const f32x2 nsa = {-sa, -sa};
        S01 = nsa * f32x2{bb.x, bb.y} + A01;
        S23 = nsa * f32x2{bb.z, bb.w} + A23;
        f32x2 yy = S01 * f32x2{rr.x, rr.y} + S23 * f32x2{rr.z, rr.w};
        ypart = yy.x + yy.y;
      }
      {
        float ylast = row16_sum(ypart);
        if ((lane & 15) == 0) yp[15 * ystride] = f2bf(ylast);
      }
#undef SCAN_LD
      if (ch + 1 < NCH) lstore((ch + 1) & 1);
      __syncthreads();
    }
  }
}

__device__ __forceinline__ void phase_scan_attn(const Params& p, int l, unsigned char* smem) {
  const int G = gridDim.x, tid = TIDX(), bid = BIDX();
  if (G > 128 && G <= 2048) {
    int* keys = (int*)smem;
    int* red = keys + 2048;
    const int* cutab = (const int*)(p.ws + OFF_CUTAB);
    __syncthreads();
    for (int i = tid; i < G; i += 256) keys[i] = cutab[i];
    if (tid == 0) { red[0] = 0; red[1] = 0; }
    __syncthreads();
    for (int i = 128 + tid; i < G; i += 256) {
      const int ki = keys[i];
      bool m = false;
      for (int j = 0; j < 128; ++j) m = m || (keys[j] == ki);
      if (!m) atomicAdd(&red[0], 1);
      if (m && i == bid) red[1] = 1;
    }
    __syncthreads();
    const int eligible = red[0], mine = red[1];
    __syncthreads();
    if (bid < 128) {
      __builtin_amdgcn_s_setprio(3);
      wscan_item(p, bid, smem);
      __builtin_amdgcn_s_setprio(0);
    } else if (eligible < 64 || !mine) {
      attn_worker(p, l, smem);
    }
  } else {
    for (int item = bid; item < 128; item += G) wscan_item(p, item, smem);
    attn_worker(p, l, smem);
  }
}

__device__ __forceinline__ void phase_wfin(const Params& p, int l, unsigned char* smem) {
  const int tid = TIDX(), col = tid;
  const u16* P2 = (const u16*)(p.ws + OFF_P2);
  const u16* prep = (const u16*)(p.ws + OFF_PREP);
  u16* concat = (u16*)(p.ws + OFF_H);
  float* sgT = (float*)smem;
  float* gateL = sgT + 128 * 16;
  const float* g2 = p.g2 + (size_t)l * 128 * 256 + col;
  const int j = tid & 31, tsub = tid >> 5, head = j >> 3, c8 = (j & 7) * 8, ch0 = head * 64 + c8;
  float lng[8], lnb[8], rho[2][8];
#pragma unroll
  for (int e = 0; e < 8; ++e) {
    lng[e] = p.ln_g[(size_t)l * 256 + ch0 + e];
    lnb[e] = p.ln_b[(size_t)l * 256 + ch0 + e];
    rho[0][e] = p.rho[((size_t)l * 2 + 0) * 256 + ch0 + e];
    rho[1][e] = p.rho[((size_t)l * 2 + 1) * 256 + ch0 + e];
  }
  for (int item = BIDX(); item < TALL / 16; item += gridDim.x) {
    const int row0 = item * 16;
    __syncthreads();
    {
      const int tok = tid >> 4, k0 = (tid & 15) * 8;
      bf16x8 g = *(const bf16x8*)(P2 + (size_t)(row0 + tok) * P2C + 1280 + k0);
#pragma unroll
      for (int e = 0; e < 8; ++e) sgT[(k0 + e) * 16 + tok] = sigmoidf_(bf2f((u16)g[e]));
    }
    __syncthreads();
    float acc[16];
#pragma unroll
    for (int t = 0; t < 16; ++t) acc[t] = 0.f;
#pragma unroll 1
    for (int k0 = 0; k0 < 128; k0 += 16) {
      float gv8[16];
#pragma unroll
      for (int u = 0; u < 16; ++u) gv8[u] = g2[(k0 + u) * 256];
#pragma unroll
      for (int u = 0; u < 16; ++u) {
        const int k = k0 + u;
        const float gv = gv8[u];
#pragma unroll
        for (int t4 = 0; t4 < 4; ++t4) {
          float4 a = *(const float4*)(sgT + k * 16 + t4 * 4);
          acc[t4 * 4 + 0] += a.x * gv; acc[t4 * 4 + 1] += a.y * gv; acc[t4 * 4 + 2] += a.z * gv; acc[t4 * 4 + 3] += a.w * gv;
        }
      }
    }
#pragma unroll
    for (int t = 0; t < 16; ++t) gateL[t * 256 + col] = acc[t];
    __syncthreads();
#pragma unroll
    for (int pass = 0; pass < 2; ++pass) {
      const int tok = pass * 8 + tsub, row = row0 + tok;
      int b, pos;
      row_bpos(row, b, pos);
      float tot[8];
#pragma unroll
      for (int e = 0; e < 8; ++e) tot[e] = 0.f;
#pragma unroll
      for (int dir = 0; dir < 2; ++dir) {
        const bf16x8 y8 = *(const bf16x8*)(P2 + (size_t)row * P2C + (dir == 0 ? YCOL0 : YCOL1) + ch0);
        const u16* pp = prep + (((size_t)(b * 4 + head) * 2 + dir) * STOT + pos) * 384 + c8;
        const bf16x8 kt8 = *(const bf16x8*)(pp + 64), r8 = *(const bf16x8*)(pp + 256), v8 = *(const bf16x8*)(pp + 320);
        float y[8], s1 = 0.f, s3 = 0.f;
#pragma unroll
        for (int e = 0; e < 8; ++e) {
          y[e] = bf2f((u16)y8[e]);
          s1 += y[e];
          s3 += bf2f((u16)r8[e]) * bf2f((u16)kt8[e]) * rho[dir][e];
        }
        s1 = half8_sum(s1);
        s3 = half8_sum(s3);
        const float mu = s1 * (1.f / 64.f);
        float s2 = 0.f;
#pragma unroll
        for (int e = 0; e < 8; ++e) { y[e] -= mu; s2 += y[e] * y[e]; }
        s2 = half8_sum(s2);
        const float rstd = rsqrtf(s2 * (1.f / 64.f) + GN_EPS);
#pragma unroll
        for (int e = 0; e < 8; ++e) tot[e] += y[e] * rstd * lng[e] + lnb[e] + s3 * bf2f((u16)v8[e]);
      }
      const float4 g0 = *(const float4*)(gateL + tok * 256 + ch0), g1 = *(const float4*)(gateL + tok * 256 + ch0 + 4);
      bf16x8 o = cat8(pack4(tot[0] * g0.x, tot[1] * g0.y, tot[2] * g0.z, tot[3] * g0.w),
                      pack4(tot[4] * g1.x, tot[5] * g1.y, tot[6] * g1.z, tot[7] * g1.w));
      *(bf16x8*)(concat + (size_t)row * D + 768 + ch0) = o;
    }
  }
}

constexpr int N_PHASES = 1 + 2 * 16 + 1;
__device__ __forceinline__ void run_phase(const Params& p_in, int ph, unsigned char* smem) {
  Params p = p_in;
  {
    unsigned long long w = (unsigned long long)p.ws;
    asm volatile("" : "+s"(w));
    p.ws = (unsigned char*)w;
  }
  if (ph == 0) { phase_init(p, smem); return; }
  if (ph == N_PHASES - 1) { phase_final_norm(p); return; }
  const int l = (ph - 1) / 16, s = (ph - 1) % 16;
  float* xc = (float*)(p.ws + OFF_XC);
  const float* lat_in = (l == 0 && s < 3) ? p.x : p.out;
  const float* cx_in = (l == 0 && s < 3) ? p.ctx : xc;
  const u16* H = (const u16*)(p.ws + OFF_H);
  const u16* ACT = (const u16*)(p.ws + OFF_P2);
  switch (s) {
    case 0: phase_norm(p, l, 0, lat_in, cx_in); break;
    case 1: phase_ffn_in(p, l, 0, smem); break;
    case 2: phase_resid_gemm(p, l, ACT, (const u16*)(p.ws + OFF_WFFO) + (size_t)0 * 1024 * DFF, DFF, 2, 0.5f, lat_in, cx_in, p.out, xc, smem); break;
    case 3: phase_norm(p, l, 1, p.out, xc); break;
    case 4: phase_inproj(p, l, smem); break;
    case 5: phase_retU(p, smem); break;
    case 6: phase_retscan(p); break;
    case 7: phase_retout(p, l, smem); break;
    case 8: phase_wprep(p, l, smem); break;
    case 9: phase_scan_attn(p, l, smem); break;
    case 10: phase_wfin(p, l, smem); break;
    case 11: phase_resid_gemm(p, l, H, (const u16*)(p.ws + OFF_WOUT), 1024, 5, 1.0f, p.out, xc, p.out, xc, smem); break;
    case 12: phase_norm(p, l, 2, p.out, xc); break;
    case 13: phase_ffn_in(p, l, 1, smem); break;
    case 14: phase_resid_gemm(p, l, ACT, (const u16*)(p.ws + OFF_WFFO) + (size_t)1 * 1024 * DFF, DFF, 8, 0.5f, p.out, xc, p.out, xc, smem); break;
    default: if (l == 0) convert_weights(p, 1, smem); break;
  }
}

#if MULTI_LAUNCH
__global__ void __launch_bounds__(256, 2) k_phase(Params p, int ph) {
  __shared__ __attribute__((aligned(16))) unsigned char smem[49152];
  run_phase(p, ph, smem);
}
#else
constexpr int SMEM_BYTES = 65536;
__global__ void __launch_bounds__(256, 2) k_mega(Params p) {
  __shared__ __attribute__((aligned(16))) unsigned char smem[SMEM_BYTES];
  cg::grid_group grid = cg::this_grid();
  volatile LAS unsigned* st = (volatile LAS unsigned*)(smem + SMEM_BYTES - 16);
  if (threadIdx.x == 0) { st[0] = 0u; st[1] = 0u; }
  __syncthreads();
  {
    unsigned* bw = (unsigned*)(p.ws + OFF_BAR);
    for (int i = blockIdx.x * 256 + threadIdx.x; i < XCD_BAR_WORDS; i += gridDim.x * 256) bw[i] = 0u;
  }
  grid.sync();
  XcdBarrier xb = xcd_barrier_post((unsigned*)(p.ws + OFF_BAR), st);
  run_phase(p, 0, smem);
  xcd_barrier(xb);
#pragma unroll 1
  for (int l = 0; l < 2; ++l) {
#pragma unroll 1
    for (int s = 0; s < 16 - l; ++s) {
      run_phase(p, 1 + l * 16 + s, smem);
      xcd_barrier(xb);
#ifdef PROBE_REPEAT
      if ((PROBE_REPEAT >> s) & 1) {
        run_phase(p, 1 + l * 16 + s, smem);
        xcd_barrier(xb);
      }
#endif
    }
  }
  run_phase(p, N_PHASES - 1, smem);
}
#endif

extern "C" void kernel_launch(void* const* d_in, const int* in_sizes, int n_in, void* d_out, int out_size, void* d_ws,
                              size_t ws_size, hipStream_t stream) {
  Params p{};
  const float** pp = (const float**)&p;
  for (int i = 0; i < 26; ++i) pp[i] = (const float*)d_in[i];
  p.out = (float*)d_out;
  p.ws = (unsigned char*)d_ws;
#if MULTI_LAUNCH
  for (int ph = 0; ph < N_PHASES; ++ph) {
    if (ph > 0 && ((ph - 1) % 16) == 15 && ph != N_PHASES - 1) continue;
    k_phase<<<dim3(512), dim3(256), 0, stream>>>(p, ph);
  }
#else
  static int grid_blocks = 0;
  if (!grid_blocks) {
    int dev = 0, cus = 0, per_cu = 0;
    hipGetDevice(&dev);
    hipDeviceGetAttribute(&cus, hipDeviceAttributeMultiprocessorCount, dev);
    hipOccupancyMaxActiveBlocksPerMultiprocessor(&per_cu, k_mega, 256, 0);
    if (per_cu > 2) per_cu = 2;
    grid_blocks = cus * per_cu;
  }
  void* args[] = {&p};
  hipError_t e = hipLaunchCooperativeKernel((void*)k_mega, dim3(grid_blocks), dim3(256), args, 0, stream);
  if (e != hipSuccess) fprintf(stderr, "cooperative launch failed: %s (grid %d)\n", hipGetErrorString(e), grid_blocks);
#endif
}
```

```cpp
#include <hip/hip_runtime.h>
#include <hip/hip_bf16.h>
#include <hip/hip_cooperative_groups.h>
#include <cstdio>
namespace cg = cooperative_groups;

#ifndef MULTI_LAUNCH
#define MULTI_LAUNCH 0
#endif

typedef unsigned short u16;
using bf16x8 = __attribute__((ext_vector_type(8))) short;
using bf16x4 = __attribute__((ext_vector_type(4))) short;
using f32x4 = __attribute__((ext_vector_type(4))) float;

constexpr int D = 1024;
constexpr int TLAT = 32768;
constexpr int TCTX = 1024;
constexpr int TALL = TLAT + TCTX;
constexpr int SEQ = 8192;
constexpr int CTXL = 256;
constexpr int STOT = SEQ + CTXL;
constexpr int DFF = 2816;
constexpr int PC = 3456;
constexpr int P2C = 1664;
constexpr int NMOD = 9 * D;
constexpr float LOG2E = 1.4426950408889634f;
constexpr float RMS_EPS = 1e-6f;
constexpr float GN_EPS = 64e-5f;

constexpr size_t MiB = 1ull << 20;
constexpr size_t OFF_WFFI = 0;
constexpr size_t OFF_WFFO = 22 * MiB;
constexpr size_t OFF_WIN = 33 * MiB;
constexpr size_t OFF_WOUT = OFF_WIN + 27 * MiB / 4;
constexpr size_t OFF_MOD = OFF_WOUT + 2 * MiB;
constexpr size_t OFF_BAR = OFF_MOD + 384 * 1024;
constexpr size_t OFF_QCTR = OFF_MOD + 400 * 1024;
constexpr size_t OFF_CUTAB = OFF_QCTR + 256;
constexpr size_t OFF_ROPE = OFF_MOD + MiB / 2;
constexpr size_t OFF_XC = OFF_ROPE + 5 * MiB / 2;
constexpr size_t OFF_H = OFF_XC + 4 * MiB;
constexpr size_t OFF_P2 = OFF_H + 66 * MiB;
constexpr size_t OFF_BIG = OFF_P2 + 429 * MiB / 4;
constexpr size_t SZ_Q = (size_t)TALL * 256 * 2;
constexpr size_t SZ_KV2 = (size_t)4 * 2 * STOT * 64 * 2;
constexpr size_t SZ_KV4 = (size_t)4 * 4 * STOT * 64 * 2;
constexpr size_t OFF_QA = OFF_BIG;
constexpr size_t OFF_QB = OFF_QA + SZ_Q;
constexpr size_t OFF_KA = OFF_QB + SZ_Q;
constexpr size_t OFF_VA = OFF_KA + SZ_KV2;
constexpr size_t OFF_KB = OFF_VA + SZ_KV2;
constexpr size_t OFF_VB = OFF_KB + SZ_KV2;
constexpr size_t OFF_R0 = OFF_VB + SZ_KV2;
constexpr size_t OFF_QR = OFF_R0;
constexpr size_t OFF_KR = OFF_QR + SZ_Q;
constexpr size_t OFF_VR = OFF_KR + SZ_KV4;
constexpr size_t OFF_U = OFF_VR + SZ_KV4;
constexpr size_t OFF_SP = OFF_U + (size_t)16 * 66 * 2 * 4096 * 4;
constexpr size_t OFF_PREP = OFF_R0;
constexpr size_t WS_END = OFF_PREP + (size_t)32 * STOT * 384 * 2;
constexpr int YCOL0 = 768, YCOL1 = 1408;
static_assert(WS_END <= 512 * MiB, "workspace overflow");
static_assert(OFF_SP + (size_t)16 * 66 * 2 * 4096 * 2 <= 512 * MiB, "workspace overflow");
static_assert(OFF_P2 + (size_t)TALL * DFF * 2 <= 512 * MiB, "act overflow");

struct Params {
  const float *x, *c, *ctx, *c_ctx, *w_mod, *b_mod, *norm_g, *ffn_w_in, *ffn_w_out, *w_in, *w_out, *attn_sink, *qk_g,
      *ret_g, *mu, *w0, *w2, *a0, *a2, *rho, *k_k, *k_a, *g2, *ln_g, *ln_b, *final_g;
  float* out;
  unsigned char* ws;
};

__device__ __forceinline__ int TIDX() { int t = threadIdx.x; asm volatile("" : "+v"(t)); return t & 255; }
__device__ __forceinline__ int BIDX() { int t = blockIdx.x; asm volatile("" : "+s"(t)); return t; }
typedef float f32x2_t __attribute__((ext_vector_type(2)));
typedef __bf16 bf16x2_t __attribute__((ext_vector_type(2)));
__device__ __forceinline__ unsigned pk2bf(float a, float b) {
  f32x2_t v = {a, b};
  return __builtin_bit_cast(unsigned, __builtin_convertvector(v, bf16x2_t));
}
__device__ __forceinline__ u16 f2bf(float f) { return (u16)(pk2bf(f, 0.f) & 0xffffu); }
__device__ __forceinline__ float bf2f(u16 h) { return __uint_as_float(((unsigned)h) << 16); }
__device__ __forceinline__ float sigmoidf_(float x) { return __builtin_amdgcn_rcpf(1.f + __expf(-x)); }
__device__ __forceinline__ float siluf_(float x) { return x * __builtin_amdgcn_rcpf(1.f + __expf(-x)); }
__device__ __forceinline__ float tanhf_(float x) { return 1.f - 2.f * __builtin_amdgcn_rcpf(__expf(2.f * x) + 1.f); }
template <int CTRL>
__device__ __forceinline__ float dpp_f(float x) {
  return __builtin_bit_cast(float, __builtin_amdgcn_update_dpp(0, __builtin_bit_cast(int, x), CTRL, 0xf, 0xf, true));
}
__device__ __forceinline__ float row16_sum(float x) {
  x += dpp_f<0xB1>(x);
  x += dpp_f<0x4E>(x);
  x += dpp_f<0x141>(x);
  x += dpp_f<0x140>(x);
  return x;
}
__device__ __forceinline__ float wave_sum(float x) {
  x = row16_sum(x);
  x += __builtin_bit_cast(float, __builtin_amdgcn_update_dpp(0, __builtin_bit_cast(int, x), 0x142, 0xa, 0xf, false));
  x += __builtin_bit_cast(float, __builtin_amdgcn_update_dpp(0, __builtin_bit_cast(int, x), 0x143, 0xc, 0xf, false));
  return __builtin_bit_cast(float, __builtin_amdgcn_readlane(__builtin_bit_cast(int, x), 63));
}
__device__ __forceinline__ float half8_sum(float x) {
  x += dpp_f<0xB1>(x);
  x += dpp_f<0x4E>(x);
  x += dpp_f<0x141>(x);
  return x;
}
__device__ __forceinline__ void row16_sum2(float& a, float& b) {
  a += dpp_f<0xB1>(a);  b += dpp_f<0xB1>(b);
  a += dpp_f<0x4E>(a);  b += dpp_f<0x4E>(b);
  a += dpp_f<0x141>(a); b += dpp_f<0x141>(b);
  a += dpp_f<0x140>(a); b += dpp_f<0x140>(b);
}
__device__ __forceinline__ bf16x4 pack4(float a, float b, float c, float d) {
  uint2 u = make_uint2(pk2bf(a, b), pk2bf(c, d));
  return __builtin_bit_cast(bf16x4, u);
}
__device__ __forceinline__ bf16x8 cat8(bf16x4 a, bf16x4 b) {
  bf16x8 r;
  r[0] = a[0]; r[1] = a[1]; r[2] = a[2]; r[3] = a[3]; r[4] = b[0]; r[5] = b[1]; r[6] = b[2]; r[7] = b[3];
  return r;
}
__device__ __forceinline__ const float* rrow(const float* lat, const float* cx, int r) {
  return r < TLAT ? lat + (size_t)r * D : cx + (size_t)(r - TLAT) * D;
}
__device__ __forceinline__ float* wrow(float* lat, float* cx, int r) {
  return r < TLAT ? lat + (size_t)r * D : cx + (size_t)(r - TLAT) * D;
}
__device__ __forceinline__ int mod_index(int r) { return r < TLAT ? (r >> 13) : 4; }
__device__ __forceinline__ void row_bpos(int r, int& b, int& pos) {
  if (r < TLAT) { b = r >> 13; pos = r & 8191; }
  else { int rc = r - TLAT; b = rc >> 8; pos = SEQ + (rc & 255); }
}
__device__ __forceinline__ int bpos_row(int b, int pos) {
  return pos < SEQ ? b * SEQ + pos : TLAT + b * CTXL + (pos - SEQ);
}


#define XB_TMO      128
#define XB_XCNT(j)  (256  + 64 * (j))
#define XB_XSUB(j)  (1280 + 64 * (j))
#define XB_XGEN(j)  (2304 + 64 * (j))
#define XB_TOP      3328
#define XB_TOPGEN   3392
#define XCD_BAR_WORDS 3456
#define XB_SPIN_CAP (1u << 18)
#define LAS __attribute__((address_space(3)))
__device__ __forceinline__ unsigned xb_ld(unsigned* p) { return __hip_atomic_load(p, __ATOMIC_RELAXED, __HIP_MEMORY_SCOPE_AGENT); }
__device__ __forceinline__ unsigned xb_add(unsigned* p, unsigned v) { return __hip_atomic_fetch_add(p, v, __ATOMIC_RELAXED, __HIP_MEMORY_SCOPE_AGENT); }
__device__ __forceinline__ unsigned xb_xcc_id() { return (unsigned)__builtin_amdgcn_s_getreg((3 << 11) | 20) & 0xFu; }
#define XB_SPIN(cond, bar) do { unsigned _sp = 0; while (cond) { __builtin_amdgcn_s_sleep(1); \
    if ((++_sp & 255u) == 0u) { if (xb_ld(&(bar)[XB_TMO])) break; if (_sp > XB_SPIN_CAP) { atomicAdd(&(bar)[XB_TMO], 1u); break; } } } } while (0)
struct XcdBarrier { unsigned* bar; unsigned x; volatile LAS unsigned* st; };
__device__ __forceinline__ XcdBarrier xcd_barrier_post(unsigned* bar, volatile LAS unsigned* st) {
  XcdBarrier b; b.bar = bar; b.x = xb_xcc_id(); b.st = st;
  if (threadIdx.x == 0) (void)xb_add(&bar[XB_XCNT(b.x)], 1u);
  return b;
}
__device__ __forceinline__ void xcd_barrier_complete(unsigned* bar, unsigned x, unsigned& nloc, unsigned& nx) {
  const unsigned G = gridDim.x * gridDim.y * gridDim.z;
  unsigned sum, cnt, mine, sp = 0u;
  for (;;) {
    sum = 0u; cnt = 0u; mine = 0u;
#pragma unroll
    for (unsigned j = 0; j < 16; ++j) { const unsigned c = xb_ld(&bar[XB_XCNT(j)]); sum += c; cnt += (c > 0u) ? 1u : 0u; mine = (j == x) ? c : mine; }
    if (sum == G) break;
    __builtin_amdgcn_s_sleep(1);
    if ((++sp & 255u) == 0u) { if (xb_ld(&bar[XB_TMO])) break; if (sp > XB_SPIN_CAP) { atomicAdd(&bar[XB_TMO], 1u); break; } }
  }
  nloc = mine > 0u ? mine : 1u; nx = cnt > 0u ? cnt : 1u;
}
__device__ __forceinline__ void xcd_barrier(const XcdBarrier& b) {
  asm volatile("s_waitcnt vmcnt(0)" ::: "memory");
  __syncthreads();
  if (threadIdx.x == 0) {
    unsigned* bar = b.bar;
    __builtin_amdgcn_s_waitcnt(0);
    unsigned nloc = b.st[0], nx = b.st[1];
    if (nloc == 0u) { xcd_barrier_complete(bar, b.x, nloc, nx); b.st[0] = nloc; b.st[1] = nx; }
    const unsigned old = xb_add(&bar[XB_XSUB(b.x)], 1u);
    const unsigned gen = old / nloc;
    if (old + 1u == (gen + 1u) * nloc) {
      __builtin_amdgcn_fence(__ATOMIC_RELEASE, "agent");
      asm volatile("s_waitcnt vmcnt(0)" ::: "memory");
      const unsigned og = xb_add(&bar[XB_TOP], 1u);
      const unsigned tg = og / nx;
      if (og + 1u == (tg + 1u) * nx) xb_add(&bar[XB_TOPGEN], 1u);
      else XB_SPIN(xb_ld(&bar[XB_TOPGEN]) == tg, bar);
      __builtin_amdgcn_fence(__ATOMIC_ACQUIRE, "agent");
      xb_add(&bar[XB_XGEN(b.x)], 1u);
      asm volatile("s_waitcnt vmcnt(0)" ::: "memory");
    } else {
      XB_SPIN(xb_ld(&bar[XB_XGEN(b.x)]) == gen, bar);
      __builtin_amdgcn_fence(__ATOMIC_ACQUIRE, "agent");
      asm volatile("s_waitcnt vmcnt(0)" ::: "memory");
    }
  }
  __syncthreads();
}

__device__ __forceinline__ void convert_weights(const Params& p, int layer, unsigned char* smem) {
  const int tid = TIDX();
  const int nb = gridDim.x, bid = BIDX();
  {
    float* tile = (float*)smem;
    constexpr int N_FFI = 2 * 16 * 88, N_FFO = 2 * 44 * 16, N_WIN = 16 * 54, N_WOUT = 16 * 16;
    for (int item = bid; item < N_FFI + N_FFO + N_WIN + N_WOUT; item += nb) {
      const float* src; u16* dst; int K, N, kt, nt; bool perm = false;
      int it = item;
      if (it < N_FFI) {
        int f = it / (16 * 88); it %= (16 * 88);
        K = 1024; N = 5632; kt = it / 88; nt = it % 88; perm = true;
        src = p.ffn_w_in + (size_t)(layer * 2 + f) * 1024 * 5632;
        dst = (u16*)(p.ws + OFF_WFFI) + (size_t)f * 5632 * 1024;
      } else if (it < N_FFI + N_FFO) {
        it -= N_FFI;
        int f = it / (44 * 16); it %= (44 * 16);
        K = 2816; N = 1024; kt = it / 16; nt = it % 16;
        src = p.ffn_w_out + (size_t)(layer * 2 + f) * 2816 * 1024;
        dst = (u16*)(p.ws + OFF_WFFO) + (size_t)f * 1024 * 2816;
      } else if (it < N_FFI + N_FFO + N_WIN) {
        it -= N_FFI + N_FFO;
        K = 1024; N = 3456; kt = it / 54; nt = it % 54;
        src = p.w_in + (size_t)layer * 1024 * 3456;
        dst = (u16*)(p.ws + OFF_WIN);
      } else {
        it -= N_FFI + N_FFO + N_WIN;
        K = 1024; N = 1024; kt = it / 16; nt = it % 16;
        src = p.w_out + (size_t)layer * 1024 * 1024;
        dst = (u16*)(p.ws + OFF_WOUT);
      }
      __syncthreads();
      {
        const int r = tid >> 4, c4 = tid & 15;
        int np = nt * 64 + c4 * 4;
        int scol = np;
        if (perm) {
          int blk = np >> 7, sub = (np & 127) >> 4, i = np & 15;
          scol = ((sub & 1) ? DFF : 0) + blk * 64 + (sub >> 1) * 16 + i;
        }
#pragma unroll
        for (int ps = 0; ps < 4; ++ps) {
          int k = kt * 64 + ps * 16 + r;
          float4 v = *(const float4*)(src + (size_t)k * N + scol);
          float* tp = tile + (ps * 16 + r) * 65 + c4 * 4;
          tp[0] = v.x; tp[1] = v.y; tp[2] = v.z; tp[3] = v.w;
        }
      }
      __syncthreads();
      {
        const int n = tid >> 2, kq = tid & 3;
        bf16x8 o0, o1;
#pragma unroll
        for (int i = 0; i < 8; ++i) {
          o0[i] = (short)f2bf(tile[(kq * 16 + i) * 65 + n]);
          o1[i] = (short)f2bf(tile[(kq * 16 + 8 + i) * 65 + n]);
        }
        u16* dp = dst + (size_t)(nt * 64 + n) * K + kt * 64 + kq * 16;
        *(bf16x8*)dp = o0;
        *(bf16x8*)(dp + 8) = o1;
      }
    }
    __syncthreads();
  }
}

__device__ __forceinline__ void phase_init(const Params& p, unsigned char* smem) {
  const int tid = TIDX();
  const int nb = gridDim.x, bid = BIDX();
  if (bid == 0 && tid < 2) ((int*)(p.ws + OFF_QCTR))[tid] = 0;
  if (tid == 0) {
    const int hw = __builtin_amdgcn_s_getreg((7 << 11) | (8 << 6) | 4);
    const int xcc = __builtin_amdgcn_s_getreg((3 << 11) | 20) & 0xF;
    ((int*)(p.ws + OFF_CUTAB))[bid] = (xcc << 8) | (hw & 0xFF);
  }
  {
    float2* seq = (float2*)(p.ws + OFF_ROPE);
    float2* rowt = seq + 8192 * 32;
    float2* colt = rowt + 128 * 16;
    for (int i = bid * 256 + tid; i < 8192 * 32 + 128 * 16 + 64 * 16; i += nb * 256) {
      float ang;
      float2* dst;
      if (i < 8192 * 32) {
        int t = i >> 5, k = i & 31;
        float inv = 1.0f / powf(10000.0f, (float)(2 * k) / 64.0f);
        ang = (float)t * inv;
        dst = seq + i;
      } else {
        int j = i - 8192 * 32;
        int pidx = (j < 128 * 16) ? (j >> 4) : ((j - 128 * 16) >> 4);
        int k = j & 15;
        float inv = 1.0f / powf(10000.0f, (float)(2 * k) / 32.0f);
        ang = (float)pidx * inv;
        dst = rowt + j;
      }
      *dst = make_float2(cosf(ang), sinf(ang));
    }
    (void)colt;
  }
  {
    float* sc = (float*)smem;
    float* red = sc + 5 * 1024;
    for (int item = bid; item < 288; item += nb) {
      const int l = item / 144, cb = item % 144;
      __syncthreads();
      for (int i = tid; i < 5 * 1024; i += 256) {
        int m = i >> 10, k = i & 1023;
        float v = (m < 4) ? p.c[m * 1024 + k] : p.c_ctx[k];
        sc[i] = siluf_(v);
      }
      __syncthreads();
      const int cq = tid & 15, kg = tid >> 4;
      float acc[5][4];
#pragma unroll
      for (int m = 0; m < 5; ++m)
#pragma unroll
        for (int q = 0; q < 4; ++q) acc[m][q] = 0.f;
      const float* wbase = p.w_mod + (size_t)l * 1024 * NMOD + cb * 64 + cq * 4;
      for (int kk = 0; kk < 64; ++kk) {
        int k = kg * 64 + kk;
        float4 w4 = *(const float4*)(wbase + (size_t)k * NMOD);
#pragma unroll
        for (int m = 0; m < 5; ++m) {
          float s = sc[m * 1024 + k];
          acc[m][0] += s * w4.x; acc[m][1] += s * w4.y; acc[m][2] += s * w4.z; acc[m][3] += s * w4.w;
        }
      }
#pragma unroll
      for (int m = 0; m < 5; ++m)
#pragma unroll
        for (int q = 0; q < 4; ++q) red[(kg * 5 + m) * 64 + cq * 4 + q] = acc[m][q];
      __syncthreads();
      float* modp = (float*)(p.ws + OFF_MOD);
      for (int o = tid; o < 320; o += 256) {
        int m = o >> 6, cc = o & 63;
        float s = 0.f;
        for (int g = 0; g < 16; ++g) s += red[(g * 5 + m) * 64 + cc];
        int col = cb * 64 + cc;
        modp[((size_t)l * 5 + m) * NMOD + col] = s + p.b_mod[(size_t)l * NMOD + col];
      }
    }
    __syncthreads();
  }
  convert_weights(p, 0, smem);
}

__device__ __forceinline__ void phase_norm(const Params& p, int l, int which, const float* lat, const float* cx) {
  const int lane = TIDX() & 63, wid = TIDX() >> 6;
  u16* h = (u16*)(p.ws + OFF_H);
  const float* g = p.norm_g + ((size_t)l * 3 + which) * D;
  const float* modp = (const float*)(p.ws + OFF_MOD) + (size_t)l * 5 * NMOD;
  for (int r = BIDX() * 4 + wid; r < TALL; r += gridDim.x * 4) {
    const float* xr = rrow(lat, cx, r);
    const float* mp = modp + (size_t)mod_index(r) * NMOD + which * 3 * D;
    float4 v[4];
    float ss = 0.f;
#pragma unroll
    for (int i = 0; i < 4; ++i) {
      v[i] = *(const float4*)(xr + i * 256 + lane * 4);
      ss += v[i].x * v[i].x + v[i].y * v[i].y + v[i].z * v[i].z + v[i].w * v[i].w;
    }
    ss = wave_sum(ss);
    float rstd = rsqrtf(ss * (1.f / 1024.f) + RMS_EPS);
#pragma unroll
    for (int i = 0; i < 4; ++i) {
      int col = i * 256 + lane * 4;
      float4 gg = *(const float4*)(g + col);
      float4 sh = *(const float4*)(mp + col);
      float4 scl = *(const float4*)(mp + D + col);
      bf16x4 o = pack4(v[i].x * rstd * gg.x * (1.f + scl.x) + sh.x, v[i].y * rstd * gg.y * (1.f + scl.y) + sh.y,
                       v[i].z * rstd * gg.z * (1.f + scl.z) + sh.z, v[i].w * rstd * gg.w * (1.f + scl.w) + sh.w);
      *(bf16x4*)(h + (size_t)r * D + col) = o;
    }
  }
}

__device__ __forceinline__ void phase_final_norm(const Params& p) {
  const int lane = TIDX() & 63, wid = TIDX() >> 6;
  for (int r = BIDX() * 4 + wid; r < TLAT; r += gridDim.x * 4) {
    float* xr = p.out + (size_t)r * D;
    float4 v[4];
    float ss = 0.f;
#pragma unroll
    for (int i = 0; i < 4; ++i) {
      v[i] = *(const float4*)(xr + i * 256 + lane * 4);
      ss += v[i].x * v[i].x + v[i].y * v[i].y + v[i].z * v[i].z + v[i].w * v[i].w;
    }
    ss = wave_sum(ss);
    float rstd = rsqrtf(ss * (1.f / 1024.f) + RMS_EPS);
#pragma unroll
    for (int i = 0; i < 4; ++i) {
      int col = i * 256 + lane * 4;
      float4 gg = *(const float4*)(p.final_g + col);
      float4 o = make_float4(v[i].x * rstd * gg.x, v[i].y * rstd * gg.y, v[i].z * rstd * gg.z, v[i].w * rstd * gg.w);
      *(float4*)(xr + col) = o;
    }
  }
}

template <int MI>
__device__ __forceinline__ void gemm_mainloop(const u16* __restrict__ A, const u16* __restrict__ Bt, int K, int brow,
                                              int bcol, f32x4 (&acc)[MI][4], unsigned char* smem) {
  const int tid = TIDX(), wid = tid >> 6, lane = tid & 63, wr = wid >> 1, wc = wid & 1, fr = lane & 15, fq = lane >> 4;
  constexpr int BM = MI * 32;
  constexpr int ACH = BM * 4 / 256;
  constexpr int STAGE = BM * 64 + 8192;
#pragma unroll
  for (int m = 0; m < MI; ++m)
#pragma unroll
    for (int n = 0; n < 4; ++n) acc[m][n] = f32x4{0.f, 0.f, 0.f, 0.f};
  const int nk = K / 32;
  const int prow = tid >> 2, pq = ((tid & 3) ^ ((0x78 >> (((tid >> 4) & 3) * 2)) & 3)) * 8;
  const u16* ga = A + (size_t)(brow + prow) * K + pq;
  const u16* gb = Bt + (size_t)(bcol + prow) * K + pq;
  auto stage = [&](int t, int buf) {
    unsigned char* base = smem + buf * STAGE;
#pragma unroll
    for (int i = 0; i < ACH; ++i)
      __builtin_amdgcn_global_load_lds((const unsigned*)(ga + (size_t)i * 64 * K + t * 32),
                                       (__attribute__((address_space(3))) unsigned*)(base + (tid + i * 256) * 16), 16, 0, 0);
#pragma unroll
    for (int i = 0; i < 2; ++i)
      __builtin_amdgcn_global_load_lds((const unsigned*)(gb + (size_t)i * 64 * K + t * 32),
                                       (__attribute__((address_space(3))) unsigned*)(base + BM * 64 + (tid + i * 256) * 16), 16, 0, 0);
  };
  const int swz = (fq ^ ((0x78 >> (((fr >> 2) & 3) * 2)) & 3)) * 16;
  __syncthreads();
  stage(0, 0);
  for (int t = 0; t < nk; ++t) {
    __syncthreads();
    if (t + 1 < nk) stage(t + 1, (t + 1) & 1);
    const unsigned char* base = smem + (t & 1) * STAGE;
    bf16x8 af[MI], bfr[4];
#pragma unroll
    for (int m = 0; m < MI; ++m) af[m] = *(const bf16x8*)(base + (wr * MI * 16 + m * 16 + fr) * 64 + swz);
#pragma unroll
    for (int n = 0; n < 4; ++n) bfr[n] = *(const bf16x8*)(base + BM * 64 + (wc * 64 + n * 16 + fr) * 64 + swz);
#pragma unroll
    for (int m = 0; m < MI; ++m)
#pragma unroll
      for (int n = 0; n < 4; ++n) acc[m][n] = __builtin_amdgcn_mfma_f32_16x16x32_bf16(af[m], bfr[n], acc[m][n], 0, 0, 0);
  }
}

__device__ __forceinline__ bool next_tile(int it, int MT, int NT, int& tm, int& tn) {
  const int G = gridDim.x, b = BIDX();
  const int total = MT * NT;
  int id;
  if ((G & 7) == 0) {
    const int per = G >> 3;
    id = it * G + (b & 7) * per + (b >> 3);
  } else {
    id = b + it * G;
  }
  if (id >= total) return false;
  constexpr int GM = 8;
  const int gsz = GM * NT;
  const int g = id / gsz, rem = id - g * gsz;
  const int rows = (MT - g * GM) < GM ? (MT - g * GM) : GM;
  tn = rem / rows;
  tm = g * GM + (rem - tn * rows);
  return true;
}

__device__ __forceinline__ void phase_ffn_in(const Params& p, int l, int f, unsigned char* smem) {
  const u16* A = (const u16*)(p.ws + OFF_H);
  const u16* Bt = (const u16*)(p.ws + OFF_WFFI) + (size_t)f * 5632 * 1024;
  u16* act = (u16*)(p.ws + OFF_P2);
  const int tid = TIDX(), wid = tid >> 6, lane = tid & 63, wr = wid >> 1, wc = wid & 1, fr = lane & 15, fq = lane >> 4;
  constexpr int MI = 8, NT = 44, MT = TALL / (MI * 32);
  for (int it = 0;; ++it) {
    int tm, tn;
    if (!next_tile(it, MT, NT, tm, tn)) break;
    f32x4 acc[MI][4];
    gemm_mainloop<MI>(A, Bt, 1024, tm * MI * 32, tn * 128, acc, smem);
#pragma unroll
    for (int m = 0; m < MI; ++m)
#pragma unroll
      for (int q = 0; q < 2; ++q)
#pragma unroll
        for (int j = 0; j < 4; ++j) {
          int row = tm * MI * 32 + wr * MI * 16 + m * 16 + fq * 4 + j;
          int col = tn * 64 + wc * 32 + q * 16 + fr;
          float u1 = acc[m][2 * q][j], u2 = acc[m][2 * q + 1][j];
          act[(size_t)row * DFF + col] = f2bf(siluf_(u1) * u2);
        }
  }
}

__device__ __forceinline__ void phase_resid_gemm(const Params& p, int l, const u16* A, const u16* Bt, int K, int gate, float gscale,
                                 const float* lat_in, const float* cx_in, float* lat_out, float* cx_out,
                                 unsigned char* smem) {
  const int tid = TIDX(), wid = tid >> 6, lane = tid & 63, wr = wid >> 1, wc = wid & 1, fr = lane & 15, fq = lane >> 4;
  constexpr int MI = 6, NT = 8, MT = TALL / (MI * 32);
  const float* modp = (const float*)(p.ws + OFF_MOD) + (size_t)l * 5 * NMOD + gate * D;
  for (int it = 0;; ++it) {
    int tm, tn;
    if (!next_tile(it, MT, NT, tm, tn)) break;
    f32x4 acc[MI][4];
    gemm_mainloop<MI>(A, Bt, K, tm * MI * 32, tn * 128, acc, smem);
    {
      const int rowa = tm * MI * 32 + wr * MI * 16 + fq * 4;
      const int mi0 = mod_index(rowa), mi1 = mod_index(rowa + (MI - 1) * 16 + 3);
      float g0[4], g1[4];
#pragma unroll
      for (int n = 0; n < 4; ++n) {
        const int col = tn * 128 + wc * 64 + n * 16 + fr;
        g0[n] = gscale * modp[(size_t)mi0 * NMOD + col];
        g1[n] = gscale * modp[(size_t)mi1 * NMOD + col];
      }
#pragma unroll
      for (int m = 0; m < MI; ++m) {
        float xv[4][4];
#pragma unroll
        for (int j = 0; j < 4; ++j) {
          const float* xi = rrow(lat_in, cx_in, rowa + m * 16 + j);
#pragma unroll
          for (int n = 0; n < 4; ++n) xv[j][n] = xi[tn * 128 + wc * 64 + n * 16 + fr];
        }
#pragma unroll
        for (int j = 0; j < 4; ++j) {
          const int row = rowa + m * 16 + j;
          const bool first = mod_index(row) == mi0;
          float* xo = wrow(lat_out, cx_out, row);
#pragma unroll
          for (int n = 0; n < 4; ++n) xo[tn * 128 + wc * 64 + n * 16 + fr] = xv[j][n] + (first ? g0[n] : g1[n]) * acc[m][n][j];
        }
      }
    }
  }
}

__device__ __forceinline__ void phase_inproj(const Params& p, int l, unsigned char* smem) {
  const u16* A = (const u16*)(p.ws + OFF_H);
  const u16* Bt = (const u16*)(p.ws + OFF_WIN);
  const int tid = TIDX(), wid = tid >> 6, lane = tid & 63, wr = wid >> 1, wc = wid & 1, fr = lane & 15, fq = lane >> 4;
  constexpr int MI = 8, NT = 27, MT = TALL / (MI * 32);
  const float2* ropeseq = (const float2*)(p.ws + OFF_ROPE);
  const float2* roperow = ropeseq + 8192 * 32;
  const float2* ropecol = roperow + 128 * 16;
  u16* QA = (u16*)(p.ws + OFF_QA); u16* QB = (u16*)(p.ws + OFF_QB); u16* QR = (u16*)(p.ws + OFF_QR);
  u16* KA = (u16*)(p.ws + OFF_KA); u16* VA = (u16*)(p.ws + OFF_VA);
  u16* KB = (u16*)(p.ws + OFF_KB); u16* VB = (u16*)(p.ws + OFF_VB);
  u16* KR = (u16*)(p.ws + OFF_KR); u16* VR = (u16*)(p.ws + OFF_VR);
  u16* P2 = (u16*)(p.ws + OFF_P2);
  for (int it = 0;; ++it) {
    int tm, tn;
    if (!next_tile(it, MT, NT, tm, tn)) break;
    f32x4 acc[MI][4];
    gemm_mainloop<MI>(A, Bt, 1024, tm * MI * 32, tn * 128, acc, smem);
    const int r0 = tm * MI * 32 + wr * MI * 16;
    const int c0 = tn * 128 + wc * 64;
    const bool latent = r0 < TLAT;
    if (c0 >= 1792) {
#pragma unroll
      for (int m = 0; m < MI; ++m)
#pragma unroll
        for (int n = 0; n < 4; ++n)
#pragma unroll
          for (int j = 0; j < 4; ++j) {
            int row = r0 + m * 16 + fq * 4 + j;
            P2[(size_t)row * P2C + (c0 - 1792) + n * 16 + fr] = f2bf(acc[m][n][j]);
          }
      continue;
    }
    int kind;
    int ropek;
    int normk;
    float scale = 1.f;
    u16* dst; int hh, nh;
    if (c0 < 256) { kind = 0; ropek = 1; normk = -1; scale = 0.125f * LOG2E; dst = QA; hh = c0 >> 6; nh = 4; }
    else if (c0 < 384) { kind = 1; ropek = 1; normk = -1; dst = KA; hh = (c0 - 256) >> 6; nh = 2; }
    else if (c0 < 512) { kind = 2; ropek = 0; normk = -1; dst = VA; hh = (c0 - 384) >> 6; nh = 2; }
    else if (c0 < 768) { kind = 0; ropek = 1; normk = 0; scale = 0.125f * LOG2E; dst = QB; hh = (c0 - 512) >> 6; nh = 4; }
    else if (c0 < 896) { kind = 1; ropek = 1; normk = 1; dst = KB; hh = (c0 - 768) >> 6; nh = 2; }
    else if (c0 < 1024) { kind = 2; ropek = 0; normk = -1; dst = VB; hh = (c0 - 896) >> 6; nh = 2; }
    else if (c0 < 1280) { kind = 0; ropek = 2; normk = -1; dst = QR; hh = (c0 - 1024) >> 6; nh = 4; }
    else if (c0 < 1536) { kind = 1; ropek = 2; normk = -1; scale = 0.125f; dst = KR; hh = (c0 - 1280) >> 6; nh = 4; }
    else { kind = 2; ropek = 0; normk = -1; dst = VR; hh = (c0 - 1536) >> 6; nh = 4; }
    if (!latent) ropek = 0;
    if (kind == 2) {
#pragma unroll
      for (int m = 0; m < MI; ++m) {
        int b, pos;
        row_bpos(r0 + m * 16 + fq * 4, b, pos);
#pragma unroll
        for (int n = 0; n < 4; ++n) {
          int d = n * 16 + fr;
          bf16x4 o = pack4(acc[m][n][0], acc[m][n][1], acc[m][n][2], acc[m][n][3]);
          *(bf16x4*)(dst + ((size_t)(b * nh + hh) * 64 + d) * STOT + pos) = o;
        }
      }
      continue;
    }
    float gq[4] = {1.f, 1.f, 1.f, 1.f};
    if (normk >= 0) {
#pragma unroll
      for (int n = 0; n < 4; ++n) gq[n] = p.qk_g[((size_t)l * 2 + normk) * 64 + n * 16 + fr];
    }
#pragma unroll
    for (int m = 0; m < MI; ++m)
#pragma unroll
      for (int j = 0; j < 4; ++j) {
        int row = r0 + m * 16 + fq * 4 + j;
        float v0 = acc[m][0][j], v1 = acc[m][1][j], v2 = acc[m][2][j], v3 = acc[m][3][j];
        if (normk >= 0) {
          float ss = v0 * v0 + v1 * v1 + v2 * v2 + v3 * v3;
          ss += __shfl_xor(ss, 1); ss += __shfl_xor(ss, 2); ss += __shfl_xor(ss, 4); ss += __shfl_xor(ss, 8);
          float rstd = rsqrtf(ss * (1.f / 64.f) + RMS_EPS);
          v0 *= rstd * gq[0]; v1 *= rstd * gq[1]; v2 *= rstd * gq[2]; v3 *= rstd * gq[3];
        }
        int b, pos;
        row_bpos(row, b, pos);
        if (ropek == 1) {
          float2 cr = roperow[(pos >> 6) * 16 + fr];
          float2 cc = ropecol[(pos & 63) * 16 + fr];
          float o0 = v0 * cr.x - v1 * cr.y, o1 = v1 * cr.x + v0 * cr.y;
          float o2 = v2 * cc.x - v3 * cc.y, o3 = v3 * cc.x + v2 * cc.y;
          v0 = o0; v1 = o1; v2 = o2; v3 = o3;
        } else if (ropek == 2) {
          float2 ca = ropeseq[pos * 32 + fr];
          float2 cb = ropeseq[pos * 32 + 16 + fr];
          float o0 = v0 * ca.x - v2 * ca.y, o2 = v2 * ca.x + v0 * ca.y;
          float o1 = v1 * cb.x - v3 * cb.y, o3 = v3 * cb.x + v1 * cb.y;
          v0 = o0; v1 = o1; v2 = o2; v3 = o3;
        }
        v0 *= scale; v1 *= scale; v2 *= scale; v3 *= scale;
        u16* dp;
        if (kind == 0) dp = dst + (size_t)row * 256 + hh * 64 + fr;
        else dp = dst + ((size_t)(b * nh + hh) * STOT + pos) * 64 + fr;
        dp[0] = f2bf(v0); dp[16] = f2bf(v1); dp[32] = f2bf(v2); dp[48] = f2bf(v3);
      }
  }
}

__device__ __forceinline__ void attn_item(const u16* __restrict__ Q, const u16* __restrict__ Kb, const u16* __restrict__ Vt,
                          u16* __restrict__ concat, int ccol0, int b, int kvh, int qrow0, int qpos0, int t0, int t1,
                          int c0, int c1, bool masked, const float* sink, unsigned char* smem) {
  const int tid = TIDX(), w = tid >> 6, lane = tid & 63, fr = lane & 15, fq = lane >> 4;
  const int head = kvh * 2 + (w & 1);
  const int qoff = (w >> 1) * 32;
  bf16x8 qf[2][2];
#pragma unroll
  for (int qg = 0; qg < 2; ++qg)
#pragma unroll
    for (int ks = 0; ks < 2; ++ks)
      qf[qg][ks] = *(const bf16x8*)(Q + (size_t)(qrow0 + qoff + qg * 16 + fr) * 256 + head * 64 + ks * 32 + fq * 8);
  f32x4 O[2][4];
  float mrow[2], lrow[2];
#pragma unroll
  for (int qg = 0; qg < 2; ++qg) {
    mrow[qg] = -1e30f; lrow[qg] = 0.f;
#pragma unroll
    for (int dt = 0; dt < 4; ++dt) O[qg][dt] = f32x4{0.f, 0.f, 0.f, 0.f};
  }
  const u16* Kbase = Kb + (size_t)(b * 2 + kvh) * STOT * 64;
  const u16* Vbase = Vt + (size_t)(b * 2 + kvh) * 64 * STOT;
  const int n1 = t1 - t0, total = n1 + (c1 - c0);
  bf16x8 kreg[2], vreg[2];
  auto gload = [&](int i) {
    int tile = i < n1 ? t0 + i : c0 + (i - n1);
#pragma unroll
    for (int ps = 0; ps < 2; ++ps) {
      int idx = tid + ps * 256;
      kreg[ps] = *(const bf16x8*)(Kbase + (size_t)tile * 4096 + idx * 8);
      int d = idx >> 3, ch = idx & 7;
      vreg[ps] = *(const bf16x8*)(Vbase + (size_t)d * STOT + tile * 64 + ch * 8);
    }
  };
  auto lstore = [&](int buf) {
    u16* Ks = (u16*)(smem + buf * 18432);
    u16* Vs = Ks + 64 * 72;
#pragma unroll
    for (int ps = 0; ps < 2; ++ps) {
      int idx = tid + ps * 256;
      int r = idx >> 3, ch = idx & 7;
      *(bf16x8*)(Ks + r * 72 + ch * 8) = kreg[ps];
      *(bf16x8*)(Vs + r * 72 + ch * 8) = vreg[ps];
    }
  };
  __syncthreads();
  gload(0);
  lstore(0);
  __syncthreads();
#pragma unroll 1
  for (int i = 0; i < total; ++i) {
    const int tile = i < n1 ? t0 + i : c0 + (i - n1);
    if (i + 1 < total) gload(i + 1);
    const u16* Ks = (const u16*)(smem + (i & 1) * 18432);
    const u16* Vs = Ks + 64 * 72;
    f32x4 s[2][4];
#pragma unroll
    for (int qg = 0; qg < 2; ++qg)
#pragma unroll
      for (int sub = 0; sub < 4; ++sub) s[qg][sub] = f32x4{0.f, 0.f, 0.f, 0.f};
#pragma unroll
    for (int sub = 0; sub < 4; ++sub)
#pragma unroll
      for (int ks = 0; ks < 2; ++ks) {
        bf16x8 a = *(const bf16x8*)(Ks + (sub * 16 + fr) * 72 + ks * 32 + fq * 8);
#pragma unroll
        for (int qg = 0; qg < 2; ++qg) s[qg][sub] = __builtin_amdgcn_mfma_f32_16x16x32_bf16(a, qf[qg][ks], s[qg][sub], 0, 0, 0);
      }
    __builtin_amdgcn_sched_barrier(0);
    const bool domask = masked && (tile < 128);
    bf16x8 pb[2][2];
#pragma unroll
    for (int qg = 0; qg < 2; ++qg) {
      if (domask) {
        int qpos = qpos0 + qoff + qg * 16 + fr;
#pragma unroll
        for (int sub = 0; sub < 4; ++sub)
#pragma unroll
          for (int j = 0; j < 4; ++j) {
            int kpos = tile * 64 + sub * 16 + fq * 4 + j;
            int dd = kpos - qpos;
            if (dd > 128 || dd < -128) s[qg][sub][j] = -INFINITY;
          }
      }
      float mx = -INFINITY;
#pragma unroll
      for (int sub = 0; sub < 4; ++sub)
#pragma unroll
        for (int j = 0; j < 4; ++j) mx = fmaxf(mx, s[qg][sub][j]);
      mx = fmaxf(mx, __shfl_xor(mx, 16));
      mx = fmaxf(mx, __shfl_xor(mx, 32));
      float mnew = fmaxf(mrow[qg], mx);
      const bool changed = mnew > mrow[qg];
      float alpha = __builtin_amdgcn_exp2f(mrow[qg] - mnew);
      mrow[qg] = mnew;
      float ps = 0.f;
#pragma unroll
      for (int sub = 0; sub < 4; ++sub)
#pragma unroll
        for (int j = 0; j < 4; ++j) {
          float pv = __builtin_amdgcn_exp2f(s[qg][sub][j] - mnew);
          s[qg][sub][j] = pv;
          ps += pv;
        }
      lrow[qg] = lrow[qg] * alpha + ps;
      if (__builtin_amdgcn_ballot_w64(changed) != 0ull) {
#pragma unroll
        for (int dt = 0; dt < 4; ++dt) O[qg][dt] *= alpha;
      }
#pragma unroll
      for (int ks = 0; ks < 2; ++ks)
        pb[qg][ks] = cat8(pack4(s[qg][2 * ks][0], s[qg][2 * ks][1], s[qg][2 * ks][2], s[qg][2 * ks][3]),
                          pack4(s[qg][2 * ks + 1][0], s[qg][2 * ks + 1][1], s[qg][2 * ks + 1][2], s[qg][2 * ks + 1][3]));
      __builtin_amdgcn_sched_barrier(0);
    }
#pragma unroll
    for (int dt = 0; dt < 4; ++dt)
#pragma unroll
      for (int ks = 0; ks < 2; ++ks) {
        const u16* vp = Vs + (dt * 16 + fr) * 72 + ks * 32 + fq * 4;
        bf16x8 va = cat8(*(const bf16x4*)vp, *(const bf16x4*)(vp + 16));
#pragma unroll
        for (int qg = 0; qg < 2; ++qg) O[qg][dt] = __builtin_amdgcn_mfma_f32_16x16x32_bf16(va, pb[qg][ks], O[qg][dt], 0, 0, 0);
      }
    __builtin_amdgcn_sched_barrier(0);
    if (i + 1 < total) lstore((i + 1) & 1);
    __syncthreads();
  }
#pragma unroll
  for (int qg = 0; qg < 2; ++qg) {
    float lt = lrow[qg];
    lt += __shfl_xor(lt, 16);
    lt += __shfl_xor(lt, 32);
    if (sink) lt += __builtin_amdgcn_exp2f(sink[head] * LOG2E - mrow[qg]);
    float inv = 1.f / lt;
    int row = qrow0 + qoff + qg * 16 + fr;
#pragma unroll
    for (int dt = 0; dt < 4; ++dt) {
      bf16x4 o = pack4(O[qg][dt][0] * inv, O[qg][dt][1] * inv, O[qg][dt][2] * inv, O[qg][dt][3] * inv);
      *(bf16x4*)(concat + (size_t)row * D + ccol0 + head * 64 + dt * 16 + fq * 4) = o;
    }
  }
}

__device__ __forceinline__ float ret_lg(int h) {
  return log2f(1.0f - exp2f(-5.0f - (float)h));
}

__device__ __forceinline__ void retU_item(const Params& p, int bh, int c, unsigned char* smem) {
  const int tid = TIDX();
  const int b = bh >> 2, h = bh & 3;
  const u16* KR = (const u16*)(p.ws + OFF_KR) + (size_t)bh * STOT * 64;
  const u16* VR = (const u16*)(p.ws + OFF_VR) + (size_t)bh * 64 * STOT;
  (void)b;
  const int pos0 = c < 64 ? c * 128 : SEQ + (c - 64) * 128;
  u16* Kc = (u16*)smem;
  u16* Vj = Kc + 128 * 64;
  __syncthreads();
#pragma unroll
  for (int ps = 0; ps < 4; ++ps) {
    int idx = tid + ps * 256;
    *(bf16x8*)(Kc + idx * 8) = *(const bf16x8*)(KR + (size_t)pos0 * 64 + idx * 8);
    int d = idx >> 4, ch = idx & 15;
    bf16x8 v = *(const bf16x8*)(VR + (size_t)d * STOT + pos0 + ch * 8);
#pragma unroll
    for (int e = 0; e < 8; ++e) Vj[(ch * 8 + e) * 72 + d] = (u16)v[e];
  }
  __syncthreads();
  const int dk = tid >> 2, dv0 = (tid & 3) * 16;
  const float lg = ret_lg(h);
  float af[16], ab[16];
#pragma unroll
  for (int q = 0; q < 16; ++q) { af[q] = 0.f; ab[q] = 0.f; }
  for (int j = 0; j < 128; ++j) {
    float kf = bf2f(Kc[j * 64 + dk]);
    float kfw = kf * exp2f(lg * (float)(127 - j));
    float kbw = kf * exp2f(lg * (float)j);
    bf16x8 v0 = *(const bf16x8*)(Vj + j * 72 + dv0);
    bf16x8 v1 = *(const bf16x8*)(Vj + j * 72 + dv0 + 8);
#pragma unroll
    for (int q = 0; q < 8; ++q) {
      float a = bf2f((u16)v0[q]), bb = bf2f((u16)v1[q]);
      af[q] += kfw * a; ab[q] += kbw * a;
      af[8 + q] += kfw * bb; ab[8 + q] += kbw * bb;
    }
  }
  float* U = (float*)(p.ws + OFF_U) + ((size_t)bh * 66 + c) * 2 * 4096;
#pragma unroll
  for (int q = 0; q < 16; ++q) {
    U[(dv0 + q) * 64 + dk] = af[q];
    U[4096 + (dv0 + q) * 64 + dk] = ab[q];
  }
}

__device__ __forceinline__ void phase_retU(const Params& p, unsigned char* smem) {
  for (int item = BIDX(); item < 16 * 66; item += gridDim.x) retU_item(p, item / 66, item % 66, smem);
}

__device__ __forceinline__ void attn_worker(const Params& p, int l, unsigned char* smem) {
  const u16* QA = (const u16*)(p.ws + OFF_QA); const u16* QB = (const u16*)(p.ws + OFF_QB);
  const u16* KA = (const u16*)(p.ws + OFF_KA); const u16* VA = (const u16*)(p.ws + OFF_VA);
  const u16* KB = (const u16*)(p.ws + OFF_KB); const u16* VB = (const u16*)(p.ws + OFF_VB);
  u16* concat = (u16*)(p.ws + OFF_H);
  const float* sink = p.attn_sink + l * 4;
  int* qctr = (int*)(p.ws + OFF_QCTR) + l;
  volatile int* slot = (volatile int*)(smem + 65536 - 32);
  for (;;) {
    __syncthreads();
    if (TIDX() == 0) *slot = atomicAdd(qctr, 1);
    __syncthreads();
    const int item = *slot;
    if (item >= 2112) break;
    const bool isB = item < 1024 || (item >= 2048 && item < 2080);
    const bool isctx = item >= 2048;
    int ii = item < 1024 ? item : item < 2048 ? item - 1024 : item < 2080 ? item - 2048 : item - 2080;
    int qt, kvh, b, qrow0, qpos0, t0, t1;
    if (!isctx) {
      qt = ii & 127; kvh = (ii >> 7) & 1; b = ii >> 8;
      qrow0 = b * SEQ + qt * 64; qpos0 = qt * 64;
      if (isB) { t0 = 0; t1 = 128; }
      else { t0 = qt - 2 < 0 ? 0 : qt - 2; t1 = qt + 3 > 128 ? 128 : qt + 3; }
    } else {
      qt = ii & 3; kvh = (ii >> 2) & 1; b = ii >> 3;
      qrow0 = TLAT + b * CTXL + qt * 64; qpos0 = 0; t0 = 0; t1 = 0;
    }
    attn_item(isB ? QB : QA, isB ? KB : KA, isB ? VB : VA, concat, isB ? 256 : 0, b, kvh, qrow0, qpos0, t0, t1, 128, 132,
              (!isB) && (!isctx), isB ? nullptr : sink, smem);
  }
}

__device__ __forceinline__ void phase_retscan(const Params& p) {
  const float* U = (const float*)(p.ws + OFF_U);
  u16* SP = (u16*)(p.ws + OFF_SP);
  for (int gid = BIDX() * 256 + TIDX(); gid < 16 * 2 * 4096; gid += gridDim.x * 256) {
    int e = gid & 4095, dir = (gid >> 12) & 1, bh = gid >> 13;
    float g128 = exp2f(128.f * ret_lg(bh & 3));
    float S = 0.f;
#pragma unroll 1
    for (int n0 = 0; n0 < 66; n0 += 11) {
      float u[11];
      size_t offs[11];
#pragma unroll
      for (int k = 0; k < 11; ++k) {
        int n = n0 + k;
        int c = dir == 0 ? (n < 2 ? 64 + n : n - 2) : 65 - n;
        offs[k] = (((size_t)bh * 66 + c) * 2 + dir) * 4096 + e;
        u[k] = U[offs[k]];
      }
#pragma unroll
      for (int k = 0; k < 11; ++k) {
        SP[offs[k]] = f2bf(S);
        S = g128 * S + u[k];
      }
    }
  }
}

__device__ __forceinline__ void retout_item(const Params& p, int l, int bh, int c, unsigned char* smem) {
  const int tid = TIDX(), w = tid >> 6, lane = tid & 63, fr = lane & 15, fq = lane >> 4;
  const int b = bh >> 2, h = bh & 3;
  const u16* QR = (const u16*)(p.ws + OFF_QR);
  const u16* KR = (const u16*)(p.ws + OFF_KR) + (size_t)bh * STOT * 64;
  const u16* VR = (const u16*)(p.ws + OFF_VR) + (size_t)bh * 64 * STOT;
  const u16* SP = (const u16*)(p.ws + OFF_SP) + ((size_t)bh * 66 + c) * 2 * 4096;
  const u16* P2 = (const u16*)(p.ws + OFF_P2);
  u16* concat = (u16*)(p.ws + OFF_H);
  const int pos0 = c < 64 ? c * 128 : SEQ + (c - 64) * 128;
  const int row0 = bpos_row(b, pos0);
  u16* Kc = (u16*)smem;
  u16* Vs = Kc + 128 * 72;
  __syncthreads();
#pragma unroll
  for (int ps = 0; ps < 4; ++ps) {
    int idx = tid + ps * 256;
    int r = idx >> 3, ch = idx & 7;
    *(bf16x8*)(Kc + r * 72 + ch * 8) = *(const bf16x8*)(KR + (size_t)(pos0 + r) * 64 + ch * 8);
    int d = idx >> 4, c16 = idx & 15;
    *(bf16x8*)(Vs + d * 136 + c16 * 8) = *(const bf16x8*)(VR + (size_t)d * STOT + pos0 + c16 * 8);
  }
  __syncthreads();
  const float lg = ret_lg(h);
#pragma unroll 1
  for (int qg = 0; qg < 2; ++qg) {
    const int i = w * 32 + qg * 16 + fr;
    const int row = row0 + i;
    bf16x8 qf[2];
#pragma unroll
    for (int ks = 0; ks < 2; ++ks) qf[ks] = *(const bf16x8*)(QR + (size_t)row * 256 + h * 64 + ks * 32 + fq * 8);
    f32x4 s[8];
#pragma unroll
    for (int sub = 0; sub < 8; ++sub) {
      s[sub] = f32x4{0.f, 0.f, 0.f, 0.f};
#pragma unroll
      for (int ks = 0; ks < 2; ++ks) {
        bf16x8 a = *(const bf16x8*)(Kc + (sub * 16 + fr) * 72 + ks * 32 + fq * 8);
        s[sub] = __builtin_amdgcn_mfma_f32_16x16x32_bf16(a, qf[ks], s[sub], 0, 0, 0);
      }
    }
    float res[4][4];
#pragma unroll
    for (int dt = 0; dt < 4; ++dt)
#pragma unroll
      for (int j = 0; j < 4; ++j) res[dt][j] = 0.f;
#pragma unroll 1
    for (int dir = 0; dir < 2; ++dir) {
      f32x4 O[4];
      const float qw = dir == 0 ? __builtin_amdgcn_exp2f(lg * (float)(i + 1)) : __builtin_amdgcn_exp2f(lg * (float)(128 - i));
#pragma unroll
      for (int dt = 0; dt < 4; ++dt) {
        O[dt] = f32x4{0.f, 0.f, 0.f, 0.f};
#pragma unroll
        for (int ks = 0; ks < 2; ++ks) {
          bf16x8 a = *(const bf16x8*)(SP + dir * 4096 + (dt * 16 + fr) * 64 + ks * 32 + fq * 8);
          O[dt] = __builtin_amdgcn_mfma_f32_16x16x32_bf16(a, qf[ks], O[dt], 0, 0, 0);
        }
        O[dt] *= qw;
      }
      int fqo = fq;
      asm volatile("" : "+v"(fqo));
#pragma unroll
      for (int ks = 0; ks < 4; ++ks) {
        float pv[8];
#pragma unroll
        for (int e = 0; e < 8; ++e) {
          const int sub = 2 * ks + (e >> 2), j = e & 3;
          const int jk = sub * 16 + fqo * 4 + j;
          const int dd = dir == 0 ? i - jk : jk - i;
          pv[e] = dd >= 0 ? s[sub][j] * __builtin_amdgcn_exp2f(lg * (float)dd) : 0.f;
        }
        bf16x8 pb = cat8(pack4(pv[0], pv[1], pv[2], pv[3]), pack4(pv[4], pv[5], pv[6], pv[7]));
#pragma unroll
        for (int dt = 0; dt < 4; ++dt) {
          const u16* vp = Vs + (dt * 16 + fr) * 136 + ks * 32 + fq * 4;
          bf16x8 va = cat8(*(const bf16x4*)vp, *(const bf16x4*)(vp + 16));
          O[dt] = __builtin_amdgcn_mfma_f32_16x16x32_bf16(va, pb, O[dt], 0, 0, 0);
        }
      }
      float sm = 0.f;
#pragma unroll
      for (int dt = 0; dt < 4; ++dt)
#pragma unroll
        for (int j = 0; j < 4; ++j) sm += O[dt][j];
      sm += __shfl_xor(sm, 16); sm += __shfl_xor(sm, 32);
      const float mu = sm * (1.f / 64.f);
      float vs = 0.f;
#pragma unroll
      for (int dt = 0; dt < 4; ++dt)
#pragma unroll
        for (int j = 0; j < 4; ++j) { float dlt = O[dt][j] - mu; vs += dlt * dlt; }
      vs += __shfl_xor(vs, 16); vs += __shfl_xor(vs, 32);
      const float rstd = rsqrtf(vs * (1.f / 64.f) + GN_EPS);
#pragma unroll
      for (int dt = 0; dt < 4; ++dt) {
        const int d = dt * 16 + fq * 4;
        bf16x4 gt = *(const bf16x4*)(P2 + (size_t)row * P2C + dir * 256 + h * 64 + d);
        float4 rg = *(const float4*)(p.ret_g + (size_t)l * 256 + h * 64 + d);
        res[dt][0] += (O[dt][0] - mu) * rstd * rg.x * siluf_(bf2f((u16)gt[0]));
        res[dt][1] += (O[dt][1] - mu) * rstd * rg.y * siluf_(bf2f((u16)gt[1]));
        res[dt][2] += (O[dt][2] - mu) * rstd * rg.z * siluf_(bf2f((u16)gt[2]));
        res[dt][3] += (O[dt][3] - mu) * rstd * rg.w * siluf_(bf2f((u16)gt[3]));
      }
    }
#pragma unroll
    for (int dt = 0; dt < 4; ++dt)
      *(bf16x4*)(concat + (size_t)row * D + 512 + h * 64 + dt * 16 + fq * 4) = pack4(res[dt][0], res[dt][1], res[dt][2], res[dt][3]);
  }
}

__device__ __forceinline__ void phase_retout(const Params& p, int l, unsigned char* smem) {
  for (int item = BIDX(); item < 16 * 66; item += gridDim.x) retout_item(p, l, item / 66, item % 66, smem);
}

__device__ __forceinline__ void phase_wprep(const Params& p, int l, unsigned char* smem) {
  const int tid = TIDX(), col = tid;
  const u16* P2 = (const u16*)(p.ws + OFF_P2);
  u16* prep = (u16*)(p.ws + OFF_PREP);
  float* twT = (float*)smem;
  float* amT = twT + 64 * 16;
  float* outW = amT + 64 * 16;
  float* outA = outW + 16 * 256;
  const int j = tid & 31, tsub = tid >> 5, head = j >> 3, c8 = (j & 7) * 8, ch0 = head * 64 + c8;
  float kkv[8], kav[8];
#pragma unroll
  for (int e = 0; e < 8; ++e) { kkv[e] = p.k_k[(size_t)l * 256 + ch0 + e]; kav[e] = p.k_a[(size_t)l * 256 + ch0 + e]; }
  for (int item = BIDX(); item < (TALL / 16) * 2; item += gridDim.x) {
    const int dir = item & 1, row0 = (item >> 1) * 16;
    const float* mu = p.mu + ((size_t)l * 2 + dir) * 896;
    __syncthreads();
    {
      const int tok = tid >> 4, e0 = (tid & 15) * 4;
      const int row = row0 + tok;
      int b, pos;
      row_bpos(row, b, pos);
      bool has;
      int nrow;
      if (dir == 0) { has = (pos != 0) && (pos != SEQ); nrow = row - 1; }
      else { has = (pos != SEQ - 1) && (pos != STOT - 1); nrow = row + 1; }
      const int srow = has ? nrow : row;
      bf16x4 zw = *(const bf16x4*)(P2 + (size_t)row * P2C + 1408 + dir * 64 + e0);
      bf16x4 za = *(const bf16x4*)(P2 + (size_t)row * P2C + 1536 + dir * 64 + e0);
      bf16x4 sw = *(const bf16x4*)(P2 + (size_t)srow * P2C + 1408 + dir * 64 + e0);
      bf16x4 sa = *(const bf16x4*)(P2 + (size_t)srow * P2C + 1536 + dir * 64 + e0);
#pragma unroll
      for (int e = 0; e < 4; ++e) {
        float z = bf2f((u16)zw[e]), zs = has ? bf2f((u16)sw[e]) : 0.f;
        twT[(e0 + e) * 16 + tok] = tanhf_(z + mu[768 + e0 + e] * (zs - z));
        float z2 = bf2f((u16)za[e]), zs2 = has ? bf2f((u16)sa[e]) : 0.f;
        amT[(e0 + e) * 16 + tok] = z2 + mu[832 + e0 + e] * (zs2 - z2);
      }
    }
    __syncthreads();
    {
      float accw[16], acca[16];
#pragma unroll
      for (int t = 0; t < 16; ++t) { accw[t] = 0.f; acca[t] = 0.f; }
      const float* w2 = p.w2 + ((size_t)l * 2 + dir) * 64 * 256 + col;
      const float* a2 = p.a2 + ((size_t)l * 2 + dir) * 64 * 256 + col;
#pragma unroll 1
      for (int k0 = 0; k0 < 64; k0 += 4) {
        float wv8[4], av8[4];
#pragma unroll
        for (int u = 0; u < 4; ++u) { wv8[u] = w2[(k0 + u) * 256]; av8[u] = a2[(k0 + u) * 256]; }
#pragma unroll
        for (int u = 0; u < 4; ++u) {
          const int kq = k0 + u;
          const float wv = wv8[u], av = av8[u];
#pragma unroll
          for (int t4 = 0; t4 < 4; ++t4) {
            float4 a = *(const float4*)(twT + kq * 16 + t4 * 4);
            float4 bq = *(const float4*)(amT + kq * 16 + t4 * 4);
            accw[t4 * 4 + 0] += a.x * wv; accw[t4 * 4 + 1] += a.y * wv; accw[t4 * 4 + 2] += a.z * wv; accw[t4 * 4 + 3] += a.w * wv;
            acca[t4 * 4 + 0] += bq.x * av; acca[t4 * 4 + 1] += bq.y * av; acca[t4 * 4 + 2] += bq.z * av; acca[t4 * 4 + 3] += bq.w * av;
          }
        }
      }
      const float w0v = p.w0[((size_t)l * 2 + dir) * 256 + col], a0v = p.a0[((size_t)l * 2 + dir) * 256 + col];
#pragma unroll
      for (int t = 0; t < 16; ++t) {
        outW[t * 256 + col] = -0.6065306597126334f * sigmoidf_(w0v + accw[t]) * LOG2E;
        outA[t * 256 + col] = sigmoidf_(a0v + acca[t]);
      }
    }
    __syncthreads();
    {
      float mur[8], muk[8], muv[8];
#pragma unroll
      for (int e = 0; e < 8; ++e) { mur[e] = mu[ch0 + e]; muk[e] = mu[256 + ch0 + e]; muv[e] = mu[512 + ch0 + e]; }
#pragma unroll
      for (int pass = 0; pass < 2; ++pass) {
        const int tok = pass * 8 + tsub, row = row0 + tok;
        int b, pos;
        row_bpos(row, b, pos);
        bool has;
        int nrow;
        if (dir == 0) { has = (pos != 0) && (pos != SEQ); nrow = row - 1; }
        else { has = (pos != SEQ - 1) && (pos != STOT - 1); nrow = row + 1; }
        const u16* cp = P2 + (size_t)row * P2C + 512 + ch0;
        const u16* np = P2 + (size_t)(has ? nrow : row) * P2C + 512 + ch0;
        const bf16x8 zr8 = *(const bf16x8*)cp, zk8 = *(const bf16x8*)(cp + 256), zv8 = *(const bf16x8*)(cp + 512);
        const bf16x8 sr8 = *(const bf16x8*)np, sk8 = *(const bf16x8*)(np + 256), sv8 = *(const bf16x8*)(np + 512);
        const float4 lw0 = *(const float4*)(outW + tok * 256 + ch0), lw1 = *(const float4*)(outW + tok * 256 + ch0 + 4);
        const float4 av0 = *(const float4*)(outA + tok * 256 + ch0), av1 = *(const float4*)(outA + tok * 256 + ch0 + 4);
        const float lw[8] = {lw0.x, lw0.y, lw0.z, lw0.w, lw1.x, lw1.y, lw1.z, lw1.w};
        const float av[8] = {av0.x, av0.y, av0.z, av0.w, av1.x, av1.y, av1.z, av1.w};
        float r[8], k[8], v[8], kkr[8], ss = 0.f;
#pragma unroll
        for (int e = 0; e < 8; ++e) {
          float zr = bf2f((u16)zr8[e]), zk = bf2f((u16)zk8[e]), zv = bf2f((u16)zv8[e]);
          float sr = has ? bf2f((u16)sr8[e]) : 0.f, sk = has ? bf2f((u16)sk8[e]) : 0.f, sv = has ? bf2f((u16)sv8[e]) : 0.f;
          r[e] = zr + mur[e] * (sr - zr); k[e] = zk + muk[e] * (sk - zk); v[e] = zv + muv[e] * (sv - zv);
          kkr[e] = k[e] * kkv[e];
          ss += kkr[e] * kkr[e];
        }
        ss = half8_sum(ss);
        const float rs = rsqrtf(fmaxf(ss, 1e-24f));
        float kt[8], kk[8], bb[8];
#pragma unroll
        for (int e = 0; e < 8; ++e) {
          kk[e] = kkr[e] * rs;
          kt[e] = k[e] * (1.f + (av[e] - 1.f) * kav[e]);
          bb[e] = kk[e] * av[e];
        }
        u16* dp = prep + (((size_t)(b * 4 + head) * 2 + dir) * STOT + pos) * 384 + c8;
        *(bf16x8*)(dp) = cat8(pack4(lw[0], lw[1], lw[2], lw[3]), pack4(lw[4], lw[5], lw[6], lw[7]));
        *(bf16x8*)(dp + 64) = cat8(pack4(kt[0], kt[1], kt[2], kt[3]), pack4(kt[4], kt[5], kt[6], kt[7]));
        *(bf16x8*)(dp + 128) = cat8(pack4(kk[0], kk[1], kk[2], kk[3]), pack4(kk[4], kk[5], kk[6], kk[7]));
        *(bf16x8*)(dp + 192) = cat8(pack4(bb[0], bb[1], bb[2], bb[3]), pack4(bb[4], bb[5], bb[6], bb[7]));
        *(bf16x8*)(dp + 256) = cat8(pack4(r[0], r[1], r[2], r[3]), pack4(r[4], r[5], r[6], r[7]));
        *(bf16x8*)(dp + 320) = cat8(pack4(v[0], v[1], v[2], v[3]), pack4(v[4], v[5], v[6], v[7]));
      }
    }
  }
}

typedef float f32x2 __attribute__((ext_vector_type(2)));
__device__ __forceinline__ void wscan_item(const Params& p, int item, unsigned char* smem) {
  const int tid = TIDX(), w = tid >> 6, lane = tid & 63;
  const int jl4 = (lane & 15) * 4, rsub = lane >> 4;
  const u16* prep = (const u16*)(p.ws + OFF_PREP);
  u16* P2w = (u16*)(p.ws + OFF_P2);
  float* bufs = (float*)smem;
  {
    const int rq = item & 3, seq = item >> 2;
    const int dir = seq & 1, h = (seq >> 1) & 3, b = seq >> 3;
    const int irow = rq * 16 + w * 4 + rsub;
    const u16* base = prep + (size_t)seq * STOT * 384;
    uint4 lreg[3];
    auto gload = [&](int ch) {
#pragma unroll
      for (int ps = 0; ps < 3; ++ps) {
        int q = tid + ps * 256;
        int sidx = q / 48, within = q % 48;
        int n = ch * 16 + sidx;
        int pos = dir == 0 ? (n < CTXL ? SEQ + n : n - CTXL) : (STOT - 1 - n);
        lreg[ps] = *(const uint4*)(base + (size_t)pos * 384 + within * 8);
      }
    };
    auto lstore = [&](int buf) {
#pragma unroll
      for (int ps = 0; ps < 3; ++ps) {
        int q = tid + ps * 256;
        int sidx = q / 48, within = q % 48;
        float* dp = bufs + buf * 6144 + sidx * 384 + within * 8;
        uint4 u = lreg[ps];
        float4 lo = make_float4(__uint_as_float(u.x << 16), __uint_as_float(u.x & 0xffff0000u), __uint_as_float(u.y << 16), __uint_as_float(u.y & 0xffff0000u));
        float4 hi = make_float4(__uint_as_float(u.z << 16), __uint_as_float(u.z & 0xffff0000u), __uint_as_float(u.w << 16), __uint_as_float(u.w & 0xffff0000u));
        if (within < 8) {
          lo.x = __builtin_amdgcn_exp2f(lo.x); lo.y = __builtin_amdgcn_exp2f(lo.y); lo.z = __builtin_amdgcn_exp2f(lo.z); lo.w = __builtin_amdgcn_exp2f(lo.w);
          hi.x = __builtin_amdgcn_exp2f(hi.x); hi.y = __builtin_amdgcn_exp2f(hi.y); hi.z = __builtin_amdgcn_exp2f(hi.z); hi.w = __builtin_amdgcn_exp2f(hi.w);
        }
        *(float4*)dp = lo;
        *(float4*)(dp + 4) = hi;
      }
    };
    f32x2 S01 = {0.f, 0.f}, S23 = {0.f, 0.f};
    __syncthreads();
    gload(0);
    lstore(0);
    __syncthreads();
    constexpr int NCH = STOT / 16;
    for (int ch = 0; ch < NCH; ++ch) {
      if (ch + 1 < NCH) gload(ch + 1);
      const float* bp = bufs + (ch & 1) * 6144;
      const int n0 = ch * 16;
      const int pos0 = dir == 0 ? (n0 < CTXL ? SEQ + n0 : n0 - CTXL) : (STOT - 1 - n0);
      u16* yp = P2w + (size_t)bpos_row(b, pos0) * P2C + (dir == 0 ? YCOL0 : YCOL1) + h * 64 + irow;
      const int ystride = dir == 0 ? P2C : -P2C;
      float4 Wq[3], Kq[3], Nq[3], Bq[3], Rq[3];
      float Vq[3];
#define SCAN_LD(slot, st)                                        \
      do {                                                         \
        const float* sp_ = bp + (st) * 384;                        \
        Wq[slot] = *(const float4*)(sp_ + jl4);                    \
        Kq[slot] = *(const float4*)(sp_ + 64 + jl4);               \
        Nq[slot] = *(const float4*)(sp_ + 128 + jl4);              \
        Bq[slot] = *(const float4*)(sp_ + 192 + jl4);              \
        Rq[slot] = *(const float4*)(sp_ + 256 + jl4);              \
        Vq[slot] = sp_[320 + irow];                                \
      } while (0)
      SCAN_LD(0, 0);
      SCAN_LD(1, 1);
      SCAN_LD(2, 2);
      float ypart = 0.f;
#pragma unroll
      for (int s = 0; s < 16; ++s) {
        const int sl = s % 3;
        const float4 wv = Wq[sl], kt = Kq[sl], kk = Nq[sl], bb = Bq[sl], rr = Rq[sl];
        const float v = Vq[sl];
        if (s + 3 < 16) SCAN_LD(sl, s + 3);
        const f32x2 vv = {v, v};
        f32x2 A01 = S01 * f32x2{wv.x, wv.y} + vv * f32x2{kt.x, kt.y};
        f32x2 A23 = S23 * f32x2{wv.z, wv.w} + vv * f32x2{kt.z, kt.w};
        f32x2 pp = S01 * f32x2{kk.x, kk.y} + S23 * f32x2{kk.z, kk.w};
        float sa = pp.x + pp.y;
        float yprev = ypart;
        row16_sum2(sa, yprev);
        if (s > 0) { if ((lane & 15) == 0) yp[(s - 1) * ystride] = f2bf(yprev); }
        const f32x2 nsa = {-sa, -sa};
        S01 = nsa * f32x2{bb.x, bb.y} + A01;
        S23 = nsa * f32x2{bb.z, bb.w} + A23;
        f32x2 yy = S01 * f32x2{rr.x, rr.y} + S23 * f32x2{rr.z, rr.w};
        ypart = yy.x + yy.y;
      }
      {
        float ylast = row16_sum(ypart);
        if ((lane & 15) == 0) yp[15 * ystride] = f2bf(ylast);
      }
#undef SCAN_LD
      if (ch + 1 < NCH) lstore((ch + 1) & 1);
      __syncthreads();
    }
  }
}

__device__ __forceinline__ void phase_scan_attn(const Params& p, int l, unsigned char* smem) {
  const int G = gridDim.x, tid = TIDX(), bid = BIDX();
  if (G > 128 && G <= 2048) {
    int* keys = (int*)smem;
    int* red = keys + 2048;
    const int* cutab = (const int*)(p.ws + OFF_CUTAB);
    __syncthreads();
    for (int i = tid; i < G; i += 256) keys[i] = cutab[i];
    if (tid == 0) { red[0] = 0; red[1] = 0; }
    __syncthreads();
    for (int i = 128 + tid; i < G; i += 256) {
      const int ki = keys[i];
      bool m = false;
      for (int j = 0; j < 128; ++j) m = m || (keys[j] == ki);
      if (!m) atomicAdd(&red[0], 1);
      if (m && i == bid) red[1] = 1;
    }
    __syncthreads();
    const int eligible = red[0], mine = red[1];
    __syncthreads();
    if (bid < 128) {
      __builtin_amdgcn_s_setprio(3);
      wscan_item(p, bid, smem);
      __builtin_amdgcn_s_setprio(0);
    } else if (eligible < 64 || !mine) {
      attn_worker(p, l, smem);
    }
  } else {
    for (int item = bid; item < 128; item += G) wscan_item(p, item, smem);
    attn_worker(p, l, smem);
  }
}

__device__ __forceinline__ void phase_wfin(const Params& p, int l, unsigned char* smem) {
  const int tid = TIDX(), col = tid;
  const u16* P2 = (const u16*)(p.ws + OFF_P2);
  const u16* prep = (const u16*)(p.ws + OFF_PREP);
  u16* concat = (u16*)(p.ws + OFF_H);
  float* sgT = (float*)smem;
  float* gateL = sgT + 128 * 16;
  const float* g2 = p.g2 + (size_t)l * 128 * 256 + col;
  const int j = tid & 31, tsub = tid >> 5, head = j >> 3, c8 = (j & 7) * 8, ch0 = head * 64 + c8;
  float lng[8], lnb[8], rho[2][8];
#pragma unroll
  for (int e = 0; e < 8; ++e) {
    lng[e] = p.ln_g[(size_t)l * 256 + ch0 + e];
    lnb[e] = p.ln_b[(size_t)l * 256 + ch0 + e];
    rho[0][e] = p.rho[((size_t)l * 2 + 0) * 256 + ch0 + e];
    rho[1][e] = p.rho[((size_t)l * 2 + 1) * 256 + ch0 + e];
  }
  for (int item = BIDX(); item < TALL / 16; item += gridDim.x) {
    const int row0 = item * 16;
    __syncthreads();
    {
      const int tok = tid >> 4, k0 = (tid & 15) * 8;
      bf16x8 g = *(const bf16x8*)(P2 + (size_t)(row0 + tok) * P2C + 1280 + k0);
#pragma unroll
      for (int e = 0; e < 8; ++e) sgT[(k0 + e) * 16 + tok] = sigmoidf_(bf2f((u16)g[e]));
    }
    __syncthreads();
    float acc[16];
#pragma unroll
    for (int t = 0; t < 16; ++t) acc[t] = 0.f;
#pragma unroll 1
    for (int k0 = 0; k0 < 128; k0 += 16) {
      float gv8[16];
#pragma unroll
      for (int u = 0; u < 16; ++u) gv8[u] = g2[(k0 + u) * 256];
#pragma unroll
      for (int u = 0; u < 16; ++u) {
        const int k = k0 + u;
        const float gv = gv8[u];
#pragma unroll
        for (int t4 = 0; t4 < 4; ++t4) {
          float4 a = *(const float4*)(sgT + k * 16 + t4 * 4);
          acc[t4 * 4 + 0] += a.x * gv; acc[t4 * 4 + 1] += a.y * gv; acc[t4 * 4 + 2] += a.z * gv; acc[t4 * 4 + 3] += a.w * gv;
        }
      }
    }
#pragma unroll
    for (int t = 0; t < 16; ++t) gateL[t * 256 + col] = acc[t];
    __syncthreads();
#pragma unroll
    for (int pass = 0; pass < 2; ++pass) {
      const int tok = pass * 8 + tsub, row = row0 + tok;
      int b, pos;
      row_bpos(row, b, pos);
      float tot[8];
#pragma unroll
      for (int e = 0; e < 8; ++e) tot[e] = 0.f;
#pragma unroll
      for (int dir = 0; dir < 2; ++dir) {
        const bf16x8 y8 = *(const bf16x8*)(P2 + (size_t)row * P2C + (dir == 0 ? YCOL0 : YCOL1) + ch0);
        const u16* pp = prep + (((size_t)(b * 4 + head) * 2 + dir) * STOT + pos) * 384 + c8;
        const bf16x8 kt8 = *(const bf16x8*)(pp + 64), r8 = *(const bf16x8*)(pp + 256), v8 = *(const bf16x8*)(pp + 320);
        float y[8], s1 = 0.f, s3 = 0.f;
#pragma unroll
        for (int e = 0; e < 8; ++e) {
          y[e] = bf2f((u16)y8[e]);
          s1 += y[e];
          s3 += bf2f((u16)r8[e]) * bf2f((u16)kt8[e]) * rho[dir][e];
        }
        s1 = half8_sum(s1);
        s3 = half8_sum(s3);
        const float mu = s1 * (1.f / 64.f);
        float s2 = 0.f;
#pragma unroll
        for (int e = 0; e < 8; ++e) { y[e] -= mu; s2 += y[e] * y[e]; }
        s2 = half8_sum(s2);
        const float rstd = rsqrtf(s2 * (1.f / 64.f) + GN_EPS);
#pragma unroll
        for (int e = 0; e < 8; ++e) tot[e] += y[e] * rstd * lng[e] + lnb[e] + s3 * bf2f((u16)v8[e]);
      }
      const float4 g0 = *(const float4*)(gateL + tok * 256 + ch0), g1 = *(const float4*)(gateL + tok * 256 + ch0 + 4);
      bf16x8 o = cat8(pack4(tot[0] * g0.x, tot[1] * g0.y, tot[2] * g0.z, tot[3] * g0.w),
                      pack4(tot[4] * g1.x, tot[5] * g1.y, tot[6] * g1.z, tot[7] * g1.w));
      *(bf16x8*)(concat + (size_t)row * D + 768 + ch0) = o;
    }
  }
}

constexpr int N_PHASES = 1 + 2 * 16 + 1;
__device__ __forceinline__ void run_phase(const Params& p_in, int ph, unsigned char* smem) {
  Params p = p_in;
  {
    unsigned long long w = (unsigned long long)p.ws;
    asm volatile("" : "+s"(w));
    p.ws = (unsigned char*)w;
  }
  if (ph == 0) { phase_init(p, smem); return; }
  if (ph == N_PHASES - 1) { phase_final_norm(p); return; }
  const int l = (ph - 1) / 16, s = (ph - 1) % 16;
  float* xc = (float*)(p.ws + OFF_XC);
  const float* lat_in = (l == 0 && s < 3) ? p.x : p.out;
  const float* cx_in = (l == 0 && s < 3) ? p.ctx : xc;
  const u16* H = (const u16*)(p.ws + OFF_H);
  const u16* ACT = (const u16*)(p.ws + OFF_P2);
  switch (s) {
    case 0: phase_norm(p, l, 0, lat_in, cx_in); break;
    case 1: phase_ffn_in(p, l, 0, smem); break;
    case 2: phase_resid_gemm(p, l, ACT, (const u16*)(p.ws + OFF_WFFO) + (size_t)0 * 1024 * DFF, DFF, 2, 0.5f, lat_in, cx_in, p.out, xc, smem); break;
    case 3: phase_norm(p, l, 1, p.out, xc); break;
    case 4: phase_inproj(p, l, smem); break;
    case 5: phase_retU(p, smem); break;
    case 6: phase_retscan(p); break;
    case 7: phase_retout(p, l, smem); break;
    case 8: phase_wprep(p, l, smem); break;
    case 9: phase_scan_attn(p, l, smem); break;
    case 10: phase_wfin(p, l, smem); break;
    case 11: phase_resid_gemm(p, l, H, (const u16*)(p.ws + OFF_WOUT), 1024, 5, 1.0f, p.out, xc, p.out, xc, smem); break;
    case 12: phase_norm(p, l, 2, p.out, xc); break;
    case 13: phase_ffn_in(p, l, 1, smem); break;
    case 14: phase_resid_gemm(p, l, ACT, (const u16*)(p.ws + OFF_WFFO) + (size_t)1 * 1024 * DFF, DFF, 8, 0.5f, p.out, xc, p.out, xc, smem); break;
    default: if (l == 0) convert_weights(p, 1, smem); break;
  }
}

#if MULTI_LAUNCH
__global__ void __launch_bounds__(256, 2) k_phase(Params p, int ph) {
  __shared__ __attribute__((aligned(16))) unsigned char smem[49152];
  run_phase(p, ph, smem);
}
#else
constexpr int SMEM_BYTES = 65536;
__global__ void __launch_bounds__(256, 2) k_mega(Params p) {
  __shared__ __attribute__((aligned(16))) unsigned char smem[SMEM_BYTES];
  cg::grid_group grid = cg::this_grid();
  volatile LAS unsigned* st = (volatile LAS unsigned*)(smem + SMEM_BYTES - 16);
  if (threadIdx.x == 0) { st[0] = 0u; st[1] = 0u; }
  __syncthreads();
  {
    unsigned* bw = (unsigned*)(p.ws + OFF_BAR);
    for (int i = blockIdx.x * 256 + threadIdx.x; i < XCD_BAR_WORDS; i += gridDim.x * 256) bw[i] = 0u;
  }
  grid.sync();
  XcdBarrier xb = xcd_barrier_post((unsigned*)(p.ws + OFF_BAR), st);
  run_phase(p, 0, smem);
  xcd_barrier(xb);
#pragma unroll 1
  for (int l = 0; l < 2; ++l) {
#pragma unroll 1
    for (int s = 0; s < 16 - l; ++s) {
      run_phase(p, 1 + l * 16 + s, smem);
      xcd_barrier(xb);
#ifdef PROBE_REPEAT
      if ((PROBE_REPEAT >> s) & 1) {
        run_phase(p, 1 + l * 16 + s, smem);
        xcd_barrier(xb);
      }
#endif
    }
  }
  run_phase(p, N_PHASES - 1, smem);
}
#endif

extern "C" void kernel_launch(void* const* d_in, const int* in_sizes, int n_in, void* d_out, int out_size, void* d_ws,
                              size_t ws_size, hipStream_t stream) {
  Params p{};
  const float** pp = (const float**)&p;
  for (int i = 0; i < 26; ++i) pp[i] = (const float*)d_in[i];
  p.out = (float*)d_out;
  p.ws = (unsigned char*)d_ws;
#if MULTI_LAUNCH
  for (int ph = 0; ph < N_PHASES; ++ph) {
    if (ph > 0 && ((ph - 1) % 16) == 15 && ph != N_PHASES - 1) continue;
    k_phase<<<dim3(512), dim3(256), 0, stream>>>(p, ph);
  }
#else
  static int grid_blocks = 0;
  if (!grid_blocks) {
    int dev = 0, cus = 0, per_cu = 0;
    hipGetDevice(&dev);
    hipDeviceGetAttribute(&cus, hipDeviceAttributeMultiprocessorCount, dev);
    hipOccupancyMaxActiveBlocksPerMultiprocessor(&per_cu, k_mega, 256, 0);
    if (per_cu > 2) per_cu = 2;
    grid_blocks = cus * per_cu;
  }
  void* args[] = {&p};
  hipError_t e = hipLaunchCooperativeKernel((void*)k_mega, dim3(grid_blocks), dim3(256), args, 0, stream);
  if (e != hipSuccess) fprintf(stderr, "cooperative launch failed: %s (grid %d)\n", hipGetErrorString(e), grid_blocks);
#endif
}
```

```cpp
#include <hip/hip_runtime.h>
#include <hip/hip_bf16.h>
#include <hip/hip_cooperative_groups.h>
#include <cstdio>
namespace cg = cooperative_groups;

#ifndef MULTI_LAUNCH
#define MULTI_LAUNCH 0
#endif

typedef unsigned short u16;
using bf16x8 = __attribute__((ext_vector_type(8))) short;
using bf16x4 = __attribute__((ext_vector_type(4))) short;
using f32x4 = __attribute__((ext_vector_type(4))) float;

constexpr int D = 1024;
constexpr int TLAT = 32768;
constexpr int TCTX = 1024;
constexpr int TALL = TLAT + TCTX;
constexpr int SEQ = 8192;
constexpr int CTXL = 256;
constexpr int STOT = SEQ + CTXL;
constexpr int DFF = 2816;
constexpr int PC = 3456;
constexpr int P2C = 1664;
constexpr int NMOD = 9 * D;
constexpr float LOG2E = 1.4426950408889634f;
constexpr float RMS_EPS = 1e-6f;
constexpr float GN_EPS = 64e-5f;

constexpr size_t MiB = 1ull << 20;
constexpr size_t OFF_WFFI = 0;
constexpr size_t OFF_WFFO = 22 * MiB;
constexpr size_t OFF_WIN = 33 * MiB;
constexpr size_t OFF_WOUT = OFF_WIN + 27 * MiB / 4;
constexpr size_t OFF_MOD = OFF_WOUT + 2 * MiB;
constexpr size_t OFF_BAR = OFF_MOD + 384 * 1024;
constexpr size_t OFF_QCTR = OFF_MOD + 400 * 1024;
constexpr size_t OFF_CUTAB = OFF_QCTR + 256;
constexpr size_t OFF_ROPE = OFF_MOD + MiB / 2;
constexpr size_t OFF_XC = OFF_ROPE + 5 * MiB / 2;
constexpr size_t OFF_H = OFF_XC + 4 * MiB;
constexpr size_t OFF_P2 = OFF_H + 66 * MiB;
constexpr size_t OFF_BIG = OFF_P2 + 429 * MiB / 4;
constexpr size_t SZ_Q = (size_t)TALL * 256 * 2;
constexpr size_t SZ_KV2 = (size_t)4 * 2 * STOT * 64 * 2;
constexpr size_t SZ_KV4 = (size_t)4 * 4 * STOT * 64 * 2;
constexpr size_t OFF_QA = OFF_BIG;
constexpr size_t OFF_QB = OFF_QA + SZ_Q;
constexpr size_t OFF_KA = OFF_QB + SZ_Q;
constexpr size_t OFF_VA = OFF_KA + SZ_KV2;
constexpr size_t OFF_KB = OFF_VA + SZ_KV2;
constexpr size_t OFF_VB = OFF_KB + SZ_KV2;
constexpr size_t OFF_R0 = OFF_VB + SZ_KV2;
constexpr size_t OFF_QR = OFF_R0;
constexpr size_t OFF_KR = OFF_QR + SZ_Q;
constexpr size_t OFF_VR = OFF_KR + SZ_KV4;
constexpr size_t OFF_U = OFF_VR + SZ_KV4;
constexpr size_t OFF_SP = OFF_U + (size_t)16 * 66 * 2 * 4096 * 4;
constexpr size_t OFF_PREP = OFF_R0;
constexpr size_t WS_END = OFF_PREP + (size_t)32 * STOT * 384 * 2;
constexpr int YCOL0 = 768, YCOL1 = 1408;
static_assert(WS_END <= 512 * MiB, "workspace overflow");
static_assert(OFF_SP + (size_t)16 * 66 * 2 * 4096 * 2 <= 512 * MiB, "workspace overflow");
static_assert(OFF_P2 + (size_t)TALL * DFF * 2 <= 512 * MiB, "act overflow");

struct Params {
  const float *x, *c, *ctx, *c_ctx, *w_mod, *b_mod, *norm_g, *ffn_w_in, *ffn_w_out, *w_in, *w_out, *attn_sink, *qk_g,
      *ret_g, *mu, *w0, *w2, *a0, *a2, *rho, *k_k, *k_a, *g2, *ln_g, *ln_b, *final_g;
  float* out;
  unsigned char* ws;
};

__device__ __forceinline__ int TIDX() { int t = threadIdx.x; asm volatile("" : "+v"(t)); return t & 255; }
__device__ __forceinline__ int BIDX() { int t = blockIdx.x; asm volatile("" : "+s"(t)); return t; }
typedef float f32x2_t __attribute__((ext_vector_type(2)));
typedef __bf16 bf16x2_t __attribute__((ext_vector_type(2)));
__device__ __forceinline__ unsigned pk2bf(float a, float b) {
  f32x2_t v = {a, b};
  return __builtin_bit_cast(unsigned, __builtin_convertvector(v, bf16x2_t));
}
__device__ __forceinline__ u16 f2bf(float f) { return (u16)(pk2bf(f, 0.f) & 0xffffu); }
__device__ __forceinline__ float bf2f(u16 h) { return __uint_as_float(((unsigned)h) << 16); }
__device__ __forceinline__ float sigmoidf_(float x) { return __builtin_amdgcn_rcpf(1.f + __expf(-x)); }
__device__ __forceinline__ float siluf_(float x) { return x * __builtin_amdgcn_rcpf(1.f + __expf(-x)); }
__device__ __forceinline__ float tanhf_(float x) { return 1.f - 2.f * __builtin_amdgcn_rcpf(__expf(2.f * x) + 1.f); }
template <int CTRL>
__device__ __forceinline__ float dpp_f(float x) {
  return __builtin_bit_cast(float, __builtin_amdgcn_update_dpp(0, __builtin_bit_cast(int, x), CTRL, 0xf, 0xf, true));
}
__device__ __forceinline__ float row16_sum(float x) {
  x += dpp_f<0xB1>(x);
  x += dpp_f<0x4E>(x);
  x += dpp_f<0x141>(x);
  x += dpp_f<0x140>(x);
  return x;
}
__device__ __forceinline__ float wave_sum(float x) {
  x = row16_sum(x);
  x += __builtin_bit_cast(float, __builtin_amdgcn_update_dpp(0, __builtin_bit_cast(int, x), 0x142, 0xa, 0xf, false));
  x += __builtin_bit_cast(float, __builtin_amdgcn_update_dpp(0, __builtin_bit_cast(int, x), 0x143, 0xc, 0xf, false));
  return __builtin_bit_cast(float, __builtin_amdgcn_readlane(__builtin_bit_cast(int, x), 63));
}
__device__ __forceinline__ float half8_sum(float x) {
  x += dpp_f<0xB1>(x);
  x += dpp_f<0x4E>(x);
  x += dpp_f<0x141>(x);
  return x;
}
__device__ __forceinline__ void row16_sum2(float& a, float& b) {
  a += dpp_f<0xB1>(a);  b += dpp_f<0xB1>(b);
  a += dpp_f<0x4E>(a);  b += dpp_f<0x4E>(b);
  a += dpp_f<0x141>(a); b += dpp_f<0x141>(b);
  a += dpp_f<0x140>(a); b += dpp_f<0x140>(b);
}
__device__ __forceinline__ bf16x4 pack4(float a, float b, float c, float d) {
  uint2 u = make_uint2(pk2bf(a, b), pk2bf(c, d));
  return __builtin_bit_cast(bf16x4, u);
}
__device__ __forceinline__ bf16x8 cat8(bf16x4 a, bf16x4 b) {
  bf16x8 r;
  r[0] = a[0]; r[1] = a[1]; r[2] = a[2]; r[3] = a[3]; r[4] = b[0]; r[5] = b[1]; r[6] = b[2]; r[7] = b[3];
  return r;
}
__device__ __forceinline__ const float* rrow(const float* lat, const float* cx, int r) {
  return r < TLAT ? lat + (size_t)r * D : cx + (size_t)(r - TLAT) * D;
}
__device__ __forceinline__ float* wrow(float* lat, float* cx, int r) {
  return r < TLAT ? lat + (size_t)r * D : cx + (size_t)(r - TLAT) * D;
}
__device__ __forceinline__ int mod_index(int r) { return r < TLAT ? (r >> 13) : 4; }
__device__ __forceinline__ void row_bpos(int r, int& b, int& pos) {
  if (r < TLAT) { b = r >> 13; pos = r & 8191; }
  else { int rc = r - TLAT; b = rc >> 8; pos = SEQ + (rc & 255); }
}
__device__ __forceinline__ int bpos_row(int b, int pos) {
  return pos < SEQ ? b * SEQ + pos : TLAT + b * CTXL + (pos - SEQ);
}


#define XB_TMO      128
#define XB_XCNT(j)  (256  + 64 * (j))
#define XB_XSUB(j)  (1280 + 64 * (j))
#define XB_XGEN(j)  (2304 + 64 * (j))
#define XB_TOP      3328
#define XB_TOPGEN   3392
#define XCD_BAR_WORDS 3456
#define XB_SPIN_CAP (1u << 18)
#define LAS __attribute__((address_space(3)))
__device__ __forceinline__ unsigned xb_ld(unsigned* p) { return __hip_atomic_load(p, __ATOMIC_RELAXED, __HIP_MEMORY_SCOPE_AGENT); }
__device__ __forceinline__ unsigned xb_add(unsigned* p, unsigned v) { return __hip_atomic_fetch_add(p, v, __ATOMIC_RELAXED, __HIP_MEMORY_SCOPE_AGENT); }
__device__ __forceinline__ unsigned xb_xcc_id() { return (unsigned)__builtin_amdgcn_s_getreg((3 << 11) | 20) & 0xFu; }
#define XB_SPIN(cond, bar) do { unsigned _sp = 0; while (cond) { __builtin_amdgcn_s_sleep(1); \
    if ((++_sp & 255u) == 0u) { if (xb_ld(&(bar)[XB_TMO])) break; if (_sp > XB_SPIN_CAP) { atomicAdd(&(bar)[XB_TMO], 1u); break; } } } } while (0)
struct XcdBarrier { unsigned* bar; unsigned x; volatile LAS unsigned* st; };
__device__ __forceinline__ XcdBarrier xcd_barrier_post(unsigned* bar, volatile LAS unsigned* st) {
  XcdBarrier b; b.bar = bar; b.x = xb_xcc_id(); b.st = st;
  if (threadIdx.x == 0) (void)xb_add(&bar[XB_XCNT(b.x)], 1u);
  return b;
}
__device__ __forceinline__ void xcd_barrier_complete(unsigned* bar, unsigned x, unsigned& nloc, unsigned& nx) {
  const unsigned G = gridDim.x * gridDim.y * gridDim.z;
  unsigned sum, cnt, mine, sp = 0u;
  for (;;) {
    sum = 0u; cnt = 0u; mine = 0u;
#pragma unroll
    for (unsigned j = 0; j < 16; ++j) { const unsigned c = xb_ld(&bar[XB_XCNT(j)]); sum += c; cnt += (c > 0u) ? 1u : 0u; mine = (j == x) ? c : mine; }
    if (sum == G) break;
    __builtin_amdgcn_s_sleep(1);
    if ((++sp & 255u) == 0u) { if (xb_ld(&bar[XB_TMO])) break; if (sp > XB_SPIN_CAP) { atomicAdd(&bar[XB_TMO], 1u); break; } }
  }
  nloc = mine > 0u ? mine : 1u; nx = cnt > 0u ? cnt : 1u;
}
__device__ __forceinline__ void xcd_barrier(const XcdBarrier& b) {
  asm volatile("s_waitcnt vmcnt(0)" ::: "memory");
  __syncthreads();
  if (threadIdx.x == 0) {
    unsigned* bar = b.bar;
    __builtin_amdgcn_s_waitcnt(0);
    unsigned nloc = b.st[0], nx = b.st[1];
    if (nloc == 0u) { xcd_barrier_complete(bar, b.x, nloc, nx); b.st[0] = nloc; b.st[1] = nx; }
    const unsigned old = xb_add(&bar[XB_XSUB(b.x)], 1u);
    const unsigned gen = old / nloc;
    if (old + 1u == (gen + 1u) * nloc) {
      __builtin_amdgcn_fence(__ATOMIC_RELEASE, "agent");
      asm volatile("s_waitcnt vmcnt(0)" ::: "memory");
      const unsigned og = xb_add(&bar[XB_TOP], 1u);
      const unsigned tg = og / nx;
      if (og + 1u == (tg + 1u) * nx) xb_add(&bar[XB_TOPGEN], 1u);
      else XB_SPIN(xb_ld(&bar[XB_TOPGEN]) == tg, bar);
      __builtin_amdgcn_fence(__ATOMIC_ACQUIRE, "agent");
      xb_add(&bar[XB_XGEN(b.x)], 1u);
      asm volatile("s_waitcnt vmcnt(0)" ::: "memory");
    } else {
      XB_SPIN(xb_ld(&bar[XB_XGEN(b.x)]) == gen, bar);
      __builtin_amdgcn_fence(__ATOMIC_ACQUIRE, "agent");
      asm volatile("s_waitcnt vmcnt(0)" ::: "memory");
    }
  }
  __syncthreads();
}

__device__ __forceinline__ void convert_weights(const Params& p, int layer, unsigned char* smem) {
  const int tid = TIDX();
  const int nb = gridDim.x, bid = BIDX();
  {
    float* tile = (float*)smem;
    constexpr int N_FFI = 2 * 16 * 88, N_FFO = 2 * 44 * 16, N_WIN = 16 * 54, N_WOUT = 16 * 16;
    for (int item = bid; item < N_FFI + N_FFO + N_WIN + N_WOUT; item += nb) {
      const float* src; u16* dst; int K, N, kt, nt; bool perm = false;
      int it = item;
      if (it < N_FFI) {
        int f = it / (16 * 88); it %= (16 * 88);
        K = 1024; N = 5632; kt = it / 88; nt = it % 88; perm = true;
        src = p.ffn_w_in + (size_t)(layer * 2 + f) * 1024 * 5632;
        dst = (u16*)(p.ws + OFF_WFFI) + (size_t)f * 5632 * 1024;
      } else if (it < N_FFI + N_FFO) {
        it -= N_FFI;
        int f = it / (44 * 16); it %= (44 * 16);
        K = 2816; N = 1024; kt = it / 16; nt = it % 16;
        src = p.ffn_w_out + (size_t)(layer * 2 + f) * 2816 * 1024;
        dst = (u16*)(p.ws + OFF_WFFO) + (size_t)f * 1024 * 2816;
      } else if (it < N_FFI + N_FFO + N_WIN) {
        it -= N_FFI + N_FFO;
        K = 1024; N = 3456; kt = it / 54; nt = it % 54;
        src = p.w_in + (size_t)layer * 1024 * 3456;
        dst = (u16*)(p.ws + OFF_WIN);
      } else {
        it -= N_FFI + N_FFO + N_WIN;
        K = 1024; N = 1024; kt = it / 16; nt = it % 16;
        src = p.w_out + (size_t)layer * 1024 * 1024;
        dst = (u16*)(p.ws + OFF_WOUT);
      }
      __syncthreads();
      {
        const int r = tid >> 4, c4 = tid & 15;
        int np = nt * 64 + c4 * 4;
        int scol = np;
        if (perm) {
          int blk = np >> 7, sub = (np & 127) >> 4, i = np & 15;
          scol = ((sub & 1) ? DFF : 0) + blk * 64 + (sub >> 1) * 16 + i;
        }
#pragma unroll
        for (int ps = 0; ps < 4; ++ps) {
          int k = kt * 64 + ps * 16 + r;
          float4 v = *(const float4*)(src + (size_t)k * N + scol);
          float* tp = tile + (ps * 16 + r) * 65 + c4 * 4;
          tp[0] = v.x; tp[1] = v.y; tp[2] = v.z; tp[3] = v.w;
        }
      }
      __syncthreads();
      {
        const int n = tid >> 2, kq = tid & 3;
        bf16x8 o0, o1;
#pragma unroll
        for (int i = 0; i < 8; ++i) {
          o0[i] = (short)f2bf(tile[(kq * 16 + i) * 65 + n]);
          o1[i] = (short)f2bf(tile[(kq * 16 + 8 + i) * 65 + n]);
        }
        u16* dp = dst + (size_t)(nt * 64 + n) * K + kt * 64 + kq * 16;
        *(bf16x8*)dp = o0;
        *(bf16x8*)(dp + 8) = o1;
      }
    }
    __syncthreads();
  }
}

__device__ __forceinline__ void phase_init(const Params& p, unsigned char* smem) {
  const int tid = TIDX();
  const int nb = gridDim.x, bid = BIDX();
  if (bid == 0 && tid < 2) ((int*)(p.ws + OFF_QCTR))[tid] = 0;
  if (tid == 0) {
    const int hw = __builtin_amdgcn_s_getreg((7 << 11) | (8 << 6) | 4);
    const int xcc = __builtin_amdgcn_s_getreg((3 << 11) | 20) & 0xF;
    ((int*)(p.ws + OFF_CUTAB))[bid] = (xcc << 8) | (hw & 0xFF);
  }
  {
    float2* seq = (float2*)(p.ws + OFF_ROPE);
    float2* rowt = seq + 8192 * 32;
    float2* colt = rowt + 128 * 16;
    for (int i = bid * 256 + tid; i < 8192 * 32 + 128 * 16 + 64 * 16; i += nb * 256) {
      float ang;
      float2* dst;
      if (i < 8192 * 32) {
        int t = i >> 5, k = i & 31;
        float inv = 1.0f / powf(10000.0f, (float)(2 * k) / 64.0f);
        ang = (float)t * inv;
        dst = seq + i;
      } else {
        int j = i - 8192 * 32;
        int pidx = (j < 128 * 16) ? (j >> 4) : ((j - 128 * 16) >> 4);
        int k = j & 15;
        float inv = 1.0f / powf(10000.0f, (float)(2 * k) / 32.0f);
        ang = (float)pidx * inv;
        dst = rowt + j;
      }
      *dst = make_float2(cosf(ang), sinf(ang));
    }
    (void)colt;
  }
  {
    float* sc = (float*)smem;
    float* red = sc + 5 * 1024;
    for (int item = bid; item < 288; item += nb) {
      const int l = item / 144, cb = item % 144;
      __syncthreads();
      for (int i = tid; i < 5 * 1024; i += 256) {
        int m = i >> 10, k = i & 1023;
        float v = (m < 4) ? p.c[m * 1024 + k] : p.c_ctx[k];
        sc[i] = siluf_(v);
      }
      __syncthreads();
      const int cq = tid & 15, kg = tid >> 4;
      float acc[5][4];
#pragma unroll
      for (int m = 0; m < 5; ++m)
#pragma unroll
        for (int q = 0; q < 4; ++q) acc[m][q] = 0.f;
      const float* wbase = p.w_mod + (size_t)l * 1024 * NMOD + cb * 64 + cq * 4;
      for (int kk = 0; kk < 64; ++kk) {
        int k = kg * 64 + kk;
        float4 w4 = *(const float4*)(wbase + (size_t)k * NMOD);
#pragma unroll
        for (int m = 0; m < 5; ++m) {
          float s = sc[m * 1024 + k];
          acc[m][0] += s * w4.x; acc[m][1] += s * w4.y; acc[m][2] += s * w4.z; acc[m][3] += s * w4.w;
        }
      }
#pragma unroll
      for (int m = 0; m < 5; ++m)
#pragma unroll
        for (int q = 0; q < 4; ++q) red[(kg * 5 + m) * 64 + cq * 4 + q] = acc[m][q];
      __syncthreads();
      float* modp = (float*)(p.ws + OFF_MOD);
      for (int o = tid; o < 320; o += 256) {
        int m = o >> 6, cc = o & 63;
        float s = 0.f;
        for (int g = 0; g < 16; ++g) s += red[(g * 5 + m) * 64 + cc];
        int col = cb * 64 + cc;
        modp[((size_t)l * 5 + m) * NMOD + col] = s + p.b_mod[(size_t)l * NMOD + col];
      }
    }
    __syncthreads();
  }
  convert_weights(p, 0, smem);
}

__device__ __forceinline__ void phase_norm(const Params& p, int l, int which, const float* lat, const float* cx) {
  const int lane = TIDX() & 63, wid = TIDX() >> 6;
  u16* h = (u16*)(p.ws + OFF_H);
  const float* g = p.norm_g + ((size_t)l * 3 + which) * D;
  const float* modp = (const float*)(p.ws + OFF_MOD) + (size_t)l * 5 * NMOD;
  for (int r = BIDX() * 4 + wid; r < TALL; r += gridDim.x * 4) {
    const float* xr = rrow(lat, cx, r);
    const float* mp = modp + (size_t)mod_index(r) * NMOD + which * 3 * D;
    float4 v[4];
    float ss = 0.f;
#pragma unroll
    for (int i = 0; i < 4; ++i) {
      v[i] = *(const float4*)(xr + i * 256 + lane * 4);
      ss += v[i].x * v[i].x + v[i].y * v[i].y + v[i].z * v[i].z + v[i].w * v[i].w;
    }
    ss = wave_sum(ss);
    float rstd = rsqrtf(ss * (1.f / 1024.f) + RMS_EPS);
#pragma unroll
    for (int i = 0; i < 4; ++i) {
      int col = i * 256 + lane * 4;
      float4 gg = *(const float4*)(g + col);
      float4 sh = *(const float4*)(mp + col);
      float4 scl = *(const float4*)(mp + D + col);
      bf16x4 o = pack4(v[i].x * rstd * gg.x * (1.f + scl.x) + sh.x, v[i].y * rstd * gg.y * (1.f + scl.y) + sh.y,
                       v[i].z * rstd * gg.z * (1.f + scl.z) + sh.z, v[i].w * rstd * gg.w * (1.f + scl.w) + sh.w);
      *(bf16x4*)(h + (size_t)r * D + col) = o;
    }
  }
}

__device__ __forceinline__ void phase_final_norm(const Params& p) {
  const int lane = TIDX() & 63, wid = TIDX() >> 6;
  for (int r = BIDX() * 4 + wid; r < TLAT; r += gridDim.x * 4) {
    float* xr = p.out + (size_t)r * D;
    float4 v[4];
    float ss = 0.f;
#pragma unroll
    for (int i = 0; i < 4; ++i) {
      v[i] = *(const float4*)(xr + i * 256 + lane * 4);
      ss += v[i].x * v[i].x + v[i].y * v[i].y + v[i].z * v[i].z + v[i].w * v[i].w;
    }
    ss = wave_sum(ss);
    float rstd = rsqrtf(ss * (1.f / 1024.f) + RMS_EPS);
#pragma unroll
    for (int i = 0; i < 4; ++i) {
      int col = i * 256 + lane * 4;
      float4 gg = *(const float4*)(p.final_g + col);
      float4 o = make_float4(v[i].x * rstd * gg.x, v[i].y * rstd * gg.y, v[i].z * rstd * gg.z, v[i].w * rstd * gg.w);
      *(float4*)(xr + col) = o;
    }
  }
}

template <int MI>
__device__ __forceinline__ void gemm_mainloop(const u16* __restrict__ A, const u16* __restrict__ Bt, int K, int brow,
                                              int bcol, f32x4 (&acc)[MI][4], unsigned char* smem) {
  const int tid = TIDX(), wid = tid >> 6, lane = tid & 63, wr = wid >> 1, wc = wid & 1, fr = lane & 15, fq = lane >> 4;
  constexpr int BM = MI * 32;
  constexpr int ACH = BM * 4 / 256;
  constexpr int STAGE = BM * 64 + 8192;
#pragma unroll
  for (int m = 0; m < MI; ++m)
#pragma unroll
    for (int n = 0; n < 4; ++n) acc[m][n] = f32x4{0.f, 0.f, 0.f, 0.f};
  const int nk = K / 32;
  const int prow = tid >> 2, pq = ((tid & 3) ^ ((0x78 >> (((tid >> 4) & 3) * 2)) & 3)) * 8;
  const u16* ga = A + (size_t)(brow + prow) * K + pq;
  const u16* gb = Bt + (size_t)(bcol + prow) * K + pq;
  auto stage = [&](int t, int buf) {
    unsigned char* base = smem + buf * STAGE;
#pragma unroll
    for (int i = 0; i < ACH; ++i)
      __builtin_amdgcn_global_load_lds((const unsigned*)(ga + (size_t)i * 64 * K + t * 32),
                                       (__attribute__((address_space(3))) unsigned*)(base + (tid + i * 256) * 16), 16, 0, 0);
#pragma unroll
    for (int i = 0; i < 2; ++i)
      __builtin_amdgcn_global_load_lds((const unsigned*)(gb + (size_t)i * 64 * K + t * 32),
                                       (__attribute__((address_space(3))) unsigned*)(base + BM * 64 + (tid + i * 256) * 16), 16, 0, 0);
  };
  const int swz = (fq ^ ((0x78 >> (((fr >> 2) & 3) * 2)) & 3)) * 16;
  __syncthreads();
  stage(0, 0);
  for (int t = 0; t < nk; ++t) {
    __syncthreads();
    if (t + 1 < nk) stage(t + 1, (t + 1) & 1);
    const unsigned char* base = smem + (t & 1) * STAGE;
    bf16x8 af[MI], bfr[4];
#pragma unroll
    for (int m = 0; m < MI; ++m) af[m] = *(const bf16x8*)(base + (wr * MI * 16 + m * 16 + fr) * 64 + swz);
#pragma unroll
    for (int n = 0; n < 4; ++n) bfr[n] = *(const bf16x8*)(base + BM * 64 + (wc * 64 + n * 16 + fr) * 64 + swz);
#pragma unroll
    for (int m = 0; m < MI; ++m)
#pragma unroll
      for (int n = 0; n < 4; ++n) acc[m][n] = __builtin_amdgcn_mfma_f32_16x16x32_bf16(af[m], bfr[n], acc[m][n], 0, 0, 0);
  }
}

__device__ __forceinline__ bool next_tile(int it, int MT, int NT, int& tm, int& tn) {
  const int G = gridDim.x, b = BIDX();
  const int total = MT * NT;
  int id;
  if ((G & 7) == 0) {
    const int per = G >> 3;
    id = it * G + (b & 7) * per + (b >> 3);
  } else {
    id = b + it * G;
  }
  if (id >= total) return false;
  constexpr int GM = 8;
  const int gsz = GM * NT;
  const int g = id / gsz, rem = id - g * gsz;
  const int rows = (MT - g * GM) < GM ? (MT - g * GM) : GM;
  tn = rem / rows;
  tm = g * GM + (rem - tn * rows);
  return true;
}

__device__ __forceinline__ void phase_ffn_in(const Params& p, int l, int f, unsigned char* smem) {
  const u16* A = (const u16*)(p.ws + OFF_H);
  const u16* Bt = (const u16*)(p.ws + OFF_WFFI) + (size_t)f * 5632 * 1024;
  u16* act = (u16*)(p.ws + OFF_P2);
  const int tid = TIDX(), wid = tid >> 6, lane = tid & 63, wr = wid >> 1, wc = wid & 1, fr = lane & 15, fq = lane >> 4;
  constexpr int MI = 8, NT = 44, MT = TALL / (MI * 32);
  for (int it = 0;; ++it) {
    int tm, tn;
    if (!next_tile(it, MT, NT, tm, tn)) break;
    f32x4 acc[MI][4];
    gemm_mainloop<MI>(A, Bt, 1024, tm * MI * 32, tn * 128, acc, smem);
#pragma unroll
    for (int m = 0; m < MI; ++m)
#pragma unroll
      for (int q = 0; q < 2; ++q)
#pragma unroll
        for (int j = 0; j < 4; ++j) {
          int row = tm * MI * 32 + wr * MI * 16 + m * 16 + fq * 4 + j;
          int col = tn * 64 + wc * 32 + q * 16 + fr;
          float u1 = acc[m][2 * q][j], u2 = acc[m][2 * q + 1][j];
          act[(size_t)row * DFF + col] = f2bf(siluf_(u1) * u2);
        }
  }
}

__device__ __forceinline__ void phase_resid_gemm(const Params& p, int l, const u16* A, const u16* Bt, int K, int gate, float gscale,
                                 const float* lat_in, const float* cx_in, float* lat_out, float* cx_out,
                                 unsigned char* smem) {
  const int tid = TIDX(), wid = tid >> 6, lane = tid & 63, wr = wid >> 1, wc = wid & 1, fr = lane & 15, fq = lane >> 4;
  constexpr int MI = 6, NT = 8, MT = TALL / (MI * 32);
  const float* modp = (const float*)(p.ws + OFF_MOD) + (size_t)l * 5 * NMOD + gate * D;
  for (int it = 0;; ++it) {
    int tm, tn;
    if (!next_tile(it, MT, NT, tm, tn)) break;
    f32x4 acc[MI][4];
    gemm_mainloop<MI>(A, Bt, K, tm * MI * 32, tn * 128, acc, smem);
    {
      const int rowa = tm * MI * 32 + wr * MI * 16 + fq * 4;
      const int mi0 = mod_index(rowa), mi1 = mod_index(rowa + (MI - 1) * 16 + 3);
      float g0[4], g1[4];
#pragma unroll
      for (int n = 0; n < 4; ++n) {
        const int col = tn * 128 + wc * 64 + n * 16 + fr;
        g0[n] = gscale * modp[(size_t)mi0 * NMOD + col];
        g1[n] = gscale * modp[(size_t)mi1 * NMOD + col];
      }
#pragma unroll
      for (int m = 0; m < MI; ++m) {
        float xv[4][4];
#pragma unroll
        for (int j = 0; j < 4; ++j) {
          const float* xi = rrow(lat_in, cx_in, rowa + m * 16 + j);
#pragma unroll
          for (int n = 0; n < 4; ++n) xv[j][n] = xi[tn * 128 + wc * 64 + n * 16 + fr];
        }
#pragma unroll
        for (int j = 0; j < 4; ++j) {
          const int row = rowa + m * 16 + j;
          const bool first = mod_index(row) == mi0;
          float* xo = wrow(lat_out, cx_out, row);
#pragma unroll
          for (int n = 0; n < 4; ++n) xo[tn * 128 + wc * 64 + n * 16 + fr] = xv[j][n] + (first ? g0[n] : g1[n]) * acc[m][n][j];
        }
      }
    }
  }
}

__device__ __forceinline__ void phase_inproj(const Params& p, int l, unsigned char* smem) {
  const u16* A = (const u16*)(p.ws + OFF_H);
  const u16* Bt = (const u16*)(p.ws + OFF_WIN);
  const int tid = TIDX(), wid = tid >> 6, lane = tid & 63, wr = wid >> 1, wc = wid & 1, fr = lane & 15, fq = lane >> 4;
  constexpr int MI = 8, NT = 27, MT = TALL / (MI * 32);
  const float2* ropeseq = (const float2*)(p.ws + OFF_ROPE);
  const float2* roperow = ropeseq + 8192 * 32;
  const float2* ropecol = roperow + 128 * 16;
  u16* QA = (u16*)(p.ws + OFF_QA); u16* QB = (u16*)(p.ws + OFF_QB); u16* QR = (u16*)(p.ws + OFF_QR);
  u16* KA = (u16*)(p.ws + OFF_KA); u16* VA = (u16*)(p.ws + OFF_VA);
  u16* KB = (u16*)(p.ws + OFF_KB); u16* VB = (u16*)(p.ws + OFF_VB);
  u16* KR = (u16*)(p.ws + OFF_KR); u16* VR = (u16*)(p.ws + OFF_VR);
  u16* P2 = (u16*)(p.ws + OFF_P2);
  for (int it = 0;; ++it) {
    int tm, tn;
    if (!next_tile(it, MT, NT, tm, tn)) break;
    f32x4 acc[MI][4];
    gemm_mainloop<MI>(A, Bt, 1024, tm * MI * 32, tn * 128, acc, smem);
    const int r0 = tm * MI * 32 + wr * MI * 16;
    const int c0 = tn * 128 + wc * 64;
    const bool latent = r0 < TLAT;
    if (c0 >= 1792) {
#pragma unroll
      for (int m = 0; m < MI; ++m)
#pragma unroll
        for (int n = 0; n < 4; ++n)
#pragma unroll
          for (int j = 0; j < 4; ++j) {
            int row = r0 + m * 16 + fq * 4 + j;
            P2[(size_t)row * P2C + (c0 - 1792) + n * 16 + fr] = f2bf(acc[m][n][j]);
          }
      continue;
    }
    int kind;
    int ropek;
    int normk;
    float scale = 1.f;
    u16* dst; int hh, nh;
    if (c0 < 256) { kind = 0; ropek = 1; normk = -1; scale = 0.125f * LOG2E; dst = QA; hh = c0 >> 6; nh = 4; }
    else if (c0 < 384) { kind = 1; ropek = 1; normk = -1; dst = KA; hh = (c0 - 256) >> 6; nh = 2; }
    else if (c0 < 512) { kind = 2; ropek = 0; normk = -1; dst = VA; hh = (c0 - 384) >> 6; nh = 2; }
    else if (c0 < 768) { kind = 0; ropek = 1; normk = 0; scale = 0.125f * LOG2E; dst = QB; hh = (c0 - 512) >> 6; nh = 4; }
    else if (c0 < 896) { kind = 1; ropek = 1; normk = 1; dst = KB; hh = (c0 - 768) >> 6; nh = 2; }
    else if (c0 < 1024) { kind = 2; ropek = 0; normk = -1; dst = VB; hh = (c0 - 896) >> 6; nh = 2; }
    else if (c0 < 1280) { kind = 0; ropek = 2; normk = -1; dst = QR; hh = (c0 - 1024) >> 6; nh = 4; }
    else if (c0 < 1536) { kind = 1; ropek = 2; normk = -1; scale = 0.125f; dst = KR; hh = (c0 - 1280) >> 6; nh = 4; }
    else { kind = 2; ropek = 0; normk = -1; dst = VR; hh = (c0 - 1536) >> 6; nh = 4; }
    if (!latent) ropek = 0;
    if (kind == 2) {
#pragma unroll
      for (int m = 0; m < MI; ++m) {
        int b, pos;
        row_bpos(r0 + m * 16 + fq * 4, b, pos);
#pragma unroll
        for (int n = 0; n < 4; ++n) {
          int d = n * 16 + fr;
          bf16x4 o = pack4(acc[m][n][0], acc[m][n][1], acc[m][n][2], acc[m][n][3]);
          *(bf16x4*)(dst + ((size_t)(b * nh + hh) * 64 + d) * STOT + pos) = o;
        }
      }
      continue;
    }
    float gq[4] = {1.f, 1.f, 1.f, 1.f};
    if (normk >= 0) {
#pragma unroll
      for (int n = 0; n < 4; ++n) gq[n] = p.qk_g[((size_t)l * 2 + normk) * 64 + n * 16 + fr];
    }
#pragma unroll
    for (int m = 0; m < MI; ++m)
#pragma unroll
      for (int j = 0; j < 4; ++j) {
        int row = r0 + m * 16 + fq * 4 + j;
        float v0 = acc[m][0][j], v1 = acc[m][1][j], v2 = acc[m][2][j], v3 = acc[m][3][j];
        if (normk >= 0) {
          float ss = v0 * v0 + v1 * v1 + v2 * v2 + v3 * v3;
          ss += __shfl_xor(ss, 1); ss += __shfl_xor(ss, 2); ss += __shfl_xor(ss, 4); ss += __shfl_xor(ss, 8);
          float rstd = rsqrtf(ss * (1.f / 64.f) + RMS_EPS);
          v0 *= rstd * gq[0]; v1 *= rstd * gq[1]; v2 *= rstd * gq[2]; v3 *= rstd * gq[3];
        }
        int b, pos;
        row_bpos(row, b, pos);
        if (ropek == 1) {
          float2 cr = roperow[(pos >> 6) * 16 + fr];
          float2 cc = ropecol[(pos & 63) * 16 + fr];
          float o0 = v0 * cr.x - v1 * cr.y, o1 = v1 * cr.x + v0 * cr.y;
          float o2 = v2 * cc.x - v3 * cc.y, o3 = v3 * cc.x + v2 * cc.y;
          v0 = o0; v1 = o1; v2 = o2; v3 = o3;
        } else if (ropek == 2) {
          float2 ca = ropeseq[pos * 32 + fr];
          float2 cb = ropeseq[pos * 32 + 16 + fr];
          float o0 = v0 * ca.x - v2 * ca.y, o2 = v2 * ca.x + v0 * ca.y;
          float o1 = v1 * cb.x - v3 * cb.y, o3 = v3 * cb.x + v1 * cb.y;
          v0 = o0; v1 = o1; v2 = o2; v3 = o3;
        }
        v0 *= scale; v1 *= scale; v2 *= scale; v3 *= scale;
        u16* dp;
        if (kind == 0) dp = dst + (size_t)row * 256 + hh * 64 + fr;
        else dp = dst + ((size_t)(b * nh + hh) * STOT + pos) * 64 + fr;
        dp[0] = f2bf(v0); dp[16] = f2bf(v1); dp[32] = f2bf(v2); dp[48] = f2bf(v3);
      }
  }
}

__device__ __forceinline__ void attn_item(const u16* __restrict__ Q, const u16* __restrict__ Kb, const u16* __restrict__ Vt,
                          u16* __restrict__ concat, int ccol0, int b, int kvh, int qrow0, int qpos0, int t0, int t1,
                          int c0, int c1, bool masked, const float* sink, unsigned char* smem) {
  const int tid = TIDX(), w = tid >> 6, lane = tid & 63, fr = lane & 15, fq = lane >> 4;
  const int head = kvh * 2 + (w & 1);
  const int qoff = (w >> 1) * 32;
  bf16x8 qf[2][2];
#pragma unroll
  for (int qg = 0; qg < 2; ++qg)
#pragma unroll
    for (int ks = 0; ks < 2; ++ks)
      qf[qg][ks] = *(const bf16x8*)(Q + (size_t)(qrow0 + qoff + qg * 16 + fr) * 256 + head * 64 + ks * 32 + fq * 8);
  f32x4 O[2][4];
  float mrow[2], lrow[2];
#pragma unroll
  for (int qg = 0; qg < 2; ++qg) {
    mrow[qg] = -1e30f; lrow[qg] = 0.f;
#pragma unroll
    for (int dt = 0; dt < 4; ++dt) O[qg][dt] = f32x4{0.f, 0.f, 0.f, 0.f};
  }
  const u16* Kbase = Kb + (size_t)(b * 2 + kvh) * STOT * 64;
  const u16* Vbase = Vt + (size_t)(b * 2 + kvh) * 64 * STOT;
  const int n1 = t1 - t0, total = n1 + (c1 - c0);
  bf16x8 kreg[2], vreg[2];
  auto gload = [&](int i) {
    int tile = i < n1 ? t0 + i : c0 + (i - n1);
#pragma unroll
    for (int ps = 0; ps < 2; ++ps) {
      int idx = tid + ps * 256;
      kreg[ps] = *(const bf16x8*)(Kbase + (size_t)tile * 4096 + idx * 8);
      int d = idx >> 3, ch = idx & 7;
      vreg[ps] = *(const bf16x8*)(Vbase + (size_t)d * STOT + tile * 64 + ch * 8);
    }
  };
  auto lstore = [&](int buf) {
    u16* Ks = (u16*)(smem + buf * 18432);
    u16* Vs = Ks + 64 * 72;
#pragma unroll
    for (int ps = 0; ps < 2; ++ps) {
      int idx = tid + ps * 256;
      int r = idx >> 3, ch = idx & 7;
      *(bf16x8*)(Ks + r * 72 + ch * 8) = kreg[ps];
      *(bf16x8*)(Vs + r * 72 + ch * 8) = vreg[ps];
    }
  };
  __syncthreads();
  gload(0);
  lstore(0);
  __syncthreads();
#pragma unroll 1
  for (int i = 0; i < total; ++i) {
    const int tile = i < n1 ? t0 + i : c0 + (i - n1);
    if (i + 1 < total) gload(i + 1);
    const u16* Ks = (const u16*)(smem + (i & 1) * 18432);
    const u16* Vs = Ks + 64 * 72;
    f32x4 s[2][4];
#pragma unroll
    for (int qg = 0; qg < 2; ++qg)
#pragma unroll
      for (int sub = 0; sub < 4; ++sub) s[qg][sub] = f32x4{0.f, 0.f, 0.f, 0.f};
#pragma unroll
    for (int sub = 0; sub < 4; ++sub)
#pragma unroll
      for (int ks = 0; ks < 2; ++ks) {
        bf16x8 a = *(const bf16x8*)(Ks + (sub * 16 + fr) * 72 + ks * 32 + fq * 8);
#pragma unroll
        for (int qg = 0; qg < 2; ++qg) s[qg][sub] = __builtin_amdgcn_mfma_f32_16x16x32_bf16(a, qf[qg][ks], s[qg][sub], 0, 0, 0);
      }
    __builtin_amdgcn_sched_barrier(0);
    const bool domask = masked && (tile < 128);
    bf16x8 pb[2][2];
#pragma unroll
    for (int qg = 0; qg < 2; ++qg) {
      if (domask) {
        int qpos = qpos0 + qoff + qg * 16 + fr;
#pragma unroll
        for (int sub = 0; sub < 4; ++sub)
#pragma unroll
          for (int j = 0; j < 4; ++j) {
            int kpos = tile * 64 + sub * 16 + fq * 4 + j;
            int dd = kpos - qpos;
            if (dd > 128 || dd < -128) s[qg][sub][j] = -INFINITY;
          }
      }
      float mx = -INFINITY;
#pragma unroll
      for (int sub = 0; sub < 4; ++sub)
#pragma unroll
        for (int j = 0; j < 4; ++j) mx = fmaxf(mx, s[qg][sub][j]);
      mx = fmaxf(mx, __shfl_xor(mx, 16));
      mx = fmaxf(mx, __shfl_xor(mx, 32));
      float mnew = fmaxf(mrow[qg], mx);
      const bool changed = mnew > mrow[qg];
      float alpha = __builtin_amdgcn_exp2f(mrow[qg] - mnew);
      mrow[qg] = mnew;
      float ps = 0.f;
#pragma unroll
      for (int sub = 0; sub < 4; ++sub)
#pragma unroll
        for (int j = 0; j < 4; ++j) {
          float pv = __builtin_amdgcn_exp2f(s[qg][sub][j] - mnew);
          s[qg][sub][j] = pv;
          ps += pv;
        }
      lrow[qg] = lrow[qg] * alpha + ps;
      if (__builtin_amdgcn_ballot_w64(changed) != 0ull) {
#pragma unroll
        for (int dt = 0; dt < 4; ++dt) O[qg][dt] *= alpha;
      }
#pragma unroll
      for (int ks = 0; ks < 2; ++ks)
        pb[qg][ks] = cat8(pack4(s[qg][2 * ks][0], s[qg][2 * ks][1], s[qg][2 * ks][2], s[qg][2 * ks][3]),
                          pack4(s[qg][2 * ks + 1][0], s[qg][2 * ks + 1][1], s[qg][2 * ks + 1][2], s[qg][2 * ks + 1][3]));
      __builtin_amdgcn_sched_barrier(0);
    }
#pragma unroll
    for (int dt = 0; dt < 4; ++dt)
#pragma unroll
      for (int ks = 0; ks < 2; ++ks) {
        const u16* vp = Vs + (dt * 16 + fr) * 72 + ks * 32 + fq * 4;
        bf16x8 va = cat8(*(const bf16x4*)vp, *(const bf16x4*)(vp + 16));
#pragma unroll
        for (int qg = 0; qg < 2; ++qg) O[qg][dt] = __builtin_amdgcn_mfma_f32_16x16x32_bf16(va, pb[qg][ks], O[qg][dt], 0, 0, 0);
      }
    __builtin_amdgcn_sched_barrier(0);
    if (i + 1 < total) lstore((i + 1) & 1);
    __syncthreads();
  }
#pragma unroll
  for (int qg = 0; qg < 2; ++qg) {
    float lt = lrow[qg];
    lt += __shfl_xor(lt, 16);
    lt += __shfl_xor(lt, 32);
    if (sink) lt += __builtin_amdgcn_exp2f(sink[head] * LOG2E - mrow[qg]);
    float inv = 1.f / lt;
    int row = qrow0 + qoff + qg * 16 + fr;
#pragma unroll
    for (int dt = 0; dt < 4; ++dt) {
      bf16x4 o = pack4(O[qg][dt][0] * inv, O[qg][dt][1] * inv, O[qg][dt][2] * inv, O[qg][dt][3] * inv);
      *(bf16x4*)(concat + (size_t)row * D + ccol0 + head * 64 + dt * 16 + fq * 4) = o;
    }
  }
}

__device__ __forceinline__ float ret_lg(int h) {
  return log2f(1.0f - exp2f(-5.0f - (float)h));
}

__device__ __forceinline__ void retU_item(const Params& p, int bh, int c, unsigned char* smem) {
  const int tid = TIDX();
  const int b = bh >> 2, h = bh & 3;
  const u16* KR = (const u16*)(p.ws + OFF_KR) + (size_t)bh * STOT * 64;
  const u16* VR = (const u16*)(p.ws + OFF_VR) + (size_t)bh * 64 * STOT;
  (void)b;
  const int pos0 = c < 64 ? c * 128 : SEQ + (c - 64) * 128;
  u16* Kc = (u16*)smem;
  u16* Vj = Kc + 128 * 64;
  __syncthreads();
#pragma unroll
  for (int ps = 0; ps < 4; ++ps) {
    int idx = tid + ps * 256;
    *(bf16x8*)(Kc + idx * 8) = *(const bf16x8*)(KR + (size_t)pos0 * 64 + idx * 8);
    int d = idx >> 4, ch = idx & 15;
    bf16x8 v = *(const bf16x8*)(VR + (size_t)d * STOT + pos0 + ch * 8);
#pragma unroll
    for (int e = 0; e < 8; ++e) Vj[(ch * 8 + e) * 72 + d] = (u16)v[e];
  }
  __syncthreads();
  const int dk = tid >> 2, dv0 = (tid & 3) * 16;
  const float lg = ret_lg(h);
  float af[16], ab[16];
#pragma unroll
  for (int q = 0; q < 16; ++q) { af[q] = 0.f; ab[q] = 0.f; }
  for (int j = 0; j < 128; ++j) {
    float kf = bf2f(Kc[j * 64 + dk]);
    float kfw = kf * exp2f(lg * (float)(127 - j));
    float kbw = kf * exp2f(lg * (float)j);
    bf16x8 v0 = *(const bf16x8*)(Vj + j * 72 + dv0);
    bf16x8 v1 = *(const bf16x8*)(Vj + j * 72 + dv0 + 8);
#pragma unroll
    for (int q = 0; q < 8; ++q) {
      float a = bf2f((u16)v0[q]), bb = bf2f((u16)v1[q]);
      af[q] += kfw * a; ab[q] += kbw * a;
      af[8 + q] += kfw * bb; ab[8 + q] += kbw * bb;
    }
  }
  float* U = (float*)(p.ws + OFF_U) + ((size_t)bh * 66 + c) * 2 * 4096;
#pragma unroll
  for (int q = 0; q < 16; ++q) {
    U[(dv0 + q) * 64 + dk] = af[q];
    U[4096 + (dv0 + q) * 64 + dk] = ab[q];
  }
}

__device__ __forceinline__ void phase_retU(const Params& p, unsigned char* smem) {
  for (int item = BIDX(); item < 16 * 66; item += gridDim.x) retU_item(p, item / 66, item % 66, smem);
}

__device__ __forceinline__ void attn_worker(const Params& p, int l, unsigned char* smem) {
  const u16* QA = (const u16*)(p.ws + OFF_QA); const u16* QB = (const u16*)(p.ws + OFF_QB);
  const u16* KA = (const u16*)(p.ws + OFF_KA); const u16* VA = (const u16*)(p.ws + OFF_VA);
  const u16* KB = (const u16*)(p.ws + OFF_KB); const u16* VB = (const u16*)(p.ws + OFF_VB);
  u16* concat = (u16*)(p.ws + OFF_H);
  const float* sink = p.attn_sink + l * 4;
  int* qctr = (int*)(p.ws + OFF_QCTR) + l;
  volatile int* slot = (volatile int*)(smem + 65536 - 32);
  for (;;) {
    __syncthreads();
    if (TIDX() == 0) *slot = atomicAdd(qctr, 1);
    __syncthreads();
    const int item = *slot;
    if (item >= 2112) break;
    const bool isB = item < 1024 || (item >= 2048 && item < 2080);
    const bool isctx = item >= 2048;
    int ii = item < 1024 ? item : item < 2048 ? item - 1024 : item < 2080 ? item - 2048 : item - 2080;
    int qt, kvh, b, qrow0, qpos0, t0, t1;
    if (!isctx) {
      qt = ii & 127; kvh = (ii >> 7) & 1; b = ii >> 8;
      qrow0 = b * SEQ + qt * 64; qpos0 = qt * 64;
      if (isB) { t0 = 0; t1 = 128; }
      else { t0 = qt - 2 < 0 ? 0 : qt - 2; t1 = qt + 3 > 128 ? 128 : qt + 3; }
    } else {
      qt = ii & 3; kvh = (ii >> 2) & 1; b = ii >> 3;
      qrow0 = TLAT + b * CTXL + qt * 64; qpos0 = 0; t0 = 0; t1 = 0;
    }
    attn_item(isB ? QB : QA, isB ? KB : KA, isB ? VB : VA, concat, isB ? 256 : 0, b, kvh, qrow0, qpos0, t0, t1, 128, 132,
              (!isB) && (!isctx), isB ? nullptr : sink, smem);
  }
}

__device__ __forceinline__ void phase_retscan(const Params& p) {
  const float* U = (const float*)(p.ws + OFF_U);
  u16* SP = (u16*)(p.ws + OFF_SP);
  for (int gid = BIDX() * 256 + TIDX(); gid < 16 * 2 * 4096; gid += gridDim.x * 256) {
    int e = gid & 4095, dir = (gid >> 12) & 1, bh = gid >> 13;
    float g128 = exp2f(128.f * ret_lg(bh & 3));
    float S = 0.f;
#pragma unroll 1
    for (int n0 = 0; n0 < 66; n0 += 11) {
      float u[11];
      size_t offs[11];
#pragma unroll
      for (int k = 0; k < 11; ++k) {
        int n = n0 + k;
        int c = dir == 0 ? (n < 2 ? 64 + n : n - 2) : 65 - n;
        offs[k] = (((size_t)bh * 66 + c) * 2 + dir) * 4096 + e;
        u[k] = U[offs[k]];
      }
#pragma unroll
      for (int k = 0; k < 11; ++k) {
        SP[offs[k]] = f2bf(S);
        S = g128 * S + u[k];
      }
    }
  }
}

__device__ __forceinline__ void retout_item(const Params& p, int l, int bh, int c, unsigned char* smem) {
  const int tid = TIDX(), w = tid >> 6, lane = tid & 63, fr = lane & 15, fq = lane >> 4;
  const int b = bh >> 2, h = bh & 3;
  const u16* QR = (const u16*)(p.ws + OFF_QR);
  const u16* KR = (const u16*)(p.ws + OFF_KR) + (size_t)bh * STOT * 64;
  const u16* VR = (const u16*)(p.ws + OFF_VR) + (size_t)bh * 64 * STOT;
  const u16* SP = (const u16*)(p.ws + OFF_SP) + ((size_t)bh * 66 + c) * 2 * 4096;
  const u16* P2 = (const u16*)(p.ws + OFF_P2);
  u16* concat = (u16*)(p.ws + OFF_H);
  const int pos0 = c < 64 ? c * 128 : SEQ + (c - 64) * 128;
  const int row0 = bpos_row(b, pos0);
  u16* Kc = (u16*)smem;
  u16* Vs = Kc + 128 * 72;
  __syncthreads();
#pragma unroll
  for (int ps = 0; ps < 4; ++ps) {
    int idx = tid + ps * 256;
    int r = idx >> 3, ch = idx & 7;
    *(bf16x8*)(Kc + r * 72 + ch * 8) = *(const bf16x8*)(KR + (size_t)(pos0 + r) * 64 + ch * 8);
    int d = idx >> 4, c16 = idx & 15;
    *(bf16x8*)(Vs + d * 136 + c16 * 8) = *(const bf16x8*)(VR + (size_t)d * STOT + pos0 + c16 * 8);
  }
  __syncthreads();
  const float lg = ret_lg(h);
#pragma unroll 1
  for (int qg = 0; qg < 2; ++qg) {
    const int i = w * 32 + qg * 16 + fr;
    const int row = row0 + i;
    bf16x8 qf[2];
#pragma unroll
    for (int ks = 0; ks < 2; ++ks) qf[ks] = *(const bf16x8*)(QR + (size_t)row * 256 + h * 64 + ks * 32 + fq * 8);
    f32x4 s[8];
#pragma unroll
    for (int sub = 0; sub < 8; ++sub) {
      s[sub] = f32x4{0.f, 0.f, 0.f, 0.f};
#pragma unroll
      for (int ks = 0; ks < 2; ++ks) {
        bf16x8 a = *(const bf16x8*)(Kc + (sub * 16 + fr) * 72 + ks * 32 + fq * 8);
        s[sub] = __builtin_amdgcn_mfma_f32_16x16x32_bf16(a, qf[ks], s[sub], 0, 0, 0);
      }
    }
    float res[4][4];
#pragma unroll
    for (int dt = 0; dt < 4; ++dt)
#pragma unroll
      for (int j = 0; j < 4; ++j) res[dt][j] = 0.f;
#pragma unroll 1
    for (int dir = 0; dir < 2; ++dir) {
      f32x4 O[4];
      const float qw = dir == 0 ? __builtin_amdgcn_exp2f(lg * (float)(i + 1)) : __builtin_amdgcn_exp2f(lg * (float)(128 - i));
#pragma unroll
      for (int dt = 0; dt < 4; ++dt) {
        O[dt] = f32x4{0.f, 0.f, 0.f, 0.f};
#pragma unroll
        for (int ks = 0; ks < 2; ++ks) {
          bf16x8 a = *(const bf16x8*)(SP + dir * 4096 + (dt * 16 + fr) * 64 + ks * 32 + fq * 8);
          O[dt] = __builtin_amdgcn_mfma_f32_16x16x32_bf16(a, qf[ks], O[dt], 0, 0, 0);
        }
        O[dt] *= qw;
      }
      int fqo = fq;
      asm volatile("" : "+v"(fqo));
#pragma unroll
      for (int ks = 0; ks < 4; ++ks) {
        float pv[8];
#pragma unroll
        for (int e = 0; e < 8; ++e) {
          const int sub = 2 * ks + (e >> 2), j = e & 3;
          const int jk = sub * 16 + fqo * 4 + j;
          const int dd = dir == 0 ? i - jk : jk - i;
          pv[e] = dd >= 0 ? s[sub][j] * __builtin_amdgcn_exp2f(lg * (float)dd) : 0.f;
        }
        bf16x8 pb = cat8(pack4(pv[0], pv[1], pv[2], pv[3]), pack4(pv[4], pv[5], pv[6], pv[7]));
#pragma unroll
        for (int dt = 0; dt < 4; ++dt) {
          const u16* vp = Vs + (dt * 16 + fr) * 136 + ks * 32 + fq * 4;
          bf16x8 va = cat8(*(const bf16x4*)vp, *(const bf16x4*)(vp + 16));
          O[dt] = __builtin_amdgcn_mfma_f32_16x16x32_bf16(va, pb, O[dt], 0, 0, 0);
        }
      }
      float sm = 0.f;
#pragma unroll
      for (int dt = 0; dt < 4; ++dt)
#pragma unroll
        for (int j = 0; j < 4; ++j) sm += O[dt][j];
      sm += __shfl_xor(sm, 16); sm += __shfl_xor(sm, 32);
      const float mu = sm * (1.f / 64.f);
      float vs = 0.f;
#pragma unroll
      for (int dt = 0; dt < 4; ++dt)
#pragma unroll
        for (int j = 0; j < 4; ++j) { float dlt = O[dt][j] - mu; vs += dlt * dlt; }
      vs += __shfl_xor(vs, 16); vs += __shfl_xor(vs, 32);
      const float rstd = rsqrtf(vs * (1.f / 64.f) + GN_EPS);
#pragma unroll
      for (int dt = 0; dt < 4; ++dt) {
        const int d = dt * 16 + fq * 4;
        bf16x4 gt = *(const bf16x4*)(P2 + (size_t)row * P2C + dir * 256 + h * 64 + d);
        float4 rg = *(const float4*)(p.ret_g + (size_t)l * 256 + h * 64 + d);
        res[dt][0] += (O[dt][0] - mu) * rstd * rg.x * siluf_(bf2f((u16)gt[0]));
        res[dt][1] += (O[dt][1] - mu) * rstd * rg.y * siluf_(bf2f((u16)gt[1]));
        res[dt][2] += (O[dt][2] - mu) * rstd * rg.z * siluf_(bf2f((u16)gt[2]));
        res[dt][3] += (O[dt][3] - mu) * rstd * rg.w * siluf_(bf2f((u16)gt[3]));
      }
    }
#pragma unroll
    for (int dt = 0; dt < 4; ++dt)
      *(bf16x4*)(concat + (size_t)row * D + 512 + h * 64 + dt * 16 + fq * 4) = pack4(res[dt][0], res[dt][1], res[dt][2], res[dt][3]);
  }
}

__device__ __forceinline__ void phase_retout(const Params& p, int l, unsigned char* smem) {
  for (int item = BIDX(); item < 16 * 66; item += gridDim.x) retout_item(p, l, item / 66, item % 66, smem);
}

__device__ __forceinline__ void phase_wprep(const Params& p, int l, unsigned char* smem) {
  const int tid = TIDX(), col = tid;
  const u16* P2 = (const u16*)(p.ws + OFF_P2);
  u16* prep = (u16*)(p.ws + OFF_PREP);
  float* twT = (float*)smem;
  float* amT = twT + 64 * 16;
  float* outW = amT + 64 * 16;
  float* outA = outW + 16 * 256;
  const int j = tid & 31, tsub = tid >> 5, head = j >> 3, c8 = (j & 7) * 8, ch0 = head * 64 + c8;
  float kkv[8], kav[8];
#pragma unroll
  for (int e = 0; e < 8; ++e) { kkv[e] = p.k_k[(size_t)l * 256 + ch0 + e]; kav[e] = p.k_a[(size_t)l * 256 + ch0 + e]; }
  for (int item = BIDX(); item < (TALL / 16) * 2; item += gridDim.x) {
    const int dir = item & 1, row0 = (item >> 1) * 16;
    const float* mu = p.mu + ((size_t)l * 2 + dir) * 896;
    __syncthreads();
    {
      const int tok = tid >> 4, e0 = (tid & 15) * 4;
      const int row = row0 + tok;
      int b, pos;
      row_bpos(row, b, pos);
      bool has;
      int nrow;
      if (dir == 0) { has = (pos != 0) && (pos != SEQ); nrow = row - 1; }
      else { has = (pos != SEQ - 1) && (pos != STOT - 1); nrow = row + 1; }
      const int srow = has ? nrow : row;
      bf16x4 zw = *(const bf16x4*)(P2 + (size_t)row * P2C + 1408 + dir * 64 + e0);
      bf16x4 za = *(const bf16x4*)(P2 + (size_t)row * P2C + 1536 + dir * 64 + e0);
      bf16x4 sw = *(const bf16x4*)(P2 + (size_t)srow * P2C + 1408 + dir * 64 + e0);
      bf16x4 sa = *(const bf16x4*)(P2 + (size_t)srow * P2C + 1536 + dir * 64 + e0);
#pragma unroll
      for (int e = 0; e < 4; ++e) {
        float z = bf2f((u16)zw[e]), zs = has ? bf2f((u16)sw[e]) : 0.f;
        twT[(e0 + e) * 16 + tok] = tanhf_(z + mu[768 + e0 + e] * (zs - z));
        float z2 = bf2f((u16)za[e]), zs2 = has ? bf2f((u16)sa[e]) : 0.f;
        amT[(e0 + e) * 16 + tok] = z2 + mu[832 + e0 + e] * (zs2 - z2);
      }
    }
    __syncthreads();
    {
      const float* w2 = p.w2 + ((size_t)l * 2 + dir) * 64 * 256 + col;
      const float* a2 = p.a2 + ((size_t)l * 2 + dir) * 64 * 256 + col;
      const float w0v = p.w0[((size_t)l * 2 + dir) * 256 + col], a0v = p.a0[((size_t)l * 2 + dir) * 256 + col];
#pragma unroll 1
      for (int pass = 0; pass < 2; ++pass) {
        const float* wcol = pass == 0 ? w2 : a2;
        const float* xT = pass == 0 ? twT : amT;
        float acc[16];
#pragma unroll
        for (int t = 0; t < 16; ++t) acc[t] = 0.f;
#pragma unroll 1
        for (int k0 = 0; k0 < 64; k0 += 16) {
          float wv[16];
#pragma unroll
          for (int u = 0; u < 16; ++u) wv[u] = wcol[(k0 + u) * 256];
#pragma unroll
          for (int u = 0; u < 16; ++u) {
            const int kq = k0 + u;
#pragma unroll
            for (int t4 = 0; t4 < 4; ++t4) {
              float4 a = *(const float4*)(xT + kq * 16 + t4 * 4);
              acc[t4 * 4 + 0] += a.x * wv[u]; acc[t4 * 4 + 1] += a.y * wv[u]; acc[t4 * 4 + 2] += a.z * wv[u]; acc[t4 * 4 + 3] += a.w * wv[u];
            }
          }
        }
        if (pass == 0) {
#pragma unroll
          for (int t = 0; t < 16; ++t) outW[t * 256 + col] = -0.6065306597126334f * sigmoidf_(w0v + acc[t]) * LOG2E;
        } else {
#pragma unroll
          for (int t = 0; t < 16; ++t) outA[t * 256 + col] = sigmoidf_(a0v + acc[t]);
        }
      }
    }
    __syncthreads();
    {
      float mur[8], muk[8], muv[8];
#pragma unroll
      for (int e = 0; e < 8; ++e) { mur[e] = mu[ch0 + e]; muk[e] = mu[256 + ch0 + e]; muv[e] = mu[512 + ch0 + e]; }
#pragma unroll
      for (int pass = 0; pass < 2; ++pass) {
        const int tok = pass * 8 + tsub, row = row0 + tok;
        int b, pos;
        row_bpos(row, b, pos);
        bool has;
        int nrow;
        if (dir == 0) { has = (pos != 0) && (pos != SEQ); nrow = row - 1; }
        else { has = (pos != SEQ - 1) && (pos != STOT - 1); nrow = row + 1; }
        const u16* cp = P2 + (size_t)row * P2C + 512 + ch0;
        const u16* np = P2 + (size_t)(has ? nrow : row) * P2C + 512 + ch0;
        const bf16x8 zr8 = *(const bf16x8*)cp, zk8 = *(const bf16x8*)(cp + 256), zv8 = *(const bf16x8*)(cp + 512);
        const bf16x8 sr8 = *(const bf16x8*)np, sk8 = *(const bf16x8*)(np + 256), sv8 = *(const bf16x8*)(np + 512);
        const float4 lw0 = *(const float4*)(outW + tok * 256 + ch0), lw1 = *(const float4*)(outW + tok * 256 + ch0 + 4);
        const float4 av0 = *(const float4*)(outA + tok * 256 + ch0), av1 = *(const float4*)(outA + tok * 256 + ch0 + 4);
        const float lw[8] = {lw0.x, lw0.y, lw0.z, lw0.w, lw1.x, lw1.y, lw1.z, lw1.w};
        const float av[8] = {av0.x, av0.y, av0.z, av0.w, av1.x, av1.y, av1.z, av1.w};
        float r[8], k[8], v[8], kkr[8], ss = 0.f;
#pragma unroll
        for (int e = 0; e < 8; ++e) {
          float zr = bf2f((u16)zr8[e]), zk = bf2f((u16)zk8[e]), zv = bf2f((u16)zv8[e]);
          float sr = has ? bf2f((u16)sr8[e]) : 0.f, sk = has ? bf2f((u16)sk8[e]) : 0.f, sv = has ? bf2f((u16)sv8[e]) : 0.f;
          r[e] = zr + mur[e] * (sr - zr); k[e] = zk + muk[e] * (sk - zk); v[e] = zv + muv[e] * (sv - zv);
          kkr[e] = k[e] * kkv[e];
          ss += kkr[e] * kkr[e];
        }
        ss = half8_sum(ss);
        const float rs = rsqrtf(fmaxf(ss, 1e-24f));
        float kt[8], kk[8], bb[8];
#pragma unroll
        for (int e = 0; e < 8; ++e) {
          kk[e] = kkr[e] * rs;
          kt[e] = k[e] * (1.f + (av[e] - 1.f) * kav[e]);
          bb[e] = kk[e] * av[e];
        }
        u16* dp = prep + (((size_t)(b * 4 + head) * 2 + dir) * STOT + pos) * 384 + c8;
        *(bf16x8*)(dp) = cat8(pack4(lw[0], lw[1], lw[2], lw[3]), pack4(lw[4], lw[5], lw[6], lw[7]));
        *(bf16x8*)(dp + 64) = cat8(pack4(kt[0], kt[1], kt[2], kt[3]), pack4(kt[4], kt[5], kt[6], kt[7]));
        *(bf16x8*)(dp + 128) = cat8(pack4(kk[0], kk[1], kk[2], kk[3]), pack4(kk[4], kk[5], kk[6], kk[7]));
        *(bf16x8*)(dp + 192) = cat8(pack4(bb[0], bb[1], bb[2], bb[3]), pack4(bb[4], bb[5], bb[6], bb[7]));
        *(bf16x8*)(dp + 256) = cat8(pack4(r[0], r[1], r[2], r[3]), pack4(r[4], r[5], r[6], r[7]));
        *(bf16x8*)(dp + 320) = cat8(pack4(v[0], v[1], v[2], v[3]), pack4(v[4], v[5], v[6], v[7]));
      }
    }
  }
}

typedef float f32x2 __attribute__((ext_vector_type(2)));
__device__ __forceinline__ void wscan_item(const Params& p, int item, unsigned char* smem) {
  const int tid = TIDX(), w = tid >> 6, lane = tid & 63;
  const int jl4 = (lane & 15) * 4, rsub = lane >> 4;
  const u16* prep = (const u16*)(p.ws + OFF_PREP);
  u16* P2w = (u16*)(p.ws + OFF_P2);
  float* bufs = (float*)smem;
  {
    const int rq = item & 3, seq = item >> 2;
    const int dir = seq & 1, h = (seq >> 1) & 3, b = seq >> 3;
    const int irow = rq * 16 + w * 4 + rsub;
    const u16* base = prep + (size_t)seq * STOT * 384;
    uint4 lreg[3];
    auto gload = [&](int ch) {
#pragma unroll
      for (int ps = 0; ps < 3; ++ps) {
        int q = tid + ps * 256;
        int sidx = q / 48, within = q % 48;
        int n = ch * 16 + sidx;
        int pos = dir == 0 ? (n < CTXL ? SEQ + n : n - CTXL) : (STOT - 1 - n);
        lreg[ps] = *(const uint4*)(base + (size_t)pos * 384 + within * 8);
      }
    };
    auto lstore = [&](int buf) {
#pragma unroll
      for (int ps = 0; ps < 3; ++ps) {
        int q = tid + ps * 256;
        int sidx = q / 48, within = q % 48;
        float* dp = bufs + buf * 6144 + sidx * 384 + within * 8;
        uint4 u = lreg[ps];
        float4 lo = make_float4(__uint_as_float(u.x << 16), __uint_as_float(u.x & 0xffff0000u), __uint_as_float(u.y << 16), __uint_as_float(u.y & 0xffff0000u));
        float4 hi = make_float4(__uint_as_float(u.z << 16), __uint_as_float(u.z & 0xffff0000u), __uint_as_float(u.w << 16), __uint_as_float(u.w & 0xffff0000u));
        if (within < 8) {
          lo.x = __builtin_amdgcn_exp2f(lo.x); lo.y = __builtin_amdgcn_exp2f(lo.y); lo.z = __builtin_amdgcn_exp2f(lo.z); lo.w = __builtin_amdgcn_exp2f(lo.w);
          hi.x = __builtin_amdgcn_exp2f(hi.x); hi.y = __builtin_amdgcn_exp2f(hi.y); hi.z = __builtin_amdgcn_exp2f(hi.z); hi.w = __builtin_amdgcn_exp2f(hi.w);
        }
        *(float4*)dp = lo;
        *(float4*)(dp + 4) = hi;
      }
    };
    f32x2 S01 = {0.f, 0.f}, S23 = {0.f, 0.f};
    __syncthreads();
    gload(0);
    lstore(0);
    __syncthreads();
    constexpr int NCH = STOT / 16;
    for (int ch = 0; ch < NCH; ++ch) {
      if (ch + 1 < NCH) gload(ch + 1);
      const float* bp = bufs + (ch & 1) * 6144;
      const int n0 = ch * 16;
      const int pos0 = dir == 0 ? (n0 < CTXL ? SEQ + n0 : n0 - CTXL) : (STOT - 1 - n0);
      u16* yp = P2w + (size_t)bpos_row(b, pos0) * P2C + (dir == 0 ? YCOL0 : YCOL1) + h * 64 + irow;
      const int ystride = dir == 0 ? P2C : -P2C;
      float4 Wq[3], Kq[3], Nq[3], Bq[3], Rq[3];
      float Vq[3];
#define SCAN_LD(slot, st)                                        \
      do {                                                         \
        const float* sp_ = bp + (st) * 384;                        \
        Wq[slot] = *(const float4*)(sp_ + jl4);                    \
        Kq[slot] = *(const float4*)(sp_ + 64 + jl4);               \
        Nq[slot] = *(const float4*)(sp_ + 128 + jl4);              \
        Bq[slot] = *(const float4*)(sp_ + 192 + jl4);              \
        Rq[slot] = *(const float4*)(sp_ + 256 + jl4);              \
        Vq[slot] = sp_[320 + irow];                                \
      } while (0)
      SCAN_LD(0, 0);
      SCAN_LD(1, 1);
      SCAN_LD(2, 2);
      float ypart = 0.f;
#pragma unroll
      for (int s = 0; s < 16; ++s) {
        const int sl = s % 3;
        const float4 wv = Wq[sl], kt = Kq[sl], kk = Nq[sl], bb = Bq[sl], rr = Rq[sl];
        const float v = Vq[sl];
        if (s + 3 < 16) SCAN_LD(sl, s + 3);
        const f32x2 vv = {v, v};
        f32x2 A01 = S01 * f32x2{wv.x, wv.y} + vv * f32x2{kt.x, kt.y};
        f32x2 A23 = S23 * f32x2{wv.z, wv.w} + vv * f32x2{kt.z, kt.w};
        f32x2 pp = S01 * f32x2{kk.x, kk.y} + S23 * f32x2{kk.z, kk.w};
        float sa = pp.x + pp.y;
        float yprev = ypart;
        row16_sum2(sa, yprev);
        if (s > 0) { if ((lane & 15) == 0) yp[(s - 1) * ystride] = f2bf(yprev); }
        const f32x2 nsa = {-sa, -sa};
        S01 = nsa * f32x2{bb.x, bb.y} + A01;
        S23 = nsa * f32x2{bb.z, bb.w} + A23;
        f32x2 yy = S01 * f32x2{rr.x, rr.y} + S23 * f32x2{rr.z, rr.w};
        ypart = yy.x + yy.y;
      }
      {
        float ylast = row16_sum(ypart);
        if ((lane & 15) == 0) yp[15 * ystride] = f2bf(ylast);
      }
#undef SCAN_LD
      if (ch + 1 < NCH) lstore((ch + 1) & 1);
      __syncthreads();
    }
  }
}

__device__ __forceinline__ void phase_scan_attn(const Params& p, int l, unsigned char* smem) {
  const int G = gridDim.x, tid = TIDX(), bid = BIDX();
  if (G > 128 && G <= 2048) {
    int* keys = (int*)smem;
    int* red = keys + 2048;
    const int* cutab = (const int*)(p.ws + OFF_CUTAB);
    __syncthreads();
    for (int i = tid; i < G; i += 256) keys[i] = cutab[i];
    if (tid == 0) { red[0] = 0; red[1] = 0; }
    __syncthreads();
    for (int i = 128 + tid; i < G; i += 256) {
      const int ki = keys[i];
      bool m = false;
      for (int j = 0; j < 128; ++j) m = m || (keys[j] == ki);
      if (!m) atomicAdd(&red[0], 1);
      if (m && i == bid) red[1] = 1;
    }
    __syncthreads();
    const int eligible = red[0], mine = red[1];
    __syncthreads();
    if (bid < 128) {
      __builtin_amdgcn_s_setprio(3);
      wscan_item(p, bid, smem);
      __builtin_amdgcn_s_setprio(0);
    } else if (eligible < 64 || !mine) {
      attn_worker(p, l, smem);
    }
  } else {
    for (int item = bid; item < 128; item += G) wscan_item(p, item, smem);
    attn_worker(p, l, smem);
  }
}

__device__ __forceinline__ void phase_wfin(const Params& p, int l, unsigned char* smem) {
  const int tid = TIDX(), col = tid;
  const u16* P2 = (const u16*)(p.ws + OFF_P2);
  const u16* prep = (const u16*)(p.ws + OFF_PREP);
  u16* concat = (u16*)(p.ws + OFF_H);
  float* sgT = (float*)smem;
  float* gateL = sgT + 128 * 16;
  const float* g2 = p.g2 + (size_t)l * 128 * 256 + col;
  const int j = tid & 31, tsub = tid >> 5, head = j >> 3, c8 = (j & 7) * 8, ch0 = head * 64 + c8;
  float lng[8], lnb[8], rho[2][8];
#pragma unroll
  for (int e = 0; e < 8; ++e) {
    lng[e] = p.ln_g[(size_t)l * 256 + ch0 + e];
    lnb[e] = p.ln_b[(size_t)l * 256 + ch0 + e];
    rho[0][e] = p.rho[((size_t)l * 2 + 0) * 256 + ch0 + e];
    rho[1][e] = p.rho[((size_t)l * 2 + 1) * 256 + ch0 + e];
  }
  for (int item = BIDX(); item < TALL / 16; item += gridDim.x) {
    const int row0 = item * 16;
    __syncthreads();
    {
      const int tok = tid >> 4, k0 = (tid & 15) * 8;
      bf16x8 g = *(const bf16x8*)(P2 + (size_t)(row0 + tok) * P2C + 1280 + k0);
#pragma unroll
      for (int e = 0; e < 8; ++e) sgT[(k0 + e) * 16 + tok] = sigmoidf_(bf2f((u16)g[e]));
    }
    __syncthreads();
    float acc[16];
#pragma unroll
    for (int t = 0; t < 16; ++t) acc[t] = 0.f;
#pragma unroll 1
    for (int k0 = 0; k0 < 128; k0 += 16) {
      float gv8[16];
#pragma unroll
      for (int u = 0; u < 16; ++u) gv8[u] = g2[(k0 + u) * 256];
#pragma unroll
      for (int u = 0; u < 16; ++u) {
        const int k = k0 + u;
        const float gv = gv8[u];
#pragma unroll
        for (int t4 = 0; t4 < 4; ++t4) {
          float4 a = *(const float4*)(sgT + k * 16 + t4 * 4);
          acc[t4 * 4 + 0] += a.x * gv; acc[t4 * 4 + 1] += a.y * gv; acc[t4 * 4 + 2] += a.z * gv; acc[t4 * 4 + 3] += a.w * gv;
        }
      }
    }
#pragma unroll
    for (int t = 0; t < 16; ++t) gateL[t * 256 + col] = acc[t];
    __syncthreads();
#pragma unroll
    for (int pass = 0; pass < 2; ++pass) {
      const int tok = pass * 8 + tsub, row = row0 + tok;
      int b, pos;
      row_bpos(row, b, pos);
      float tot[8];
#pragma unroll
      for (int e = 0; e < 8; ++e) tot[e] = 0.f;
#pragma unroll
      for (int dir = 0; dir < 2; ++dir) {
        const bf16x8 y8 = *(const bf16x8*)(P2 + (size_t)row * P2C + (dir == 0 ? YCOL0 : YCOL1) + ch0);
        const u16* pp = prep + (((size_t)(b * 4 + head) * 2 + dir) * STOT + pos) * 384 + c8;
        const bf16x8 kt8 = *(const bf16x8*)(pp + 64), r8 = *(const bf16x8*)(pp + 256), v8 = *(const bf16x8*)(pp + 320);
        float y[8], s1 = 0.f, s3 = 0.f;
#pragma unroll
        for (int e = 0; e < 8; ++e) {
          y[e] = bf2f((u16)y8[e]);
          s1 += y[e];
          s3 += bf2f((u16)r8[e]) * bf2f((u16)kt8[e]) * rho[dir][e];
        }
        s1 = half8_sum(s1);
        s3 = half8_sum(s3);
        const float mu = s1 * (1.f / 64.f);
        float s2 = 0.f;
#pragma unroll
        for (int e = 0; e < 8; ++e) { y[e] -= mu; s2 += y[e] * y[e]; }
        s2 = half8_sum(s2);
        const float rstd = rsqrtf(s2 * (1.f / 64.f) + GN_EPS);
#pragma unroll
        for (int e = 0; e < 8; ++e) tot[e] += y[e] * rstd * lng[e] + lnb[e] + s3 * bf2f((u16)v8[e]);
      }
      const float4 g0 = *(const float4*)(gateL + tok * 256 + ch0), g1 = *(const float4*)(gateL + tok * 256 + ch0 + 4);
      bf16x8 o = cat8(pack4(tot[0] * g0.x, tot[1] * g0.y, tot[2] * g0.z, tot[3] * g0.w),
                      pack4(tot[4] * g1.x, tot[5] * g1.y, tot[6] * g1.z, tot[7] * g1.w));
      *(bf16x8*)(concat + (size_t)row * D + 768 + ch0) = o;
    }
  }
}

constexpr int N_PHASES = 1 + 2 * 16 + 1;
__device__ __forceinline__ void run_phase(const Params& p_in, int ph, unsigned char* smem) {
  Params p = p_in;
  {
    unsigned long long w = (unsigned long long)p.ws;
    asm volatile("" : "+s"(w));
    p.ws = (unsigned char*)w;
  }
  if (ph == 0) { phase_init(p, smem); return; }
  if (ph == N_PHASES - 1) { phase_final_norm(p); return; }
  const int l = (ph - 1) / 16, s = (ph - 1) % 16;
  float* xc = (float*)(p.ws + OFF_XC);
  const float* lat_in = (l == 0 && s < 3) ? p.x : p.out;
  const float* cx_in = (l == 0 && s < 3) ? p.ctx : xc;
  const u16* H = (const u16*)(p.ws + OFF_H);
  const u16* ACT = (const u16*)(p.ws + OFF_P2);
  switch (s) {
    case 0: phase_norm(p, l, 0, lat_in, cx_in); break;
    case 1: phase_ffn_in(p, l, 0, smem); break;
    case 2: phase_resid_gemm(p, l, ACT, (const u16*)(p.ws + OFF_WFFO) + (size_t)0 * 1024 * DFF, DFF, 2, 0.5f, lat_in, cx_in, p.out, xc, smem); break;
    case 3: phase_norm(p, l, 1, p.out, xc); break;
    case 4: phase_inproj(p, l, smem); break;
    case 5: phase_retU(p, smem); break;
    case 6: phase_retscan(p); break;
    case 7: phase_retout(p, l, smem); break;
    case 8: phase_wprep(p, l, smem); break;
    case 9: phase_scan_attn(p, l, smem); break;
    case 10: phase_wfin(p, l, smem); break;
    case 11: phase_resid_gemm(p, l, H, (const u16*)(p.ws + OFF_WOUT), 1024, 5, 1.0f, p.out, xc, p.out, xc, smem); break;
    case 12: phase_norm(p, l, 2, p.out, xc); break;
    case 13: phase_ffn_in(p, l, 1, smem); break;
    case 14: phase_resid_gemm(p, l, ACT, (const u16*)(p.ws + OFF_WFFO) + (size_t)1 * 1024 * DFF, DFF, 8, 0.5f, p.out, xc, p.out, xc, smem); break;
    default: if (l == 0) convert_weights(p, 1, smem); break;
  }
}

#if MULTI_LAUNCH
__global__ void __launch_bounds__(256, 2) k_phase(Params p, int ph) {
  __shared__ __attribute__((aligned(16))) unsigned char smem[49152];
  run_phase(p, ph, smem);
}
#else
constexpr int SMEM_BYTES = 65536;
__global__ void __launch_bounds__(256, 2) k_mega(Params p) {
  __shared__ __attribute__((aligned(16))) unsigned char smem[SMEM_BYTES];
  cg::grid_group grid = cg::this_grid();
  volatile LAS unsigned* st = (volatile LAS unsigned*)(smem + SMEM_BYTES - 16);
  if (threadIdx.x == 0) { st[0] = 0u; st[1] = 0u; }
  __syncthreads();
  {
    unsigned* bw = (unsigned*)(p.ws + OFF_BAR);
    for (int i = blockIdx.x * 256 + threadIdx.x; i < XCD_BAR_WORDS; i += gridDim.x * 256) bw[i] = 0u;
  }
  grid.sync();
  XcdBarrier xb = xcd_barrier_post((unsigned*)(p.ws + OFF_BAR), st);
  run_phase(p, 0, smem);
  xcd_barrier(xb);
#pragma unroll 1
  for (int l = 0; l < 2; ++l) {
#pragma unroll 1
    for (int s = 0; s < 16 - l; ++s) {
      run_phase(p, 1 + l * 16 + s, smem);
      xcd_barrier(xb);
#ifdef PROBE_REPEAT
      if ((PROBE_REPEAT >> s) & 1) {
        run_phase(p, 1 + l * 16 + s, smem);
        xcd_barrier(xb);
      }
#endif
    }
  }
  run_phase(p, N_PHASES - 1, smem);
}
#endif

extern "C" void kernel_launch(void* const* d_in, const int* in_sizes, int n_in, void* d_out, int out_size, void* d_ws,
                              size_t ws_size, hipStream_t stream) {
  Params p{};
  const float** pp = (const float**)&p;
  for (int i = 0; i < 26; ++i) pp[i] = (const float*)d_in[i];
  p.out = (float*)d_out;
  p.ws = (unsigned char*)d_ws;
#if MULTI_LAUNCH
  for (int ph = 0; ph < N_PHASES; ++ph) {
    if (ph > 0 && ((ph - 1) % 16) == 15 && ph != N_PHASES - 1) continue;
    k_phase<<<dim3(512), dim3(256), 0, stream>>>(p, ph);
  }
#else
  static int grid_blocks = 0;
  if (!grid_blocks) {
    int dev = 0, cus = 0, per_cu = 0;
    hipGetDevice(&dev);
    hipDeviceGetAttribute(&cus, hipDeviceAttributeMultiprocessorCount, dev);
    hipOccupancyMaxActiveBlocksPerMultiprocessor(&per_cu, k_mega, 256, 0);
    if (per_cu > 2) per_cu = 2;
    grid_blocks = cus * per_cu;
  }
  void* args[] = {&p};
  hipError_t e = hipLaunchCooperativeKernel((void*)k_mega, dim3(grid_blocks), dim3(256), args, 0, stream);
  if (e != hipSuccess) fprintf(stderr, "cooperative launch failed: %s (grid %d)\n", hipGetErrorString(e), grid_blocks);
#endif
}
```

```cpp
#include <hip/hip_runtime.h>
#include <hip/hip_bf16.h>
#include <hip/hip_cooperative_groups.h>
#include <cstdio>
namespace cg = cooperative_groups;

#ifndef MULTI_LAUNCH
#define MULTI_LAUNCH 0
#endif

typedef unsigned short u16;
using bf16x8 = __attribute__((ext_vector_type(8))) short;
using bf16x4 = __attribute__((ext_vector_type(4))) short;
using f32x4 = __attribute__((ext_vector_type(4))) float;

constexpr int D = 1024;
constexpr int TLAT = 32768;
constexpr int TCTX = 1024;
constexpr int TALL = TLAT + TCTX;
constexpr int SEQ = 8192;
constexpr int CTXL = 256;
constexpr int STOT = SEQ + CTXL;
constexpr int DFF = 2816;
constexpr int PC = 3456;
constexpr int P2C = 1664;
constexpr int NMOD = 9 * D;
constexpr float LOG2E = 1.4426950408889634f;
constexpr float RMS_EPS = 1e-6f;
constexpr float GN_EPS = 64e-5f;

constexpr size_t MiB = 1ull << 20;
constexpr size_t OFF_WFFI = 0;
constexpr size_t OFF_WFFO = 22 * MiB;
constexpr size_t OFF_WIN = 33 * MiB;
constexpr size_t OFF_WOUT = OFF_WIN + 27 * MiB / 4;
constexpr size_t OFF_MOD = OFF_WOUT + 2 * MiB;
constexpr size_t OFF_BAR = OFF_MOD + 384 * 1024;
constexpr size_t OFF_QCTR = OFF_MOD + 400 * 1024;
constexpr size_t OFF_CUTAB = OFF_QCTR + 256;
constexpr size_t OFF_ROPE = OFF_MOD + MiB / 2;
constexpr size_t OFF_XC = OFF_ROPE + 5 * MiB / 2;
constexpr size_t OFF_H = OFF_XC + 4 * MiB;
constexpr size_t OFF_P2 = OFF_H + 66 * MiB;
constexpr size_t OFF_BIG = OFF_P2 + 429 * MiB / 4;
constexpr size_t SZ_Q = (size_t)TALL * 256 * 2;
constexpr size_t SZ_KV2 = (size_t)4 * 2 * STOT * 64 * 2;
constexpr size_t SZ_KV4 = (size_t)4 * 4 * STOT * 64 * 2;
constexpr size_t OFF_QA = OFF_BIG;
constexpr size_t OFF_QB = OFF_QA + SZ_Q;
constexpr size_t OFF_KA = OFF_QB + SZ_Q;
constexpr size_t OFF_VA = OFF_KA + SZ_KV2;
constexpr size_t OFF_KB = OFF_VA + SZ_KV2;
constexpr size_t OFF_VB = OFF_KB + SZ_KV2;
constexpr size_t OFF_R0 = OFF_VB + SZ_KV2;
constexpr size_t OFF_QR = OFF_R0;
constexpr size_t OFF_KR = OFF_QR + SZ_Q;
constexpr size_t OFF_VR = OFF_KR + SZ_KV4;
constexpr size_t OFF_U = OFF_VR + SZ_KV4;
constexpr size_t OFF_SP = OFF_U + (size_t)16 * 66 * 2 * 4096 * 4;
constexpr size_t OFF_PREP = OFF_R0;
constexpr size_t WS_END = OFF_PREP + (size_t)32 * STOT * 384 * 2;
constexpr int YCOL0 = 768, YCOL1 = 1408;
static_assert(WS_END <= 512 * MiB, "workspace overflow");
static_assert(OFF_SP + (size_t)16 * 66 * 2 * 4096 * 2 <= 512 * MiB, "workspace overflow");
static_assert(OFF_P2 + (size_t)TALL * DFF * 2 <= 512 * MiB, "act overflow");

struct Params {
  const float *x, *c, *ctx, *c_ctx, *w_mod, *b_mod, *norm_g, *ffn_w_in, *ffn_w_out, *w_in, *w_out, *attn_sink, *qk_g,
      *ret_g, *mu, *w0, *w2, *a0, *a2, *rho, *k_k, *k_a, *g2, *ln_g, *ln_b, *final_g;
  float* out;
  unsigned char* ws;
};

__device__ __forceinline__ int TIDX() { int t = threadIdx.x; asm volatile("" : "+v"(t)); return t & 255; }
__device__ __forceinline__ int BIDX() { int t = blockIdx.x; asm volatile("" : "+s"(t)); return t; }
typedef float f32x2_t __attribute__((ext_vector_type(2)));
typedef __bf16 bf16x2_t __attribute__((ext_vector_type(2)));
__device__ __forceinline__ unsigned pk2bf(float a, float b) {
  f32x2_t v = {a, b};
  return __builtin_bit_cast(unsigned, __builtin_convertvector(v, bf16x2_t));
}
__device__ __forceinline__ u16 f2bf(float f) { return (u16)(pk2bf(f, 0.f) & 0xffffu); }
__device__ __forceinline__ float bf2f(u16 h) { return __uint_as_float(((unsigned)h) << 16); }
__device__ __forceinline__ float sigmoidf_(float x) { return __builtin_amdgcn_rcpf(1.f + __expf(-x)); }
__device__ __forceinline__ float siluf_(float x) { return x * __builtin_amdgcn_rcpf(1.f + __expf(-x)); }
__device__ __forceinline__ float tanhf_(float x) { return 1.f - 2.f * __builtin_amdgcn_rcpf(__expf(2.f * x) + 1.f); }
template <int CTRL>
__device__ __forceinline__ float dpp_f(float x) {
  return __builtin_bit_cast(float, __builtin_amdgcn_update_dpp(0, __builtin_bit_cast(int, x), CTRL, 0xf, 0xf, true));
}
__device__ __forceinline__ float row16_sum(float x) {
  x += dpp_f<0xB1>(x);
  x += dpp_f<0x4E>(x);
  x += dpp_f<0x141>(x);
  x += dpp_f<0x140>(x);
  return x;
}
__device__ __forceinline__ float wave_sum(float x) {
  x = row16_sum(x);
  x += __builtin_bit_cast(float, __builtin_amdgcn_update_dpp(0, __builtin_bit_cast(int, x), 0x142, 0xa, 0xf, false));
  x += __builtin_bit_cast(float, __builtin_amdgcn_update_dpp(0, __builtin_bit_cast(int, x), 0x143, 0xc, 0xf, false));
  return __builtin_bit_cast(float, __builtin_amdgcn_readlane(__builtin_bit_cast(int, x), 63));
}
__device__ __forceinline__ float half8_sum(float x) {
  x += dpp_f<0xB1>(x);
  x += dpp_f<0x4E>(x);
  x += dpp_f<0x141>(x);
  return x;
}
__device__ __forceinline__ void row16_sum2(float& a, float& b) {
  a += dpp_f<0xB1>(a);  b += dpp_f<0xB1>(b);
  a += dpp_f<0x4E>(a);  b += dpp_f<0x4E>(b);
  a += dpp_f<0x141>(a); b += dpp_f<0x141>(b);
  a += dpp_f<0x140>(a); b += dpp_f<0x140>(b);
}
__device__ __forceinline__ bf16x4 pack4(float a, float b, float c, float d) {
  uint2 u = make_uint2(pk2bf(a, b), pk2bf(c, d));
  return __builtin_bit_cast(bf16x4, u);
}
__device__ __forceinline__ bf16x8 cat8(bf16x4 a, bf16x4 b) {
  bf16x8 r;
  r[0] = a[0]; r[1] = a[1]; r[2] = a[2]; r[3] = a[3]; r[4] = b[0]; r[5] = b[1]; r[6] = b[2]; r[7] = b[3];
  return r;
}
__device__ __forceinline__ const float* rrow(const float* lat, const float* cx, int r) {
  return r < TLAT ? lat + (size_t)r * D : cx + (size_t)(r - TLAT) * D;
}
__device__ __forceinline__ float* wrow(float* lat, float* cx, int r) {
  return r < TLAT ? lat + (size_t)r * D : cx + (size_t)(r - TLAT) * D;
}
__device__ __forceinline__ int mod_index(int r) { return r < TLAT ? (r >> 13) : 4; }
__device__ __forceinline__ void row_bpos(int r, int& b, int& pos) {
  if (r < TLAT) { b = r >> 13; pos = r & 8191; }
  else { int rc = r - TLAT; b = rc >> 8; pos = SEQ + (rc & 255); }
}
__device__ __forceinline__ int bpos_row(int b, int pos) {
  return pos < SEQ ? b * SEQ + pos : TLAT + b * CTXL + (pos - SEQ);
}


#define XB_TMO      128
#define XB_XCNT(j)  (256  + 64 * (j))
#define XB_XSUB(j)  (1280 + 64 * (j))
#define XB_XGEN(j)  (2304 + 64 * (j))
#define XB_TOP      3328
#define XB_TOPGEN   3392
#define XCD_BAR_WORDS 3456
#define XB_SPIN_CAP (1u << 18)
#define LAS __attribute__((address_space(3)))
__device__ __forceinline__ unsigned xb_ld(unsigned* p) { return __hip_atomic_load(p, __ATOMIC_RELAXED, __HIP_MEMORY_SCOPE_AGENT); }
__device__ __forceinline__ unsigned xb_add(unsigned* p, unsigned v) { return __hip_atomic_fetch_add(p, v, __ATOMIC_RELAXED, __HIP_MEMORY_SCOPE_AGENT); }
__device__ __forceinline__ unsigned xb_xcc_id() { return (unsigned)__builtin_amdgcn_s_getreg((3 << 11) | 20) & 0xFu; }
#define XB_SPIN(cond, bar) do { unsigned _sp = 0; while (cond) { __builtin_amdgcn_s_sleep(1); \
    if ((++_sp & 255u) == 0u) { if (xb_ld(&(bar)[XB_TMO])) break; if (_sp > XB_SPIN_CAP) { atomicAdd(&(bar)[XB_TMO], 1u); break; } } } } while (0)
struct XcdBarrier { unsigned* bar; unsigned x; volatile LAS unsigned* st; };
__device__ __forceinline__ XcdBarrier xcd_barrier_post(unsigned* bar, volatile LAS unsigned* st) {
  XcdBarrier b; b.bar = bar; b.x = xb_xcc_id(); b.st = st;
  if (threadIdx.x == 0) (void)xb_add(&bar[XB_XCNT(b.x)], 1u);
  return b;
}
__device__ __forceinline__ void xcd_barrier_complete(unsigned* bar, unsigned x, unsigned& nloc, unsigned& nx) {
  const unsigned G = gridDim.x * gridDim.y * gridDim.z;
  unsigned sum, cnt, mine, sp = 0u;
  for (;;) {
    sum = 0u; cnt = 0u; mine = 0u;
#pragma unroll
    for (unsigned j = 0; j < 16; ++j) { const unsigned c = xb_ld(&bar[XB_XCNT(j)]); sum += c; cnt += (c > 0u) ? 1u : 0u; mine = (j == x) ? c : mine; }
    if (sum == G) break;
    __builtin_amdgcn_s_sleep(1);
    if ((++sp & 255u) == 0u) { if (xb_ld(&bar[XB_TMO])) break; if (sp > XB_SPIN_CAP) { atomicAdd(&bar[XB_TMO], 1u); break; } }
  }
  nloc = mine > 0u ? mine : 1u; nx = cnt > 0u ? cnt : 1u;
}
__device__ __forceinline__ void xcd_barrier(const XcdBarrier& b) {
  asm volatile("s_waitcnt vmcnt(0)" ::: "memory");
  __syncthreads();
  if (threadIdx.x == 0) {
    unsigned* bar = b.bar;
    __builtin_amdgcn_s_waitcnt(0);
    unsigned nloc = b.st[0], nx = b.st[1];
    if (nloc == 0u) { xcd_barrier_complete(bar, b.x, nloc, nx); b.st[0] = nloc; b.st[1] = nx; }
    const unsigned old = xb_add(&bar[XB_XSUB(b.x)], 1u);
    const unsigned gen = old / nloc;
    if (old + 1u == (gen + 1u) * nloc) {
      __builtin_amdgcn_fence(__ATOMIC_RELEASE, "agent");
      asm volatile("s_waitcnt vmcnt(0)" ::: "memory");
      const unsigned og = xb_add(&bar[XB_TOP], 1u);
      const unsigned tg = og / nx;
      if (og + 1u == (tg + 1u) * nx) xb_add(&bar[XB_TOPGEN], 1u);
      else XB_SPIN(xb_ld(&bar[XB_TOPGEN]) == tg, bar);
      __builtin_amdgcn_fence(__ATOMIC_ACQUIRE, "agent");
      xb_add(&bar[XB_XGEN(b.x)], 1u);
      asm volatile("s_waitcnt vmcnt(0)" ::: "memory");
    } else {
      XB_SPIN(xb_ld(&bar[XB_XGEN(b.x)]) == gen, bar);
      __builtin_amdgcn_fence(__ATOMIC_ACQUIRE, "agent");
      asm volatile("s_waitcnt vmcnt(0)" ::: "memory");
    }
  }
  __syncthreads();
}

__device__ __forceinline__ void convert_weights(const Params& p, int layer, unsigned char* smem) {
  const int tid = TIDX();
  const int nb = gridDim.x, bid = BIDX();
  {
    float* tile = (float*)smem;
    constexpr int N_FFI = 2 * 16 * 88, N_FFO = 2 * 44 * 16, N_WIN = 16 * 54, N_WOUT = 16 * 16;
    for (int item = bid; item < N_FFI + N_FFO + N_WIN + N_WOUT; item += nb) {
      const float* src; u16* dst; int K, N, kt, nt; bool perm = false;
      int it = item;
      if (it < N_FFI) {
        int f = it / (16 * 88); it %= (16 * 88);
        K = 1024; N = 5632; kt = it / 88; nt = it % 88; perm = true;
        src = p.ffn_w_in + (size_t)(layer * 2 + f) * 1024 * 5632;
        dst = (u16*)(p.ws + OFF_WFFI) + (size_t)f * 5632 * 1024;
      } else if (it < N_FFI + N_FFO) {
        it -= N_FFI;
        int f = it / (44 * 16); it %= (44 * 16);
        K = 2816; N = 1024; kt = it / 16; nt = it % 16;
        src = p.ffn_w_out + (size_t)(layer * 2 + f) * 2816 * 1024;
        dst = (u16*)(p.ws + OFF_WFFO) + (size_t)f * 1024 * 2816;
      } else if (it < N_FFI + N_FFO + N_WIN) {
        it -= N_FFI + N_FFO;
        K = 1024; N = 3456; kt = it / 54; nt = it % 54;
        src = p.w_in + (size_t)layer * 1024 * 3456;
        dst = (u16*)(p.ws + OFF_WIN);
      } else {
        it -= N_FFI + N_FFO + N_WIN;
        K = 1024; N = 1024; kt = it / 16; nt = it % 16;
        src = p.w_out + (size_t)layer * 1024 * 1024;
        dst = (u16*)(p.ws + OFF_WOUT);
      }
      __syncthreads();
      {
        const int r = tid >> 4, c4 = tid & 15;
        int np = nt * 64 + c4 * 4;
        int scol = np;
        if (perm) {
          int blk = np >> 7, sub = (np & 127) >> 4, i = np & 15;
          scol = ((sub & 1) ? DFF : 0) + blk * 64 + (sub >> 1) * 16 + i;
        }
#pragma unroll
        for (int ps = 0; ps < 4; ++ps) {
          int k = kt * 64 + ps * 16 + r;
          float4 v = *(const float4*)(src + (size_t)k * N + scol);
          float* tp = tile + (ps * 16 + r) * 65 + c4 * 4;
          tp[0] = v.x; tp[1] = v.y; tp[2] = v.z; tp[3] = v.w;
        }
      }
      __syncthreads();
      {
        const int n = tid >> 2, kq = tid & 3;
        bf16x8 o0, o1;
#pragma unroll
        for (int i = 0; i < 8; ++i) {
          o0[i] = (short)f2bf(tile[(kq * 16 + i) * 65 + n]);
          o1[i] = (short)f2bf(tile[(kq * 16 + 8 + i) * 65 + n]);
        }
        u16* dp = dst + (size_t)(nt * 64 + n) * K + kt * 64 + kq * 16;
        *(bf16x8*)dp = o0;
        *(bf16x8*)(dp + 8) = o1;
      }
    }
    __syncthreads();
  }
}

__device__ __forceinline__ void phase_init(const Params& p, unsigned char* smem) {
  const int tid = TIDX();
  const int nb = gridDim.x, bid = BIDX();
  if (bid == 0 && tid < 2) ((int*)(p.ws + OFF_QCTR))[tid] = 0;
  if (tid == 0) {
    const int hw = __builtin_amdgcn_s_getreg((7 << 11) | (8 << 6) | 4);
    const int xcc = __builtin_amdgcn_s_getreg((3 << 11) | 20) & 0xF;
    ((int*)(p.ws + OFF_CUTAB))[bid] = (xcc << 8) | (hw & 0xFF);
  }
  {
    float2* seq = (float2*)(p.ws + OFF_ROPE);
    float2* rowt = seq + 8192 * 32;
    float2* colt = rowt + 128 * 16;
    for (int i = bid * 256 + tid; i < 8192 * 32 + 128 * 16 + 64 * 16; i += nb * 256) {
      float ang;
      float2* dst;
      if (i < 8192 * 32) {
        int t = i >> 5, k = i & 31;
        float inv = 1.0f / powf(10000.0f, (float)(2 * k) / 64.0f);
        ang = (float)t * inv;
        dst = seq + i;
      } else {
        int j = i - 8192 * 32;
        int pidx = (j < 128 * 16) ? (j >> 4) : ((j - 128 * 16) >> 4);
        int k = j & 15;
        float inv = 1.0f / powf(10000.0f, (float)(2 * k) / 32.0f);
        ang = (float)pidx * inv;
        dst = rowt + j;
      }
      *dst = make_float2(cosf(ang), sinf(ang));
    }
    (void)colt;
  }
  {
    float* sc = (float*)smem;
    float* red = sc + 5 * 1024;
    for (int item = bid; item < 288; item += nb) {
      const int l = item / 144, cb = item % 144;
      __syncthreads();
      for (int i = tid; i < 5 * 1024; i += 256) {
        int m = i >> 10, k = i & 1023;
        float v = (m < 4) ? p.c[m * 1024 + k] : p.c_ctx[k];
        sc[i] = siluf_(v);
      }
      __syncthreads();
      const int cq = tid & 15, kg = tid >> 4;
      float acc[5][4];
#pragma unroll
      for (int m = 0; m < 5; ++m)
#pragma unroll
        for (int q = 0; q < 4; ++q) acc[m][q] = 0.f;
      const float* wbase = p.w_mod + (size_t)l * 1024 * NMOD + cb * 64 + cq * 4;
      for (int kk = 0; kk < 64; ++kk) {
        int k = kg * 64 + kk;
        float4 w4 = *(const float4*)(wbase + (size_t)k * NMOD);
#pragma unroll
        for (int m = 0; m < 5; ++m) {
          float s = sc[m * 1024 + k];
          acc[m][0] += s * w4.x; acc[m][1] += s * w4.y; acc[m][2] += s * w4.z; acc[m][3] += s * w4.w;
        }
      }
#pragma unroll
      for (int m = 0; m < 5; ++m)
#pragma unroll
        for (int q = 0; q < 4; ++q) red[(kg * 5 + m) * 64 + cq * 4 + q] = acc[m][q];
      __syncthreads();
      float* modp = (float*)(p.ws + OFF_MOD);
      for (int o = tid; o < 320; o += 256) {
        int m = o >> 6, cc = o & 63;
        float s = 0.f;
        for (int g = 0; g < 16; ++g) s += red[(g * 5 + m) * 64 + cc];
        int col = cb * 64 + cc;
        modp[((size_t)l * 5 + m) * NMOD + col] = s + p.b_mod[(size_t)l * NMOD + col];
      }
    }
    __syncthreads();
  }
  convert_weights(p, 0, smem);
}

__device__ __forceinline__ void phase_norm(const Params& p, int l, int which, const float* lat, const float* cx) {
  const int lane = TIDX() & 63, wid = TIDX() >> 6;
  u16* h = (u16*)(p.ws + OFF_H);
  const float* g = p.norm_g + ((size_t)l * 3 + which) * D;
  const float* modp = (const float*)(p.ws + OFF_MOD) + (size_t)l * 5 * NMOD;
  for (int r = BIDX() * 4 + wid; r < TALL; r += gridDim.x * 4) {
    const float* xr = rrow(lat, cx, r);
    const float* mp = modp + (size_t)mod_index(r) * NMOD + which * 3 * D;
    float4 v[4];
    float ss = 0.f;
#pragma unroll
    for (int i = 0; i < 4; ++i) {
      v[i] = *(const float4*)(xr + i * 256 + lane * 4);
      ss += v[i].x * v[i].x + v[i].y * v[i].y + v[i].z * v[i].z + v[i].w * v[i].w;
    }
    ss = wave_sum(ss);
    float rstd = rsqrtf(ss * (1.f / 1024.f) + RMS_EPS);
#pragma unroll
    for (int i = 0; i < 4; ++i) {
      int col = i * 256 + lane * 4;
      float4 gg = *(const float4*)(g + col);
      float4 sh = *(const float4*)(mp + col);
      float4 scl = *(const float4*)(mp + D + col);
      bf16x4 o = pack4(v[i].x * rstd * gg.x * (1.f + scl.x) + sh.x, v[i].y * rstd * gg.y * (1.f + scl.y) + sh.y,
                       v[i].z * rstd * gg.z * (1.f + scl.z) + sh.z, v[i].w * rstd * gg.w * (1.f + scl.w) + sh.w);
      *(bf16x4*)(h + (size_t)r * D + col) = o;
    }
  }
}

__device__ __forceinline__ void phase_final_norm(const Params& p) {
  const int lane = TIDX() & 63, wid = TIDX() >> 6;
  for (int r = BIDX() * 4 + wid; r < TLAT; r += gridDim.x * 4) {
    float* xr = p.out + (size_t)r * D;
    float4 v[4];
    float ss = 0.f;
#pragma unroll
    for (int i = 0; i < 4; ++i) {
      v[i] = *(const float4*)(xr + i * 256 + lane * 4);
      ss += v[i].x * v[i].x + v[i].y * v[i].y + v[i].z * v[i].z + v[i].w * v[i].w;
    }
    ss = wave_sum(ss);
    float rstd = rsqrtf(ss * (1.f / 1024.f) + RMS_EPS);
#pragma unroll
    for (int i = 0; i < 4; ++i) {
      int col = i * 256 + lane * 4;
      float4 gg = *(const float4*)(p.final_g + col);
      float4 o = make_float4(v[i].x * rstd * gg.x, v[i].y * rstd * gg.y, v[i].z * rstd * gg.z, v[i].w * rstd * gg.w);
      *(float4*)(xr + col) = o;
    }
  }
}

template <int MI>
__device__ __forceinline__ void gemm_mainloop(const u16* __restrict__ A, const u16* __restrict__ Bt, int K, int brow,
                                              int bcol, f32x4 (&acc)[MI][4], unsigned char* smem) {
  const int tid = TIDX(), wid = tid >> 6, lane = tid & 63, wr = wid >> 1, wc = wid & 1, fr = lane & 15, fq = lane >> 4;
  constexpr int BM = MI * 32;
  constexpr int ACH = BM * 4 / 256;
  constexpr int STAGE = BM * 64 + 8192;
#pragma unroll
  for (int m = 0; m < MI; ++m)
#pragma unroll
    for (int n = 0; n < 4; ++n) acc[m][n] = f32x4{0.f, 0.f, 0.f, 0.f};
  const int nk = K / 32;
  const int prow = tid >> 2, pq = ((tid & 3) ^ ((0x78 >> (((tid >> 4) & 3) * 2)) & 3)) * 8;
  const u16* ga = A + (size_t)(brow + prow) * K + pq;
  const u16* gb = Bt + (size_t)(bcol + prow) * K + pq;
  auto stage = [&](int t, int buf) {
    unsigned char* base = smem + buf * STAGE;
#pragma unroll
    for (int i = 0; i < ACH; ++i)
      __builtin_amdgcn_global_load_lds((const unsigned*)(ga + (size_t)i * 64 * K + t * 32),
                                       (__attribute__((address_space(3))) unsigned*)(base + (tid + i * 256) * 16), 16, 0, 0);
#pragma unroll
    for (int i = 0; i < 2; ++i)
      __builtin_amdgcn_global_load_lds((const unsigned*)(gb + (size_t)i * 64 * K + t * 32),
                                       (__attribute__((address_space(3))) unsigned*)(base + BM * 64 + (tid + i * 256) * 16), 16, 0, 0);
  };
  const int swz = (fq ^ ((0x78 >> (((fr >> 2) & 3) * 2)) & 3)) * 16;
  __syncthreads();
  stage(0, 0);
  for (int t = 0; t < nk; ++t) {
    __syncthreads();
    if (t + 1 < nk) stage(t + 1, (t + 1) & 1);
    const unsigned char* base = smem + (t & 1) * STAGE;
    bf16x8 af[MI], bfr[4];
#pragma unroll
    for (int m = 0; m < MI; ++m) af[m] = *(const bf16x8*)(base + (wr * MI * 16 + m * 16 + fr) * 64 + swz);
#pragma unroll
    for (int n = 0; n < 4; ++n) bfr[n] = *(const bf16x8*)(base + BM * 64 + (wc * 64 + n * 16 + fr) * 64 + swz);
#pragma unroll
    for (int m = 0; m < MI; ++m)
#pragma unroll
      for (int n = 0; n < 4; ++n) acc[m][n] = __builtin_amdgcn_mfma_f32_16x16x32_bf16(af[m], bfr[n], acc[m][n], 0, 0, 0);
  }
}

__device__ __forceinline__ bool next_tile(int it, int MT, int NT, int& tm, int& tn) {
  const int G = gridDim.x, b = BIDX();
  const int total = MT * NT;
  int id;
  if ((G & 7) == 0) {
    const int per = G >> 3;
    id = it * G + (b & 7) * per + (b >> 3);
  } else {
    id = b + it * G;
  }
  if (id >= total) return false;
  constexpr int GM = 8;
  const int gsz = GM * NT;
  const int g = id / gsz, rem = id - g * gsz;
  const int rows = (MT - g * GM) < GM ? (MT - g * GM) : GM;
  tn = rem / rows;
  tm = g * GM + (rem - tn * rows);
  return true;
}

template <int MI>
__device__ __forceinline__ void ffn_in_tile(const u16* A, const u16* Bt, u16* act, int brow, int tn, unsigned char* smem) {
  const int tid = TIDX(), wid = tid >> 6, lane = tid & 63, wr = wid >> 1, wc = wid & 1, fr = lane & 15, fq = lane >> 4;
  f32x4 acc[MI][4];
  gemm_mainloop<MI>(A, Bt, 1024, brow, tn * 128, acc, smem);
#pragma unroll
  for (int m = 0; m < MI; ++m)
#pragma unroll
    for (int q = 0; q < 2; ++q)
#pragma unroll
      for (int j = 0; j < 4; ++j) {
        int row = brow + wr * MI * 16 + m * 16 + fq * 4 + j;
        int col = tn * 64 + wc * 32 + q * 16 + fr;
        float u1 = acc[m][2 * q][j], u2 = acc[m][2 * q + 1][j];
        act[(size_t)row * DFF + col] = f2bf(siluf_(u1) * u2);
      }
}
__device__ __forceinline__ void phase_ffn_in(const Params& p, int l, int f, unsigned char* smem) {
  const u16* A = (const u16*)(p.ws + OFF_H);
  const u16* Bt = (const u16*)(p.ws + OFF_WFFI) + (size_t)f * 5632 * 1024;
  u16* act = (u16*)(p.ws + OFF_P2);
  constexpr int NT = 44, MT = TLAT / 256;
  for (int it = 0;; ++it) {
    int tm, tn;
    if (!next_tile(it, MT, NT, tm, tn)) break;
    ffn_in_tile<8>(A, Bt, act, tm * 256, tn, smem);
  }
  for (int id = BIDX(); id < 8 * NT; id += gridDim.x) ffn_in_tile<4>(A, Bt, act, TLAT + (id & 7) * 128, id >> 3, smem);
}

__device__ __forceinline__ void phase_resid_gemm(const Params& p, int l, const u16* A, const u16* Bt, int K, int gate, float gscale,
                                 const float* lat_in, const float* cx_in, float* lat_out, float* cx_out,
                                 unsigned char* smem) {
  const int tid = TIDX(), wid = tid >> 6, lane = tid & 63, wr = wid >> 1, wc = wid & 1, fr = lane & 15, fq = lane >> 4;
  constexpr int MI = 6, NT = 8, MT = TALL / (MI * 32);
  const float* modp = (const float*)(p.ws + OFF_MOD) + (size_t)l * 5 * NMOD + gate * D;
  for (int it = 0;; ++it) {
    int tm, tn;
    if (!next_tile(it, MT, NT, tm, tn)) break;
    f32x4 acc[MI][4];
    gemm_mainloop<MI>(A, Bt, K, tm * MI * 32, tn * 128, acc, smem);
    {
      const int rowa = tm * MI * 32 + wr * MI * 16 + fq * 4;
      const int mi0 = mod_index(rowa), mi1 = mod_index(rowa + (MI - 1) * 16 + 3);
      float g0[4], g1[4];
#pragma unroll
      for (int n = 0; n < 4; ++n) {
        const int col = tn * 128 + wc * 64 + n * 16 + fr;
        g0[n] = gscale * modp[(size_t)mi0 * NMOD + col];
        g1[n] = gscale * modp[(size_t)mi1 * NMOD + col];
      }
#pragma unroll
      for (int m = 0; m < MI; ++m) {
        float xv[4][4];
#pragma unroll
        for (int j = 0; j < 4; ++j) {
          const float* xi = rrow(lat_in, cx_in, rowa + m * 16 + j);
#pragma unroll
          for (int n = 0; n < 4; ++n) xv[j][n] = xi[tn * 128 + wc * 64 + n * 16 + fr];
        }
#pragma unroll
        for (int j = 0; j < 4; ++j) {
          const int row = rowa + m * 16 + j;
          const bool first = mod_index(row) == mi0;
          float* xo = wrow(lat_out, cx_out, row);
#pragma unroll
          for (int n = 0; n < 4; ++n) xo[tn * 128 + wc * 64 + n * 16 + fr] = xv[j][n] + (first ? g0[n] : g1[n]) * acc[m][n][j];
        }
      }
    }
  }
}

__device__ __forceinline__ void phase_inproj(const Params& p, int l, unsigned char* smem) {
  const u16* A = (const u16*)(p.ws + OFF_H);
  const u16* Bt = (const u16*)(p.ws + OFF_WIN);
  const int tid = TIDX(), wid = tid >> 6, lane = tid & 63, wr = wid >> 1, wc = wid & 1, fr = lane & 15, fq = lane >> 4;
  constexpr int MI = 8, NT = 27, MT = TALL / (MI * 32);
  const float2* ropeseq = (const float2*)(p.ws + OFF_ROPE);
  const float2* roperow = ropeseq + 8192 * 32;
  const float2* ropecol = roperow + 128 * 16;
  u16* QA = (u16*)(p.ws + OFF_QA); u16* QB = (u16*)(p.ws + OFF_QB); u16* QR = (u16*)(p.ws + OFF_QR);
  u16* KA = (u16*)(p.ws + OFF_KA); u16* VA = (u16*)(p.ws + OFF_VA);
  u16* KB = (u16*)(p.ws + OFF_KB); u16* VB = (u16*)(p.ws + OFF_VB);
  u16* KR = (u16*)(p.ws + OFF_KR); u16* VR = (u16*)(p.ws + OFF_VR);
  u16* P2 = (u16*)(p.ws + OFF_P2);
  for (int it = 0;; ++it) {
    int tm, tn;
    if (!next_tile(it, MT, NT, tm, tn)) break;
    f32x4 acc[MI][4];
    gemm_mainloop<MI>(A, Bt, 1024, tm * MI * 32, tn * 128, acc, smem);
    const int r0 = tm * MI * 32 + wr * MI * 16;
    const int c0 = tn * 128 + wc * 64;
    const bool latent = r0 < TLAT;
    if (c0 >= 1792) {
#pragma unroll
      for (int m = 0; m < MI; ++m)
#pragma unroll
        for (int n = 0; n < 4; ++n)
#pragma unroll
          for (int j = 0; j < 4; ++j) {
            int row = r0 + m * 16 + fq * 4 + j;
            P2[(size_t)row * P2C + (c0 - 1792) + n * 16 + fr] = f2bf(acc[m][n][j]);
          }
      continue;
    }
    int kind;
    int ropek;
    int normk;
    float scale = 1.f;
    u16* dst; int hh, nh;
    if (c0 < 256) { kind = 0; ropek = 1; normk = -1; scale = 0.125f * LOG2E; dst = QA; hh = c0 >> 6; nh = 4; }
    else if (c0 < 384) { kind = 1; ropek = 1; normk = -1; dst = KA; hh = (c0 - 256) >> 6; nh = 2; }
    else if (c0 < 512) { kind = 2; ropek = 0; normk = -1; dst = VA; hh = (c0 - 384) >> 6; nh = 2; }
    else if (c0 < 768) { kind = 0; ropek = 1; normk = 0; scale = 0.125f * LOG2E; dst = QB; hh = (c0 - 512) >> 6; nh = 4; }
    else if (c0 < 896) { kind = 1; ropek = 1; normk = 1; dst = KB; hh = (c0 - 768) >> 6; nh = 2; }
    else if (c0 < 1024) { kind = 2; ropek = 0; normk = -1; dst = VB; hh = (c0 - 896) >> 6; nh = 2; }
    else if (c0 < 1280) { kind = 0; ropek = 2; normk = -1; dst = QR; hh = (c0 - 1024) >> 6; nh = 4; }
    else if (c0 < 1536) { kind = 1; ropek = 2; normk = -1; scale = 0.125f; dst = KR; hh = (c0 - 1280) >> 6; nh = 4; }
    else { kind = 2; ropek = 0; normk = -1; dst = VR; hh = (c0 - 1536) >> 6; nh = 4; }
    if (!latent) ropek = 0;
    if (kind == 2) {
#pragma unroll
      for (int m = 0; m < MI; ++m) {
        int b, pos;
        row_bpos(r0 + m * 16 + fq * 4, b, pos);
#pragma unroll
        for (int n = 0; n < 4; ++n) {
          int d = n * 16 + fr;
          bf16x4 o = pack4(acc[m][n][0], acc[m][n][1], acc[m][n][2], acc[m][n][3]);
          *(bf16x4*)(dst + ((size_t)(b * nh + hh) * 64 + d) * STOT + pos) = o;
        }
      }
      continue;
    }
    float gq[4] = {1.f, 1.f, 1.f, 1.f};
    if (normk >= 0) {
#pragma unroll
      for (int n = 0; n < 4; ++n) gq[n] = p.qk_g[((size_t)l * 2 + normk) * 64 + n * 16 + fr];
    }
#pragma unroll
    for (int m = 0; m < MI; ++m)
#pragma unroll
      for (int j = 0; j < 4; ++j) {
        int row = r0 + m * 16 + fq * 4 + j;
        float v0 = acc[m][0][j], v1 = acc[m][1][j], v2 = acc[m][2][j], v3 = acc[m][3][j];
        if (normk >= 0) {
          float ss = v0 * v0 + v1 * v1 + v2 * v2 + v3 * v3;
          ss += __shfl_xor(ss, 1); ss += __shfl_xor(ss, 2); ss += __shfl_xor(ss, 4); ss += __shfl_xor(ss, 8);
          float rstd = rsqrtf(ss * (1.f / 64.f) + RMS_EPS);
          v0 *= rstd * gq[0]; v1 *= rstd * gq[1]; v2 *= rstd * gq[2]; v3 *= rstd * gq[3];
        }
        int b, pos;
        row_bpos(row, b, pos);
        if (ropek == 1) {
          float2 cr = roperow[(pos >> 6) * 16 + fr];
          float2 cc = ropecol[(pos & 63) * 16 + fr];
          float o0 = v0 * cr.x - v1 * cr.y, o1 = v1 * cr.x + v0 * cr.y;
          float o2 = v2 * cc.x - v3 * cc.y, o3 = v3 * cc.x + v2 * cc.y;
          v0 = o0; v1 = o1; v2 = o2; v3 = o3;
        } else if (ropek == 2) {
          float2 ca = ropeseq[pos * 32 + fr];
          float2 cb = ropeseq[pos * 32 + 16 + fr];
          float o0 = v0 * ca.x - v2 * ca.y, o2 = v2 * ca.x + v0 * ca.y;
          float o1 = v1 * cb.x - v3 * cb.y, o3 = v3 * cb.x + v1 * cb.y;
          v0 = o0; v1 = o1; v2 = o2; v3 = o3;
        }
        v0 *= scale; v1 *= scale; v2 *= scale; v3 *= scale;
        u16* dp;
        if (kind == 0) dp = dst + (size_t)row * 256 + hh * 64 + fr;
        else dp = dst + ((size_t)(b * nh + hh) * STOT + pos) * 64 + fr;
        dp[0] = f2bf(v0); dp[16] = f2bf(v1); dp[32] = f2bf(v2); dp[48] = f2bf(v3);
      }
  }
}

__device__ __forceinline__ void attn_item(const u16* __restrict__ Q, const u16* __restrict__ Kb, const u16* __restrict__ Vt,
                          u16* __restrict__ concat, int ccol0, int b, int kvh, int qrow0, int qpos0, int t0, int t1,
                          int c0, int c1, bool masked, const float* sink, unsigned char* smem) {
  const int tid = TIDX(), w = tid >> 6, lane = tid & 63, fr = lane & 15, fq = lane >> 4;
  const int head = kvh * 2 + (w & 1);
  const int qoff = (w >> 1) * 32;
  bf16x8 qf[2][2];
#pragma unroll
  for (int qg = 0; qg < 2; ++qg)
#pragma unroll
    for (int ks = 0; ks < 2; ++ks)
      qf[qg][ks] = *(const bf16x8*)(Q + (size_t)(qrow0 + qoff + qg * 16 + fr) * 256 + head * 64 + ks * 32 + fq * 8);
  f32x4 O[2][4];
  float mrow[2], lrow[2];
#pragma unroll
  for (int qg = 0; qg < 2; ++qg) {
    mrow[qg] = -1e30f; lrow[qg] = 0.f;
#pragma unroll
    for (int dt = 0; dt < 4; ++dt) O[qg][dt] = f32x4{0.f, 0.f, 0.f, 0.f};
  }
  const u16* Kbase = Kb + (size_t)(b * 2 + kvh) * STOT * 64;
  const u16* Vbase = Vt + (size_t)(b * 2 + kvh) * 64 * STOT;
  const int n1 = t1 - t0, total = n1 + (c1 - c0);
  bf16x8 kreg[2], vreg[2];
  auto gload = [&](int i) {
    int tile = i < n1 ? t0 + i : c0 + (i - n1);
#pragma unroll
    for (int ps = 0; ps < 2; ++ps) {
      int idx = tid + ps * 256;
      kreg[ps] = *(const bf16x8*)(Kbase + (size_t)tile * 4096 + idx * 8);
      int d = idx >> 3, ch = idx & 7;
      vreg[ps] = *(const bf16x8*)(Vbase + (size_t)d * STOT + tile * 64 + ch * 8);
    }
  };
  auto lstore = [&](int buf) {
    u16* Ks = (u16*)(smem + buf * 18432);
    u16* Vs = Ks + 64 * 72;
#pragma unroll
    for (int ps = 0; ps < 2; ++ps) {
      int idx = tid + ps * 256;
      int r = idx >> 3, ch = idx & 7;
      *(bf16x8*)(Ks + r * 72 + ch * 8) = kreg[ps];
      *(bf16x8*)(Vs + r * 72 + ch * 8) = vreg[ps];
    }
  };
  __syncthreads();
  gload(0);
  lstore(0);
  __syncthreads();
#pragma unroll 1
  for (int i = 0; i < total; ++i) {
    const int tile = i < n1 ? t0 + i : c0 + (i - n1);
    if (i + 1 < total) gload(i + 1);
    const u16* Ks = (const u16*)(smem + (i & 1) * 18432);
    const u16* Vs = Ks + 64 * 72;
    f32x4 s[2][4];
#pragma unroll
    for (int qg = 0; qg < 2; ++qg)
#pragma unroll
      for (int sub = 0; sub < 4; ++sub) s[qg][sub] = f32x4{0.f, 0.f, 0.f, 0.f};
#pragma unroll
    for (int sub = 0; sub < 4; ++sub)
#pragma unroll
      for (int ks = 0; ks < 2; ++ks) {
        bf16x8 a = *(const bf16x8*)(Ks + (sub * 16 + fr) * 72 + ks * 32 + fq * 8);
#pragma unroll
        for (int qg = 0; qg < 2; ++qg) s[qg][sub] = __builtin_amdgcn_mfma_f32_16x16x32_bf16(a, qf[qg][ks], s[qg][sub], 0, 0, 0);
      }
    __builtin_amdgcn_sched_barrier(0);
    const bool domask = masked && (tile < 128);
    bf16x8 pb[2][2];
#pragma unroll
    for (int qg = 0; qg < 2; ++qg) {
      if (domask) {
        int qpos = qpos0 + qoff + qg * 16 + fr;
#pragma unroll
        for (int sub = 0; sub < 4; ++sub)
#pragma unroll
          for (int j = 0; j < 4; ++j) {
            int kpos = tile * 64 + sub * 16 + fq * 4 + j;
            int dd = kpos - qpos;
            if (dd > 128 || dd < -128) s[qg][sub][j] = -INFINITY;
          }
      }
      float mx = -INFINITY;
#pragma unroll
      for (int sub = 0; sub < 4; ++sub)
#pragma unroll
        for (int j = 0; j < 4; ++j) mx = fmaxf(mx, s[qg][sub][j]);
      mx = fmaxf(mx, __shfl_xor(mx, 16));
      mx = fmaxf(mx, __shfl_xor(mx, 32));
      float mnew = fmaxf(mrow[qg], mx);
      const bool changed = mnew > mrow[qg];
      float alpha = __builtin_amdgcn_exp2f(mrow[qg] - mnew);
      mrow[qg] = mnew;
      float ps = 0.f;
#pragma unroll
      for (int sub = 0; sub < 4; ++sub)
#pragma unroll
        for (int j = 0; j < 4; ++j) {
          float pv = __builtin_amdgcn_exp2f(s[qg][sub][j] - mnew);
          s[qg][sub][j] = pv;
          ps += pv;
        }
      lrow[qg] = lrow[qg] * alpha + ps;
      if (__builtin_amdgcn_ballot_w64(changed) != 0ull) {
#pragma unroll
        for (int dt = 0; dt < 4; ++dt) O[qg][dt] *= alpha;
      }
#pragma unroll
      for (int ks = 0; ks < 2; ++ks)
        pb[qg][ks] = cat8(pack4(s[qg][2 * ks][0], s[qg][2 * ks][1], s[qg][2 * ks][2], s[qg][2 * ks][3]),
                          pack4(s[qg][2 * ks + 1][0], s[qg][2 * ks + 1][1], s[qg][2 * ks + 1][2], s[qg][2 * ks + 1][3]));
      __builtin_amdgcn_sched_barrier(0);
    }
#pragma unroll
    for (int dt = 0; dt < 4; ++dt)
#pragma unroll
      for (int ks = 0; ks < 2; ++ks) {
        const u16* vp = Vs + (dt * 16 + fr) * 72 + ks * 32 + fq * 4;
        bf16x8 va = cat8(*(const bf16x4*)vp, *(const bf16x4*)(vp + 16));
#pragma unroll
        for (int qg = 0; qg < 2; ++qg) O[qg][dt] = __builtin_amdgcn_mfma_f32_16x16x32_bf16(va, pb[qg][ks], O[qg][dt], 0, 0, 0);
      }
    __builtin_amdgcn_sched_barrier(0);
    if (i + 1 < total) lstore((i + 1) & 1);
    __syncthreads();
  }
#pragma unroll
  for (int qg = 0; qg < 2; ++qg) {
    float lt = lrow[qg];
    lt += __shfl_xor(lt, 16);
    lt += __shfl_xor(lt, 32);
    if (sink) lt += __builtin_amdgcn_exp2f(sink[head] * LOG2E - mrow[qg]);
    float inv = 1.f / lt;
    int row = qrow0 + qoff + qg * 16 + fr;
#pragma unroll
    for (int dt = 0; dt < 4; ++dt) {
      bf16x4 o = pack4(O[qg][dt][0] * inv, O[qg][dt][1] * inv, O[qg][dt][2] * inv, O[qg][dt][3] * inv);
      *(bf16x4*)(concat + (size_t)row * D + ccol0 + head * 64 + dt * 16 + fq * 4) = o;
    }
  }
}

__device__ __forceinline__ float ret_lg(int h) {
  return log2f(1.0f - exp2f(-5.0f - (float)h));
}

__device__ __forceinline__ void retU_item(const Params& p, int bh, int c, unsigned char* smem) {
  const int tid = TIDX();
  const int b = bh >> 2, h = bh & 3;
  const u16* KR = (const u16*)(p.ws + OFF_KR) + (size_t)bh * STOT * 64;
  const u16* VR = (const u16*)(p.ws + OFF_VR) + (size_t)bh * 64 * STOT;
  (void)b;
  const int pos0 = c < 64 ? c * 128 : SEQ + (c - 64) * 128;
  u16* Kc = (u16*)smem;
  u16* Vj = Kc + 128 * 64;
  __syncthreads();
#pragma unroll
  for (int ps = 0; ps < 4; ++ps) {
    int idx = tid + ps * 256;
    *(bf16x8*)(Kc + idx * 8) = *(const bf16x8*)(KR + (size_t)pos0 * 64 + idx * 8);
    int d = idx >> 4, ch = idx & 15;
    bf16x8 v = *(const bf16x8*)(VR + (size_t)d * STOT + pos0 + ch * 8);
#pragma unroll
    for (int e = 0; e < 8; ++e) Vj[(ch * 8 + e) * 72 + d] = (u16)v[e];
  }
  __syncthreads();
  const int dk = tid >> 2, dv0 = (tid & 3) * 16;
  const float lg = ret_lg(h);
  float af[16], ab[16];
#pragma unroll
  for (int q = 0; q < 16; ++q) { af[q] = 0.f; ab[q] = 0.f; }
  for (int j = 0; j < 128; ++j) {
    float kf = bf2f(Kc[j * 64 + dk]);
    float kfw = kf * exp2f(lg * (float)(127 - j));
    float kbw = kf * exp2f(lg * (float)j);
    bf16x8 v0 = *(const bf16x8*)(Vj + j * 72 + dv0);
    bf16x8 v1 = *(const bf16x8*)(Vj + j * 72 + dv0 + 8);
#pragma unroll
    for (int q = 0; q < 8; ++q) {
      float a = bf2f((u16)v0[q]), bb = bf2f((u16)v1[q]);
      af[q] += kfw * a; ab[q] += kbw * a;
      af[8 + q] += kfw * bb; ab[8 + q] += kbw * bb;
    }
  }
  float* U = (float*)(p.ws + OFF_U) + ((size_t)bh * 66 + c) * 2 * 4096;
#pragma unroll
  for (int q = 0; q < 16; ++q) {
    U[(dv0 + q) * 64 + dk] = af[q];
    U[4096 + (dv0 + q) * 64 + dk] = ab[q];
  }
}

__device__ __forceinline__ void phase_retU(const Params& p, unsigned char* smem) {
  for (int item = BIDX(); item < 16 * 66; item += gridDim.x) retU_item(p, item / 66, item % 66, smem);
}

__device__ __forceinline__ void attn_worker(const Params& p, int l, unsigned char* smem) {
  const u16* QA = (const u16*)(p.ws + OFF_QA); const u16* QB = (const u16*)(p.ws + OFF_QB);
  const u16* KA = (const u16*)(p.ws + OFF_KA); const u16* VA = (const u16*)(p.ws + OFF_VA);
  const u16* KB = (const u16*)(p.ws + OFF_KB); const u16* VB = (const u16*)(p.ws + OFF_VB);
  u16* concat = (u16*)(p.ws + OFF_H);
  const float* sink = p.attn_sink + l * 4;
  int* qctr = (int*)(p.ws + OFF_QCTR) + l;
  volatile int* slot = (volatile int*)(smem + 65536 - 32);
  for (;;) {
    __syncthreads();
    if (TIDX() == 0) *slot = atomicAdd(qctr, 1);
    __syncthreads();
    const int item = *slot;
    if (item >= 2112) break;
    const bool isB = item < 1024 || (item >= 2048 && item < 2080);
    const bool isctx = item >= 2048;
    int ii = item < 1024 ? item : item < 2048 ? item - 1024 : item < 2080 ? item - 2048 : item - 2080;
    int qt, kvh, b, qrow0, qpos0, t0, t1;
    if (!isctx) {
      qt = ii & 127; kvh = (ii >> 7) & 1; b = ii >> 8;
      qrow0 = b * SEQ + qt * 64; qpos0 = qt * 64;
      if (isB) { t0 = 0; t1 = 128; }
      else { t0 = qt - 2 < 0 ? 0 : qt - 2; t1 = qt + 3 > 128 ? 128 : qt + 3; }
    } else {
      qt = ii & 3; kvh = (ii >> 2) & 1; b = ii >> 3;
      qrow0 = TLAT + b * CTXL + qt * 64; qpos0 = 0; t0 = 0; t1 = 0;
    }
    attn_item(isB ? QB : QA, isB ? KB : KA, isB ? VB : VA, concat, isB ? 256 : 0, b, kvh, qrow0, qpos0, t0, t1, 128, 132,
              (!isB) && (!isctx), isB ? nullptr : sink, smem);
  }
}

__device__ __forceinline__ void phase_retscan(const Params& p) {
  const float* U = (const float*)(p.ws + OFF_U);
  u16* SP = (u16*)(p.ws + OFF_SP);
  for (int gid = BIDX() * 256 + TIDX(); gid < 16 * 2 * 4096; gid += gridDim.x * 256) {
    int e = gid & 4095, dir = (gid >> 12) & 1, bh = gid >> 13;
    float g128 = exp2f(128.f * ret_lg(bh & 3));
    float S = 0.f;
#pragma unroll 1
    for (int n0 = 0; n0 < 66; n0 += 11) {
      float u[11];
      size_t offs[11];
#pragma unroll
      for (int k = 0; k < 11; ++k) {
        int n = n0 + k;
        int c = dir == 0 ? (n < 2 ? 64 + n : n - 2) : 65 - n;
        offs[k] = (((size_t)bh * 66 + c) * 2 + dir) * 4096 + e;
        u[k] = U[offs[k]];
      }
#pragma unroll
      for (int k = 0; k < 11; ++k) {
        SP[offs[k]] = f2bf(S);
        S = g128 * S + u[k];
      }
    }
  }
}

__device__ __forceinline__ void retout_item(const Params& p, int l, int bh, int c, unsigned char* smem) {
  const int tid = TIDX(), w = tid >> 6, lane = tid & 63, fr = lane & 15, fq = lane >> 4;
  const int b = bh >> 2, h = bh & 3;
  const u16* QR = (const u16*)(p.ws + OFF_QR);
  const u16* KR = (const u16*)(p.ws + OFF_KR) + (size_t)bh * STOT * 64;
  const u16* VR = (const u16*)(p.ws + OFF_VR) + (size_t)bh * 64 * STOT;
  const u16* SP = (const u16*)(p.ws + OFF_SP) + ((size_t)bh * 66 + c) * 2 * 4096;
  const u16* P2 = (const u16*)(p.ws + OFF_P2);
  u16* concat = (u16*)(p.ws + OFF_H);
  const int pos0 = c < 64 ? c * 128 : SEQ + (c - 64) * 128;
  const int row0 = bpos_row(b, pos0);
  u16* Kc = (u16*)smem;
  u16* Vs = Kc + 128 * 72;
  __syncthreads();
#pragma unroll
  for (int ps = 0; ps < 4; ++ps) {
    int idx = tid + ps * 256;
    int r = idx >> 3, ch = idx & 7;
    *(bf16x8*)(Kc + r * 72 + ch * 8) = *(const bf16x8*)(KR + (size_t)(pos0 + r) * 64 + ch * 8);
    int d = idx >> 4, c16 = idx & 15;
    *(bf16x8*)(Vs + d * 136 + c16 * 8) = *(const bf16x8*)(VR + (size_t)d * STOT + pos0 + c16 * 8);
  }
  __syncthreads();
  const float lg = ret_lg(h);
#pragma unroll 1
  for (int qg = 0; qg < 2; ++qg) {
    const int i = w * 32 + qg * 16 + fr;
    const int row = row0 + i;
    bf16x8 qf[2];
#pragma unroll
    for (int ks = 0; ks < 2; ++ks) qf[ks] = *(const bf16x8*)(QR + (size_t)row * 256 + h * 64 + ks * 32 + fq * 8);
    f32x4 s[8];
#pragma unroll
    for (int sub = 0; sub < 8; ++sub) {
      s[sub] = f32x4{0.f, 0.f, 0.f, 0.f};
#pragma unroll
      for (int ks = 0; ks < 2; ++ks) {
        bf16x8 a = *(const bf16x8*)(Kc + (sub * 16 + fr) * 72 + ks * 32 + fq * 8);
        s[sub] = __builtin_amdgcn_mfma_f32_16x16x32_bf16(a, qf[ks], s[sub], 0, 0, 0);
      }
    }
    float res[4][4];
#pragma unroll
    for (int dt = 0; dt < 4; ++dt)
#pragma unroll
      for (int j = 0; j < 4; ++j) res[dt][j] = 0.f;
#pragma unroll 1
    for (int dir = 0; dir < 2; ++dir) {
      f32x4 O[4];
      const float qw = dir == 0 ? __builtin_amdgcn_exp2f(lg * (float)(i + 1)) : __builtin_amdgcn_exp2f(lg * (float)(128 - i));
#pragma unroll
      for (int dt = 0; dt < 4; ++dt) {
        O[dt] = f32x4{0.f, 0.f, 0.f, 0.f};
#pragma unroll
        for (int ks = 0; ks < 2; ++ks) {
          bf16x8 a = *(const bf16x8*)(SP + dir * 4096 + (dt * 16 + fr) * 64 + ks * 32 + fq * 8);
          O[dt] = __builtin_amdgcn_mfma_f32_16x16x32_bf16(a, qf[ks], O[dt], 0, 0, 0);
        }
        O[dt] *= qw;
      }
      int fqo = fq;
      asm volatile("" : "+v"(fqo));
#pragma unroll
      for (int ks = 0; ks < 4; ++ks) {
        float pv[8];
#pragma unroll
        for (int e = 0; e < 8; ++e) {
          const int sub = 2 * ks + (e >> 2), j = e & 3;
          const int jk = sub * 16 + fqo * 4 + j;
          const int dd = dir == 0 ? i - jk : jk - i;
          pv[e] = dd >= 0 ? s[sub][j] * __builtin_amdgcn_exp2f(lg * (float)dd) : 0.f;
        }
        bf16x8 pb = cat8(pack4(pv[0], pv[1], pv[2], pv[3]), pack4(pv[4], pv[5], pv[6], pv[7]));
#pragma unroll
        for (int dt = 0; dt < 4; ++dt) {
          const u16* vp = Vs + (dt * 16 + fr) * 136 + ks * 32 + fq * 4;
          bf16x8 va = cat8(*(const bf16x4*)vp, *(const bf16x4*)(vp + 16));
          O[dt] = __builtin_amdgcn_mfma_f32_16x16x32_bf16(va, pb, O[dt], 0, 0, 0);
        }
      }
      float sm = 0.f;
#pragma unroll
      for (int dt = 0; dt < 4; ++dt)
#pragma unroll
        for (int j = 0; j < 4; ++j) sm += O[dt][j];
      sm += __shfl_xor(sm, 16); sm += __shfl_xor(sm, 32);
      const float mu = sm * (1.f / 64.f);
      float vs = 0.f;
#pragma unroll
      for (int dt = 0; dt < 4; ++dt)
#pragma unroll
        for (int j = 0; j < 4; ++j) { float dlt = O[dt][j] - mu; vs += dlt * dlt; }
      vs += __shfl_xor(vs, 16); vs += __shfl_xor(vs, 32);
      const float rstd = rsqrtf(vs * (1.f / 64.f) + GN_EPS);
#pragma unroll
      for (int dt = 0; dt < 4; ++dt) {
        const int d = dt * 16 + fq * 4;
        bf16x4 gt = *(const bf16x4*)(P2 + (size_t)row * P2C + dir * 256 + h * 64 + d);
        float4 rg = *(const float4*)(p.ret_g + (size_t)l * 256 + h * 64 + d);
        res[dt][0] += (O[dt][0] - mu) * rstd * rg.x * siluf_(bf2f((u16)gt[0]));
        res[dt][1] += (O[dt][1] - mu) * rstd * rg.y * siluf_(bf2f((u16)gt[1]));
        res[dt][2] += (O[dt][2] - mu) * rstd * rg.z * siluf_(bf2f((u16)gt[2]));
        res[dt][3] += (O[dt][3] - mu) * rstd * rg.w * siluf_(bf2f((u16)gt[3]));
      }
    }
#pragma unroll
    for (int dt = 0; dt < 4; ++dt)
      *(bf16x4*)(concat + (size_t)row * D + 512 + h * 64 + dt * 16 + fq * 4) = pack4(res[dt][0], res[dt][1], res[dt][2], res[dt][3]);
  }
}

__device__ __forceinline__ void phase_retout(const Params& p, int l, unsigned char* smem) {
  for (int item = BIDX(); item < 16 * 66; item += gridDim.x) retout_item(p, l, item / 66, item % 66, smem);
}

__device__ __forceinline__ void phase_wprep(const Params& p, int l, unsigned char* smem) {
  const int tid = TIDX(), col = tid;
  const u16* P2 = (const u16*)(p.ws + OFF_P2);
  u16* prep = (u16*)(p.ws + OFF_PREP);
  float* twT = (float*)smem;
  float* amT = twT + 64 * 16;
  float* outW = amT + 64 * 16;
  float* outA = outW + 16 * 256;
  const int j = tid & 31, tsub = tid >> 5, head = j >> 3, c8 = (j & 7) * 8, ch0 = head * 64 + c8;
  float kkv[8], kav[8];
#pragma unroll
  for (int e = 0; e < 8; ++e) { kkv[e] = p.k_k[(size_t)l * 256 + ch0 + e]; kav[e] = p.k_a[(size_t)l * 256 + ch0 + e]; }
  for (int item = BIDX(); item < (TALL / 16) * 2; item += gridDim.x) {
    const int dir = item & 1, row0 = (item >> 1) * 16;
    const float* mu = p.mu + ((size_t)l * 2 + dir) * 896;
    __syncthreads();
    {
      const int tok = tid >> 4, e0 = (tid & 15) * 4;
      const int row = row0 + tok;
      int b, pos;
      row_bpos(row, b, pos);
      bool has;
      int nrow;
      if (dir == 0) { has = (pos != 0) && (pos != SEQ); nrow = row - 1; }
      else { has = (pos != SEQ - 1) && (pos != STOT - 1); nrow = row + 1; }
      const int srow = has ? nrow : row;
      bf16x4 zw = *(const bf16x4*)(P2 + (size_t)row * P2C + 1408 + dir * 64 + e0);
      bf16x4 za = *(const bf16x4*)(P2 + (size_t)row * P2C + 1536 + dir * 64 + e0);
      bf16x4 sw = *(const bf16x4*)(P2 + (size_t)srow * P2C + 1408 + dir * 64 + e0);
      bf16x4 sa = *(const bf16x4*)(P2 + (size_t)srow * P2C + 1536 + dir * 64 + e0);
#pragma unroll
      for (int e = 0; e < 4; ++e) {
        float z = bf2f((u16)zw[e]), zs = has ? bf2f((u16)sw[e]) : 0.f;
        twT[(e0 + e) * 16 + tok] = tanhf_(z + mu[768 + e0 + e] * (zs - z));
        float z2 = bf2f((u16)za[e]), zs2 = has ? bf2f((u16)sa[e]) : 0.f;
        amT[(e0 + e) * 16 + tok] = z2 + mu[832 + e0 + e] * (zs2 - z2);
      }
    }
    __syncthreads();
    {
      const float* w2 = p.w2 + ((size_t)l * 2 + dir) * 64 * 256 + col;
      const float* a2 = p.a2 + ((size_t)l * 2 + dir) * 64 * 256 + col;
      const float w0v = p.w0[((size_t)l * 2 + dir) * 256 + col], a0v = p.a0[((size_t)l * 2 + dir) * 256 + col];
#pragma unroll 1
      for (int pass = 0; pass < 2; ++pass) {
        const float* wcol = pass == 0 ? w2 : a2;
        const float* xT = pass == 0 ? twT : amT;
        float acc[16];
#pragma unroll
        for (int t = 0; t < 16; ++t) acc[t] = 0.f;
#pragma unroll 1
        for (int k0 = 0; k0 < 64; k0 += 16) {
          float wv[16];
#pragma unroll
          for (int u = 0; u < 16; ++u) wv[u] = wcol[(k0 + u) * 256];
#pragma unroll
          for (int u = 0; u < 16; ++u) {
            const int kq = k0 + u;
#pragma unroll
            for (int t4 = 0; t4 < 4; ++t4) {
              float4 a = *(const float4*)(xT + kq * 16 + t4 * 4);
              acc[t4 * 4 + 0] += a.x * wv[u]; acc[t4 * 4 + 1] += a.y * wv[u]; acc[t4 * 4 + 2] += a.z * wv[u]; acc[t4 * 4 + 3] += a.w * wv[u];
            }
          }
        }
        if (pass == 0) {
#pragma unroll
          for (int t = 0; t < 16; ++t) outW[t * 256 + col] = -0.6065306597126334f * sigmoidf_(w0v + acc[t]) * LOG2E;
        } else {
#pragma unroll
          for (int t = 0; t < 16; ++t) outA[t * 256 + col] = sigmoidf_(a0v + acc[t]);
        }
      }
    }
    __syncthreads();
    {
      float mur[8], muk[8], muv[8];
#pragma unroll
      for (int e = 0; e < 8; ++e) { mur[e] = mu[ch0 + e]; muk[e] = mu[256 + ch0 + e]; muv[e] = mu[512 + ch0 + e]; }
#pragma unroll
      for (int pass = 0; pass < 2; ++pass) {
        const int tok = pass * 8 + tsub, row = row0 + tok;
        int b, pos;
        row_bpos(row, b, pos);
        bool has;
        int nrow;
        if (dir == 0) { has = (pos != 0) && (pos != SEQ); nrow = row - 1; }
        else { has = (pos != SEQ - 1) && (pos != STOT - 1); nrow = row + 1; }
        const u16* cp = P2 + (size_t)row * P2C + 512 + ch0;
        const u16* np = P2 + (size_t)(has ? nrow : row) * P2C + 512 + ch0;
        const bf16x8 zr8 = *(const bf16x8*)cp, zk8 = *(const bf16x8*)(cp + 256), zv8 = *(const bf16x8*)(cp + 512);
        const bf16x8 sr8 = *(const bf16x8*)np, sk8 = *(const bf16x8*)(np + 256), sv8 = *(const bf16x8*)(np + 512);
        const float4 lw0 = *(const float4*)(outW + tok * 256 + ch0), lw1 = *(const float4*)(outW + tok * 256 + ch0 + 4);
        const float4 av0 = *(const float4*)(outA + tok * 256 + ch0), av1 = *(const float4*)(outA + tok * 256 + ch0 + 4);
        const float lw[8] = {lw0.x, lw0.y, lw0.z, lw0.w, lw1.x, lw1.y, lw1.z, lw1.w};
        const float av[8] = {av0.x, av0.y, av0.z, av0.w, av1.x, av1.y, av1.z, av1.w};
        float r[8], k[8], v[8], kkr[8], ss = 0.f;
#pragma unroll
        for (int e = 0; e < 8; ++e) {
          float zr = bf2f((u16)zr8[e]), zk = bf2f((u16)zk8[e]), zv = bf2f((u16)zv8[e]);
          float sr = has ? bf2f((u16)sr8[e]) : 0.f, sk = has ? bf2f((u16)sk8[e]) : 0.f, sv = has ? bf2f((u16)sv8[e]) : 0.f;
          r[e] = zr + mur[e] * (sr - zr); k[e] = zk + muk[e] * (sk - zk); v[e] = zv + muv[e] * (sv - zv);
          kkr[e] = k[e] * kkv[e];
          ss += kkr[e] * kkr[e];
        }
        ss = half8_sum(ss);
        const float rs = rsqrtf(fmaxf(ss, 1e-24f));
        float kt[8], kk[8], bb[8];
#pragma unroll
        for (int e = 0; e < 8; ++e) {
          kk[e] = kkr[e] * rs;
          kt[e] = k[e] * (1.f + (av[e] - 1.f) * kav[e]);
          bb[e] = kk[e] * av[e];
        }
        u16* dp = prep + (((size_t)(b * 4 + head) * 2 + dir) * STOT + pos) * 384 + c8;
        *(bf16x8*)(dp) = cat8(pack4(lw[0], lw[1], lw[2], lw[3]), pack4(lw[4], lw[5], lw[6], lw[7]));
        *(bf16x8*)(dp + 64) = cat8(pack4(kt[0], kt[1], kt[2], kt[3]), pack4(kt[4], kt[5], kt[6], kt[7]));
        *(bf16x8*)(dp + 128) = cat8(pack4(kk[0], kk[1], kk[2], kk[3]), pack4(kk[4], kk[5], kk[6], kk[7]));
        *(bf16x8*)(dp + 192) = cat8(pack4(bb[0], bb[1], bb[2], bb[3]), pack4(bb[4], bb[5], bb[6], bb[7]));
        *(bf16x8*)(dp + 256) = cat8(pack4(r[0], r[1], r[2], r[3]), pack4(r[4], r[5], r[6], r[7]));
        *(bf16x8*)(dp + 320) = cat8(pack4(v[0], v[1], v[2], v[3]), pack4(v[4], v[5], v[6], v[7]));
      }
    }
  }
}

typedef float f32x2 __attribute__((ext_vector_type(2)));
__device__ __forceinline__ void wscan_item(const Params& p, int item, unsigned char* smem) {
  const int tid = TIDX(), w = tid >> 6, lane = tid & 63;
  const int jl4 = (lane & 15) * 4, rsub = lane >> 4;
  const u16* prep = (const u16*)(p.ws + OFF_PREP);
  u16* P2w = (u16*)(p.ws + OFF_P2);
  float* bufs = (float*)smem;
  {
    const int rq = item & 3, seq = item >> 2;
    const int dir = seq & 1, h = (seq >> 1) & 3, b = seq >> 3;
    const int irow = rq * 16 + w * 4 + rsub;
    const u16* base = prep + (size_t)seq * STOT * 384;
    uint4 lreg[3];
    auto gload = [&](int ch) {
#pragma unroll
      for (int ps = 0; ps < 3; ++ps) {
        int q = tid + ps * 256;
        int sidx = q / 48, within = q % 48;
        int n = ch * 16 + sidx;
        int pos = dir == 0 ? (n < CTXL ? SEQ + n : n - CTXL) : (STOT - 1 - n);
        lreg[ps] = *(const uint4*)(base + (size_t)pos * 384 + within * 8);
      }
    };
    auto lstore = [&](int buf) {
#pragma unroll
      for (int ps = 0; ps < 3; ++ps) {
        int q = tid + ps * 256;
        int sidx = q / 48, within = q % 48;
        float* dp = bufs + buf * 6144 + sidx * 384 + within * 8;
        uint4 u = lreg[ps];
        float4 lo = make_float4(__uint_as_float(u.x << 16), __uint_as_float(u.x & 0xffff0000u), __uint_as_float(u.y << 16), __uint_as_float(u.y & 0xffff0000u));
        float4 hi = make_float4(__uint_as_float(u.z << 16), __uint_as_float(u.z & 0xffff0000u), __uint_as_float(u.w << 16), __uint_as_float(u.w & 0xffff0000u));
        if (within < 8) {
          lo.x = __builtin_amdgcn_exp2f(lo.x); lo.y = __builtin_amdgcn_exp2f(lo.y); lo.z = __builtin_amdgcn_exp2f(lo.z); lo.w = __builtin_amdgcn_exp2f(lo.w);
          hi.x = __builtin_amdgcn_exp2f(hi.x); hi.y = __builtin_amdgcn_exp2f(hi.y); hi.z = __builtin_amdgcn_exp2f(hi.z); hi.w = __builtin_amdgcn_exp2f(hi.w);
        }
        *(float4*)dp = lo;
        *(float4*)(dp + 4) = hi;
      }
    };
    f32x2 S01 = {0.f, 0.f}, S23 = {0.f, 0.f};
    __syncthreads();
    gload(0);
    lstore(0);
    __syncthreads();
    constexpr int NCH = STOT / 16;
    for (int ch = 0; ch < NCH; ++ch) {
      if (ch + 1 < NCH) gload(ch + 1);
      const float* bp = bufs + (ch & 1) * 6144;
      const int n0 = ch * 16;
      const int pos0 = dir == 0 ? (n0 < CTXL ? SEQ + n0 : n0 - CTXL) : (STOT - 1 - n0);
      u16* yp = P2w + (size_t)bpos_row(b, pos0) * P2C + (dir == 0 ? YCOL0 : YCOL1) + h * 64 + irow;
      const int ystride = dir == 0 ? P2C : -P2C;
      float4 Wq[3], Kq[3], Nq[3], Bq[3], Rq[3];
      float Vq[3];
#define SCAN_LD(slot, st)                                        \
      do {                                                         \
        const float* sp_ = bp + (st) * 384;                        \
        Wq[slot] = *(const float4*)(sp_ + jl4);                    \
        Kq[slot] = *(const float4*)(sp_ + 64 + jl4);               \
        Nq[slot] = *(const float4*)(sp_ + 128 + jl4);              \
        Bq[slot] = *(const float4*)(sp_ + 192 + jl4);              \
        Rq[slot] = *(const float4*)(sp_ + 256 + jl4);              \
        Vq[slot] = sp_[320 + irow];                                \
      } while (0)
      SCAN_LD(0, 0);
      SCAN_LD(1, 1);
      SCAN_LD(2, 2);
      float ypart = 0.f;
#pragma unroll
      for (int s = 0; s < 16; ++s) {
        const int sl = s % 3;
        const float4 wv = Wq[sl], kt = Kq[sl], kk = Nq[sl], bb = Bq[sl], rr = Rq[sl];
        const float v = Vq[sl];
        if (s + 3 < 16) SCAN_LD(sl, s + 3);
        const f32x2 vv = {v, v};
        f32x2 A01 = S01 * f32x2{wv.x, wv.y} + vv * f32x2{kt.x, kt.y};
        f32x2 A23 = S23 * f32x2{wv.z, wv.w} + vv * f32x2{kt.z, kt.w};
        f32x2 pp = S01 * f32x2{kk.x, kk.y} + S23 * f32x2{kk.z, kk.w};
        float sa = pp.x + pp.y;
        float yprev = ypart;
        row16_sum2(sa, yprev);
        if (s > 0) { if ((lane & 15) == 0) yp[(s - 1) * ystride] = f2bf(yprev); }
        const f32x2 nsa = {-sa, -sa};
        S01 = nsa * f32x2{bb.x, bb.y} + A01;
        S23 = nsa * f32x2{bb.z, bb.w} + A23;
        f32x2 yy = S01 * f32x2{rr.x, rr.y} + S23 * f32x2{rr.z, rr.w};
        ypart = yy.x + yy.y;
      }
      {
        float ylast = row16_sum(ypart);
        if ((lane & 15) == 0) yp[15 * ystride] = f2bf(ylast);
      }
#undef SCAN_LD
      if (ch + 1 < NCH) lstore((ch + 1) & 1);
      __syncthreads();
    }
  }
}

__device__ __forceinline__ void phase_scan_attn(const Params& p, int l, unsigned char* smem) {
  const int G = gridDim.x, tid = TIDX(), bid = BIDX();
  if (G > 128 && G <= 2048) {
    int* keys = (int*)smem;
    int* red = keys + 2048;
    const int* cutab = (const int*)(p.ws + OFF_CUTAB);
    __syncthreads();
    for (int i = tid; i < G; i += 256) keys[i] = cutab[i];
    if (tid == 0) { red[0] = 0; red[1] = 0; }
    __syncthreads();
    for (int i = 128 + tid; i < G; i += 256) {
      const int ki = keys[i];
      bool m = false;
      for (int j = 0; j < 128; ++j) m = m || (keys[j] == ki);
      if (!m) atomicAdd(&red[0], 1);
      if (m && i == bid) red[1] = 1;
    }
    __syncthreads();
    const int eligible = red[0], mine = red[1];
    __syncthreads();
    if (bid < 128) {
      __builtin_amdgcn_s_setprio(3);
      wscan_item(p, bid, smem);
      __builtin_amdgcn_s_setprio(0);
    } else if (eligible < 64 || !mine) {
      attn_worker(p, l, smem);
    }
  } else {
    for (int item = bid; item < 128; item += G) wscan_item(p, item, smem);
    attn_worker(p, l, smem);
  }
}

__device__ __forceinline__ void phase_wfin(const Params& p, int l, unsigned char* smem) {
  const int tid = TIDX(), col = tid;
  const u16* P2 = (const u16*)(p.ws + OFF_P2);
  const u16* prep = (const u16*)(p.ws + OFF_PREP);
  u16* concat = (u16*)(p.ws + OFF_H);
  float* sgT = (float*)smem;
  float* gateL = sgT + 128 * 16;
  const float* g2 = p.g2 + (size_t)l * 128 * 256 + col;
  const int j = tid & 31, tsub = tid >> 5, head = j >> 3, c8 = (j & 7) * 8, ch0 = head * 64 + c8;
  float lng[8], lnb[8], rho[2][8];
#pragma unroll
  for (int e = 0; e < 8; ++e) {
    lng[e] = p.ln_g[(size_t)l * 256 + ch0 + e];
    lnb[e] = p.ln_b[(size_t)l * 256 + ch0 + e];
    rho[0][e] = p.rho[((size_t)l * 2 + 0) * 256 + ch0 + e];
    rho[1][e] = p.rho[((size_t)l * 2 + 1) * 256 + ch0 + e];
  }
  for (int item = BIDX(); item < TALL / 16; item += gridDim.x) {
    const int row0 = item * 16;
    __syncthreads();
    {
      const int tok = tid >> 4, k0 = (tid & 15) * 8;
      bf16x8 g = *(const bf16x8*)(P2 + (size_t)(row0 + tok) * P2C + 1280 + k0);
#pragma unroll
      for (int e = 0; e < 8; ++e) sgT[(k0 + e) * 16 + tok] = sigmoidf_(bf2f((u16)g[e]));
    }
    __syncthreads();
    float acc[16];
#pragma unroll
    for (int t = 0; t < 16; ++t) acc[t] = 0.f;
#pragma unroll 1
    for (int k0 = 0; k0 < 128; k0 += 16) {
      float gv8[16];
#pragma unroll
      for (int u = 0; u < 16; ++u) gv8[u] = g2[(k0 + u) * 256];
#pragma unroll
      for (int u = 0; u < 16; ++u) {
        const int k = k0 + u;
        const float gv = gv8[u];
#pragma unroll
        for (int t4 = 0; t4 < 4; ++t4) {
          float4 a = *(const float4*)(sgT + k * 16 + t4 * 4);
          acc[t4 * 4 + 0] += a.x * gv; acc[t4 * 4 + 1] += a.y * gv; acc[t4 * 4 + 2] += a.z * gv; acc[t4 * 4 + 3] += a.w * gv;
        }
      }
    }
#pragma unroll
    for (int t = 0; t < 16; ++t) gateL[t * 256 + col] = acc[t];
    __syncthreads();
#pragma unroll
    for (int pass = 0; pass < 2; ++pass) {
      const int tok = pass * 8 + tsub, row = row0 + tok;
      int b, pos;
      row_bpos(row, b, pos);
      float tot[8];
#pragma unroll
      for (int e = 0; e < 8; ++e) tot[e] = 0.f;
#pragma unroll
      for (int dir = 0; dir < 2; ++dir) {
        const bf16x8 y8 = *(const bf16x8*)(P2 + (size_t)row * P2C + (dir == 0 ? YCOL0 : YCOL1) + ch0);
        const u16* pp = prep + (((size_t)(b * 4 + head) * 2 + dir) * STOT + pos) * 384 + c8;
        const bf16x8 kt8 = *(const bf16x8*)(pp + 64), r8 = *(const bf16x8*)(pp + 256), v8 = *(const bf16x8*)(pp + 320);
        float y[8], s1 = 0.f, s3 = 0.f;
#pragma unroll
        for (int e = 0; e < 8; ++e) {
          y[e] = bf2f((u16)y8[e]);
          s1 += y[e];
          s3 += bf2f((u16)r8[e]) * bf2f((u16)kt8[e]) * rho[dir][e];
        }
        s1 = half8_sum(s1);
        s3 = half8_sum(s3);
        const float mu = s1 * (1.f / 64.f);
        float s2 = 0.f;
#pragma unroll
        for (int e = 0; e < 8; ++e) { y[e] -= mu; s2 += y[e] * y[e]; }
        s2 = half8_sum(s2);
        const float rstd = rsqrtf(s2 * (1.f / 64.f) + GN_EPS);
#pragma unroll
        for (int e = 0; e < 8; ++e) tot[e] += y[e] * rstd * lng[e] + lnb[e] + s3 * bf2f((u16)v8[e]);
      }
      const float4 g0 = *(const float4*)(gateL + tok * 256 + ch0), g1 = *(const float4*)(gateL + tok * 256 + ch0 + 4);
      bf16x8 o = cat8(pack4(tot[0] * g0.x, tot[1] * g0.y, tot[2] * g0.z, tot[3] * g0.w),
                      pack4(tot[4] * g1.x, tot[5] * g1.y, tot[6] * g1.z, tot[7] * g1.w));
      *(bf16x8*)(concat + (size_t)row * D + 768 + ch0) = o;
    }
  }
}

constexpr int N_PHASES = 1 + 2 * 16 + 1;
__device__ __forceinline__ void run_phase(const Params& p_in, int ph, unsigned char* smem) {
  Params p = p_in;
  {
    unsigned long long w = (unsigned long long)p.ws;
    asm volatile("" : "+s"(w));
    p.ws = (unsigned char*)w;
  }
  if (ph == 0) { phase_init(p, smem); return; }
  if (ph == N_PHASES - 1) { phase_final_norm(p); return; }
  const int l = (ph - 1) / 16, s = (ph - 1) % 16;
  float* xc = (float*)(p.ws + OFF_XC);
  const float* lat_in = (l == 0 && s < 3) ? p.x : p.out;
  const float* cx_in = (l == 0 && s < 3) ? p.ctx : xc;
  const u16* H = (const u16*)(p.ws + OFF_H);
  const u16* ACT = (const u16*)(p.ws + OFF_P2);
  switch (s) {
    case 0: phase_norm(p, l, 0, lat_in, cx_in); break;
    case 1: phase_ffn_in(p, l, 0, smem); break;
    case 2: phase_resid_gemm(p, l, ACT, (const u16*)(p.ws + OFF_WFFO) + (size_t)0 * 1024 * DFF, DFF, 2, 0.5f, lat_in, cx_in, p.out, xc, smem); break;
    case 3: phase_norm(p, l, 1, p.out, xc); break;
    case 4: phase_inproj(p, l, smem); break;
    case 5: phase_retU(p, smem); break;
    case 6: phase_retscan(p); break;
    case 7: phase_retout(p, l, smem); break;
    case 8: phase_wprep(p, l, smem); break;
    case 9: phase_scan_attn(p, l, smem); break;
    case 10: phase_wfin(p, l, smem); break;
    case 11: phase_resid_gemm(p, l, H, (const u16*)(p.ws + OFF_WOUT), 1024, 5, 1.0f, p.out, xc, p.out, xc, smem); break;
    case 12: phase_norm(p, l, 2, p.out, xc); break;
    case 13: phase_ffn_in(p, l, 1, smem); break;
    case 14: phase_resid_gemm(p, l, ACT, (const u16*)(p.ws + OFF_WFFO) + (size_t)1 * 1024 * DFF, DFF, 8, 0.5f, p.out, xc, p.out, xc, smem); break;
    default: if (l == 0) convert_weights(p, 1, smem); break;
  }
}

#if MULTI_LAUNCH
__global__ void __launch_bounds__(256, 2) k_phase(Params p, int ph) {
  __shared__ __attribute__((aligned(16))) unsigned char smem[49152];
  run_phase(p, ph, smem);
}
#else
constexpr int SMEM_BYTES = 65536;
__global__ void __launch_bounds__(256, 2) k_mega(Params p) {
  __shared__ __attribute__((aligned(16))) unsigned char smem[SMEM_BYTES];
  cg::grid_group grid = cg::this_grid();
  volatile LAS unsigned* st = (volatile LAS unsigned*)(smem + SMEM_BYTES - 16);
  if (threadIdx.x == 0) { st[0] = 0u; st[1] = 0u; }
  __syncthreads();
  {
    unsigned* bw = (unsigned*)(p.ws + OFF_BAR);
    for (int i = blockIdx.x * 256 + threadIdx.x; i < XCD_BAR_WORDS; i += gridDim.x * 256) bw[i] = 0u;
  }
  grid.sync();
  XcdBarrier xb = xcd_barrier_post((unsigned*)(p.ws + OFF_BAR), st);
  run_phase(p, 0, smem);
  xcd_barrier(xb);
#pragma unroll 1
  for (int l = 0; l < 2; ++l) {
#pragma unroll 1
    for (int s = 0; s < 16 - l; ++s) {
      run_phase(p, 1 + l * 16 + s, smem);
      xcd_barrier(xb);
#ifdef PROBE_REPEAT
      if ((PROBE_REPEAT >> s) & 1) {
        run_phase(p, 1 + l * 16 + s, smem);
        xcd_barrier(xb);
      }
#endif
    }
  }
  run_phase(p, N_PHASES - 1, smem);
}
#endif

extern "C" void kernel_launch(void* const* d_in, const int* in_sizes, int n_in, void* d_out, int out_size, void* d_ws,
                              size_t ws_size, hipStream_t stream) {
  Params p{};
  const float** pp = (const float**)&p;
  for (int i = 0; i < 26; ++i) pp[i] = (const float*)d_in[i];
  p.out = (float*)d_out;
  p.ws = (unsigned char*)d_ws;
#if MULTI_LAUNCH
  for (int ph = 0; ph < N_PHASES; ++ph) {
    if (ph > 0 && ((ph - 1) % 16) == 15 && ph != N_PHASES - 1) continue;
    k_phase<<<dim3(512), dim3(256), 0, stream>>>(p, ph);
  }
#else
  static int grid_blocks = 0;
  if (!grid_blocks) {
    int dev = 0, cus = 0, per_cu = 0;
    hipGetDevice(&dev);
    hipDeviceGetAttribute(&cus, hipDeviceAttributeMultiprocessorCount, dev);
    hipOccupancyMaxActiveBlocksPerMultiprocessor(&per_cu, k_mega, 256, 0);
    if (per_cu > 2) per_cu = 2;
    grid_blocks = cus * per_cu;
  }
  void* args[] = {&p};
  hipError_t e = hipLaunchCooperativeKernel((void*)k_mega, dim3(grid_blocks), dim3(256), args, 0, stream);
  if (e != hipSuccess) fprintf(stderr, "cooperative launch failed: %s (grid %d)\n", hipGetErrorString(e), grid_blocks);
#endif
}
```

```cpp
#include <hip/hip_runtime.h>
#include <hip/hip_bf16.h>
#include <hip/hip_cooperative_groups.h>
#include <cstdio>
namespace cg = cooperative_groups;

#ifndef MULTI_LAUNCH
#define MULTI_LAUNCH 0
#endif

typedef unsigned short u16;
using bf16x8 = __attribute__((ext_vector_type(8))) short;
using bf16x4 = __attribute__((ext_vector_type(4))) short;
using f32x4 = __attribute__((ext_vector_type(4))) float;

constexpr int D = 1024;
constexpr int TLAT = 32768;
constexpr int TCTX = 1024;
constexpr int TALL = TLAT + TCTX;
constexpr int SEQ = 8192;
constexpr int CTXL = 256;
constexpr int STOT = SEQ + CTXL;
constexpr int DFF = 2816;
constexpr int PC = 3456;
constexpr int P2C = 1664;
constexpr int NMOD = 9 * D;
constexpr float LOG2E = 1.4426950408889634f;
constexpr float RMS_EPS = 1e-6f;
constexpr float GN_EPS = 64e-5f;

constexpr size_t MiB = 1ull << 20;
constexpr size_t OFF_WFFI = 0;
constexpr size_t OFF_WFFO = 22 * MiB;
constexpr size_t OFF_WIN = 33 * MiB;
constexpr size_t OFF_WOUT = OFF_WIN + 27 * MiB / 4;
constexpr size_t OFF_MOD = OFF_WOUT + 2 * MiB;
constexpr size_t OFF_BAR = OFF_MOD + 384 * 1024;
constexpr size_t OFF_QCTR = OFF_MOD + 400 * 1024;
constexpr size_t OFF_CUTAB = OFF_QCTR + 256;
constexpr size_t OFF_ROPE = OFF_MOD + MiB / 2;
constexpr size_t OFF_XC = OFF_ROPE + 5 * MiB / 2;
constexpr size_t OFF_H = OFF_XC + 4 * MiB;
constexpr size_t OFF_P2 = OFF_H + 66 * MiB;
constexpr size_t OFF_BIG = OFF_P2 + 429 * MiB / 4;
constexpr size_t SZ_Q = (size_t)TALL * 256 * 2;
constexpr size_t SZ_KV2 = (size_t)4 * 2 * STOT * 64 * 2;
constexpr size_t SZ_KV4 = (size_t)4 * 4 * STOT * 64 * 2;
constexpr size_t OFF_QA = OFF_BIG;
constexpr size_t OFF_QB = OFF_QA + SZ_Q;
constexpr size_t OFF_KA = OFF_QB + SZ_Q;
constexpr size_t OFF_VA = OFF_KA + SZ_KV2;
constexpr size_t OFF_KB = OFF_VA + SZ_KV2;
constexpr size_t OFF_VB = OFF_KB + SZ_KV2;
constexpr size_t OFF_R0 = OFF_VB + SZ_KV2;
constexpr size_t OFF_QR = OFF_R0;
constexpr size_t OFF_KR = OFF_QR + SZ_Q;
constexpr size_t OFF_VR = OFF_KR + SZ_KV4;
constexpr size_t OFF_U = OFF_VR + SZ_KV4;
constexpr size_t OFF_SP = OFF_U + (size_t)16 * 66 * 2 * 4096 * 4;
constexpr size_t OFF_PREP = OFF_R0;
constexpr size_t WS_END = OFF_PREP + (size_t)32 * STOT * 384 * 2;
constexpr int YCOL0 = 768, YCOL1 = 1408;
static_assert(WS_END <= 512 * MiB, "workspace overflow");
static_assert(OFF_SP + (size_t)16 * 66 * 2 * 4096 * 2 <= 512 * MiB, "workspace overflow");
static_assert(OFF_P2 + (size_t)TALL * DFF * 2 <= 512 * MiB, "act overflow");

struct Params {
  const float *x, *c, *ctx, *c_ctx, *w_mod, *b_mod, *norm_g, *ffn_w_in, *ffn_w_out, *w_in, *w_out, *attn_sink, *qk_g,
      *ret_g, *mu, *w0, *w2, *a0, *a2, *rho, *k_k, *k_a, *g2, *ln_g, *ln_b, *final_g;
  float* out;
  unsigned char* ws;
};

__device__ __forceinline__ int TIDX() { int t = threadIdx.x; asm volatile("" : "+v"(t)); return t & 255; }
__device__ __forceinline__ int BIDX() { int t = blockIdx.x; asm volatile("" : "+s"(t)); return t; }
typedef float f32x2_t __attribute__((ext_vector_type(2)));
typedef __bf16 bf16x2_t __attribute__((ext_vector_type(2)));
__device__ __forceinline__ unsigned pk2bf(float a, float b) {
  f32x2_t v = {a, b};
  return __builtin_bit_cast(unsigned, __builtin_convertvector(v, bf16x2_t));
}
__device__ __forceinline__ u16 f2bf(float f) { return (u16)(pk2bf(f, 0.f) & 0xffffu); }
__device__ __forceinline__ float bf2f(u16 h) { return __uint_as_float(((unsigned)h) << 16); }
__device__ __forceinline__ float sigmoidf_(float x) { return __builtin_amdgcn_rcpf(1.f + __expf(-x)); }
__device__ __forceinline__ float siluf_(float x) { return x * __builtin_amdgcn_rcpf(1.f + __expf(-x)); }
__device__ __forceinline__ float tanhf_(float x) { return 1.f - 2.f * __builtin_amdgcn_rcpf(__expf(2.f * x) + 1.f); }
template <int CTRL>
__device__ __forceinline__ float dpp_f(float x) {
  return __builtin_bit_cast(float, __builtin_amdgcn_update_dpp(0, __builtin_bit_cast(int, x), CTRL, 0xf, 0xf, true));
}
__device__ __forceinline__ float row16_sum(float x) {
  x += dpp_f<0xB1>(x);
  x += dpp_f<0x4E>(x);
  x += dpp_f<0x141>(x);
  x += dpp_f<0x140>(x);
  return x;
}
__device__ __forceinline__ float wave_sum(float x) {
  x = row16_sum(x);
  x += __builtin_bit_cast(float, __builtin_amdgcn_update_dpp(0, __builtin_bit_cast(int, x), 0x142, 0xa, 0xf, false));
  x += __builtin_bit_cast(float, __builtin_amdgcn_update_dpp(0, __builtin_bit_cast(int, x), 0x143, 0xc, 0xf, false));
  return __builtin_bit_cast(float, __builtin_amdgcn_readlane(__builtin_bit_cast(int, x), 63));
}
__device__ __forceinline__ float half8_sum(float x) {
  x += dpp_f<0xB1>(x);
  x += dpp_f<0x4E>(x);
  x += dpp_f<0x141>(x);
  return x;
}
__device__ __forceinline__ void row16_sum2(float& a, float& b) {
  a += dpp_f<0xB1>(a);  b += dpp_f<0xB1>(b);
  a += dpp_f<0x4E>(a);  b += dpp_f<0x4E>(b);
  a += dpp_f<0x141>(a); b += dpp_f<0x141>(b);
  a += dpp_f<0x140>(a); b += dpp_f<0x140>(b);
}
__device__ __forceinline__ bf16x4 pack4(float a, float b, float c, float d) {
  uint2 u = make_uint2(pk2bf(a, b), pk2bf(c, d));
  return __builtin_bit_cast(bf16x4, u);
}
__device__ __forceinline__ bf16x8 cat8(bf16x4 a, bf16x4 b) {
  bf16x8 r;
  r[0] = a[0]; r[1] = a[1]; r[2] = a[2]; r[3] = a[3]; r[4] = b[0]; r[5] = b[1]; r[6] = b[2]; r[7] = b[3];
  return r;
}
__device__ __forceinline__ const float* rrow(const float* lat, const float* cx, int r) {
  return r < TLAT ? lat + (size_t)r * D : cx + (size_t)(r - TLAT) * D;
}
__device__ __forceinline__ float* wrow(float* lat, float* cx, int r) {
  return r < TLAT ? lat + (size_t)r * D : cx + (size_t)(r - TLAT) * D;
}
__device__ __forceinline__ int mod_index(int r) { return r < TLAT ? (r >> 13) : 4; }
__device__ __forceinline__ void row_bpos(int r, int& b, int& pos) {
  if (r < TLAT) { b = r >> 13; pos = r & 8191; }
  else { int rc = r - TLAT; b = rc >> 8; pos = SEQ + (rc & 255); }
}
__device__ __forceinline__ int bpos_row(int b, int pos) {
  return pos < SEQ ? b * SEQ + pos : TLAT + b * CTXL + (pos - SEQ);
}


#define XB_TMO      128
#define XB_XCNT(j)  (256  + 64 * (j))
#define XB_XSUB(j)  (1280 + 64 * (j))
#define XB_XGEN(j)  (2304 + 64 * (j))
#define XB_TOP      3328
#define XB_TOPGEN   3392
#define XCD_BAR_WORDS 3456
#define XB_SPIN_CAP (1u << 18)
#define LAS __attribute__((address_space(3)))
__device__ __forceinline__ unsigned xb_ld(unsigned* p) { return __hip_atomic_load(p, __ATOMIC_RELAXED, __HIP_MEMORY_SCOPE_AGENT); }
__device__ __forceinline__ unsigned xb_add(unsigned* p, unsigned v) { return __hip_atomic_fetch_add(p, v, __ATOMIC_RELAXED, __HIP_MEMORY_SCOPE_AGENT); }
__device__ __forceinline__ unsigned xb_xcc_id() { return (unsigned)__builtin_amdgcn_s_getreg((3 << 11) | 20) & 0xFu; }
#define XB_SPIN(cond, bar) do { unsigned _sp = 0; while (cond) { __builtin_amdgcn_s_sleep(1); \
    if ((++_sp & 255u) == 0u) { if (xb_ld(&(bar)[XB_TMO])) break; if (_sp > XB_SPIN_CAP) { atomicAdd(&(bar)[XB_TMO], 1u); break; } } } } while (0)
struct XcdBarrier { unsigned* bar; unsigned x; volatile LAS unsigned* st; };
__device__ __forceinline__ XcdBarrier xcd_barrier_post(unsigned* bar, volatile LAS unsigned* st) {
  XcdBarrier b; b.bar = bar; b.x = xb_xcc_id(); b.st = st;
  if (threadIdx.x == 0) (void)xb_add(&bar[XB_XCNT(b.x)], 1u);
  return b;
}
__device__ __forceinline__ void xcd_barrier_complete(unsigned* bar, unsigned x, unsigned& nloc, unsigned& nx) {
  const unsigned G = gridDim.x * gridDim.y * gridDim.z;
  unsigned sum, cnt, mine, sp = 0u;
  for (;;) {
    sum = 0u; cnt = 0u; mine = 0u;
#pragma unroll
    for (unsigned j = 0; j < 16; ++j) { const unsigned c = xb_ld(&bar[XB_XCNT(j)]); sum += c; cnt += (c > 0u) ? 1u : 0u; mine = (j == x) ? c : mine; }
    if (sum == G) break;
    __builtin_amdgcn_s_sleep(1);
    if ((++sp & 255u) == 0u) { if (xb_ld(&bar[XB_TMO])) break; if (sp > XB_SPIN_CAP) { atomicAdd(&bar[XB_TMO], 1u); break; } }
  }
  nloc = mine > 0u ? mine : 1u; nx = cnt > 0u ? cnt : 1u;
}
__device__ __forceinline__ void xcd_barrier(const XcdBarrier& b) {
  asm volatile("s_waitcnt vmcnt(0)" ::: "memory");
  __syncthreads();
  if (threadIdx.x == 0) {
    unsigned* bar = b.bar;
    __builtin_amdgcn_s_waitcnt(0);
    unsigned nloc = b.st[0], nx = b.st[1];
    if (nloc == 0u) { xcd_barrier_complete(bar, b.x, nloc, nx); b.st[0] = nloc; b.st[1] = nx; }
    const unsigned old = xb_add(&bar[XB_XSUB(b.x)], 1u);
    const unsigned gen = old / nloc;
    if (old + 1u == (gen + 1u) * nloc) {
      __builtin_amdgcn_fence(__ATOMIC_RELEASE, "agent");
      asm volatile("s_waitcnt vmcnt(0)" ::: "memory");
      const unsigned og = xb_add(&bar[XB_TOP], 1u);
      const unsigned tg = og / nx;
      if (og + 1u == (tg + 1u) * nx) xb_add(&bar[XB_TOPGEN], 1u);
      else XB_SPIN(xb_ld(&bar[XB_TOPGEN]) == tg, bar);
      __builtin_amdgcn_fence(__ATOMIC_ACQUIRE, "agent");
      xb_add(&bar[XB_XGEN(b.x)], 1u);
      asm volatile("s_waitcnt vmcnt(0)" ::: "memory");
    } else {
      XB_SPIN(xb_ld(&bar[XB_XGEN(b.x)]) == gen, bar);
      __builtin_amdgcn_fence(__ATOMIC_ACQUIRE, "agent");
      asm volatile("s_waitcnt vmcnt(0)" ::: "memory");
    }
  }
  __syncthreads();
}

__device__ __forceinline__ void convert_weights(const Params& p, int layer, unsigned char* smem) {
  const int tid = TIDX();
  const int nb = gridDim.x, bid = BIDX();
  {
    float* tile = (float*)smem;
    constexpr int N_FFI = 2 * 16 * 88, N_FFO = 2 * 44 * 16, N_WIN = 16 * 54, N_WOUT = 16 * 16;
    for (int item = bid; item < N_FFI + N_FFO + N_WIN + N_WOUT; item += nb) {
      const float* src; u16* dst; int K, N, kt, nt; bool perm = false;
      int it = item;
      if (it < N_FFI) {
        int f = it / (16 * 88); it %= (16 * 88);
        K = 1024; N = 5632; kt = it / 88; nt = it % 88; perm = true;
        src = p.ffn_w_in + (size_t)(layer * 2 + f) * 1024 * 5632;
        dst = (u16*)(p.ws + OFF_WFFI) + (size_t)f * 5632 * 1024;
      } else if (it < N_FFI + N_FFO) {
        it -= N_FFI;
        int f = it / (44 * 16); it %= (44 * 16);
        K = 2816; N = 1024; kt = it / 16; nt = it % 16;
        src = p.ffn_w_out + (size_t)(layer * 2 + f) * 2816 * 1024;
        dst = (u16*)(p.ws + OFF_WFFO) + (size_t)f * 1024 * 2816;
      } else if (it < N_FFI + N_FFO + N_WIN) {
        it -= N_FFI + N_FFO;
        K = 1024; N = 3456; kt = it / 54; nt = it % 54;
        src = p.w_in + (size_t)layer * 1024 * 3456;
        dst = (u16*)(p.ws + OFF_WIN);
      } else {
        it -= N_FFI + N_FFO + N_WIN;
        K = 1024; N = 1024; kt = it / 16; nt = it % 16;
        src = p.w_out + (size_t)layer * 1024 * 1024;
        dst = (u16*)(p.ws + OFF_WOUT);
      }
      __syncthreads();
      {
        const int r = tid >> 4, c4 = tid & 15;
        int np = nt * 64 + c4 * 4;
        int scol = np;
        if (perm) {
          int blk = np >> 7, sub = (np & 127) >> 4, i = np & 15;
          scol = ((sub & 1) ? DFF : 0) + blk * 64 + (sub >> 1) * 16 + i;
        }
#pragma unroll
        for (int ps = 0; ps < 4; ++ps) {
          int k = kt * 64 + ps * 16 + r;
          float4 v = *(const float4*)(src + (size_t)k * N + scol);
          float* tp = tile + (ps * 16 + r) * 65 + c4 * 4;
          tp[0] = v.x; tp[1] = v.y; tp[2] = v.z; tp[3] = v.w;
        }
      }
      __syncthreads();
      {
        const int n = tid >> 2, kq = tid & 3;
        bf16x8 o0, o1;
#pragma unroll
        for (int i = 0; i < 8; ++i) {
          o0[i] = (short)f2bf(tile[(kq * 16 + i) * 65 + n]);
          o1[i] = (short)f2bf(tile[(kq * 16 + 8 + i) * 65 + n]);
        }
        u16* dp = dst + (size_t)(nt * 64 + n) * K + kt * 64 + kq * 16;
        *(bf16x8*)dp = o0;
        *(bf16x8*)(dp + 8) = o1;
      }
    }
    __syncthreads();
  }
}

__device__ __forceinline__ void phase_init(const Params& p, unsigned char* smem) {
  const int tid = TIDX();
  const int nb = gridDim.x, bid = BIDX();
  if (bid == 0 && tid < 2) ((int*)(p.ws + OFF_QCTR))[tid] = 0;
  if (tid == 0) {
    const int hw = __builtin_amdgcn_s_getreg((7 << 11) | (8 << 6) | 4);
    const int xcc = __builtin_amdgcn_s_getreg((3 << 11) | 20) & 0xF;
    ((int*)(p.ws + OFF_CUTAB))[bid] = (xcc << 8) | (hw & 0xFF);
  }
  {
    float2* seq = (float2*)(p.ws + OFF_ROPE);
    float2* rowt = seq + 8192 * 32;
    float2* colt = rowt + 128 * 16;
    for (int i = bid * 256 + tid; i < 8192 * 32 + 128 * 16 + 64 * 16; i += nb * 256) {
      float ang;
      float2* dst;
      if (i < 8192 * 32) {
        int t = i >> 5, k = i & 31;
        float inv = 1.0f / powf(10000.0f, (float)(2 * k) / 64.0f);
        ang = (float)t * inv;
        dst = seq + i;
      } else {
        int j = i - 8192 * 32;
        int pidx = (j < 128 * 16) ? (j >> 4) : ((j - 128 * 16) >> 4);
        int k = j & 15;
        float inv = 1.0f / powf(10000.0f, (float)(2 * k) / 32.0f);
        ang = (float)pidx * inv;
        dst = rowt + j;
      }
      *dst = make_float2(cosf(ang), sinf(ang));
    }
    (void)colt;
  }
  {
    float* sc = (float*)smem;
    float* red = sc + 5 * 1024;
    for (int item = bid; item < 288; item += nb) {
      const int l = item / 144, cb = item % 144;
      __syncthreads();
      for (int i = tid; i < 5 * 1024; i += 256) {
        int m = i >> 10, k = i & 1023;
        float v = (m < 4) ? p.c[m * 1024 + k] : p.c_ctx[k];
        sc[i] = siluf_(v);
      }
      __syncthreads();
      const int cq = tid & 15, kg = tid >> 4;
      float acc[5][4];
#pragma unroll
      for (int m = 0; m < 5; ++m)
#pragma unroll
        for (int q = 0; q < 4; ++q) acc[m][q] = 0.f;
      const float* wbase = p.w_mod + (size_t)l * 1024 * NMOD + cb * 64 + cq * 4;
      for (int kk = 0; kk < 64; ++kk) {
        int k = kg * 64 + kk;
        float4 w4 = *(const float4*)(wbase + (size_t)k * NMOD);
#pragma unroll
        for (int m = 0; m < 5; ++m) {
          float s = sc[m * 1024 + k];
          acc[m][0] += s * w4.x; acc[m][1] += s * w4.y; acc[m][2] += s * w4.z; acc[m][3] += s * w4.w;
        }
      }
#pragma unroll
      for (int m = 0; m < 5; ++m)
#pragma unroll
        for (int q = 0; q < 4; ++q) red[(kg * 5 + m) * 64 + cq * 4 + q] = acc[m][q];
      __syncthreads();
      float* modp = (float*)(p.ws + OFF_MOD);
      for (int o = tid; o < 320; o += 256) {
        int m = o >> 6, cc = o & 63;
        float s = 0.f;
        for (int g = 0; g < 16; ++g) s += red[(g * 5 + m) * 64 + cc];
        int col = cb * 64 + cc;
        modp[((size_t)l * 5 + m) * NMOD + col] = s + p.b_mod[(size_t)l * NMOD + col];
      }
    }
    __syncthreads();
  }
  convert_weights(p, 0, smem);
}

__device__ __forceinline__ void phase_norm(const Params& p, int l, int which, const float* lat, const float* cx) {
  const int lane = TIDX() & 63, wid = TIDX() >> 6;
  u16* h = (u16*)(p.ws + OFF_H);
  const float* g = p.norm_g + ((size_t)l * 3 + which) * D;
  const float* modp = (const float*)(p.ws + OFF_MOD) + (size_t)l * 5 * NMOD;
  for (int r = BIDX() * 4 + wid; r < TALL; r += gridDim.x * 4) {
    const float* xr = rrow(lat, cx, r);
    const float* mp = modp + (size_t)mod_index(r) * NMOD + which * 3 * D;
    float4 v[4];
    float ss = 0.f;
#pragma unroll
    for (int i = 0; i < 4; ++i) {
      v[i] = *(const float4*)(xr + i * 256 + lane * 4);
      ss += v[i].x * v[i].x + v[i].y * v[i].y + v[i].z * v[i].z + v[i].w * v[i].w;
    }
    ss = wave_sum(ss);
    float rstd = rsqrtf(ss * (1.f / 1024.f) + RMS_EPS);
#pragma unroll
    for (int i = 0; i < 4; ++i) {
      int col = i * 256 + lane * 4;
      float4 gg = *(const float4*)(g + col);
      float4 sh = *(const float4*)(mp + col);
      float4 scl = *(const float4*)(mp + D + col);
      bf16x4 o = pack4(v[i].x * rstd * gg.x * (1.f + scl.x) + sh.x, v[i].y * rstd * gg.y * (1.f + scl.y) + sh.y,
                       v[i].z * rstd * gg.z * (1.f + scl.z) + sh.z, v[i].w * rstd * gg.w * (1.f + scl.w) + sh.w);
      *(bf16x4*)(h + (size_t)r * D + col) = o;
    }
  }
}

__device__ __forceinline__ void phase_final_norm(const Params& p) {
  const int lane = TIDX() & 63, wid = TIDX() >> 6;
  for (int r = BIDX() * 4 + wid; r < TLAT; r += gridDim.x * 4) {
    float* xr = p.out + (size_t)r * D;
    float4 v[4];
    float ss = 0.f;
#pragma unroll
    for (int i = 0; i < 4; ++i) {
      v[i] = *(const float4*)(xr + i * 256 + lane * 4);
      ss += v[i].x * v[i].x + v[i].y * v[i].y + v[i].z * v[i].z + v[i].w * v[i].w;
    }
    ss = wave_sum(ss);
    float rstd = rsqrtf(ss * (1.f / 1024.f) + RMS_EPS);
#pragma unroll
    for (int i = 0; i < 4; ++i) {
      int col = i * 256 + lane * 4;
      float4 gg = *(const float4*)(p.final_g + col);
      float4 o = make_float4(v[i].x * rstd * gg.x, v[i].y * rstd * gg.y, v[i].z * rstd * gg.z, v[i].w * rstd * gg.w);
      *(float4*)(xr + col) = o;
    }
  }
}

template <int MI>
__device__ __forceinline__ void gemm_mainloop(const u16* __restrict__ A, const u16* __restrict__ Bt, int K, int brow,
                                              int bcol, f32x4 (&acc)[MI][4], unsigned char* smem) {
  const int tid = TIDX(), wid = tid >> 6, lane = tid & 63, wr = wid >> 1, wc = wid & 1, fr = lane & 15, fq = lane >> 4;
  constexpr int BM = MI * 32;
  constexpr int ACH = BM * 4 / 256;
  constexpr int STAGE = BM * 64 + 8192;
#pragma unroll
  for (int m = 0; m < MI; ++m)
#pragma unroll
    for (int n = 0; n < 4; ++n) acc[m][n] = f32x4{0.f, 0.f, 0.f, 0.f};
  const int nk = K / 32;
  const int prow = tid >> 2, pq = ((tid & 3) ^ ((0x78 >> (((tid >> 4) & 3) * 2)) & 3)) * 8;
  const u16* ga = A + (size_t)(brow + prow) * K + pq;
  const u16* gb = Bt + (size_t)(bcol + prow) * K + pq;
  auto stage = [&](int t, int buf) {
    unsigned char* base = smem + buf * STAGE;
#pragma unroll
    for (int i = 0; i < ACH; ++i)
      __builtin_amdgcn_global_load_lds((const unsigned*)(ga + (size_t)i * 64 * K + t * 32),
                                       (__attribute__((address_space(3))) unsigned*)(base + (tid + i * 256) * 16), 16, 0, 0);
#pragma unroll
    for (int i = 0; i < 2; ++i)
      __builtin_amdgcn_global_load_lds((const unsigned*)(gb + (size_t)i * 64 * K + t * 32),
                                       (__attribute__((address_space(3))) unsigned*)(base + BM * 64 + (tid + i * 256) * 16), 16, 0, 0);
  };
  const int swz = (fq ^ ((0x78 >> (((fr >> 2) & 3) * 2)) & 3)) * 16;
  __syncthreads();
  stage(0, 0);
  for (int t = 0; t < nk; ++t) {
    __syncthreads();
    if (t + 1 < nk) stage(t + 1, (t + 1) & 1);
    const unsigned char* base = smem + (t & 1) * STAGE;
    bf16x8 af[MI], bfr[4];
#pragma unroll
    for (int m = 0; m < MI; ++m) af[m] = *(const bf16x8*)(base + (wr * MI * 16 + m * 16 + fr) * 64 + swz);
#pragma unroll
    for (int n = 0; n < 4; ++n) bfr[n] = *(const bf16x8*)(base + BM * 64 + (wc * 64 + n * 16 + fr) * 64 + swz);
#pragma unroll
    for (int m = 0; m < MI; ++m)
#pragma unroll
      for (int n = 0; n < 4; ++n) acc[m][n] = __builtin_amdgcn_mfma_f32_16x16x32_bf16(af[m], bfr[n], acc[m][n], 0, 0, 0);
  }
}

__device__ __forceinline__ bool next_tile(int it, int MT, int NT, int& tm, int& tn) {
  const int G = gridDim.x, b = BIDX();
  const int total = MT * NT;
  int id;
  if ((G & 7) == 0) {
    const int per = G >> 3;
    id = it * G + (b & 7) * per + (b >> 3);
  } else {
    id = b + it * G;
  }
  if (id >= total) return false;
  constexpr int GM = 8;
  const int gsz = GM * NT;
  const int g = id / gsz, rem = id - g * gsz;
  const int rows = (MT - g * GM) < GM ? (MT - g * GM) : GM;
  tn = rem / rows;
  tm = g * GM + (rem - tn * rows);
  return true;
}

template <int MI>
__device__ __forceinline__ void ffn_in_tile(const u16* A, const u16* Bt, u16* act, int brow, int tn, unsigned char* smem) {
  const int tid = TIDX(), wid = tid >> 6, lane = tid & 63, wr = wid >> 1, wc = wid & 1, fr = lane & 15, fq = lane >> 4;
  f32x4 acc[MI][4];
  gemm_mainloop<MI>(A, Bt, 1024, brow, tn * 128, acc, smem);
#pragma unroll
  for (int m = 0; m < MI; ++m)
#pragma unroll
    for (int q = 0; q < 2; ++q)
#pragma unroll
      for (int j = 0; j < 4; ++j) {
        int row = brow + wr * MI * 16 + m * 16 + fq * 4 + j;
        int col = tn * 64 + wc * 32 + q * 16 + fr;
        float u1 = acc[m][2 * q][j], u2 = acc[m][2 * q + 1][j];
        act[(size_t)row * DFF + col] = f2bf(siluf_(u1) * u2);
      }
}
__device__ __forceinline__ void phase_ffn_in(const Params& p, int l, int f, unsigned char* smem) {
  const u16* A = (const u16*)(p.ws + OFF_H);
  const u16* Bt = (const u16*)(p.ws + OFF_WFFI) + (size_t)f * 5632 * 1024;
  u16* act = (u16*)(p.ws + OFF_P2);
  constexpr int NT = 44, MT = TLAT / 256;
  for (int it = 0;; ++it) {
    int tm, tn;
    if (!next_tile(it, MT, NT, tm, tn)) break;
    ffn_in_tile<8>(A, Bt, act, tm * 256, tn, smem);
  }
  if (!(l == 1 && f == 1))
    for (int id = BIDX(); id < 8 * NT; id += gridDim.x) ffn_in_tile<4>(A, Bt, act, TLAT + (id & 7) * 128, id >> 3, smem);
}

__device__ __forceinline__ void phase_resid_gemm(const Params& p, int l, const u16* A, const u16* Bt, int K, int gate, float gscale,
                                 const float* lat_in, const float* cx_in, float* lat_out, float* cx_out,
                                 unsigned char* smem) {
  const int tid = TIDX(), wid = tid >> 6, lane = tid & 63, wr = wid >> 1, wc = wid & 1, fr = lane & 15, fq = lane >> 4;
  constexpr int MI = 6, NT = 8, MT = TALL / (MI * 32);
  const float* modp = (const float*)(p.ws + OFF_MOD) + (size_t)l * 5 * NMOD + gate * D;
  for (int it = 0;; ++it) {
    int tm, tn;
    if (!next_tile(it, MT, NT, tm, tn)) break;
    f32x4 acc[MI][4];
    gemm_mainloop<MI>(A, Bt, K, tm * MI * 32, tn * 128, acc, smem);
    {
      const int rowa = tm * MI * 32 + wr * MI * 16 + fq * 4;
      const int mi0 = mod_index(rowa), mi1 = mod_index(rowa + (MI - 1) * 16 + 3);
      float g0[4], g1[4];
#pragma unroll
      for (int n = 0; n < 4; ++n) {
        const int col = tn * 128 + wc * 64 + n * 16 + fr;
        g0[n] = gscale * modp[(size_t)mi0 * NMOD + col];
        g1[n] = gscale * modp[(size_t)mi1 * NMOD + col];
      }
#pragma unroll
      for (int m = 0; m < MI; ++m) {
        float xv[4][4];
#pragma unroll
        for (int j = 0; j < 4; ++j) {
          const float* xi = rrow(lat_in, cx_in, rowa + m * 16 + j);
#pragma unroll
          for (int n = 0; n < 4; ++n) xv[j][n] = xi[tn * 128 + wc * 64 + n * 16 + fr];
        }
#pragma unroll
        for (int j = 0; j < 4; ++j) {
          const int row = rowa + m * 16 + j;
          const bool first = mod_index(row) == mi0;
          float* xo = wrow(lat_out, cx_out, row);
#pragma unroll
          for (int n = 0; n < 4; ++n) xo[tn * 128 + wc * 64 + n * 16 + fr] = xv[j][n] + (first ? g0[n] : g1[n]) * acc[m][n][j];
        }
      }
    }
  }
}

__device__ __forceinline__ void phase_inproj(const Params& p, int l, unsigned char* smem) {
  const u16* A = (const u16*)(p.ws + OFF_H);
  const u16* Bt = (const u16*)(p.ws + OFF_WIN);
  const int tid = TIDX(), wid = tid >> 6, lane = tid & 63, wr = wid >> 1, wc = wid & 1, fr = lane & 15, fq = lane >> 4;
  constexpr int MI = 8, NT = 27, MT = TALL / (MI * 32);
  const float2* ropeseq = (const float2*)(p.ws + OFF_ROPE);
  const float2* roperow = ropeseq + 8192 * 32;
  const float2* ropecol = roperow + 128 * 16;
  u16* QA = (u16*)(p.ws + OFF_QA); u16* QB = (u16*)(p.ws + OFF_QB); u16* QR = (u16*)(p.ws + OFF_QR);
  u16* KA = (u16*)(p.ws + OFF_KA); u16* VA = (u16*)(p.ws + OFF_VA);
  u16* KB = (u16*)(p.ws + OFF_KB); u16* VB = (u16*)(p.ws + OFF_VB);
  u16* KR = (u16*)(p.ws + OFF_KR); u16* VR = (u16*)(p.ws + OFF_VR);
  u16* P2 = (u16*)(p.ws + OFF_P2);
  for (int it = 0;; ++it) {
    int tm, tn;
    if (!next_tile(it, MT, NT, tm, tn)) break;
    f32x4 acc[MI][4];
    gemm_mainloop<MI>(A, Bt, 1024, tm * MI * 32, tn * 128, acc, smem);
    const int r0 = tm * MI * 32 + wr * MI * 16;
    const int c0 = tn * 128 + wc * 64;
    const bool latent = r0 < TLAT;
    if (c0 >= 1792) {
#pragma unroll
      for (int m = 0; m < MI; ++m)
#pragma unroll
        for (int n = 0; n < 4; ++n)
#pragma unroll
          for (int j = 0; j < 4; ++j) {
            int row = r0 + m * 16 + fq * 4 + j;
            P2[(size_t)row * P2C + (c0 - 1792) + n * 16 + fr] = f2bf(acc[m][n][j]);
          }
      continue;
    }
    int kind;
    int ropek;
    int normk;
    float scale = 1.f;
    u16* dst; int hh, nh;
    if (c0 < 256) { kind = 0; ropek = 1; normk = -1; scale = 0.125f * LOG2E; dst = QA; hh = c0 >> 6; nh = 4; }
    else if (c0 < 384) { kind = 1; ropek = 1; normk = -1; dst = KA; hh = (c0 - 256) >> 6; nh = 2; }
    else if (c0 < 512) { kind = 2; ropek = 0; normk = -1; dst = VA; hh = (c0 - 384) >> 6; nh = 2; }
    else if (c0 < 768) { kind = 0; ropek = 1; normk = 0; scale = 0.125f * LOG2E; dst = QB; hh = (c0 - 512) >> 6; nh = 4; }
    else if (c0 < 896) { kind = 1; ropek = 1; normk = 1; dst = KB; hh = (c0 - 768) >> 6; nh = 2; }
    else if (c0 < 1024) { kind = 2; ropek = 0; normk = -1; dst = VB; hh = (c0 - 896) >> 6; nh = 2; }
    else if (c0 < 1280) { kind = 0; ropek = 2; normk = -1; dst = QR; hh = (c0 - 1024) >> 6; nh = 4; }
    else if (c0 < 1536) { kind = 1; ropek = 2; normk = -1; scale = 0.125f; dst = KR; hh = (c0 - 1280) >> 6; nh = 4; }
    else { kind = 2; ropek = 0; normk = -1; dst = VR; hh = (c0 - 1536) >> 6; nh = 4; }
    if (!latent) ropek = 0;
    if (kind == 2) {
#pragma unroll
      for (int m = 0; m < MI; ++m) {
        int b, pos;
        row_bpos(r0 + m * 16 + fq * 4, b, pos);
#pragma unroll
        for (int n = 0; n < 4; ++n) {
          int d = n * 16 + fr;
          bf16x4 o = pack4(acc[m][n][0], acc[m][n][1], acc[m][n][2], acc[m][n][3]);
          *(bf16x4*)(dst + ((size_t)(b * nh + hh) * 64 + d) * STOT + pos) = o;
        }
      }
      continue;
    }
    float gq[4] = {1.f, 1.f, 1.f, 1.f};
    if (normk >= 0) {
#pragma unroll
      for (int n = 0; n < 4; ++n) gq[n] = p.qk_g[((size_t)l * 2 + normk) * 64 + n * 16 + fr];
    }
#pragma unroll
    for (int m = 0; m < MI; ++m)
#pragma unroll
      for (int j = 0; j < 4; ++j) {
        int row = r0 + m * 16 + fq * 4 + j;
        float v0 = acc[m][0][j], v1 = acc[m][1][j], v2 = acc[m][2][j], v3 = acc[m][3][j];
        if (normk >= 0) {
          float ss = v0 * v0 + v1 * v1 + v2 * v2 + v3 * v3;
          ss += __shfl_xor(ss, 1); ss += __shfl_xor(ss, 2); ss += __shfl_xor(ss, 4); ss += __shfl_xor(ss, 8);
          float rstd = rsqrtf(ss * (1.f / 64.f) + RMS_EPS);
          v0 *= rstd * gq[0]; v1 *= rstd * gq[1]; v2 *= rstd * gq[2]; v3 *= rstd * gq[3];
        }
        int b, pos;
        row_bpos(row, b, pos);
        if (ropek == 1) {
          float2 cr = roperow[(pos >> 6) * 16 + fr];
          float2 cc = ropecol[(pos & 63) * 16 + fr];
          float o0 = v0 * cr.x - v1 * cr.y, o1 = v1 * cr.x + v0 * cr.y;
          float o2 = v2 * cc.x - v3 * cc.y, o3 = v3 * cc.x + v2 * cc.y;
          v0 = o0; v1 = o1; v2 = o2; v3 = o3;
        } else if (ropek == 2) {
          float2 ca = ropeseq[pos * 32 + fr];
          float2 cb = ropeseq[pos * 32 + 16 + fr];
          float o0 = v0 * ca.x - v2 * ca.y, o2 = v2 * ca.x + v0 * ca.y;
          float o1 = v1 * cb.x - v3 * cb.y, o3 = v3 * cb.x + v1 * cb.y;
          v0 = o0; v1 = o1; v2 = o2; v3 = o3;
        }
        v0 *= scale; v1 *= scale; v2 *= scale; v3 *= scale;
        u16* dp;
        if (kind == 0) dp = dst + (size_t)row * 256 + hh * 64 + fr;
        else dp = dst + ((size_t)(b * nh + hh) * STOT + pos) * 64 + fr;
        dp[0] = f2bf(v0); dp[16] = f2bf(v1); dp[32] = f2bf(v2); dp[48] = f2bf(v3);
      }
  }
}

__device__ __forceinline__ void attn_item(const u16* __restrict__ Q, const u16* __restrict__ Kb, const u16* __restrict__ Vt,
                          u16* __restrict__ concat, int ccol0, int b, int kvh, int qrow0, int qpos0, int t0, int t1,
                          int c0, int c1, bool masked, const float* sink, unsigned char* smem) {
  const int tid = TIDX(), w = tid >> 6, lane = tid & 63, fr = lane & 15, fq = lane >> 4;
  const int head = kvh * 2 + (w & 1);
  const int qoff = (w >> 1) * 32;
  bf16x8 qf[2][2];
#pragma unroll
  for (int qg = 0; qg < 2; ++qg)
#pragma unroll
    for (int ks = 0; ks < 2; ++ks)
      qf[qg][ks] = *(const bf16x8*)(Q + (size_t)(qrow0 + qoff + qg * 16 + fr) * 256 + head * 64 + ks * 32 + fq * 8);
  f32x4 O[2][4];
  float mrow[2], lrow[2];
#pragma unroll
  for (int qg = 0; qg < 2; ++qg) {
    mrow[qg] = -1e30f; lrow[qg] = 0.f;
#pragma unroll
    for (int dt = 0; dt < 4; ++dt) O[qg][dt] = f32x4{0.f, 0.f, 0.f, 0.f};
  }
  const u16* Kbase = Kb + (size_t)(b * 2 + kvh) * STOT * 64;
  const u16* Vbase = Vt + (size_t)(b * 2 + kvh) * 64 * STOT;
  const int n1 = t1 - t0, total = n1 + (c1 - c0);
  bf16x8 kreg[2], vreg[2];
  auto gload = [&](int i) {
    int tile = i < n1 ? t0 + i : c0 + (i - n1);
#pragma unroll
    for (int ps = 0; ps < 2; ++ps) {
      int idx = tid + ps * 256;
      kreg[ps] = *(const bf16x8*)(Kbase + (size_t)tile * 4096 + idx * 8);
      int d = idx >> 3, ch = idx & 7;
      vreg[ps] = *(const bf16x8*)(Vbase + (size_t)d * STOT + tile * 64 + ch * 8);
    }
  };
  auto lstore = [&](int buf) {
    u16* Ks = (u16*)(smem + buf * 18432);
    u16* Vs = Ks + 64 * 72;
#pragma unroll
    for (int ps = 0; ps < 2; ++ps) {
      int idx = tid + ps * 256;
      int r = idx >> 3, ch = idx & 7;
      *(bf16x8*)(Ks + r * 72 + ch * 8) = kreg[ps];
      *(bf16x8*)(Vs + r * 72 + ch * 8) = vreg[ps];
    }
  };
  __syncthreads();
  gload(0);
  lstore(0);
  __syncthreads();
#pragma unroll 1
  for (int i = 0; i < total; ++i) {
    const int tile = i < n1 ? t0 + i : c0 + (i - n1);
    if (i + 1 < total) gload(i + 1);
    const u16* Ks = (const u16*)(smem + (i & 1) * 18432);
    const u16* Vs = Ks + 64 * 72;
    f32x4 s[2][4];
#pragma unroll
    for (int qg = 0; qg < 2; ++qg)
#pragma unroll
      for (int sub = 0; sub < 4; ++sub) s[qg][sub] = f32x4{0.f, 0.f, 0.f, 0.f};
#pragma unroll
    for (int sub = 0; sub < 4; ++sub)
#pragma unroll
      for (int ks = 0; ks < 2; ++ks) {
        bf16x8 a = *(const bf16x8*)(Ks + (sub * 16 + fr) * 72 + ks * 32 + fq * 8);
#pragma unroll
        for (int qg = 0; qg < 2; ++qg) s[qg][sub] = __builtin_amdgcn_mfma_f32_16x16x32_bf16(a, qf[qg][ks], s[qg][sub], 0, 0, 0);
      }
    __builtin_amdgcn_sched_barrier(0);
    const bool domask = masked && (tile < 128);
    bf16x8 pb[2][2];
#pragma unroll
    for (int qg = 0; qg < 2; ++qg) {
      if (domask) {
        int qpos = qpos0 + qoff + qg * 16 + fr;
#pragma unroll
        for (int sub = 0; sub < 4; ++sub)
#pragma unroll
          for (int j = 0; j < 4; ++j) {
            int kpos = tile * 64 + sub * 16 + fq * 4 + j;
            int dd = kpos - qpos;
            if (dd > 128 || dd < -128) s[qg][sub][j] = -INFINITY;
          }
      }
      float mx = -INFINITY;
#pragma unroll
      for (int sub = 0; sub < 4; ++sub)
#pragma unroll
        for (int j = 0; j < 4; ++j) mx = fmaxf(mx, s[qg][sub][j]);
      mx = fmaxf(mx, __shfl_xor(mx, 16));
      mx = fmaxf(mx, __shfl_xor(mx, 32));
      float mnew = fmaxf(mrow[qg], mx);
      const bool changed = mnew > mrow[qg];
      float alpha = __builtin_amdgcn_exp2f(mrow[qg] - mnew);
      mrow[qg] = mnew;
      float ps = 0.f;
#pragma unroll
      for (int sub = 0; sub < 4; ++sub)
#pragma unroll
        for (int j = 0; j < 4; ++j) {
          float pv = __builtin_amdgcn_exp2f(s[qg][sub][j] - mnew);
          s[qg][sub][j] = pv;
          ps += pv;
        }
      lrow[qg] = lrow[qg] * alpha + ps;
      if (__builtin_amdgcn_ballot_w64(changed) != 0ull) {
#pragma unroll
        for (int dt = 0; dt < 4; ++dt) O[qg][dt] *= alpha;
      }
#pragma unroll
      for (int ks = 0; ks < 2; ++ks)
        pb[qg][ks] = cat8(pack4(s[qg][2 * ks][0], s[qg][2 * ks][1], s[qg][2 * ks][2], s[qg][2 * ks][3]),
                          pack4(s[qg][2 * ks + 1][0], s[qg][2 * ks + 1][1], s[qg][2 * ks + 1][2], s[qg][2 * ks + 1][3]));
      __builtin_amdgcn_sched_barrier(0);
    }
#pragma unroll
    for (int dt = 0; dt < 4; ++dt)
#pragma unroll
      for (int ks = 0; ks < 2; ++ks) {
        const u16* vp = Vs + (dt * 16 + fr) * 72 + ks * 32 + fq * 4;
        bf16x8 va = cat8(*(const bf16x4*)vp, *(const bf16x4*)(vp + 16));
#pragma unroll
        for (int qg = 0; qg < 2; ++qg) O[qg][dt] = __builtin_amdgcn_mfma_f32_16x16x32_bf16(va, pb[qg][ks], O[qg][dt], 0, 0, 0);
      }
    __builtin_amdgcn_sched_barrier(0);
    if (i + 1 < total) lstore((i + 1) & 1);
    __syncthreads();
  }
#pragma unroll
  for (int qg = 0; qg < 2; ++qg) {
    float lt = lrow[qg];
    lt += __shfl_xor(lt, 16);
    lt += __shfl_xor(lt, 32);
    if (sink) lt += __builtin_amdgcn_exp2f(sink[head] * LOG2E - mrow[qg]);
    float inv = 1.f / lt;
    int row = qrow0 + qoff + qg * 16 + fr;
#pragma unroll
    for (int dt = 0; dt < 4; ++dt) {
      bf16x4 o = pack4(O[qg][dt][0] * inv, O[qg][dt][1] * inv, O[qg][dt][2] * inv, O[qg][dt][3] * inv);
      *(bf16x4*)(concat + (size_t)row * D + ccol0 + head * 64 + dt * 16 + fq * 4) = o;
    }
  }
}

__device__ __forceinline__ float ret_lg(int h) {
  return log2f(1.0f - exp2f(-5.0f - (float)h));
}

__device__ __forceinline__ void retU_item(const Params& p, int bh, int c, unsigned char* smem) {
  const int tid = TIDX();
  const int b = bh >> 2, h = bh & 3;
  const u16* KR = (const u16*)(p.ws + OFF_KR) + (size_t)bh * STOT * 64;
  const u16* VR = (const u16*)(p.ws + OFF_VR) + (size_t)bh * 64 * STOT;
  (void)b;
  const int pos0 = c < 64 ? c * 128 : SEQ + (c - 64) * 128;
  u16* Kc = (u16*)smem;
  u16* Vj = Kc + 128 * 64;
  __syncthreads();
#pragma unroll
  for (int ps = 0; ps < 4; ++ps) {
    int idx = tid + ps * 256;
    *(bf16x8*)(Kc + idx * 8) = *(const bf16x8*)(KR + (size_t)pos0 * 64 + idx * 8);
    int d = idx >> 4, ch = idx & 15;
    bf16x8 v = *(const bf16x8*)(VR + (size_t)d * STOT + pos0 + ch * 8);
#pragma unroll
    for (int e = 0; e < 8; ++e) Vj[(ch * 8 + e) * 72 + d] = (u16)v[e];
  }
  __syncthreads();
  const int dk = tid >> 2, dv0 = (tid & 3) * 16;
  const float lg = ret_lg(h);
  float af[16], ab[16];
#pragma unroll
  for (int q = 0; q < 16; ++q) { af[q] = 0.f; ab[q] = 0.f; }
  for (int j = 0; j < 128; ++j) {
    float kf = bf2f(Kc[j * 64 + dk]);
    float kfw = kf * exp2f(lg * (float)(127 - j));
    float kbw = kf * exp2f(lg * (float)j);
    bf16x8 v0 = *(const bf16x8*)(Vj + j * 72 + dv0);
    bf16x8 v1 = *(const bf16x8*)(Vj + j * 72 + dv0 + 8);
#pragma unroll
    for (int q = 0; q < 8; ++q) {
      float a = bf2f((u16)v0[q]), bb = bf2f((u16)v1[q]);
      af[q] += kfw * a; ab[q] += kbw * a;
      af[8 + q] += kfw * bb; ab[8 + q] += kbw * bb;
    }
  }
  float* U = (float*)(p.ws + OFF_U) + ((size_t)bh * 66 + c) * 2 * 4096;
#pragma unroll
  for (int q = 0; q < 16; ++q) {
    U[(dv0 + q) * 64 + dk] = af[q];
    U[4096 + (dv0 + q) * 64 + dk] = ab[q];
  }
}

__device__ __forceinline__ void phase_retU(const Params& p, unsigned char* smem) {
  for (int item = BIDX(); item < 16 * 66; item += gridDim.x) retU_item(p, item / 66, item % 66, smem);
}

__device__ __forceinline__ void attn_worker(const Params& p, int l, unsigned char* smem) {
  const u16* QA = (const u16*)(p.ws + OFF_QA); const u16* QB = (const u16*)(p.ws + OFF_QB);
  const u16* KA = (const u16*)(p.ws + OFF_KA); const u16* VA = (const u16*)(p.ws + OFF_VA);
  const u16* KB = (const u16*)(p.ws + OFF_KB); const u16* VB = (const u16*)(p.ws + OFF_VB);
  u16* concat = (u16*)(p.ws + OFF_H);
  const float* sink = p.attn_sink + l * 4;
  int* qctr = (int*)(p.ws + OFF_QCTR) + l;
  volatile int* slot = (volatile int*)(smem + 65536 - 32);
  for (;;) {
    __syncthreads();
    if (TIDX() == 0) *slot = atomicAdd(qctr, 1);
    __syncthreads();
    const int item = *slot;
    if (item >= 2112) break;
    const bool isB = item < 1024 || (item >= 2048 && item < 2080);
    const bool isctx = item >= 2048;
    int ii = item < 1024 ? item : item < 2048 ? item - 1024 : item < 2080 ? item - 2048 : item - 2080;
    int qt, kvh, b, qrow0, qpos0, t0, t1;
    if (!isctx) {
      qt = ii & 127; kvh = (ii >> 7) & 1; b = ii >> 8;
      qrow0 = b * SEQ + qt * 64; qpos0 = qt * 64;
      if (isB) { t0 = 0; t1 = 128; }
      else { t0 = qt - 2 < 0 ? 0 : qt - 2; t1 = qt + 3 > 128 ? 128 : qt + 3; }
    } else {
      qt = ii & 3; kvh = (ii >> 2) & 1; b = ii >> 3;
      qrow0 = TLAT + b * CTXL + qt * 64; qpos0 = 0; t0 = 0; t1 = 0;
    }
    attn_item(isB ? QB : QA, isB ? KB : KA, isB ? VB : VA, concat, isB ? 256 : 0, b, kvh, qrow0, qpos0, t0, t1, 128, 132,
              (!isB) && (!isctx), isB ? nullptr : sink, smem);
  }
}

__device__ __forceinline__ void phase_retscan(const Params& p) {
  const float* U = (const float*)(p.ws + OFF_U);
  u16* SP = (u16*)(p.ws + OFF_SP);
  for (int gid = BIDX() * 256 + TIDX(); gid < 16 * 2 * 4096; gid += gridDim.x * 256) {
    int e = gid & 4095, dir = (gid >> 12) & 1, bh = gid >> 13;
    float g128 = exp2f(128.f * ret_lg(bh & 3));
    float S = 0.f;
#pragma unroll 1
    for (int n0 = 0; n0 < 66; n0 += 11) {
      float u[11];
      size_t offs[11];
#pragma unroll
      for (int k = 0; k < 11; ++k) {
        int n = n0 + k;
        int c = dir == 0 ? (n < 2 ? 64 + n : n - 2) : 65 - n;
        offs[k] = (((size_t)bh * 66 + c) * 2 + dir) * 4096 + e;
        u[k] = U[offs[k]];
      }
#pragma unroll
      for (int k = 0; k < 11; ++k) {
        SP[offs[k]] = f2bf(S);
        S = g128 * S + u[k];
      }
    }
  }
}

__device__ __forceinline__ void retout_item(const Params& p, int l, int bh, int c, unsigned char* smem) {
  const int tid = TIDX(), w = tid >> 6, lane = tid & 63, fr = lane & 15, fq = lane >> 4;
  const int b = bh >> 2, h = bh & 3;
  const u16* QR = (const u16*)(p.ws + OFF_QR);
  const u16* KR = (const u16*)(p.ws + OFF_KR) + (size_t)bh * STOT * 64;
  const u16* VR = (const u16*)(p.ws + OFF_VR) + (size_t)bh * 64 * STOT;
  const u16* SP = (const u16*)(p.ws + OFF_SP) + ((size_t)bh * 66 + c) * 2 * 4096;
  const u16* P2 = (const u16*)(p.ws + OFF_P2);
  u16* concat = (u16*)(p.ws + OFF_H);
  const int pos0 = c < 64 ? c * 128 : SEQ + (c - 64) * 128;
  const int row0 = bpos_row(b, pos0);
  u16* Kc = (u16*)smem;
  u16* Vs = Kc + 128 * 72;
  __syncthreads();
#pragma unroll
  for (int ps = 0; ps < 4; ++ps) {
    int idx = tid + ps * 256;
    int r = idx >> 3, ch = idx & 7;
    *(bf16x8*)(Kc + r * 72 + ch * 8) = *(const bf16x8*)(KR + (size_t)(pos0 + r) * 64 + ch * 8);
    int d = idx >> 4, c16 = idx & 15;
    *(bf16x8*)(Vs + d * 136 + c16 * 8) = *(const bf16x8*)(VR + (size_t)d * STOT + pos0 + c16 * 8);
  }
  __syncthreads();
  const float lg = ret_lg(h);
#pragma unroll 1
  for (int qg = 0; qg < 2; ++qg) {
    const int i = w * 32 + qg * 16 + fr;
    const int row = row0 + i;
    bf16x8 qf[2];
#pragma unroll
    for (int ks = 0; ks < 2; ++ks) qf[ks] = *(const bf16x8*)(QR + (size_t)row * 256 + h * 64 + ks * 32 + fq * 8);
    f32x4 s[8];
#pragma unroll
    for (int sub = 0; sub < 8; ++sub) {
      s[sub] = f32x4{0.f, 0.f, 0.f, 0.f};
#pragma unroll
      for (int ks = 0; ks < 2; ++ks) {
        bf16x8 a = *(const bf16x8*)(Kc + (sub * 16 + fr) * 72 + ks * 32 + fq * 8);
        s[sub] = __builtin_amdgcn_mfma_f32_16x16x32_bf16(a, qf[ks], s[sub], 0, 0, 0);
      }
    }
    float res[4][4];
#pragma unroll
    for (int dt = 0; dt < 4; ++dt)
#pragma unroll
      for (int j = 0; j < 4; ++j) res[dt][j] = 0.f;
#pragma unroll 1
    for (int dir = 0; dir < 2; ++dir) {
      f32x4 O[4];
      const float qw = dir == 0 ? __builtin_amdgcn_exp2f(lg * (float)(i + 1)) : __builtin_amdgcn_exp2f(lg * (float)(128 - i));
#pragma unroll
      for (int dt = 0; dt < 4; ++dt) {
        O[dt] = f32x4{0.f, 0.f, 0.f, 0.f};
#pragma unroll
        for (int ks = 0; ks < 2; ++ks) {
          bf16x8 a = *(const bf16x8*)(SP + dir * 4096 + (dt * 16 + fr) * 64 + ks * 32 + fq * 8);
          O[dt] = __builtin_amdgcn_mfma_f32_16x16x32_bf16(a, qf[ks], O[dt], 0, 0, 0);
        }
        O[dt] *= qw;
      }
      int fqo = fq;
      asm volatile("" : "+v"(fqo));
#pragma unroll
      for (int ks = 0; ks < 4; ++ks) {
        float pv[8];
#pragma unroll
        for (int e = 0; e < 8; ++e) {
          const int sub = 2 * ks + (e >> 2), j = e & 3;
          const int jk = sub * 16 + fqo * 4 + j;
          const int dd = dir == 0 ? i - jk : jk - i;
          pv[e] = dd >= 0 ? s[sub][j] * __builtin_amdgcn_exp2f(lg * (float)dd) : 0.f;
        }
        bf16x8 pb = cat8(pack4(pv[0], pv[1], pv[2], pv[3]), pack4(pv[4], pv[5], pv[6], pv[7]));
#pragma unroll
        for (int dt = 0; dt < 4; ++dt) {
          const u16* vp = Vs + (dt * 16 + fr) * 136 + ks * 32 + fq * 4;
          bf16x8 va = cat8(*(const bf16x4*)vp, *(const bf16x4*)(vp + 16));
          O[dt] = __builtin_amdgcn_mfma_f32_16x16x32_bf16(va, pb, O[dt], 0, 0, 0);
        }
      }
      float sm = 0.f;
#pragma unroll
      for (int dt = 0; dt < 4; ++dt)
#pragma unroll
        for (int j = 0; j < 4; ++j) sm += O[dt][j];
      sm += __shfl_xor(sm, 16); sm += __shfl_xor(sm, 32);
      const float mu = sm * (1.f / 64.f);
      float vs = 0.f;
#pragma unroll
      for (int dt = 0; dt < 4; ++dt)
#pragma unroll
        for (int j = 0; j < 4; ++j) { float dlt = O[dt][j] - mu; vs += dlt * dlt; }
      vs += __shfl_xor(vs, 16); vs += __shfl_xor(vs, 32);
      const float rstd = rsqrtf(vs * (1.f / 64.f) + GN_EPS);
#pragma unroll
      for (int dt = 0; dt < 4; ++dt) {
        const int d = dt * 16 + fq * 4;
        bf16x4 gt = *(const bf16x4*)(P2 + (size_t)row * P2C + dir * 256 + h * 64 + d);
        float4 rg = *(const float4*)(p.ret_g + (size_t)l * 256 + h * 64 + d);
        res[dt][0] += (O[dt][0] - mu) * rstd * rg.x * siluf_(bf2f((u16)gt[0]));
        res[dt][1] += (O[dt][1] - mu) * rstd * rg.y * siluf_(bf2f((u16)gt[1]));
        res[dt][2] += (O[dt][2] - mu) * rstd * rg.z * siluf_(bf2f((u16)gt[2]));
        res[dt][3] += (O[dt][3] - mu) * rstd * rg.w * siluf_(bf2f((u16)gt[3]));
      }
    }
#pragma unroll
    for (int dt = 0; dt < 4; ++dt)
      *(bf16x4*)(concat + (size_t)row * D + 512 + h * 64 + dt * 16 + fq * 4) = pack4(res[dt][0], res[dt][1], res[dt][2], res[dt][3]);
  }
}

__device__ __forceinline__ void phase_retout(const Params& p, int l, unsigned char* smem) {
  for (int item = BIDX(); item < 16 * 66; item += gridDim.x) retout_item(p, l, item / 66, item % 66, smem);
}

__device__ __forceinline__ void phase_wprep(const Params& p, int l, unsigned char* smem) {
  const int tid = TIDX(), col = tid;
  const u16* P2 = (const u16*)(p.ws + OFF_P2);
  u16* prep = (u16*)(p.ws + OFF_PREP);
  float* twT = (float*)smem;
  float* amT = twT + 64 * 16;
  float* outW = amT + 64 * 16;
  float* outA = outW + 16 * 256;
  const int j = tid & 31, tsub = tid >> 5, head = j >> 3, c8 = (j & 7) * 8, ch0 = head * 64 + c8;
  float kkv[8], kav[8];
#pragma unroll
  for (int e = 0; e < 8; ++e) { kkv[e] = p.k_k[(size_t)l * 256 + ch0 + e]; kav[e] = p.k_a[(size_t)l * 256 + ch0 + e]; }
  for (int item = BIDX(); item < (TALL / 16) * 2; item += gridDim.x) {
    const int dir = item & 1, row0 = (item >> 1) * 16;
    const float* mu = p.mu + ((size_t)l * 2 + dir) * 896;
    __syncthreads();
    {
      const int tok = tid >> 4, e0 = (tid & 15) * 4;
      const int row = row0 + tok;
      int b, pos;
      row_bpos(row, b, pos);
      bool has;
      int nrow;
      if (dir == 0) { has = (pos != 0) && (pos != SEQ); nrow = row - 1; }
      else { has = (pos != SEQ - 1) && (pos != STOT - 1); nrow = row + 1; }
      const int srow = has ? nrow : row;
      bf16x4 zw = *(const bf16x4*)(P2 + (size_t)row * P2C + 1408 + dir * 64 + e0);
      bf16x4 za = *(const bf16x4*)(P2 + (size_t)row * P2C + 1536 + dir * 64 + e0);
      bf16x4 sw = *(const bf16x4*)(P2 + (size_t)srow * P2C + 1408 + dir * 64 + e0);
      bf16x4 sa = *(const bf16x4*)(P2 + (size_t)srow * P2C + 1536 + dir * 64 + e0);
#pragma unroll
      for (int e = 0; e < 4; ++e) {
        float z = bf2f((u16)zw[e]), zs = has ? bf2f((u16)sw[e]) : 0.f;
        twT[(e0 + e) * 16 + tok] = tanhf_(z + mu[768 + e0 + e] * (zs - z));
        float z2 = bf2f((u16)za[e]), zs2 = has ? bf2f((u16)sa[e]) : 0.f;
        amT[(e0 + e) * 16 + tok] = z2 + mu[832 + e0 + e] * (zs2 - z2);
      }
    }
    __syncthreads();
    {
      const float* w2 = p.w2 + ((size_t)l * 2 + dir) * 64 * 256 + col;
      const float* a2 = p.a2 + ((size_t)l * 2 + dir) * 64 * 256 + col;
      const float w0v = p.w0[((size_t)l * 2 + dir) * 256 + col], a0v = p.a0[((size_t)l * 2 + dir) * 256 + col];
#pragma unroll 1
      for (int pass = 0; pass < 2; ++pass) {
        const float* wcol = pass == 0 ? w2 : a2;
        const float* xT = pass == 0 ? twT : amT;
        float acc[16];
#pragma unroll
        for (int t = 0; t < 16; ++t) acc[t] = 0.f;
#pragma unroll 1
        for (int k0 = 0; k0 < 64; k0 += 16) {
          float wv[16];
#pragma unroll
          for (int u = 0; u < 16; ++u) wv[u] = wcol[(k0 + u) * 256];
#pragma unroll
          for (int u = 0; u < 16; ++u) {
            const int kq = k0 + u;
#pragma unroll
            for (int t4 = 0; t4 < 4; ++t4) {
              float4 a = *(const float4*)(xT + kq * 16 + t4 * 4);
              acc[t4 * 4 + 0] += a.x * wv[u]; acc[t4 * 4 + 1] += a.y * wv[u]; acc[t4 * 4 + 2] += a.z * wv[u]; acc[t4 * 4 + 3] += a.w * wv[u];
            }
          }
        }
        if (pass == 0) {
#pragma unroll
          for (int t = 0; t < 16; ++t) outW[t * 256 + col] = -0.6065306597126334f * sigmoidf_(w0v + acc[t]) * LOG2E;
        } else {
#pragma unroll
          for (int t = 0; t < 16; ++t) outA[t * 256 + col] = sigmoidf_(a0v + acc[t]);
        }
      }
    }
    __syncthreads();
    {
      float mur[8], muk[8], muv[8];
#pragma unroll
      for (int e = 0; e < 8; ++e) { mur[e] = mu[ch0 + e]; muk[e] = mu[256 + ch0 + e]; muv[e] = mu[512 + ch0 + e]; }
#pragma unroll
      for (int pass = 0; pass < 2; ++pass) {
        const int tok = pass * 8 + tsub, row = row0 + tok;
        int b, pos;
        row_bpos(row, b, pos);
        bool has;
        int nrow;
        if (dir == 0) { has = (pos != 0) && (pos != SEQ); nrow = row - 1; }
        else { has = (pos != SEQ - 1) && (pos != STOT - 1); nrow = row + 1; }
        const u16* cp = P2 + (size_t)row * P2C + 512 + ch0;
        const u16* np = P2 + (size_t)(has ? nrow : row) * P2C + 512 + ch0;
        const bf16x8 zr8 = *(const bf16x8*)cp, zk8 = *(const bf16x8*)(cp + 256), zv8 = *(const bf16x8*)(cp + 512);
        const bf16x8 sr8 = *(const bf16x8*)np, sk8 = *(const bf16x8*)(np + 256), sv8 = *(const bf16x8*)(np + 512);
        const float4 lw0 = *(const float4*)(outW + tok * 256 + ch0), lw1 = *(const float4*)(outW + tok * 256 + ch0 + 4);
        const float4 av0 = *(const float4*)(outA + tok * 256 + ch0), av1 = *(const float4*)(outA + tok * 256 + ch0 + 4);
        const float lw[8] = {lw0.x, lw0.y, lw0.z, lw0.w, lw1.x, lw1.y, lw1.z, lw1.w};
        const float av[8] = {av0.x, av0.y, av0.z, av0.w, av1.x, av1.y, av1.z, av1.w};
        float r[8], k[8], v[8], kkr[8], ss = 0.f;
#pragma unroll
        for (int e = 0; e < 8; ++e) {
          float zr = bf2f((u16)zr8[e]), zk = bf2f((u16)zk8[e]), zv = bf2f((u16)zv8[e]);
          float sr = has ? bf2f((u16)sr8[e]) : 0.f, sk = has ? bf2f((u16)sk8[e]) : 0.f, sv = has ? bf2f((u16)sv8[e]) : 0.f;
          r[e] = zr + mur[e] * (sr - zr); k[e] = zk + muk[e] * (sk - zk); v[e] = zv + muv[e] * (sv - zv);
          kkr[e] = k[e] * kkv[e];
          ss += kkr[e] * kkr[e];
        }
        ss = half8_sum(ss);
        const float rs = rsqrtf(fmaxf(ss, 1e-24f));
        float kt[8], kk[8], bb[8];
#pragma unroll
        for (int e = 0; e < 8; ++e) {
          kk[e] = kkr[e] * rs;
          kt[e] = k[e] * (1.f + (av[e] - 1.f) * kav[e]);
          bb[e] = kk[e] * av[e];
        }
        u16* dp = prep + (((size_t)(b * 4 + head) * 2 + dir) * STOT + pos) * 384 + c8;
        *(bf16x8*)(dp) = cat8(pack4(lw[0], lw[1], lw[2], lw[3]), pack4(lw[4], lw[5], lw[6], lw[7]));
        *(bf16x8*)(dp + 64) = cat8(pack4(kt[0], kt[1], kt[2], kt[3]), pack4(kt[4], kt[5], kt[6], kt[7]));
        *(bf16x8*)(dp + 128) = cat8(pack4(kk[0], kk[1], kk[2], kk[3]), pack4(kk[4], kk[5], kk[6], kk[7]));
        *(bf16x8*)(dp + 192) = cat8(pack4(bb[0], bb[1], bb[2], bb[3]), pack4(bb[4], bb[5], bb[6], bb[7]));
        *(bf16x8*)(dp + 256) = cat8(pack4(r[0], r[1], r[2], r[3]), pack4(r[4], r[5], r[6], r[7]));
        *(bf16x8*)(dp + 320) = cat8(pack4(v[0], v[1], v[2], v[3]), pack4(v[4], v[5], v[6], v[7]));
      }
    }
  }
}

typedef float f32x2 __attribute__((ext_vector_type(2)));
__device__ __forceinline__ void wscan_item(const Params& p, int item, unsigned char* smem) {
  const int tid = TIDX(), w = tid >> 6, lane = tid & 63;
  const int jl4 = (lane & 15) * 4, rsub = lane >> 4;
  const u16* prep = (const u16*)(p.ws + OFF_PREP);
  u16* P2w = (u16*)(p.ws + OFF_P2);
  float* bufs = (float*)smem;
  {
    const int rq = item & 3, seq = item >> 2;
    const int dir = seq & 1, h = (seq >> 1) & 3, b = seq >> 3;
    const int irow = rq * 16 + w * 4 + rsub;
    const u16* base = prep + (size_t)seq * STOT * 384;
    uint4 lreg[3];
    auto gload = [&](int ch) {
#pragma unroll
      for (int ps = 0; ps < 3; ++ps) {
        int q = tid + ps * 256;
        int sidx = q / 48, within = q % 48;
        int n = ch * 16 + sidx;
        int pos = dir == 0 ? (n < CTXL ? SEQ + n : n - CTXL) : (STOT - 1 - n);
        lreg[ps] = *(const uint4*)(base + (size_t)pos * 384 + within * 8);
      }
    };
    auto lstore = [&](int buf) {
#pragma unroll
      for (int ps = 0; ps < 3; ++ps) {
        int q = tid + ps * 256;
        int sidx = q / 48, within = q % 48;
        float* dp = bufs + buf * 6144 + sidx * 384 + within * 8;
        uint4 u = lreg[ps];
        float4 lo = make_float4(__uint_as_float(u.x << 16), __uint_as_float(u.x & 0xffff0000u), __uint_as_float(u.y << 16), __uint_as_float(u.y & 0xffff0000u));
        float4 hi = make_float4(__uint_as_float(u.z << 16), __uint_as_float(u.z & 0xffff0000u), __uint_as_float(u.w << 16), __uint_as_float(u.w & 0xffff0000u));
        if (within < 8) {
          lo.x = __builtin_amdgcn_exp2f(lo.x); lo.y = __builtin_amdgcn_exp2f(lo.y); lo.z = __builtin_amdgcn_exp2f(lo.z); lo.w = __builtin_amdgcn_exp2f(lo.w);
          hi.x = __builtin_amdgcn_exp2f(hi.x); hi.y = __builtin_amdgcn_exp2f(hi.y); hi.z = __builtin_amdgcn_exp2f(hi.z); hi.w = __builtin_amdgcn_exp2f(hi.w);
        }
        *(float4*)dp = lo;
        *(float4*)(dp + 4) = hi;
      }
    };
    f32x2 S01 = {0.f, 0.f}, S23 = {0.f, 0.f};
    __syncthreads();
    gload(0);
    lstore(0);
    __syncthreads();
    constexpr int NCH = STOT / 16;
    for (int ch = 0; ch < NCH; ++ch) {
      if (ch + 1 < NCH) gload(ch + 1);
      const float* bp = bufs + (ch & 1) * 6144;
      const int n0 = ch * 16;
      const int pos0 = dir == 0 ? (n0 < CTXL ? SEQ + n0 : n0 - CTXL) : (STOT - 1 - n0);
      u16* yp = P2w + (size_t)bpos_row(b, pos0) * P2C + (dir == 0 ? YCOL0 : YCOL1) + h * 64 + irow;
      const int ystride = dir == 0 ? P2C : -P2C;
      float4 Wq[3], Kq[3], Nq[3], Bq[3], Rq[3];
      float Vq[3];
#define SCAN_LD(slot, st)                                        \
      do {                                                         \
        const float* sp_ = bp + (st) * 384;                        \
        Wq[slot] = *(const float4*)(sp_ + jl4);                    \
        Kq[slot] = *(const float4*)(sp_ + 64 + jl4);               \
        Nq[slot] = *(const float4*)(sp_ + 128 + jl4);              \
        Bq[slot] = *(const float4*)(sp_ + 192 + jl4);              \
        Rq[slot] = *(const float4*)(sp_ + 256 + jl4);              \
        Vq[slot] = sp_[320 + irow];                                \
      } while (0)
      SCAN_LD(0, 0);
      SCAN_LD(1, 1);
      SCAN_LD(2, 2);
      float ypart = 0.f;
#pragma unroll
      for (int s = 0; s < 16; ++s) {
        const int sl = s % 3;
        const float4 wv = Wq[sl], kt = Kq[sl], kk = Nq[sl], bb = Bq[sl], rr = Rq[sl];
        const float v = Vq[sl];
        if (s + 3 < 16) SCAN_LD(sl, s + 3);
        const f32x2 vv = {v, v};
        f32x2 A01 = S01 * f32x2{wv.x, wv.y} + vv * f32x2{kt.x, kt.y};
        f32x2 A23 = S23 * f32x2{wv.z, wv.w} + vv * f32x2{kt.z, kt.w};
        f32x2 pp = S01 * f32x2{kk.x, kk.y} + S23 * f32x2{kk.z, kk.w};
        float sa = pp.x + pp.y;
        float yprev = ypart;
        row16_sum2(sa, yprev);
        if (s > 0) { if ((lane & 15) == 0) yp[(s - 1) * ystride] = f2bf(yprev); }
        const f32x2 nsa = {-sa, -sa};
        S01 = nsa * f32x2{bb.x, bb.y} + A01;
        S23 = nsa * f32x2{bb.z, bb.w} + A23;
        f32x2 yy = S01 * f32x2{rr.x, rr.y} + S23 * f32x2{rr.z, rr.w};
        ypart = yy.x + yy.y;
      }
      {
        float ylast = row16_sum(ypart);
        if ((lane & 15) == 0) yp[15 * ystride] = f2bf(ylast);
      }
#undef SCAN_LD
      if (ch + 1 < NCH) lstore((ch + 1) & 1);
      __syncthreads();
    }
  }
}

__device__ __forceinline__ void phase_scan_attn(const Params& p, int l, unsigned char* smem) {
  const int G = gridDim.x, tid = TIDX(), bid = BIDX();
  if (G > 128 && G <= 2048) {
    int* keys = (int*)smem;
    int* red = keys + 2048;
    const int* cutab = (const int*)(p.ws + OFF_CUTAB);
    __syncthreads();
    for (int i = tid; i < G; i += 256) keys[i] = cutab[i];
    if (tid == 0) { red[0] = 0; red[1] = 0; }
    __syncthreads();
    for (int i = 128 + tid; i < G; i += 256) {
      const int ki = keys[i];
      bool m = false;
      for (int j = 0; j < 128; ++j) m = m || (keys[j] == ki);
      if (!m) atomicAdd(&red[0], 1);
      if (m && i == bid) red[1] = 1;
    }
    __syncthreads();
    const int eligible = red[0], mine = red[1];
    __syncthreads();
    if (bid < 128) {
      __builtin_amdgcn_s_setprio(3);
      wscan_item(p, bid, smem);
      __builtin_amdgcn_s_setprio(0);
    } else if (eligible < 64 || !mine) {
      attn_worker(p, l, smem);
    }
  } else {
    for (int item = bid; item < 128; item += G) wscan_item(p, item, smem);
    attn_worker(p, l, smem);
  }
}

__device__ __forceinline__ void phase_wfin(const Params& p, int l, unsigned char* smem) {
  const int tid = TIDX(), col = tid;
  const u16* P2 = (const u16*)(p.ws + OFF_P2);
  const u16* prep = (const u16*)(p.ws + OFF_PREP);
  u16* concat = (u16*)(p.ws + OFF_H);
  float* sgT = (float*)smem;
  float* gateL = sgT + 128 * 16;
  const float* g2 = p.g2 + (size_t)l * 128 * 256 + col;
  const int j = tid & 31, tsub = tid >> 5, head = j >> 3, c8 = (j & 7) * 8, ch0 = head * 64 + c8;
  float lng[8], lnb[8], rho[2][8];
#pragma unroll
  for (int e = 0; e < 8; ++e) {
    lng[e] = p.ln_g[(size_t)l * 256 + ch0 + e];
    lnb[e] = p.ln_b[(size_t)l * 256 + ch0 + e];
    rho[0][e] = p.rho[((size_t)l * 2 + 0) * 256 + ch0 + e];
    rho[1][e] = p.rho[((size_t)l * 2 + 1) * 256 + ch0 + e];
  }
  for (int item = BIDX(); item < TALL / 16; item += gridDim.x) {
    const int row0 = item * 16;
    __syncthreads();
    {
      const int tok = tid >> 4, k0 = (tid & 15) * 8;
      bf16x8 g = *(const bf16x8*)(P2 + (size_t)(row0 + tok) * P2C + 1280 + k0);
#pragma unroll
      for (int e = 0; e < 8; ++e) sgT[(k0 + e) * 16 + tok] = sigmoidf_(bf2f((u16)g[e]));
    }
    __syncthreads();
    float acc[16];
#pragma unroll
    for (int t = 0; t < 16; ++t) acc[t] = 0.f;
#pragma unroll 1
    for (int k0 = 0; k0 < 128; k0 += 16) {
      float gv8[16];
#pragma unroll
      for (int u = 0; u < 16; ++u) gv8[u] = g2[(k0 + u) * 256];
#pragma unroll
      for (int u = 0; u < 16; ++u) {
        const int k = k0 + u;
        const float gv = gv8[u];
#pragma unroll
        for (int t4 = 0; t4 < 4; ++t4) {
          float4 a = *(const float4*)(sgT + k * 16 + t4 * 4);
          acc[t4 * 4 + 0] += a.x * gv; acc[t4 * 4 + 1] += a.y * gv; acc[t4 * 4 + 2] += a.z * gv; acc[t4 * 4 + 3] += a.w * gv;
        }
      }
    }
#pragma unroll
    for (int t = 0; t < 16; ++t) gateL[t * 256 + col] = acc[t];
    __syncthreads();
#pragma unroll
    for (int pass = 0; pass < 2; ++pass) {
      const int tok = pass * 8 + tsub, row = row0 + tok;
      int b, pos;
      row_bpos(row, b, pos);
      float tot[8];
#pragma unroll
      for (int e = 0; e < 8; ++e) tot[e] = 0.f;
#pragma unroll
      for (int dir = 0; dir < 2; ++dir) {
        const bf16x8 y8 = *(const bf16x8*)(P2 + (size_t)row * P2C + (dir == 0 ? YCOL0 : YCOL1) + ch0);
        const u16* pp = prep + (((size_t)(b * 4 + head) * 2 + dir) * STOT + pos) * 384 + c8;
        const bf16x8 kt8 = *(const bf16x8*)(pp + 64), r8 = *(const bf16x8*)(pp + 256), v8 = *(const bf16x8*)(pp + 320);
        float y[8], s1 = 0.f, s3 = 0.f;
#pragma unroll
        for (int e = 0; e < 8; ++e) {
          y[e] = bf2f((u16)y8[e]);
          s1 += y[e];
          s3 += bf2f((u16)r8[e]) * bf2f((u16)kt8[e]) * rho[dir][e];
        }
        s1 = half8_sum(s1);
        s3 = half8_sum(s3);
        const float mu = s1 * (1.f / 64.f);
        float s2 = 0.f;
#pragma unroll
        for (int e = 0; e < 8; ++e) { y[e] -= mu; s2 += y[e] * y[e]; }
        s2 = half8_sum(s2);
        const float rstd = rsqrtf(s2 * (1.f / 64.f) + GN_EPS);
#pragma unroll
        for (int e = 0; e < 8; ++e) tot[e] += y[e] * rstd * lng[e] + lnb[e] + s3 * bf2f((u16)v8[e]);
      }
      const float4 g0 = *(const float4*)(gateL + tok * 256 + ch0), g1 = *(const float4*)(gateL + tok * 256 + ch0 + 4);
      bf16x8 o = cat8(pack4(tot[0] * g0.x, tot[1] * g0.y, tot[2] * g0.z, tot[3] * g0.w),
                      pack4(tot[4] * g1.x, tot[5] * g1.y, tot[6] * g1.z, tot[7] * g1.w));
      *(bf16x8*)(concat + (size_t)row * D + 768 + ch0) = o;
    }
  }
}

constexpr int N_PHASES = 1 + 2 * 16 + 1;
__device__ __forceinline__ void run_phase(const Params& p_in, int ph, unsigned char* smem) {
  Params p = p_in;
  {
    unsigned long long w = (unsigned long long)p.ws;
    asm volatile("" : "+s"(w));
    p.ws = (unsigned char*)w;
  }
  if (ph == 0) { phase_init(p, smem); return; }
  if (ph == N_PHASES - 1) { phase_final_norm(p); return; }
  const int l = (ph - 1) / 16, s = (ph - 1) % 16;
  float* xc = (float*)(p.ws + OFF_XC);
  const float* lat_in = (l == 0 && s < 3) ? p.x : p.out;
  const float* cx_in = (l == 0 && s < 3) ? p.ctx : xc;
  const u16* H = (const u16*)(p.ws + OFF_H);
  const u16* ACT = (const u16*)(p.ws + OFF_P2);
  switch (s) {
    case 0: phase_norm(p, l, 0, lat_in, cx_in); break;
    case 1: phase_ffn_in(p, l, 0, smem); break;
    case 2: phase_resid_gemm(p, l, ACT, (const u16*)(p.ws + OFF_WFFO) + (size_t)0 * 1024 * DFF, DFF, 2, 0.5f, lat_in, cx_in, p.out, xc, smem); break;
    case 3: phase_norm(p, l, 1, p.out, xc); break;
    case 4: phase_inproj(p, l, smem); break;
    case 5: phase_retU(p, smem); break;
    case 6: phase_retscan(p); break;
    case 7: phase_retout(p, l, smem); break;
    case 8: phase_wprep(p, l, smem); break;
    case 9: phase_scan_attn(p, l, smem); break;
    case 10: phase_wfin(p, l, smem); break;
    case 11: phase_resid_gemm(p, l, H, (const u16*)(p.ws + OFF_WOUT), 1024, 5, 1.0f, p.out, xc, p.out, xc, smem); break;
    case 12: phase_norm(p, l, 2, p.out, xc); break;
    case 13: phase_ffn_in(p, l, 1, smem); break;
    case 14: phase_resid_gemm(p, l, ACT, (const u16*)(p.ws + OFF_WFFO) + (size_t)1 * 1024 * DFF, DFF, 8, 0.5f, p.out, xc, p.out, xc, smem); break;
    default: if (l == 0) convert_weights(p, 1, smem); break;
  }
}

#if MULTI_LAUNCH
__global__ void __launch_bounds__(256, 2) k_phase(Params p, int ph) {
  __shared__ __attribute__((aligned(16))) unsigned char smem[49152];
  run_phase(p, ph, smem);
}
#else
constexpr int SMEM_BYTES = 65536;
__global__ void __launch_bounds__(256, 2) k_mega(Params p) {
  __shared__ __attribute__((aligned(16))) unsigned char smem[SMEM_BYTES];
  cg::grid_group grid = cg::this_grid();
  volatile LAS unsigned* st = (volatile LAS unsigned*)(smem + SMEM_BYTES - 16);
  if (threadIdx.x == 0) { st[0] = 0u; st[1] = 0u; }
  __syncthreads();
  {
    unsigned* bw = (unsigned*)(p.ws + OFF_BAR);
    for (int i = blockIdx.x * 256 + threadIdx.x; i < XCD_BAR_WORDS; i += gridDim.x * 256) bw[i] = 0u;
  }
  grid.sync();
  XcdBarrier xb = xcd_barrier_post((unsigned*)(p.ws + OFF_BAR), st);
  run_phase(p, 0, smem);
  xcd_barrier(xb);
#pragma unroll 1
  for (int l = 0; l < 2; ++l) {
#pragma unroll 1
    for (int s = 0; s < 16 - l; ++s) {
      run_phase(p, 1 + l * 16 + s, smem);
      xcd_barrier(xb);
#ifdef PROBE_REPEAT
      if ((PROBE_REPEAT >> s) & 1) {
        run_phase(p, 1 + l * 16 + s, smem);
        xcd_barrier(xb);
      }
#endif
    }
  }
  run_phase(p, N_PHASES - 1, smem);
}
#endif

extern "C" void kernel_launch(void* const* d_in, const int* in_sizes, int n_in, void* d_out, int out_size, void* d_ws,
                              size_t ws_size, hipStream_t stream) {
  Params p{};
  const float** pp = (const float**)&p;
  for (int i = 0; i < 26; ++i) pp[i] = (const float*)d_in[i];
  p.out = (float*)d_out;
  p.ws = (unsigned char*)d_ws;
#if MULTI_LAUNCH
  for (int ph = 0; ph < N_PHASES; ++ph) {
    if (ph > 0 && ((ph - 1) % 16) == 15 && ph != N_PHASES - 1) continue;
    k_phase<<<dim3(512), dim3(256), 0, stream>>>(p, ph);
  }
#else
  static int grid_blocks = 0;
  if (!grid_blocks) {
    int dev = 0, cus = 0, per_cu = 0;
    hipGetDevice(&dev);
    hipDeviceGetAttribute(&cus, hipDeviceAttributeMultiprocessorCount, dev);
    hipOccupancyMaxActiveBlocksPerMultiprocessor(&per_cu, k_mega, 256, 0);
    if (per_cu > 2) per_cu = 2;
    grid_blocks = cus * per_cu;
  }
  void* args[] = {&p};
  hipError_t e = hipLaunchCooperativeKernel((void*)k_mega, dim3(grid_blocks), dim3(256), args, 0, stream);
  if (e != hipSuccess) fprintf(stderr, "cooperative launch failed: %s (grid %d)\n", hipGetErrorString(e), grid_blocks);
#endif
}
```

```cpp
#include <hip/hip_runtime.h>
#include <hip/hip_bf16.h>
#include <hip/hip_cooperative_groups.h>
#include <cstdio>
namespace cg = cooperative_groups;

#ifndef MULTI_LAUNCH
#define MULTI_LAUNCH 0
#endif

typedef unsigned short u16;
using bf16x8 = __attribute__((ext_vector_type(8))) short;
using bf16x4 = __attribute__((ext_vector_type(4))) short;
using f32x4 = __attribute__((ext_vector_type(4))) float;

constexpr int D = 1024;
constexpr int TLAT = 32768;
constexpr int TCTX = 1024;
constexpr int TALL = TLAT + TCTX;
constexpr int SEQ = 8192;
constexpr int CTXL = 256;
constexpr int STOT = SEQ + CTXL;
constexpr int DFF = 2816;
constexpr int PC = 3456;
constexpr int P2C = 1664;
constexpr int NMOD = 9 * D;
constexpr float LOG2E = 1.4426950408889634f;
constexpr float RMS_EPS = 1e-6f;
constexpr float GN_EPS = 64e-5f;

constexpr size_t MiB = 1ull << 20;
constexpr size_t OFF_WFFI = 0;
constexpr size_t OFF_WFFO = 22 * MiB;
constexpr size_t OFF_WIN = 33 * MiB;
constexpr size_t OFF_WOUT = OFF_WIN + 27 * MiB / 4;
constexpr size_t OFF_MOD = OFF_WOUT + 2 * MiB;
constexpr size_t OFF_BAR = OFF_MOD + 384 * 1024;
constexpr size_t OFF_QCTR = OFF_MOD + 400 * 1024;
constexpr size_t OFF_CUTAB = OFF_QCTR + 256;
constexpr size_t OFF_ROPE = OFF_MOD + MiB / 2;
constexpr size_t OFF_XC = OFF_ROPE + 5 * MiB / 2;
constexpr size_t OFF_H = OFF_XC + 4 * MiB;
constexpr size_t OFF_P2 = OFF_H + 66 * MiB;
constexpr size_t OFF_BIG = OFF_P2 + 429 * MiB / 4;
constexpr size_t SZ_Q = (size_t)TALL * 256 * 2;
constexpr size_t SZ_KV2 = (size_t)4 * 2 * STOT * 64 * 2;
constexpr size_t SZ_KV4 = (size_t)4 * 4 * STOT * 64 * 2;
constexpr size_t OFF_QA = OFF_BIG;
constexpr size_t OFF_QB = OFF_QA + SZ_Q;
constexpr size_t OFF_KA = OFF_QB + SZ_Q;
constexpr size_t OFF_VA = OFF_KA + SZ_KV2;
constexpr size_t OFF_KB = OFF_VA + SZ_KV2;
constexpr size_t OFF_VB = OFF_KB + SZ_KV2;
constexpr size_t OFF_R0 = OFF_VB + SZ_KV2;
constexpr size_t OFF_QR = OFF_R0;
constexpr size_t OFF_KR = OFF_QR + SZ_Q;
constexpr size_t OFF_VR = OFF_KR + SZ_KV4;
constexpr size_t OFF_U = OFF_VR + SZ_KV4;
constexpr size_t OFF_SP = OFF_U + (size_t)16 * 66 * 2 * 4096 * 4;
constexpr size_t OFF_PREP = OFF_R0;
constexpr size_t WS_END = OFF_PREP + (size_t)32 * STOT * 384 * 2;
constexpr int YCOL0 = 768, YCOL1 = 1408;
static_assert(WS_END <= 512 * MiB, "workspace overflow");
static_assert(OFF_SP + (size_t)16 * 66 * 2 * 4096 * 2 <= 512 * MiB, "workspace overflow");
static_assert(OFF_P2 + (size_t)TALL * DFF * 2 <= 512 * MiB, "act overflow");

struct Params {
  const float *x, *c, *ctx, *c_ctx, *w_mod, *b_mod, *norm_g, *ffn_w_in, *ffn_w_out, *w_in, *w_out, *attn_sink, *qk_g,
      *ret_g, *mu, *w0, *w2, *a0, *a2, *rho, *k_k, *k_a, *g2, *ln_g, *ln_b, *final_g;
  float* out;
  unsigned char* ws;
};

__device__ __forceinline__ int TIDX() { int t = threadIdx.x; asm volatile("" : "+v"(t)); return t & 255; }
__device__ __forceinline__ int BIDX() { int t = blockIdx.x; asm volatile("" : "+s"(t)); return t; }
typedef float f32x2_t __attribute__((ext_vector_type(2)));
typedef __bf16 bf16x2_t __attribute__((ext_vector_type(2)));
__device__ __forceinline__ unsigned pk2bf(float a, float b) {
  f32x2_t v = {a, b};
  return __builtin_bit_cast(unsigned, __builtin_convertvector(v, bf16x2_t));
}
__device__ __forceinline__ u16 f2bf(float f) { return (u16)(pk2bf(f, 0.f) & 0xffffu); }
__device__ __forceinline__ float bf2f(u16 h) { return __uint_as_float(((unsigned)h) << 16); }
__device__ __forceinline__ float sigmoidf_(float x) { return __builtin_amdgcn_rcpf(1.f + __expf(-x)); }
__device__ __forceinline__ float siluf_(float x) { return x * __builtin_amdgcn_rcpf(1.f + __expf(-x)); }
__device__ __forceinline__ float tanhf_(float x) { return 1.f - 2.f * __builtin_amdgcn_rcpf(__expf(2.f * x) + 1.f); }
template <int CTRL>
__device__ __forceinline__ float dpp_f(float x) {
  return __builtin_bit_cast(float, __builtin_amdgcn_update_dpp(0, __builtin_bit_cast(int, x), CTRL, 0xf, 0xf, true));
}
__device__ __forceinline__ float row16_sum(float x) {
  x += dpp_f<0xB1>(x);
  x += dpp_f<0x4E>(x);
  x += dpp_f<0x141>(x);
  x += dpp_f<0x140>(x);
  return x;
}
__device__ __forceinline__ float wave_sum(float x) {
  x = row16_sum(x);
  x += __builtin_bit_cast(float, __builtin_amdgcn_update_dpp(0, __builtin_bit_cast(int, x), 0x142, 0xa, 0xf, false));
  x += __builtin_bit_cast(float, __builtin_amdgcn_update_dpp(0, __builtin_bit_cast(int, x), 0x143, 0xc, 0xf, false));
  return __builtin_bit_cast(float, __builtin_amdgcn_readlane(__builtin_bit_cast(int, x), 63));
}
__device__ __forceinline__ float half8_sum(float x) {
  x += dpp_f<0xB1>(x);
  x += dpp_f<0x4E>(x);
  x += dpp_f<0x141>(x);
  return x;
}
__device__ __forceinline__ void row16_sum2(float& a, float& b) {
  a += dpp_f<0xB1>(a);  b += dpp_f<0xB1>(b);
  a += dpp_f<0x4E>(a);  b += dpp_f<0x4E>(b);
  a += dpp_f<0x141>(a); b += dpp_f<0x141>(b);
  a += dpp_f<0x140>(a); b += dpp_f<0x140>(b);
}
__device__ __forceinline__ bf16x4 pack4(float a, float b, float c, float d) {
  uint2 u = make_uint2(pk2bf(a, b), pk2bf(c, d));
  return __builtin_bit_cast(bf16x4, u);
}
__device__ __forceinline__ bf16x8 cat8(bf16x4 a, bf16x4 b) {
  bf16x8 r;
  r[0] = a[0]; r[1] = a[1]; r[2] = a[2]; r[3] = a[3]; r[4] = b[0]; r[5] = b[1]; r[6] = b[2]; r[7] = b[3];
  return r;
}
__device__ __forceinline__ const float* rrow(const float* lat, const float* cx, int r) {
  return r < TLAT ? lat + (size_t)r * D : cx + (size_t)(r - TLAT) * D;
}
__device__ __forceinline__ float* wrow(float* lat, float* cx, int r) {
  return r < TLAT ? lat + (size_t)r * D : cx + (size_t)(r - TLAT) * D;
}
__device__ __forceinline__ int mod_index(int r) { return r < TLAT ? (r >> 13) : 4; }
__device__ __forceinline__ void row_bpos(int r, int& b, int& pos) {
  if (r < TLAT) { b = r >> 13; pos = r & 8191; }
  else { int rc = r - TLAT; b = rc >> 8; pos = SEQ + (rc & 255); }
}
__device__ __forceinline__ int bpos_row(int b, int pos) {
  return pos < SEQ ? b * SEQ + pos : TLAT + b * CTXL + (pos - SEQ);
}


#define XB_TMO      128
#define XB_XCNT(j)  (256  + 64 * (j))
#define XB_XSUB(j)  (1280 + 64 * (j))
#define XB_XGEN(j)  (2304 + 64 * (j))
#define XB_TOP      3328
#define XB_TOPGEN   3392
#define XCD_BAR_WORDS 3456
#define XB_SPIN_CAP (1u << 18)
#define LAS __attribute__((address_space(3)))
__device__ __forceinline__ unsigned xb_ld(unsigned* p) { return __hip_atomic_load(p, __ATOMIC_RELAXED, __HIP_MEMORY_SCOPE_AGENT); }
__device__ __forceinline__ unsigned xb_add(unsigned* p, unsigned v) { return __hip_atomic_fetch_add(p, v, __ATOMIC_RELAXED, __HIP_MEMORY_SCOPE_AGENT); }
__device__ __forceinline__ unsigned xb_xcc_id() { return (unsigned)__builtin_amdgcn_s_getreg((3 << 11) | 20) & 0xFu; }
#define XB_SPIN(cond, bar) do { unsigned _sp = 0; while (cond) { __builtin_amdgcn_s_sleep(1); \
    if ((++_sp & 255u) == 0u) { if (xb_ld(&(bar)[XB_TMO])) break; if (_sp > XB_SPIN_CAP) { atomicAdd(&(bar)[XB_TMO], 1u); break; } } } } while (0)
struct XcdBarrier { unsigned* bar; unsigned x; volatile LAS unsigned* st; };
__device__ __forceinline__ XcdBarrier xcd_barrier_post(unsigned* bar, volatile LAS unsigned* st) {
  XcdBarrier b; b.bar = bar; b.x = xb_xcc_id(); b.st = st;
  if (threadIdx.x == 0) (void)xb_add(&bar[XB_XCNT(b.x)], 1u);
  return b;
}
__device__ __forceinline__ void xcd_barrier_complete(unsigned* bar, unsigned x, unsigned& nloc, unsigned& nx) {
  const unsigned G = gridDim.x * gridDim.y * gridDim.z;
  unsigned sum, cnt, mine, sp = 0u;
  for (;;) {
    sum = 0u; cnt = 0u; mine = 0u;
#pragma unroll
    for (unsigned j = 0; j < 16; ++j) { const unsigned c = xb_ld(&bar[XB_XCNT(j)]); sum += c; cnt += (c > 0u) ? 1u : 0u; mine = (j == x) ? c : mine; }
    if (sum == G) break;
    __builtin_amdgcn_s_sleep(1);
    if ((++sp & 255u) == 0u) { if (xb_ld(&bar[XB_TMO])) break; if (sp > XB_SPIN_CAP) { atomicAdd(&bar[XB_TMO], 1u); break; } }
  }
  nloc = mine > 0u ? mine : 1u; nx = cnt > 0u ? cnt : 1u;
}
__device__ __forceinline__ void xcd_barrier(const XcdBarrier& b) {
  asm volatile("s_waitcnt vmcnt(0)" ::: "memory");
  __syncthreads();
  if (threadIdx.x == 0) {
    unsigned* bar = b.bar;
    __builtin_amdgcn_s_waitcnt(0);
    unsigned nloc = b.st[0], nx = b.st[1];
    if (nloc == 0u) { xcd_barrier_complete(bar, b.x, nloc, nx); b.st[0] = nloc; b.st[1] = nx; }
    const unsigned old = xb_add(&bar[XB_XSUB(b.x)], 1u);
    const unsigned gen = old / nloc;
    if (old + 1u == (gen + 1u) * nloc) {
      __builtin_amdgcn_fence(__ATOMIC_RELEASE, "agent");
      asm volatile("s_waitcnt vmcnt(0)" ::: "memory");
      const unsigned og = xb_add(&bar[XB_TOP], 1u);
      const unsigned tg = og / nx;
      if (og + 1u == (tg + 1u) * nx) xb_add(&bar[XB_TOPGEN], 1u);
      else XB_SPIN(xb_ld(&bar[XB_TOPGEN]) == tg, bar);
      __builtin_amdgcn_fence(__ATOMIC_ACQUIRE, "agent");
      xb_add(&bar[XB_XGEN(b.x)], 1u);
      asm volatile("s_waitcnt vmcnt(0)" ::: "memory");
    } else {
      XB_SPIN(xb_ld(&bar[XB_XGEN(b.x)]) == gen, bar);
      __builtin_amdgcn_fence(__ATOMIC_ACQUIRE, "agent");
      asm volatile("s_waitcnt vmcnt(0)" ::: "memory");
    }
  }
  __syncthreads();
}

__device__ __forceinline__ void convert_weights(const Params& p, int layer, unsigned char* smem) {
  const int tid = TIDX();
  const int nb = gridDim.x, bid = BIDX();
  {
    float* tile = (float*)smem;
    constexpr int N_FFI = 2 * 16 * 88, N_FFO = 2 * 44 * 16, N_WIN = 16 * 54, N_WOUT = 16 * 16;
    for (int item = bid; item < N_FFI + N_FFO + N_WIN + N_WOUT; item += nb) {
      const float* src; u16* dst; int K, N, kt, nt; bool perm = false;
      int it = item;
      if (it < N_FFI) {
        int f = it / (16 * 88); it %= (16 * 88);
        K = 1024; N = 5632; kt = it / 88; nt = it % 88; perm = true;
        src = p.ffn_w_in + (size_t)(layer * 2 + f) * 1024 * 5632;
        dst = (u16*)(p.ws + OFF_WFFI) + (size_t)f * 5632 * 1024;
      } else if (it < N_FFI + N_FFO) {
        it -= N_FFI;
        int f = it / (44 * 16); it %= (44 * 16);
        K = 2816; N = 1024; kt = it / 16; nt = it % 16;
        src = p.ffn_w_out + (size_t)(layer * 2 + f) * 2816 * 1024;
        dst = (u16*)(p.ws + OFF_WFFO) + (size_t)f * 1024 * 2816;
      } else if (it < N_FFI + N_FFO + N_WIN) {
        it -= N_FFI + N_FFO;
        K = 1024; N = 3456; kt = it / 54; nt = it % 54;
        src = p.w_in + (size_t)layer * 1024 * 3456;
        dst = (u16*)(p.ws + OFF_WIN);
      } else {
        it -= N_FFI + N_FFO + N_WIN;
        K = 1024; N = 1024; kt = it / 16; nt = it % 16;
        src = p.w_out + (size_t)layer * 1024 * 1024;
        dst = (u16*)(p.ws + OFF_WOUT);
      }
      __syncthreads();
      {
        const int r = tid >> 4, c4 = tid & 15;
        int np = nt * 64 + c4 * 4;
        int scol = np;
        if (perm) {
          int blk = np >> 7, sub = (np & 127) >> 4, i = np & 15;
          scol = ((sub & 1) ? DFF : 0) + blk * 64 + (sub >> 1) * 16 + i;
        }
#pragma unroll
        for (int ps = 0; ps < 4; ++ps) {
          int k = kt * 64 + ps * 16 + r;
          float4 v = *(const float4*)(src + (size_t)k * N + scol);
          float* tp = tile + (ps * 16 + r) * 65 + c4 * 4;
          tp[0] = v.x; tp[1] = v.y; tp[2] = v.z; tp[3] = v.w;
        }
      }
      __syncthreads();
      {
        const int n = tid >> 2, kq = tid & 3;
        bf16x8 o0, o1;
#pragma unroll
        for (int i = 0; i < 8; ++i) {
          o0[i] = (short)f2bf(tile[(kq * 16 + i) * 65 + n]);
          o1[i] = (short)f2bf(tile[(kq * 16 + 8 + i) * 65 + n]);
        }
        u16* dp = dst + (size_t)(nt * 64 + n) * K + kt * 64 + kq * 16;
        *(bf16x8*)dp = o0;
        *(bf16x8*)(dp + 8) = o1;
      }
    }
    __syncthreads();
  }
}

__device__ __forceinline__ void phase_init(const Params& p, unsigned char* smem) {
  const int tid = TIDX();
  const int nb = gridDim.x, bid = BIDX();
  if (bid == 0 && tid < 2) ((int*)(p.ws + OFF_QCTR))[tid] = 0;
  if (tid == 0) {
    const int hw = __builtin_amdgcn_s_getreg((7 << 11) | (8 << 6) | 4);
    const int xcc = __builtin_amdgcn_s_getreg((3 << 11) | 20) & 0xF;
    ((int*)(p.ws + OFF_CUTAB))[bid] = (xcc << 8) | (hw & 0xFF);
  }
  {
    float2* seq = (float2*)(p.ws + OFF_ROPE);
    float2* rowt = seq + 8192 * 32;
    float2* colt = rowt + 128 * 16;
    for (int i = bid * 256 + tid; i < 8192 * 32 + 128 * 16 + 64 * 16; i += nb * 256) {
      float ang;
      float2* dst;
      if (i < 8192 * 32) {
        int t = i >> 5, k = i & 31;
        float inv = 1.0f / powf(10000.0f, (float)(2 * k) / 64.0f);
        ang = (float)t * inv;
        dst = seq + i;
      } else {
        int j = i - 8192 * 32;
        int pidx = (j < 128 * 16) ? (j >> 4) : ((j - 128 * 16) >> 4);
        int k = j & 15;
        float inv = 1.0f / powf(10000.0f, (float)(2 * k) / 32.0f);
        ang = (float)pidx * inv;
        dst = rowt + j;
      }
      *dst = make_float2(cosf(ang), sinf(ang));
    }
    (void)colt;
  }
  {
    float* sc = (float*)smem;
    float* red = sc + 5 * 1024;
    for (int item = bid; item < 288; item += nb) {
      const int l = item / 144, cb = item % 144;
      __syncthreads();
      for (int i = tid; i < 5 * 1024; i += 256) {
        int m = i >> 10, k = i & 1023;
        float v = (m < 4) ? p.c[m * 1024 + k] : p.c_ctx[k];
        sc[i] = siluf_(v);
      }
      __syncthreads();
      const int cq = tid & 15, kg = tid >> 4;
      float acc[5][4];
#pragma unroll
      for (int m = 0; m < 5; ++m)
#pragma unroll
        for (int q = 0; q < 4; ++q) acc[m][q] = 0.f;
      const float* wbase = p.w_mod + (size_t)l * 1024 * NMOD + cb * 64 + cq * 4;
      for (int kk = 0; kk < 64; ++kk) {
        int k = kg * 64 + kk;
        float4 w4 = *(const float4*)(wbase + (size_t)k * NMOD);
#pragma unroll
        for (int m = 0; m < 5; ++m) {
          float s = sc[m * 1024 + k];
          acc[m][0] += s * w4.x; acc[m][1] += s * w4.y; acc[m][2] += s * w4.z; acc[m][3] += s * w4.w;
        }
      }
#pragma unroll
      for (int m = 0; m < 5; ++m)
#pragma unroll
        for (int q = 0; q < 4; ++q) red[(kg * 5 + m) * 64 + cq * 4 + q] = acc[m][q];
      __syncthreads();
      float* modp = (float*)(p.ws + OFF_MOD);
      for (int o = tid; o < 320; o += 256) {
        int m = o >> 6, cc = o & 63;
        float s = 0.f;
        for (int g = 0; g < 16; ++g) s += red[(g * 5 + m) * 64 + cc];
        int col = cb * 64 + cc;
        modp[((size_t)l * 5 + m) * NMOD + col] = s + p.b_mod[(size_t)l * NMOD + col];
      }
    }
    __syncthreads();
  }
  convert_weights(p, 0, smem);
}

__device__ __forceinline__ void phase_norm(const Params& p, int l, int which, const float* lat, const float* cx) {
  const int lane = TIDX() & 63, wid = TIDX() >> 6;
  u16* h = (u16*)(p.ws + OFF_H);
  const float* g = p.norm_g + ((size_t)l * 3 + which) * D;
  const float* modp = (const float*)(p.ws + OFF_MOD) + (size_t)l * 5 * NMOD;
  const int nrows = (l == 1 && which == 2) ? TLAT : TALL;
  for (int r = BIDX() * 4 + wid; r < nrows; r += gridDim.x * 4) {
    const float* xr = rrow(lat, cx, r);
    const float* mp = modp + (size_t)mod_index(r) * NMOD + which * 3 * D;
    float4 v[4];
    float ss = 0.f;
#pragma unroll
    for (int i = 0; i < 4; ++i) {
      v[i] = *(const float4*)(xr + i * 256 + lane * 4);
      ss += v[i].x * v[i].x + v[i].y * v[i].y + v[i].z * v[i].z + v[i].w * v[i].w;
    }
    ss = wave_sum(ss);
    float rstd = rsqrtf(ss * (1.f / 1024.f) + RMS_EPS);
#pragma unroll
    for (int i = 0; i < 4; ++i) {
      int col = i * 256 + lane * 4;
      float4 gg = *(const float4*)(g + col);
      float4 sh = *(const float4*)(mp + col);
      float4 scl = *(const float4*)(mp + D + col);
      bf16x4 o = pack4(v[i].x * rstd * gg.x * (1.f + scl.x) + sh.x, v[i].y * rstd * gg.y * (1.f + scl.y) + sh.y,
                       v[i].z * rstd * gg.z * (1.f + scl.z) + sh.z, v[i].w * rstd * gg.w * (1.f + scl.w) + sh.w);
      *(bf16x4*)(h + (size_t)r * D + col) = o;
    }
  }
}

__device__ __forceinline__ void phase_final_norm(const Params& p) {
  const int lane = TIDX() & 63, wid = TIDX() >> 6;
  for (int r = BIDX() * 4 + wid; r < TLAT; r += gridDim.x * 4) {
    float* xr = p.out + (size_t)r * D;
    float4 v[4];
    float ss = 0.f;
#pragma unroll
    for (int i = 0; i < 4; ++i) {
      v[i] = *(const float4*)(xr + i * 256 + lane * 4);
      ss += v[i].x * v[i].x + v[i].y * v[i].y + v[i].z * v[i].z + v[i].w * v[i].w;
    }
    ss = wave_sum(ss);
    float rstd = rsqrtf(ss * (1.f / 1024.f) + RMS_EPS);
#pragma unroll
    for (int i = 0; i < 4; ++i) {
      int col = i * 256 + lane * 4;
      float4 gg = *(const float4*)(p.final_g + col);
      float4 o = make_float4(v[i].x * rstd * gg.x, v[i].y * rstd * gg.y, v[i].z * rstd * gg.z, v[i].w * rstd * gg.w);
      *(float4*)(xr + col) = o;
    }
  }
}

template <int MI>
__device__ __forceinline__ void gemm_mainloop(const u16* __restrict__ A, const u16* __restrict__ Bt, int K, int brow,
                                              int bcol, f32x4 (&acc)[MI][4], unsigned char* smem) {
  const int tid = TIDX(), wid = tid >> 6, lane = tid & 63, wr = wid >> 1, wc = wid & 1, fr = lane & 15, fq = lane >> 4;
  constexpr int BM = MI * 32;
  constexpr int ACH = BM * 4 / 256;
  constexpr int STAGE = BM * 64 + 8192;
#pragma unroll
  for (int m = 0; m < MI; ++m)
#pragma unroll
    for (int n = 0; n < 4; ++n) acc[m][n] = f32x4{0.f, 0.f, 0.f, 0.f};
  const int nk = K / 32;
  const int prow = tid >> 2, pq = ((tid & 3) ^ ((0x78 >> (((tid >> 4) & 3) * 2)) & 3)) * 8;
  const u16* ga = A + (size_t)(brow + prow) * K + pq;
  const u16* gb = Bt + (size_t)(bcol + prow) * K + pq;
  auto stage = [&](int t, int buf) {
    unsigned char* base = smem + buf * STAGE;
#pragma unroll
    for (int i = 0; i < ACH; ++i)
      __builtin_amdgcn_global_load_lds((const unsigned*)(ga + (size_t)i * 64 * K + t * 32),
                                       (__attribute__((address_space(3))) unsigned*)(base + (tid + i * 256) * 16), 16, 0, 0);
#pragma unroll
    for (int i = 0; i < 2; ++i)
      __builtin_amdgcn_global_load_lds((const unsigned*)(gb + (size_t)i * 64 * K + t * 32),
                                       (__attribute__((address_space(3))) unsigned*)(base + BM * 64 + (tid + i * 256) * 16), 16, 0, 0);
  };
  const int swz = (fq ^ ((0x78 >> (((fr >> 2) & 3) * 2)) & 3)) * 16;
  __syncthreads();
  stage(0, 0);
  for (int t = 0; t < nk; ++t) {
    __syncthreads();
    if (t + 1 < nk) stage(t + 1, (t + 1) & 1);
    const unsigned char* base = smem + (t & 1) * STAGE;
    bf16x8 af[MI], bfr[4];
#pragma unroll
    for (int m = 0; m < MI; ++m) af[m] = *(const bf16x8*)(base + (wr * MI * 16 + m * 16 + fr) * 64 + swz);
#pragma unroll
    for (int n = 0; n < 4; ++n) bfr[n] = *(const bf16x8*)(base + BM * 64 + (wc * 64 + n * 16 + fr) * 64 + swz);
#pragma unroll
    for (int m = 0; m < MI; ++m)
#pragma unroll
      for (int n = 0; n < 4; ++n) acc[m][n] = __builtin_amdgcn_mfma_f32_16x16x32_bf16(af[m], bfr[n], acc[m][n], 0, 0, 0);
  }
}

__device__ __forceinline__ bool next_tile(int it, int MT, int NT, int& tm, int& tn) {
  const int G = gridDim.x, b = BIDX();
  const int total = MT * NT;
  int id;
  if ((G & 7) == 0) {
    const int per = G >> 3;
    id = it * G + (b & 7) * per + (b >> 3);
  } else {
    id = b + it * G;
  }
  if (id >= total) return false;
  constexpr int GM = 8;
  const int gsz = GM * NT;
  const int g = id / gsz, rem = id - g * gsz;
  const int rows = (MT - g * GM) < GM ? (MT - g * GM) : GM;
  tn = rem / rows;
  tm = g * GM + (rem - tn * rows);
  return true;
}

template <int MI>
__device__ __forceinline__ void ffn_in_tile(const u16* A, const u16* Bt, u16* act, int brow, int tn, unsigned char* smem) {
  const int tid = TIDX(), wid = tid >> 6, lane = tid & 63, wr = wid >> 1, wc = wid & 1, fr = lane & 15, fq = lane >> 4;
  f32x4 acc[MI][4];
  gemm_mainloop<MI>(A, Bt, 1024, brow, tn * 128, acc, smem);
#pragma unroll
  for (int m = 0; m < MI; ++m)
#pragma unroll
    for (int q = 0; q < 2; ++q)
#pragma unroll
      for (int j = 0; j < 4; ++j) {
        int row = brow + wr * MI * 16 + m * 16 + fq * 4 + j;
        int col = tn * 64 + wc * 32 + q * 16 + fr;
        float u1 = acc[m][2 * q][j], u2 = acc[m][2 * q + 1][j];
        act[(size_t)row * DFF + col] = f2bf(siluf_(u1) * u2);
      }
}
__device__ __forceinline__ void phase_ffn_in(const Params& p, int l, int f, unsigned char* smem) {
  const u16* A = (const u16*)(p.ws + OFF_H);
  const u16* Bt = (const u16*)(p.ws + OFF_WFFI) + (size_t)f * 5632 * 1024;
  u16* act = (u16*)(p.ws + OFF_P2);
  constexpr int NT = 44, MT = TLAT / 256;
  for (int it = 0;; ++it) {
    int tm, tn;
    if (!next_tile(it, MT, NT, tm, tn)) break;
    ffn_in_tile<8>(A, Bt, act, tm * 256, tn, smem);
  }
  if (!(l == 1 && f == 1))
    for (int id = BIDX(); id < 8 * NT; id += gridDim.x) ffn_in_tile<4>(A, Bt, act, TLAT + (id & 7) * 128, id >> 3, smem);
}

__device__ __forceinline__ void phase_resid_gemm(const Params& p, int l, const u16* A, const u16* Bt, int K, int gate, float gscale,
                                 const float* lat_in, const float* cx_in, float* lat_out, float* cx_out,
                                 unsigned char* smem) {
  const int tid = TIDX(), wid = tid >> 6, lane = tid & 63, wr = wid >> 1, wc = wid & 1, fr = lane & 15, fq = lane >> 4;
  constexpr int MI = 6, NT = 8, MT = TALL / (MI * 32);
  const float* modp = (const float*)(p.ws + OFF_MOD) + (size_t)l * 5 * NMOD + gate * D;
  for (int it = 0;; ++it) {
    int tm, tn;
    if (!next_tile(it, MT, NT, tm, tn)) break;
    f32x4 acc[MI][4];
    gemm_mainloop<MI>(A, Bt, K, tm * MI * 32, tn * 128, acc, smem);
    {
      const int rowa = tm * MI * 32 + wr * MI * 16 + fq * 4;
      const int mi0 = mod_index(rowa), mi1 = mod_index(rowa + (MI - 1) * 16 + 3);
      float g0[4], g1[4];
#pragma unroll
      for (int n = 0; n < 4; ++n) {
        const int col = tn * 128 + wc * 64 + n * 16 + fr;
        g0[n] = gscale * modp[(size_t)mi0 * NMOD + col];
        g1[n] = gscale * modp[(size_t)mi1 * NMOD + col];
      }
#pragma unroll
      for (int m = 0; m < MI; ++m) {
        float xv[4][4];
#pragma unroll
        for (int j = 0; j < 4; ++j) {
          const float* xi = rrow(lat_in, cx_in, rowa + m * 16 + j);
#pragma unroll
          for (int n = 0; n < 4; ++n) xv[j][n] = xi[tn * 128 + wc * 64 + n * 16 + fr];
        }
#pragma unroll
        for (int j = 0; j < 4; ++j) {
          const int row = rowa + m * 16 + j;
          const bool first = mod_index(row) == mi0;
          float* xo = wrow(lat_out, cx_out, row);
#pragma unroll
          for (int n = 0; n < 4; ++n) xo[tn * 128 + wc * 64 + n * 16 + fr] = xv[j][n] + (first ? g0[n] : g1[n]) * acc[m][n][j];
        }
      }
    }
  }
}

__device__ __forceinline__ void phase_inproj(const Params& p, int l, unsigned char* smem) {
  const u16* A = (const u16*)(p.ws + OFF_H);
  const u16* Bt = (const u16*)(p.ws + OFF_WIN);
  const int tid = TIDX(), wid = tid >> 6, lane = tid & 63, wr = wid >> 1, wc = wid & 1, fr = lane & 15, fq = lane >> 4;
  constexpr int MI = 8, NT = 27, MT = TALL / (MI * 32);
  const float2* ropeseq = (const float2*)(p.ws + OFF_ROPE);
  const float2* roperow = ropeseq + 8192 * 32;
  const float2* ropecol = roperow + 128 * 16;
  u16* QA = (u16*)(p.ws + OFF_QA); u16* QB = (u16*)(p.ws + OFF_QB); u16* QR = (u16*)(p.ws + OFF_QR);
  u16* KA = (u16*)(p.ws + OFF_KA); u16* VA = (u16*)(p.ws + OFF_VA);
  u16* KB = (u16*)(p.ws + OFF_KB); u16* VB = (u16*)(p.ws + OFF_VB);
  u16* KR = (u16*)(p.ws + OFF_KR); u16* VR = (u16*)(p.ws + OFF_VR);
  u16* P2 = (u16*)(p.ws + OFF_P2);
  for (int it = 0;; ++it) {
    int tm, tn;
    if (!next_tile(it, MT, NT, tm, tn)) break;
    f32x4 acc[MI][4];
    gemm_mainloop<MI>(A, Bt, 1024, tm * MI * 32, tn * 128, acc, smem);
    const int r0 = tm * MI * 32 + wr * MI * 16;
    const int c0 = tn * 128 + wc * 64;
    const bool latent = r0 < TLAT;
    if (c0 >= 1792) {
#pragma unroll
      for (int m = 0; m < MI; ++m)
#pragma unroll
        for (int n = 0; n < 4; ++n)
#pragma unroll
          for (int j = 0; j < 4; ++j) {
            int row = r0 + m * 16 + fq * 4 + j;
            P2[(size_t)row * P2C + (c0 - 1792) + n * 16 + fr] = f2bf(acc[m][n][j]);
          }
      continue;
    }
    int kind;
    int ropek;
    int normk;
    float scale = 1.f;
    u16* dst; int hh, nh;
    if (c0 < 256) { kind = 0; ropek = 1; normk = -1; scale = 0.125f * LOG2E; dst = QA; hh = c0 >> 6; nh = 4; }
    else if (c0 < 384) { kind = 1; ropek = 1; normk = -1; dst = KA; hh = (c0 - 256) >> 6; nh = 2; }
    else if (c0 < 512) { kind = 2; ropek = 0; normk = -1; dst = VA; hh = (c0 - 384) >> 6; nh = 2; }
    else if (c0 < 768) { kind = 0; ropek = 1; normk = 0; scale = 0.125f * LOG2E; dst = QB; hh = (c0 - 512) >> 6; nh = 4; }
    else if (c0 < 896) { kind = 1; ropek = 1; normk = 1; dst = KB; hh = (c0 - 768) >> 6; nh = 2; }
    else if (c0 < 1024) { kind = 2; ropek = 0; normk = -1; dst = VB; hh = (c0 - 896) >> 6; nh = 2; }
    else if (c0 < 1280) { kind = 0; ropek = 2; normk = -1; dst = QR; hh = (c0 - 1024) >> 6; nh = 4; }
    else if (c0 < 1536) { kind = 1; ropek = 2; normk = -1; scale = 0.125f; dst = KR; hh = (c0 - 1280) >> 6; nh = 4; }
    else { kind = 2; ropek = 0; normk = -1; dst = VR; hh = (c0 - 1536) >> 6; nh = 4; }
    if (!latent) ropek = 0;
    if (kind == 2) {
#pragma unroll
      for (int m = 0; m < MI; ++m) {
        int b, pos;
        row_bpos(r0 + m * 16 + fq * 4, b, pos);
#pragma unroll
        for (int n = 0; n < 4; ++n) {
          int d = n * 16 + fr;
          bf16x4 o = pack4(acc[m][n][0], acc[m][n][1], acc[m][n][2], acc[m][n][3]);
          *(bf16x4*)(dst + ((size_t)(b * nh + hh) * 64 + d) * STOT + pos) = o;
        }
      }
      continue;
    }
    float gq[4] = {1.f, 1.f, 1.f, 1.f};
    if (normk >= 0) {
#pragma unroll
      for (int n = 0; n < 4; ++n) gq[n] = p.qk_g[((size_t)l * 2 + normk) * 64 + n * 16 + fr];
    }
#pragma unroll
    for (int m = 0; m < MI; ++m)
#pragma unroll
      for (int j = 0; j < 4; ++j) {
        int row = r0 + m * 16 + fq * 4 + j;
        float v0 = acc[m][0][j], v1 = acc[m][1][j], v2 = acc[m][2][j], v3 = acc[m][3][j];
        if (normk >= 0) {
          float ss = v0 * v0 + v1 * v1 + v2 * v2 + v3 * v3;
          ss += __shfl_xor(ss, 1); ss += __shfl_xor(ss, 2); ss += __shfl_xor(ss, 4); ss += __shfl_xor(ss, 8);
          float rstd = rsqrtf(ss * (1.f / 64.f) + RMS_EPS);
          v0 *= rstd * gq[0]; v1 *= rstd * gq[1]; v2 *= rstd * gq[2]; v3 *= rstd * gq[3];
        }
        int b, pos;
        row_bpos(row, b, pos);
        if (ropek == 1) {
          float2 cr = roperow[(pos >> 6) * 16 + fr];
          float2 cc = ropecol[(pos & 63) * 16 + fr];
          float o0 = v0 * cr.x - v1 * cr.y, o1 = v1 * cr.x + v0 * cr.y;
          float o2 = v2 * cc.x - v3 * cc.y, o3 = v3 * cc.x + v2 * cc.y;
          v0 = o0; v1 = o1; v2 = o2; v3 = o3;
        } else if (ropek == 2) {
          float2 ca = ropeseq[pos * 32 + fr];
          float2 cb = ropeseq[pos * 32 + 16 + fr];
          float o0 = v0 * ca.x - v2 * ca.y, o2 = v2 * ca.x + v0 * ca.y;
          float o1 = v1 * cb.x - v3 * cb.y, o3 = v3 * cb.x + v1 * cb.y;
          v0 = o0; v1 = o1; v2 = o2; v3 = o3;
        }
        v0 *= scale; v1 *= scale; v2 *= scale; v3 *= scale;
        u16* dp;
        if (kind == 0) dp = dst + (size_t)row * 256 + hh * 64 + fr;
        else dp = dst + ((size_t)(b * nh + hh) * STOT + pos) * 64 + fr;
        dp[0] = f2bf(v0); dp[16] = f2bf(v1); dp[32] = f2bf(v2); dp[48] = f2bf(v3);
      }
  }
}

__device__ __forceinline__ void attn_item(const u16* __restrict__ Q, const u16* __restrict__ Kb, const u16* __restrict__ Vt,
                          u16* __restrict__ concat, int ccol0, int b, int kvh, int qrow0, int qpos0, int t0, int t1,
                          int c0, int c1, bool masked, const float* sink, unsigned char* smem) {
  const int tid = TIDX(), w = tid >> 6, lane = tid & 63, fr = lane & 15, fq = lane >> 4;
  const int head = kvh * 2 + (w & 1);
  const int qoff = (w >> 1) * 32;
  bf16x8 qf[2][2];
#pragma unroll
  for (int qg = 0; qg < 2; ++qg)
#pragma unroll
    for (int ks = 0; ks < 2; ++ks)
      qf[qg][ks] = *(const bf16x8*)(Q + (size_t)(qrow0 + qoff + qg * 16 + fr) * 256 + head * 64 + ks * 32 + fq * 8);
  f32x4 O[2][4];
  float mrow[2], lrow[2];
#pragma unroll
  for (int qg = 0; qg < 2; ++qg) {
    mrow[qg] = -1e30f; lrow[qg] = 0.f;
#pragma unroll
    for (int dt = 0; dt < 4; ++dt) O[qg][dt] = f32x4{0.f, 0.f, 0.f, 0.f};
  }
  const u16* Kbase = Kb + (size_t)(b * 2 + kvh) * STOT * 64;
  const u16* Vbase = Vt + (size_t)(b * 2 + kvh) * 64 * STOT;
  const int n1 = t1 - t0, total = n1 + (c1 - c0);
  bf16x8 kreg[2], vreg[2];
  auto gload = [&](int i) {
    int tile = i < n1 ? t0 + i : c0 + (i - n1);
#pragma unroll
    for (int ps = 0; ps < 2; ++ps) {
      int idx = tid + ps * 256;
      kreg[ps] = *(const bf16x8*)(Kbase + (size_t)tile * 4096 + idx * 8);
      int d = idx >> 3, ch = idx & 7;
      vreg[ps] = *(const bf16x8*)(Vbase + (size_t)d * STOT + tile * 64 + ch * 8);
    }
  };
  auto lstore = [&](int buf) {
    u16* Ks = (u16*)(smem + buf * 18432);
    u16* Vs = Ks + 64 * 72;
#pragma unroll
    for (int ps = 0; ps < 2; ++ps) {
      int idx = tid + ps * 256;
      int r = idx >> 3, ch = idx & 7;
      *(bf16x8*)(Ks + r * 72 + ch * 8) = kreg[ps];
      *(bf16x8*)(Vs + r * 72 + ch * 8) = vreg[ps];
    }
  };
  __syncthreads();
  gload(0);
  lstore(0);
  __syncthreads();
#pragma unroll 1
  for (int i = 0; i < total; ++i) {
    const int tile = i < n1 ? t0 + i : c0 + (i - n1);
    if (i + 1 < total) gload(i + 1);
    const u16* Ks = (const u16*)(smem + (i & 1) * 18432);
    const u16* Vs = Ks + 64 * 72;
    f32x4 s[2][4];
#pragma unroll
    for (int qg = 0; qg < 2; ++qg)
#pragma unroll
      for (int sub = 0; sub < 4; ++sub) s[qg][sub] = f32x4{0.f, 0.f, 0.f, 0.f};
#pragma unroll
    for (int sub = 0; sub < 4; ++sub)
#pragma unroll
      for (int ks = 0; ks < 2; ++ks) {
        bf16x8 a = *(const bf16x8*)(Ks + (sub * 16 + fr) * 72 + ks * 32 + fq * 8);
#pragma unroll
        for (int qg = 0; qg < 2; ++qg) s[qg][sub] = __builtin_amdgcn_mfma_f32_16x16x32_bf16(a, qf[qg][ks], s[qg][sub], 0, 0, 0);
      }
    __builtin_amdgcn_sched_barrier(0);
    const bool domask = masked && (tile < 128);
    bf16x8 pb[2][2];
#pragma unroll
    for (int qg = 0; qg < 2; ++qg) {
      if (domask) {
        int qpos = qpos0 + qoff + qg * 16 + fr;
#pragma unroll
        for (int sub = 0; sub < 4; ++sub)
#pragma unroll
          for (int j = 0; j < 4; ++j) {
            int kpos = tile * 64 + sub * 16 + fq * 4 + j;
            int dd = kpos - qpos;
            if (dd > 128 || dd < -128) s[qg][sub][j] = -INFINITY;
          }
      }
      float mx = -INFINITY;
#pragma unroll
      for (int sub = 0; sub < 4; ++sub)
#pragma unroll
        for (int j = 0; j < 4; ++j) mx = fmaxf(mx, s[qg][sub][j]);
      mx = fmaxf(mx, __shfl_xor(mx, 16));
      mx = fmaxf(mx, __shfl_xor(mx, 32));
      float mnew = fmaxf(mrow[qg], mx);
      const bool changed = mnew > mrow[qg];
      float alpha = __builtin_amdgcn_exp2f(mrow[qg] - mnew);
      mrow[qg] = mnew;
      float ps = 0.f;
#pragma unroll
      for (int sub = 0; sub < 4; ++sub)
#pragma unroll
        for (int j = 0; j < 4; ++j) {
          float pv = __builtin_amdgcn_exp2f(s[qg][sub][j] - mnew);
          s[qg][sub][j] = pv;
          ps += pv;
        }
      lrow[qg] = lrow[qg] * alpha + ps;
      if (__builtin_amdgcn_ballot_w64(changed) != 0ull) {
#pragma unroll
        for (int dt = 0; dt < 4; ++dt) O[qg][dt] *= alpha;
      }
#pragma unroll
      for (int ks = 0; ks < 2; ++ks)
        pb[qg][ks] = cat8(pack4(s[qg][2 * ks][0], s[qg][2 * ks][1], s[qg][2 * ks][2], s[qg][2 * ks][3]),
                          pack4(s[qg][2 * ks + 1][0], s[qg][2 * ks + 1][1], s[qg][2 * ks + 1][2], s[qg][2 * ks + 1][3]));
      __builtin_amdgcn_sched_barrier(0);
    }
#pragma unroll
    for (int dt = 0; dt < 4; ++dt)
#pragma unroll
      for (int ks = 0; ks < 2; ++ks) {
        const u16* vp = Vs + (dt * 16 + fr) * 72 + ks * 32 + fq * 4;
        bf16x8 va = cat8(*(const bf16x4*)vp, *(const bf16x4*)(vp + 16));
#pragma unroll
        for (int qg = 0; qg < 2; ++qg) O[qg][dt] = __builtin_amdgcn_mfma_f32_16x16x32_bf16(va, pb[qg][ks], O[qg][dt], 0, 0, 0);
      }
    __builtin_amdgcn_sched_barrier(0);
    if (i + 1 < total) lstore((i + 1) & 1);
    __syncthreads();
  }
#pragma unroll
  for (int qg = 0; qg < 2; ++qg) {
    float lt = lrow[qg];
    lt += __shfl_xor(lt, 16);
    lt += __shfl_xor(lt, 32);
    if (sink) lt += __builtin_amdgcn_exp2f(sink[head] * LOG2E - mrow[qg]);
    float inv = 1.f / lt;
    int row = qrow0 + qoff + qg * 16 + fr;
#pragma unroll
    for (int dt = 0; dt < 4; ++dt) {
      bf16x4 o = pack4(O[qg][dt][0] * inv, O[qg][dt][1] * inv, O[qg][dt][2] * inv, O[qg][dt][3] * inv);
      *(bf16x4*)(concat + (size_t)row * D + ccol0 + head * 64 + dt * 16 + fq * 4) = o;
    }
  }
}

__device__ __forceinline__ float ret_lg(int h) {
  return log2f(1.0f - exp2f(-5.0f - (float)h));
}

__device__ __forceinline__ void retU_item(const Params& p, int bh, int c, unsigned char* smem) {
  const int tid = TIDX();
  const int b = bh >> 2, h = bh & 3;
  const u16* KR = (const u16*)(p.ws + OFF_KR) + (size_t)bh * STOT * 64;
  const u16* VR = (const u16*)(p.ws + OFF_VR) + (size_t)bh * 64 * STOT;
  (void)b;
  const int pos0 = c < 64 ? c * 128 : SEQ + (c - 64) * 128;
  u16* Kc = (u16*)smem;
  u16* Vj = Kc + 128 * 64;
  __syncthreads();
#pragma unroll
  for (int ps = 0; ps < 4; ++ps) {
    int idx = tid + ps * 256;
    *(bf16x8*)(Kc + idx * 8) = *(const bf16x8*)(KR + (size_t)pos0 * 64 + idx * 8);
    int d = idx >> 4, ch = idx & 15;
    bf16x8 v = *(const bf16x8*)(VR + (size_t)d * STOT + pos0 + ch * 8);
#pragma unroll
    for (int e = 0; e < 8; ++e) Vj[(ch * 8 + e) * 72 + d] = (u16)v[e];
  }
  __syncthreads();
  const int dk = tid >> 2, dv0 = (tid & 3) * 16;
  const float lg = ret_lg(h);
  float af[16], ab[16];
#pragma unroll
  for (int q = 0; q < 16; ++q) { af[q] = 0.f; ab[q] = 0.f; }
  for (int j = 0; j < 128; ++j) {
    float kf = bf2f(Kc[j * 64 + dk]);
    float kfw = kf * exp2f(lg * (float)(127 - j));
    float kbw = kf * exp2f(lg * (float)j);
    bf16x8 v0 = *(const bf16x8*)(Vj + j * 72 + dv0);
    bf16x8 v1 = *(const bf16x8*)(Vj + j * 72 + dv0 + 8);
#pragma unroll
    for (int q = 0; q < 8; ++q) {
      float a = bf2f((u16)v0[q]), bb = bf2f((u16)v1[q]);
      af[q] += kfw * a; ab[q] += kbw * a;
      af[8 + q] += kfw * bb; ab[8 + q] += kbw * bb;
    }
  }
  float* U = (float*)(p.ws + OFF_U) + ((size_t)bh * 66 + c) * 2 * 4096;
#pragma unroll
  for (int q = 0; q < 16; ++q) {
    U[(dv0 + q) * 64 + dk] = af[q];
    U[4096 + (dv0 + q) * 64 + dk] = ab[q];
  }
}

__device__ __forceinline__ void phase_retU(const Params& p, unsigned char* smem) {
  for (int item = BIDX(); item < 16 * 66; item += gridDim.x) retU_item(p, item / 66, item % 66, smem);
}

__device__ __forceinline__ void attn_worker(const Params& p, int l, unsigned char* smem) {
  const u16* QA = (const u16*)(p.ws + OFF_QA); const u16* QB = (const u16*)(p.ws + OFF_QB);
  const u16* KA = (const u16*)(p.ws + OFF_KA); const u16* VA = (const u16*)(p.ws + OFF_VA);
  const u16* KB = (const u16*)(p.ws + OFF_KB); const u16* VB = (const u16*)(p.ws + OFF_VB);
  u16* concat = (u16*)(p.ws + OFF_H);
  const float* sink = p.attn_sink + l * 4;
  int* qctr = (int*)(p.ws + OFF_QCTR) + l;
  volatile int* slot = (volatile int*)(smem + 65536 - 32);
  for (;;) {
    __syncthreads();
    if (TIDX() == 0) *slot = atomicAdd(qctr, 1);
    __syncthreads();
    const int item = *slot;
    if (item >= (l == 1 ? 2048 : 2112)) break;
    const bool isB = item < 1024 || (item >= 2048 && item < 2080);
    const bool isctx = item >= 2048;
    int ii = item < 1024 ? item : item < 2048 ? item - 1024 : item < 2080 ? item - 2048 : item - 2080;
    int qt, kvh, b, qrow0, qpos0, t0, t1;
    if (!isctx) {
      qt = ii & 127; kvh = (ii >> 7) & 1; b = ii >> 8;
      qrow0 = b * SEQ + qt * 64; qpos0 = qt * 64;
      if (isB) { t0 = 0; t1 = 128; }
      else { t0 = qt - 2 < 0 ? 0 : qt - 2; t1 = qt + 3 > 128 ? 128 : qt + 3; }
    } else {
      qt = ii & 3; kvh = (ii >> 2) & 1; b = ii >> 3;
      qrow0 = TLAT + b * CTXL + qt * 64; qpos0 = 0; t0 = 0; t1 = 0;
    }
    attn_item(isB ? QB : QA, isB ? KB : KA, isB ? VB : VA, concat, isB ? 256 : 0, b, kvh, qrow0, qpos0, t0, t1, 128, 132,
              (!isB) && (!isctx), isB ? nullptr : sink, smem);
  }
}

__device__ __forceinline__ void phase_retscan(const Params& p) {
  const float* U = (const float*)(p.ws + OFF_U);
  u16* SP = (u16*)(p.ws + OFF_SP);
  for (int gid = BIDX() * 256 + TIDX(); gid < 16 * 2 * 4096; gid += gridDim.x * 256) {
    int e = gid & 4095, dir = (gid >> 12) & 1, bh = gid >> 13;
    float g128 = exp2f(128.f * ret_lg(bh & 3));
    float S = 0.f;
#pragma unroll 1
    for (int n0 = 0; n0 < 66; n0 += 11) {
      float u[11];
      size_t offs[11];
#pragma unroll
      for (int k = 0; k < 11; ++k) {
        int n = n0 + k;
        int c = dir == 0 ? (n < 2 ? 64 + n : n - 2) : 65 - n;
        offs[k] = (((size_t)bh * 66 + c) * 2 + dir) * 4096 + e;
        u[k] = U[offs[k]];
      }
#pragma unroll
      for (int k = 0; k < 11; ++k) {
        SP[offs[k]] = f2bf(S);
        S = g128 * S + u[k];
      }
    }
  }
}

__device__ __forceinline__ void retout_item(const Params& p, int l, int bh, int c, unsigned char* smem) {
  const int tid = TIDX(), w = tid >> 6, lane = tid & 63, fr = lane & 15, fq = lane >> 4;
  const int b = bh >> 2, h = bh & 3;
  const u16* QR = (const u16*)(p.ws + OFF_QR);
  const u16* KR = (const u16*)(p.ws + OFF_KR) + (size_t)bh * STOT * 64;
  const u16* VR = (const u16*)(p.ws + OFF_VR) + (size_t)bh * 64 * STOT;
  const u16* SP = (const u16*)(p.ws + OFF_SP) + ((size_t)bh * 66 + c) * 2 * 4096;
  const u16* P2 = (const u16*)(p.ws + OFF_P2);
  u16* concat = (u16*)(p.ws + OFF_H);
  const int pos0 = c < 64 ? c * 128 : SEQ + (c - 64) * 128;
  const int row0 = bpos_row(b, pos0);
  u16* Kc = (u16*)smem;
  u16* Vs = Kc + 128 * 72;
  __syncthreads();
#pragma unroll
  for (int ps = 0; ps < 4; ++ps) {
    int idx = tid + ps * 256;
    int r = idx >> 3, ch = idx & 7;
    *(bf16x8*)(Kc + r * 72 + ch * 8) = *(const bf16x8*)(KR + (size_t)(pos0 + r) * 64 + ch * 8);
    int d = idx >> 4, c16 = idx & 15;
    *(bf16x8*)(Vs + d * 136 + c16 * 8) = *(const bf16x8*)(VR + (size_t)d * STOT + pos0 + c16 * 8);
  }
  __syncthreads();
  const float lg = ret_lg(h);
#pragma unroll 1
  for (int qg = 0; qg < 2; ++qg) {
    const int i = w * 32 + qg * 16 + fr;
    const int row = row0 + i;
    bf16x8 qf[2];
#pragma unroll
    for (int ks = 0; ks < 2; ++ks) qf[ks] = *(const bf16x8*)(QR + (size_t)row * 256 + h * 64 + ks * 32 + fq * 8);
    f32x4 s[8];
#pragma unroll
    for (int sub = 0; sub < 8; ++sub) {
      s[sub] = f32x4{0.f, 0.f, 0.f, 0.f};
#pragma unroll
      for (int ks = 0; ks < 2; ++ks) {
        bf16x8 a = *(const bf16x8*)(Kc + (sub * 16 + fr) * 72 + ks * 32 + fq * 8);
        s[sub] = __builtin_amdgcn_mfma_f32_16x16x32_bf16(a, qf[ks], s[sub], 0, 0, 0);
      }
    }
    float res[4][4];
#pragma unroll
    for (int dt = 0; dt < 4; ++dt)
#pragma unroll
      for (int j = 0; j < 4; ++j) res[dt][j] = 0.f;
#pragma unroll 1
    for (int dir = 0; dir < 2; ++dir) {
      f32x4 O[4];
      const float qw = dir == 0 ? __builtin_amdgcn_exp2f(lg * (float)(i + 1)) : __builtin_amdgcn_exp2f(lg * (float)(128 - i));
#pragma unroll
      for (int dt = 0; dt < 4; ++dt) {
        O[dt] = f32x4{0.f, 0.f, 0.f, 0.f};
#pragma unroll
        for (int ks = 0; ks < 2; ++ks) {
          bf16x8 a = *(const bf16x8*)(SP + dir * 4096 + (dt * 16 + fr) * 64 + ks * 32 + fq * 8);
          O[dt] = __builtin_amdgcn_mfma_f32_16x16x32_bf16(a, qf[ks], O[dt], 0, 0, 0);
        }
        O[dt] *= qw;
      }
      int fqo = fq;
      asm volatile("" : "+v"(fqo));
#pragma unroll
      for (int ks = 0; ks < 4; ++ks) {
        float pv[8];
#pragma unroll
        for (int e = 0; e < 8; ++e) {
          const int sub = 2 * ks + (e >> 2), j = e & 3;
          const int jk = sub * 16 + fqo * 4 + j;
          const int dd = dir == 0 ? i - jk : jk - i;
          pv[e] = dd >= 0 ? s[sub][j] * __builtin_amdgcn_exp2f(lg * (float)dd) : 0.f;
        }
        bf16x8 pb = cat8(pack4(pv[0], pv[1], pv[2], pv[3]), pack4(pv[4], pv[5], pv[6], pv[7]));
#pragma unroll
        for (int dt = 0; dt < 4; ++dt) {
          const u16* vp = Vs + (dt * 16 + fr) * 136 + ks * 32 + fq * 4;
          bf16x8 va = cat8(*(const bf16x4*)vp, *(const bf16x4*)(vp + 16));
          O[dt] = __builtin_amdgcn_mfma_f32_16x16x32_bf16(va, pb, O[dt], 0, 0, 0);
        }
      }
      float sm = 0.f;
#pragma unroll
      for (int dt = 0; dt < 4; ++dt)
#pragma unroll
        for (int j = 0; j < 4; ++j) sm += O[dt][j];
      sm += __shfl_xor(sm, 16); sm += __shfl_xor(sm, 32);
      const float mu = sm * (1.f / 64.f);
      float vs = 0.f;
#pragma unroll
      for (int dt = 0; dt < 4; ++dt)
#pragma unroll
        for (int j = 0; j < 4; ++j) { float dlt = O[dt][j] - mu; vs += dlt * dlt; }
      vs += __shfl_xor(vs, 16); vs += __shfl_xor(vs, 32);
      const float rstd = rsqrtf(vs * (1.f / 64.f) + GN_EPS);
#pragma unroll
      for (int dt = 0; dt < 4; ++dt) {
        const int d = dt * 16 + fq * 4;
        bf16x4 gt = *(const bf16x4*)(P2 + (size_t)row * P2C + dir * 256 + h * 64 + d);
        float4 rg = *(const float4*)(p.ret_g + (size_t)l * 256 + h * 64 + d);
        res[dt][0] += (O[dt][0] - mu) * rstd * rg.x * siluf_(bf2f((u16)gt[0]));
        res[dt][1] += (O[dt][1] - mu) * rstd * rg.y * siluf_(bf2f((u16)gt[1]));
        res[dt][2] += (O[dt][2] - mu) * rstd * rg.z * siluf_(bf2f((u16)gt[2]));
        res[dt][3] += (O[dt][3] - mu) * rstd * rg.w * siluf_(bf2f((u16)gt[3]));
      }
    }
#pragma unroll
    for (int dt = 0; dt < 4; ++dt)
      *(bf16x4*)(concat + (size_t)row * D + 512 + h * 64 + dt * 16 + fq * 4) = pack4(res[dt][0], res[dt][1], res[dt][2], res[dt][3]);
  }
}

__device__ __forceinline__ void phase_retout(const Params& p, int l, unsigned char* smem) {
  for (int item = BIDX(); item < 16 * 66; item += gridDim.x) {
    if (l == 1 && (item % 66) >= 64) continue;
    retout_item(p, l, item / 66, item % 66, smem);
  }
}

__device__ __forceinline__ void phase_wprep(const Params& p, int l, unsigned char* smem) {
  const int tid = TIDX(), col = tid;
  const u16* P2 = (const u16*)(p.ws + OFF_P2);
  u16* prep = (u16*)(p.ws + OFF_PREP);
  float* twT = (float*)smem;
  float* amT = twT + 64 * 16;
  float* outW = amT + 64 * 16;
  float* outA = outW + 16 * 256;
  const int j = tid & 31, tsub = tid >> 5, head = j >> 3, c8 = (j & 7) * 8, ch0 = head * 64 + c8;
  float kkv[8], kav[8];
#pragma unroll
  for (int e = 0; e < 8; ++e) { kkv[e] = p.k_k[(size_t)l * 256 + ch0 + e]; kav[e] = p.k_a[(size_t)l * 256 + ch0 + e]; }
  for (int item = BIDX(); item < (TALL / 16) * 2; item += gridDim.x) {
    const int dir = item & 1, row0 = (item >> 1) * 16;
    const float* mu = p.mu + ((size_t)l * 2 + dir) * 896;
    __syncthreads();
    {
      const int tok = tid >> 4, e0 = (tid & 15) * 4;
      const int row = row0 + tok;
      int b, pos;
      row_bpos(row, b, pos);
      bool has;
      int nrow;
      if (dir == 0) { has = (pos != 0) && (pos != SEQ); nrow = row - 1; }
      else { has = (pos != SEQ - 1) && (pos != STOT - 1); nrow = row + 1; }
      const int srow = has ? nrow : row;
      bf16x4 zw = *(const bf16x4*)(P2 + (size_t)row * P2C + 1408 + dir * 64 + e0);
      bf16x4 za = *(const bf16x4*)(P2 + (size_t)row * P2C + 1536 + dir * 64 + e0);
      bf16x4 sw = *(const bf16x4*)(P2 + (size_t)srow * P2C + 1408 + dir * 64 + e0);
      bf16x4 sa = *(const bf16x4*)(P2 + (size_t)srow * P2C + 1536 + dir * 64 + e0);
#pragma unroll
      for (int e = 0; e < 4; ++e) {
        float z = bf2f((u16)zw[e]), zs = has ? bf2f((u16)sw[e]) : 0.f;
        twT[(e0 + e) * 16 + tok] = tanhf_(z + mu[768 + e0 + e] * (zs - z));
        float z2 = bf2f((u16)za[e]), zs2 = has ? bf2f((u16)sa[e]) : 0.f;
        amT[(e0 + e) * 16 + tok] = z2 + mu[832 + e0 + e] * (zs2 - z2);
      }
    }
    __syncthreads();
    {
      const float* w2 = p.w2 + ((size_t)l * 2 + dir) * 64 * 256 + col;
      const float* a2 = p.a2 + ((size_t)l * 2 + dir) * 64 * 256 + col;
      const float w0v = p.w0[((size_t)l * 2 + dir) * 256 + col], a0v = p.a0[((size_t)l * 2 + dir) * 256 + col];
#pragma unroll 1
      for (int pass = 0; pass < 2; ++pass) {
        const float* wcol = pass == 0 ? w2 : a2;
        const float* xT = pass == 0 ? twT : amT;
        float acc[16];
#pragma unroll
        for (int t = 0; t < 16; ++t) acc[t] = 0.f;
#pragma unroll 1
        for (int k0 = 0; k0 < 64; k0 += 16) {
          float wv[16];
#pragma unroll
          for (int u = 0; u < 16; ++u) wv[u] = wcol[(k0 + u) * 256];
#pragma unroll
          for (int u = 0; u < 16; ++u) {
            const int kq = k0 + u;
#pragma unroll
            for (int t4 = 0; t4 < 4; ++t4) {
              float4 a = *(const float4*)(xT + kq * 16 + t4 * 4);
              acc[t4 * 4 + 0] += a.x * wv[u]; acc[t4 * 4 + 1] += a.y * wv[u]; acc[t4 * 4 + 2] += a.z * wv[u]; acc[t4 * 4 + 3] += a.w * wv[u];
            }
          }
        }
        if (pass == 0) {
#pragma unroll
          for (int t = 0; t < 16; ++t) outW[t * 256 + col] = -0.6065306597126334f * sigmoidf_(w0v + acc[t]) * LOG2E;
        } else {
#pragma unroll
          for (int t = 0; t < 16; ++t) outA[t * 256 + col] = sigmoidf_(a0v + acc[t]);
        }
      }
    }
    __syncthreads();
    {
      float mur[8], muk[8], muv[8];
#pragma unroll
      for (int e = 0; e < 8; ++e) { mur[e] = mu[ch0 + e]; muk[e] = mu[256 + ch0 + e]; muv[e] = mu[512 + ch0 + e]; }
#pragma unroll
      for (int pass = 0; pass < 2; ++pass) {
        const int tok = pass * 8 + tsub, row = row0 + tok;
        int b, pos;
        row_bpos(row, b, pos);
        bool has;
        int nrow;
        if (dir == 0) { has = (pos != 0) && (pos != SEQ); nrow = row - 1; }
        else { has = (pos != SEQ - 1) && (pos != STOT - 1); nrow = row + 1; }
        const u16* cp = P2 + (size_t)row * P2C + 512 + ch0;
        const u16* np = P2 + (size_t)(has ? nrow : row) * P2C + 512 + ch0;
        const bf16x8 zr8 = *(const bf16x8*)cp, zk8 = *(const bf16x8*)(cp + 256), zv8 = *(const bf16x8*)(cp + 512);
        const bf16x8 sr8 = *(const bf16x8*)np, sk8 = *(const bf16x8*)(np + 256), sv8 = *(const bf16x8*)(np + 512);
        const float4 lw0 = *(const float4*)(outW + tok * 256 + ch0), lw1 = *(const float4*)(outW + tok * 256 + ch0 + 4);
        const float4 av0 = *(const float4*)(outA + tok * 256 + ch0), av1 = *(const float4*)(outA + tok * 256 + ch0 + 4);
        const float lw[8] = {lw0.x, lw0.y, lw0.z, lw0.w, lw1.x, lw1.y, lw1.z, lw1.w};
        const float av[8] = {av0.x, av0.y, av0.z, av0.w, av1.x, av1.y, av1.z, av1.w};
        float r[8], k[8], v[8], kkr[8], ss = 0.f;
#pragma unroll
        for (int e = 0; e < 8; ++e) {
          float zr = bf2f((u16)zr8[e]), zk = bf2f((u16)zk8[e]), zv = bf2f((u16)zv8[e]);
          float sr = has ? bf2f((u16)sr8[e]) : 0.f, sk = has ? bf2f((u16)sk8[e]) : 0.f, sv = has ? bf2f((u16)sv8[e]) : 0.f;
          r[e] = zr + mur[e] * (sr - zr); k[e] = zk + muk[e] * (sk - zk); v[e] = zv + muv[e] * (sv - zv);
          kkr[e] = k[e] * kkv[e];
          ss += kkr[e] * kkr[e];
        }
        ss = half8_sum(ss);
        const float rs = rsqrtf(fmaxf(ss, 1e-24f));
        float kt[8], kk[8], bb[8];
#pragma unroll
        for (int e = 0; e < 8; ++e) {
          kk[e] = kkr[e] * rs;
          kt[e] = k[e] * (1.f + (av[e] - 1.f) * kav[e]);
          bb[e] = kk[e] * av[e];
        }
        u16* dp = prep + (((size_t)(b * 4 + head) * 2 + dir) * STOT + pos) * 384 + c8;
        *(bf16x8*)(dp) = cat8(pack4(lw[0], lw[1], lw[2], lw[3]), pack4(lw[4], lw[5], lw[6], lw[7]));
        *(bf16x8*)(dp + 64) = cat8(pack4(kt[0], kt[1], kt[2], kt[3]), pack4(kt[4], kt[5], kt[6], kt[7]));
        *(bf16x8*)(dp + 128) = cat8(pack4(kk[0], kk[1], kk[2], kk[3]), pack4(kk[4], kk[5], kk[6], kk[7]));
        *(bf16x8*)(dp + 192) = cat8(pack4(bb[0], bb[1], bb[2], bb[3]), pack4(bb[4], bb[5], bb[6], bb[7]));
        *(bf16x8*)(dp + 256) = cat8(pack4(r[0], r[1], r[2], r[3]), pack4(r[4], r[5], r[6], r[7]));
        *(bf16x8*)(dp + 320) = cat8(pack4(v[0], v[1], v[2], v[3]), pack4(v[4], v[5], v[6], v[7]));
      }
    }
  }
}

typedef float f32x2 __attribute__((ext_vector_type(2)));
__device__ __forceinline__ void wscan_item(const Params& p, int item, unsigned char* smem) {
  const int tid = TIDX(), w = tid >> 6, lane = tid & 63;
  const int jl4 = (lane & 15) * 4, rsub = lane >> 4;
  const u16* prep = (const u16*)(p.ws + OFF_PREP);
  u16* P2w = (u16*)(p.ws + OFF_P2);
  float* bufs = (float*)smem;
  {
    const int rq = item & 3, seq = item >> 2;
    const int dir = seq & 1, h = (seq >> 1) & 3, b = seq >> 3;
    const int irow = rq * 16 + w * 4 + rsub;
    const u16* base = prep + (size_t)seq * STOT * 384;
    uint4 lreg[3];
    auto gload = [&](int ch) {
#pragma unroll
      for (int ps = 0; ps < 3; ++ps) {
        int q = tid + ps * 256;
        int sidx = q / 48, within = q % 48;
        int n = ch * 16 + sidx;
        int pos = dir == 0 ? (n < CTXL ? SEQ + n : n - CTXL) : (STOT - 1 - n);
        lreg[ps] = *(const uint4*)(base + (size_t)pos * 384 + within * 8);
      }
    };
    auto lstore = [&](int buf) {
#pragma unroll
      for (int ps = 0; ps < 3; ++ps) {
        int q = tid + ps * 256;
        int sidx = q / 48, within = q % 48;
        float* dp = bufs + buf * 6144 + sidx * 384 + within * 8;
        uint4 u = lreg[ps];
        float4 lo = make_float4(__uint_as_float(u.x << 16), __uint_as_float(u.x & 0xffff0000u), __uint_as_float(u.y << 16), __uint_as_float(u.y & 0xffff0000u));
        float4 hi = make_float4(__uint_as_float(u.z << 16), __uint_as_float(u.z & 0xffff0000u), __uint_as_float(u.w << 16), __uint_as_float(u.w & 0xffff0000u));
        if (within < 8) {
          lo.x = __builtin_amdgcn_exp2f(lo.x); lo.y = __builtin_amdgcn_exp2f(lo.y); lo.z = __builtin_amdgcn_exp2f(lo.z); lo.w = __builtin_amdgcn_exp2f(lo.w);
          hi.x = __builtin_amdgcn_exp2f(hi.x); hi.y = __builtin_amdgcn_exp2f(hi.y); hi.z = __builtin_amdgcn_exp2f(hi.z); hi.w = __builtin_amdgcn_exp2f(hi.w);
        }
        *(float4*)dp = lo;
        *(float4*)(dp + 4) = hi;
      }
    };
    f32x2 S01 = {0.f, 0.f}, S23 = {0.f, 0.f};
    __syncthreads();
    gload(0);
    lstore(0);
    __syncthreads();
    constexpr int NCH = STOT / 16;
    for (int ch = 0; ch < NCH; ++ch) {
      if (ch + 1 < NCH) gload(ch + 1);
      const float* bp = bufs + (ch & 1) * 6144;
      const int n0 = ch * 16;
      const int pos0 = dir == 0 ? (n0 < CTXL ? SEQ + n0 : n0 - CTXL) : (STOT - 1 - n0);
      u16* yp = P2w + (size_t)bpos_row(b, pos0) * P2C + (dir == 0 ? YCOL0 : YCOL1) + h * 64 + irow;
      const int ystride = dir == 0 ? P2C : -P2C;
      float4 Wq[3], Kq[3], Nq[3], Bq[3], Rq[3];
      float Vq[3];
#define SCAN_LD(slot, st)                                        \
      do {                                                         \
        const float* sp_ = bp + (st) * 384;                        \
        Wq[slot] = *(const float4*)(sp_ + jl4);                    \
        Kq[slot] = *(const float4*)(sp_ + 64 + jl4);               \
        Nq[slot] = *(const float4*)(sp_ + 128 + jl4);              \
        Bq[slot] = *(const float4*)(sp_ + 192 + jl4);              \
        Rq[slot] = *(const float4*)(sp_ + 256 + jl4);              \
        Vq[slot] = sp_[320 + irow];                                \
      } while (0)
      SCAN_LD(0, 0);
      SCAN_LD(1, 1);
      SCAN_LD(2, 2);
      float ypart = 0.f;
#pragma unroll
      for (int s = 0; s < 16; ++s) {
        const int sl = s % 3;
        const float4 wv = Wq[sl], kt = Kq[sl], kk = Nq[sl], bb = Bq[sl], rr = Rq[sl];
        const float v = Vq[sl];
        if (s + 3 < 16) SCAN_LD(sl, s + 3);
        const f32x2 vv = {v, v};
        f32x2 A01 = S01 * f32x2{wv.x, wv.y} + vv * f32x2{kt.x, kt.y};
        f32x2 A23 = S23 * f32x2{wv.z, wv.w} + vv * f32x2{kt.z, kt.w};
        f32x2 pp = S01 * f32x2{kk.x, kk.y} + S23 * f32x2{kk.z, kk.w};
        float sa = pp.x + pp.y;
        float yprev = ypart;
        row16_sum2(sa, yprev);
        if (s > 0) { if ((lane & 15) == 0) yp[(s - 1) * ystride] = f2bf(yprev); }
        const f32x2 nsa = {-sa, -sa};
        S01 = nsa * f32x2{bb.x, bb.y} + A01;
        S23 = nsa * f32x2{bb.z, bb.w} + A23;
        f32x2 yy = S01 * f32x2{rr.x, rr.y} + S23 * f32x2{rr.z, rr.w};
        ypart = yy.x + yy.y;
      }
      {
        float ylast = row16_sum(ypart);
        if ((lane & 15) == 0) yp[15 * ystride] = f2bf(ylast);
      }
#undef SCAN_LD
      if (ch + 1 < NCH) lstore((ch + 1) & 1);
      __syncthreads();
    }
  }
}

__device__ __forceinline__ void phase_scan_attn(const Params& p, int l, unsigned char* smem) {
  const int G = gridDim.x, tid = TIDX(), bid = BIDX();
  if (G > 128 && G <= 2048) {
    int* keys = (int*)smem;
    int* red = keys + 2048;
    const int* cutab = (const int*)(p.ws + OFF_CUTAB);
    __syncthreads();
    for (int i = tid; i < G; i += 256) keys[i] = cutab[i];
    if (tid == 0) { red[0] = 0; red[1] = 0; }
    __syncthreads();
    for (int i = 128 + tid; i < G; i += 256) {
      const int ki = keys[i];
      bool m = false;
      for (int j = 0; j < 128; ++j) m = m || (keys[j] == ki);
      if (!m) atomicAdd(&red[0], 1);
      if (m && i == bid) red[1] = 1;
    }
    __syncthreads();
    const int eligible = red[0], mine = red[1];
    __syncthreads();
    if (bid < 128) {
      __builtin_amdgcn_s_setprio(3);
      wscan_item(p, bid, smem);
      __builtin_amdgcn_s_setprio(0);
    } else if (eligible < 64 || !mine) {
      attn_worker(p, l, smem);
    }
  } else {
    for (int item = bid; item < 128; item += G) wscan_item(p, item, smem);
    attn_worker(p, l, smem);
  }
}

__device__ __forceinline__ void phase_wfin(const Params& p, int l, unsigned char* smem) {
  const int tid = TIDX(), col = tid;
  const u16* P2 = (const u16*)(p.ws + OFF_P2);
  const u16* prep = (const u16*)(p.ws + OFF_PREP);
  u16* concat = (u16*)(p.ws + OFF_H);
  float* sgT = (float*)smem;
  float* gateL = sgT + 128 * 16;
  const float* g2 = p.g2 + (size_t)l * 128 * 256 + col;
  const int j = tid & 31, tsub = tid >> 5, head = j >> 3, c8 = (j & 7) * 8, ch0 = head * 64 + c8;
  float lng[8], lnb[8], rho[2][8];
#pragma unroll
  for (int e = 0; e < 8; ++e) {
    lng[e] = p.ln_g[(size_t)l * 256 + ch0 + e];
    lnb[e] = p.ln_b[(size_t)l * 256 + ch0 + e];
    rho[0][e] = p.rho[((size_t)l * 2 + 0) * 256 + ch0 + e];
    rho[1][e] = p.rho[((size_t)l * 2 + 1) * 256 + ch0 + e];
  }
  const int nitems = (l == 1 ? TLAT : TALL) / 16;
  for (int item = BIDX(); item < nitems; item += gridDim.x) {
    const int row0 = item * 16;
    __syncthreads();
    {
      const int tok = tid >> 4, k0 = (tid & 15) * 8;
      bf16x8 g = *(const bf16x8*)(P2 + (size_t)(row0 + tok) * P2C + 1280 + k0);
#pragma unroll
      for (int e = 0; e < 8; ++e) sgT[(k0 + e) * 16 + tok] = sigmoidf_(bf2f((u16)g[e]));
    }
    __syncthreads();
    float acc[16];
#pragma unroll
    for (int t = 0; t < 16; ++t) acc[t] = 0.f;
#pragma unroll 1
    for (int k0 = 0; k0 < 128; k0 += 16) {
      float gv8[16];
#pragma unroll
      for (int u = 0; u < 16; ++u) gv8[u] = g2[(k0 + u) * 256];
#pragma unroll
      for (int u = 0; u < 16; ++u) {
        const int k = k0 + u;
        const float gv = gv8[u];
#pragma unroll
        for (int t4 = 0; t4 < 4; ++t4) {
          float4 a = *(const float4*)(sgT + k * 16 + t4 * 4);
          acc[t4 * 4 + 0] += a.x * gv; acc[t4 * 4 + 1] += a.y * gv; acc[t4 * 4 + 2] += a.z * gv; acc[t4 * 4 + 3] += a.w * gv;
        }
      }
    }
#pragma unroll
    for (int t = 0; t < 16; ++t) gateL[t * 256 + col] = acc[t];
    __syncthreads();
#pragma unroll
    for (int pass = 0; pass < 2; ++pass) {
      const int tok = pass * 8 + tsub, row = row0 + tok;
      int b, pos;
      row_bpos(row, b, pos);
      float tot[8];
#pragma unroll
      for (int e = 0; e < 8; ++e) tot[e] = 0.f;
#pragma unroll
      for (int dir = 0; dir < 2; ++dir) {
        const bf16x8 y8 = *(const bf16x8*)(P2 + (size_t)row * P2C + (dir == 0 ? YCOL0 : YCOL1) + ch0);
        const u16* pp = prep + (((size_t)(b * 4 + head) * 2 + dir) * STOT + pos) * 384 + c8;
        const bf16x8 kt8 = *(const bf16x8*)(pp + 64), r8 = *(const bf16x8*)(pp + 256), v8 = *(const bf16x8*)(pp + 320);
        float y[8], s1 = 0.f, s3 = 0.f;
#pragma unroll
        for (int e = 0; e < 8; ++e) {
          y[e] = bf2f((u16)y8[e]);
          s1 += y[e];
          s3 += bf2f((u16)r8[e]) * bf2f((u16)kt8[e]) * rho[dir][e];
        }
        s1 = half8_sum(s1);
        s3 = half8_sum(s3);
        const float mu = s1 * (1.f / 64.f);
        float s2 = 0.f;
#pragma unroll
        for (int e = 0; e < 8; ++e) { y[e] -= mu; s2 += y[e] * y[e]; }
        s2 = half8_sum(s2);
        const float rstd = rsqrtf(s2 * (1.f / 64.f) + GN_EPS);
#pragma unroll
        for (int e = 0; e < 8; ++e) tot[e] += y[e] * rstd * lng[e] + lnb[e] + s3 * bf2f((u16)v8[e]);
      }
      const float4 g0 = *(const float4*)(gateL + tok * 256 + ch0), g1 = *(const float4*)(gateL + tok * 256 + ch0 + 4);
      bf16x8 o = cat8(pack4(tot[0] * g0.x, tot[1] * g0.y, tot[2] * g0.z, tot[3] * g0.w),
                      pack4(tot[4] * g1.x, tot[5] * g1.y, tot[6] * g1.z, tot[7] * g1.w));
      *(bf16x8*)(concat + (size_t)row * D + 768 + ch0) = o;
    }
  }
}

constexpr int N_PHASES = 1 + 2 * 16 + 1;
__device__ __forceinline__ void run_phase(const Params& p_in, int ph, unsigned char* smem) {
  Params p = p_in;
  {
    unsigned long long w = (unsigned long long)p.ws;
    asm volatile("" : "+s"(w));
    p.ws = (unsigned char*)w;
  }
  if (ph == 0) { phase_init(p, smem); return; }
  if (ph == N_PHASES - 1) { phase_final_norm(p); return; }
  const int l = (ph - 1) / 16, s = (ph - 1) % 16;
  float* xc = (float*)(p.ws + OFF_XC);
  const float* lat_in = (l == 0 && s < 3) ? p.x : p.out;
  const float* cx_in = (l == 0 && s < 3) ? p.ctx : xc;
  const u16* H = (const u16*)(p.ws + OFF_H);
  const u16* ACT = (const u16*)(p.ws + OFF_P2);
  switch (s) {
    case 0: phase_norm(p, l, 0, lat_in, cx_in); break;
    case 1: phase_ffn_in(p, l, 0, smem); break;
    case 2: phase_resid_gemm(p, l, ACT, (const u16*)(p.ws + OFF_WFFO) + (size_t)0 * 1024 * DFF, DFF, 2, 0.5f, lat_in, cx_in, p.out, xc, smem); break;
    case 3: phase_norm(p, l, 1, p.out, xc); break;
    case 4: phase_inproj(p, l, smem); break;
    case 5: phase_retU(p, smem); break;
    case 6: phase_retscan(p); break;
    case 7: phase_retout(p, l, smem); break;
    case 8: phase_wprep(p, l, smem); break;
    case 9: phase_scan_attn(p, l, smem); break;
    case 10: phase_wfin(p, l, smem); break;
    case 11: phase_resid_gemm(p, l, H, (const u16*)(p.ws + OFF_WOUT), 1024, 5, 1.0f, p.out, xc, p.out, xc, smem); break;
    case 12: phase_norm(p, l, 2, p.out, xc); break;
    case 13: phase_ffn_in(p, l, 1, smem); break;
    case 14: phase_resid_gemm(p, l, ACT, (const u16*)(p.ws + OFF_WFFO) + (size_t)1 * 1024 * DFF, DFF, 8, 0.5f, p.out, xc, p.out, xc, smem); break;
    default: if (l == 0) convert_weights(p, 1, smem); break;
  }
}

#if MULTI_LAUNCH
__global__ void __launch_bounds__(256, 2) k_phase(Params p, int ph) {
  __shared__ __attribute__((aligned(16))) unsigned char smem[49152];
  run_phase(p, ph, smem);
}
#else
constexpr int SMEM_BYTES = 65536;
__global__ void __launch_bounds__(256, 2) k_mega(Params p) {
  __shared__ __attribute__((aligned(16))) unsigned char smem[SMEM_BYTES];
  cg::grid_group grid = cg::this_grid();
  volatile LAS unsigned* st = (volatile LAS unsigned*)(smem + SMEM_BYTES - 16);
  if (threadIdx.x == 0) { st[0] = 0u; st[1] = 0u; }
  __syncthreads();
  {
    unsigned* bw = (unsigned*)(p.ws + OFF_BAR);
    for (int i = blockIdx.x * 256 + threadIdx.x; i < XCD_BAR_WORDS; i += gridDim.x * 256) bw[i] = 0u;
  }
  grid.sync();
  XcdBarrier xb = xcd_barrier_post((unsigned*)(p.ws + OFF_BAR), st);
  run_phase(p, 0, smem);
  xcd_barrier(xb);
#pragma unroll 1
  for (int l = 0; l < 2; ++l) {
#pragma unroll 1
    for (int s = 0; s < 16 - l; ++s) {
      run_phase(p, 1 + l * 16 + s, smem);
      xcd_barrier(xb);
#ifdef PROBE_REPEAT
      if ((PROBE_REPEAT >> s) & 1) {
        run_phase(p, 1 + l * 16 + s, smem);
        xcd_barrier(xb);
      }
#endif
    }
  }
  run_phase(p, N_PHASES - 1, smem);
}
#endif

extern "C" void kernel_launch(void* const* d_in, const int* in_sizes, int n_in, void* d_out, int out_size, void* d_ws,
                              size_t ws_size, hipStream_t stream) {
  Params p{};
  const float** pp = (const float**)&p;
  for (int i = 0; i < 26; ++i) pp[i] = (const float*)d_in[i];
  p.out = (float*)d_out;
  p.ws = (unsigned char*)d_ws;
#if MULTI_LAUNCH
  for (int ph = 0; ph < N_PHASES; ++ph) {
    if (ph > 0 && ((ph - 1) % 16) == 15 && ph != N_PHASES - 1) continue;
    k_phase<<<dim3(512), dim3(256), 0, stream>>>(p, ph);
  }
#else
  static int grid_blocks = 0;
  if (!grid_blocks) {
    int dev = 0, cus = 0, per_cu = 0;
    hipGetDevice(&dev);
    hipDeviceGetAttribute(&cus, hipDeviceAttributeMultiprocessorCount, dev);
    hipOccupancyMaxActiveBlocksPerMultiprocessor(&per_cu, k_mega, 256, 0);
    if (per_cu > 2) per_cu = 2;
    grid_blocks = cus * per_cu;
  }
  void* args[] = {&p};
  hipError_t e = hipLaunchCooperativeKernel((void*)k_mega, dim3(grid_blocks), dim3(256), args, 0, stream);
  if (e != hipSuccess) fprintf(stderr, "cooperative launch failed: %s (grid %d)\n", hipGetErrorString(e), grid_blocks);
#endif
}
```
